# Optimizing an MI355X kernel written in HIP

```python
import jax, jax.numpy as jnp
from jax import lax
import numpy as np

D_MODEL = 1024
BATCH = 8
SEQ = 2048
DEPTH = 4

ATTN_Q_HEADS = 8
ATTN_KV_HEADS = 2
ATTN_HEAD_DIM = 64
ATTN_GROUP = ATTN_Q_HEADS // ATTN_KV_HEADS
WINDOW = 128
ATTN_BLOCK = 128
ROPE_THETA = 500000.0
ROPE_DIM = ATTN_HEAD_DIM // 4

RET_HEADS = 4
RET_QK_DIM = 64
RET_V_DIM = 128
RET_CHUNK = 128
RET_ROPE_THETA = 10000.0

CONV_CH = 512
CONV_WIDTH = 3

N_BRANCH = 3
BRANCH_W = 512

D_FF = ((8 * D_MODEL // 3 + 255) // 256) * 256

EPS = 1e-6

COL_SIZES = [
    ATTN_Q_HEADS * ATTN_HEAD_DIM,
    ATTN_KV_HEADS * ATTN_HEAD_DIM,
    ATTN_KV_HEADS * ATTN_HEAD_DIM,
    RET_HEADS * RET_QK_DIM,
    RET_HEADS * RET_QK_DIM,
    RET_HEADS * RET_V_DIM,
    RET_HEADS * RET_V_DIM,
    CONV_CH,
    CONV_CH,
    CONV_CH,
    N_BRANCH * D_MODEL,
]
D_IN = int(sum(COL_SIZES))
SPLIT_POINTS = [int(v) for v in np.cumsum(COL_SIZES)[:-1]]

kernel_name = "hybrid_swa_retention_shortconv_gated_block"


def rms_norm(x, g):
    x32 = x.astype(jnp.float32)
    y = x32 * lax.rsqrt(jnp.mean(x32 * x32, axis=-1, keepdims=True) + EPS)
    return (y * g.astype(jnp.float32)).astype(x.dtype)


def rotary(x, rot_dim, theta):
    seq = x.shape[1]
    half = rot_dim // 2
    inv = theta ** (-jnp.arange(half, dtype=jnp.float32) / half)
    ang = jnp.arange(seq, dtype=jnp.float32)[:, None] * inv[None, :]
    cos = jnp.cos(ang)[None, :, None, :]
    sin = jnp.sin(ang)[None, :, None, :]
    xr = x[..., :rot_dim].astype(jnp.float32)
    x1, x2 = xr[..., :half], xr[..., half:]
    rot = jnp.concatenate([x1 * cos - x2 * sin, x2 * cos + x1 * sin], axis=-1)
    return jnp.concatenate([rot.astype(x.dtype), x[..., rot_dim:]], axis=-1)


def swa_attention(q, k, v, sinks):
    b, s, _ = q.shape
    nb = s // ATTN_BLOCK
    dt = q.dtype
    q = rotary(q.reshape(b, s, ATTN_Q_HEADS, ATTN_HEAD_DIM), ROPE_DIM, ROPE_THETA)
    k = rotary(k.reshape(b, s, ATTN_KV_HEADS, ATTN_HEAD_DIM), ROPE_DIM, ROPE_THETA)
    v = v.reshape(b, s, ATTN_KV_HEADS, ATTN_HEAD_DIM)
    qb = (q.astype(jnp.float32) * ATTN_HEAD_DIM ** -0.5).reshape(
        b, nb, ATTN_BLOCK, ATTN_KV_HEADS, ATTN_GROUP, ATTN_HEAD_DIM)
    pad = ((0, 0), (ATTN_BLOCK, 0), (0, 0), (0, 0))
    kp = jnp.pad(k, pad).astype(jnp.float32).reshape(b, nb + 1, ATTN_BLOCK, ATTN_KV_HEADS, ATTN_HEAD_DIM)
    vp = jnp.pad(v, pad).astype(jnp.float32).reshape(b, nb + 1, ATTN_BLOCK, ATTN_KV_HEADS, ATTN_HEAD_DIM)
    kw = jnp.concatenate([kp[:, :-1], kp[:, 1:]], axis=2)
    vw = jnp.concatenate([vp[:, :-1], vp[:, 1:]], axis=2)
    qi = jnp.arange(ATTN_BLOCK)[:, None]
    kj = jnp.arange(2 * ATTN_BLOCK)[None, :]
    diff = ATTN_BLOCK + qi - kj
    n_idx = jnp.arange(nb)[:, None, None]
    kpos = (n_idx - 1) * ATTN_BLOCK + kj[None]
    mask = (diff[None] >= 0) & (diff[None] < WINDOW) & (kpos >= 0)
    scores = jnp.einsum('bnqhgd,bnkhd->bnhgqk', qb, kw)
    scores = jnp.where(mask[None, :, None, None], scores, -jnp.inf)
    sink = sinks.astype(jnp.float32).reshape(1, 1, ATTN_KV_HEADS, ATTN_GROUP, 1, 1)
    m = jnp.maximum(jnp.max(scores, axis=-1, keepdims=True), sink)
    p = jnp.exp(scores - m)
    denom = jnp.sum(p, axis=-1, keepdims=True) + jnp.exp(sink - m)
    p = p / denom
    out = jnp.einsum('bnhgqk,bnkhd->bnqhgd', p, vw)
    return out.reshape(b, s, ATTN_Q_HEADS * ATTN_HEAD_DIM).astype(dt)


def retention(q, k, v, g):
    b, s, _ = q.shape
    nc = s // RET_CHUNK
    dt = q.dtype
    q = rotary(q.reshape(b, s, RET_HEADS, RET_QK_DIM), RET_QK_DIM, RET_ROPE_THETA)
    k = rotary(k.reshape(b, s, RET_HEADS, RET_QK_DIM), RET_QK_DIM, RET_ROPE_THETA)
    qc = q.astype(jnp.float32).reshape(b, nc, RET_CHUNK, RET_HEADS, RET_QK_DIM)
    kc = (k.astype(jnp.float32) * RET_QK_DIM ** -0.5).reshape(b, nc, RET_CHUNK, RET_HEADS, RET_QK_DIM)
    vc = v.astype(jnp.float32).reshape(b, nc, RET_CHUNK, RET_HEADS, RET_V_DIM)
    log_gamma = jnp.log1p(-jnp.exp2(-(5.0 + jnp.arange(RET_HEADS, dtype=jnp.float32))))
    idx = jnp.arange(RET_CHUNK, dtype=jnp.float32)
    rel = idx[:, None] - idx[None, :]
    dmask = jnp.exp(jnp.where(rel[None] >= 0, log_gamma[:, None, None] * rel[None], -jnp.inf))
    att = jnp.einsum('bnqhd,bnkhd->bnhqk', qc, kc) * dmask[None, None]
    inner = jnp.einsum('bnhqk,bnkhe->bnqhe', att, vc)
    zeta = jnp.exp(log_gamma[:, None] * (RET_CHUNK - 1.0 - idx)[None])
    xi = jnp.exp(log_gamma[:, None] * (idx + 1.0)[None])
    chunk_decay = jnp.exp(log_gamma * RET_CHUNK)[None, :, None, None]
    kv = jnp.einsum('bnkhd,hk,bnkhe->nbhde', kc, zeta, vc)

    def step(state, kv_n):
        return chunk_decay * state + kv_n, state

    _, state_prev = lax.scan(step, jnp.zeros((b, RET_HEADS, RET_QK_DIM, RET_V_DIM), jnp.float32), kv)
    cross = jnp.einsum('bnqhd,hq,nbhde->bnqhe', qc, xi, state_prev)
    y = (inner + cross).reshape(b, s, RET_HEADS, RET_V_DIM)
    y = y * lax.rsqrt(jnp.mean(y * y, axis=-1, keepdims=True) + EPS)
    out = jax.nn.silu(g.reshape(b, s, RET_HEADS, RET_V_DIM).astype(jnp.float32)) * y
    return out.reshape(b, s, RET_HEADS * RET_V_DIM).astype(dt)


def short_conv(gate_b, gate_c, xv, w):
    u = gate_c * xv
    y = lax.conv_general_dilated(
        u, w.astype(u.dtype)[:, None, :], window_strides=(1,),
        padding=[(CONV_WIDTH - 1, 0)], dimension_numbers=('NWC', 'WIO', 'NWC'),
        feature_group_count=CONV_CH)
    return gate_b * y


def token_mixer(u, w_in_l, sinks_l, conv_w_l, w_branch_l, b_gate_l, w_out_l):
    b, s, _ = u.shape
    proj = u @ w_in_l
    (aq, ak, av, rq, rk, rv, rg, cb, cc, cx, gates) = jnp.split(proj, SPLIT_POINTS, axis=-1)
    ya = swa_attention(aq, ak, av, sinks_l)
    yr = retention(rq, rk, rv, rg)
    yc = short_conv(cb, cc, cx, conv_w_l)
    branches = jnp.stack([ya, yr, yc], axis=-2)
    branch_out = jnp.einsum('bsnc,ncd->bsnd', branches, w_branch_l)
    g = jax.nn.sigmoid(gates.reshape(b, s, N_BRANCH, D_MODEL) + b_gate_l)
    merged = jnp.sum(g * branch_out, axis=-2)
    return merged @ w_out_l


def swiglu(u, wg, wu, wd):
    return (jax.nn.silu(u @ wg) * (u @ wu)) @ wd


def setup_inputs(seed: int = 0) -> dict:
    key = jax.random.key(seed)
    ks = jax.random.split(key, 14)
    f32 = jnp.float32
    nrm = lambda k, shp, sc: jax.random.normal(k, shp, f32) * sc
    return {
        "x": nrm(ks[0], (BATCH, SEQ, D_MODEL), 1.0),
        "norm_mix": 1.0 + nrm(ks[1], (DEPTH, D_MODEL), 0.02),
        "w_in": nrm(ks[2], (DEPTH, D_MODEL, D_IN), D_MODEL ** -0.5),
        "attn_sinks": nrm(ks[3], (DEPTH, ATTN_Q_HEADS), 0.5),
        "conv_w": nrm(ks[4], (DEPTH, CONV_WIDTH, CONV_CH), CONV_WIDTH ** -0.5),
        "w_branch": nrm(ks[5], (DEPTH, N_BRANCH, BRANCH_W, D_MODEL), BRANCH_W ** -0.5),
        "b_gate": nrm(ks[6], (DEPTH, N_BRANCH, D_MODEL), 0.1),
        "w_out": nrm(ks[7], (DEPTH, D_MODEL, D_MODEL), D_MODEL ** -0.5),
        "norm_ffn": 1.0 + nrm(ks[8], (DEPTH, D_MODEL), 0.02),
        "w_ffn_gate": nrm(ks[9], (DEPTH, D_MODEL, D_FF), D_MODEL ** -0.5),
        "w_ffn_up": nrm(ks[10], (DEPTH, D_MODEL, D_FF), D_MODEL ** -0.5),
        "w_ffn_down": nrm(ks[11], (DEPTH, D_FF, D_MODEL), D_FF ** -0.5),
        "norm_final": 1.0 + nrm(ks[12], (D_MODEL,), 0.02),
    }


def reference(x, norm_mix, w_in, attn_sinks, conv_w, w_branch, b_gate, w_out,
              norm_ffn, w_ffn_gate, w_ffn_up, w_ffn_down, norm_final):
    h = x
    for layer in range(DEPTH):
        u = rms_norm(h, norm_mix[layer])
        h = h + token_mixer(u, w_in[layer], attn_sinks[layer], conv_w[layer],
                            w_branch[layer], b_gate[layer], w_out[layer])
        u = rms_norm(h, norm_ffn[layer])
        h = h + swiglu(u, w_ffn_gate[layer], w_ffn_up[layer], w_ffn_down[layer])
    return rms_norm(h, norm_final)
```

```cpp
#include <hip/hip_runtime.h>
#include <cstdio>
#include <cstdint>

#define LAS __attribute__((address_space(3)))
#define GAS __attribute__((address_space(1)))
typedef unsigned short bf16_t;
typedef short bf16x8 __attribute__((ext_vector_type(8)));
typedef float f32x4 __attribute__((ext_vector_type(4)));
typedef float f32x2 __attribute__((ext_vector_type(2)));
typedef unsigned u32x4 __attribute__((ext_vector_type(4)));
typedef unsigned u32x2 __attribute__((ext_vector_type(2)));
typedef __bf16 bf16x2_t __attribute__((ext_vector_type(2)));

constexpr int BATCH = 8, SEQ = 2048, DM = 1024, M = BATCH * SEQ, DEPTH = 4, DFF = 2816, DIN = 6912;
constexpr int PW = 3328;
constexpr int XW = 2560;
constexpr int NIN = 3840;
constexpr int NGU = 2 * DFF;
constexpr int KC = 1536;
constexpr float EPS = 1e-6f;
constexpr float LOG2E = 1.4426950408889634f;
constexpr float QSCALE = 0.18033688011112042f;

constexpr size_t MiB = 1u << 20;
constexpr size_t WS_CTL = 0, CTL_ZERO_BYTES = 65536;
constexpr size_t WS_SS = 376 * MiB;
constexpr size_t WS_TABA = 2 * MiB;
constexpr size_t WS_TABR = 2 * MiB + 131072;
constexpr size_t WS_W = 4 * MiB;
constexpr size_t WL_IN = 0, WL_C = 7864320, WL_OUT = 17301504, WL_GU = 19398656, WL_D = 30932992, WL_SIZE = 36700160;
constexpr size_t WS_X = 144 * MiB;
constexpr size_t WS_P = 224 * MiB;
constexpr size_t WS_MACC = WS_P, WS_MB = WS_P + 64 * MiB, WS_FF = WS_P;
constexpr size_t WS_GS = 328 * MiB;
constexpr size_t WS_KV = 360 * MiB;
constexpr size_t WS_END = 386 * MiB;
static_assert(WS_W + DEPTH * WL_SIZE <= WS_X, "weights");
static_assert((size_t)M * XW * 2 <= 80 * MiB && (size_t)M * PW * 2 <= 104 * MiB && (size_t)M * DFF * 2 <= 104 * MiB, "buffers");

constexpr int RING_BYTES = 131072, LDS_BYTES = 147456, MISC_OFF = RING_BYTES + 320;

__device__ __forceinline__ unsigned pk2(float lo, float hi) { f32x2 v = {lo, hi}; bf16x2_t b = __builtin_convertvector(v, bf16x2_t); return __builtin_bit_cast(unsigned, b); }
__device__ __forceinline__ float bflo(unsigned u) { return __uint_as_float(u << 16); }
__device__ __forceinline__ float bfhi(unsigned u) { return __uint_as_float(u & 0xffff0000u); }
__device__ __forceinline__ float bf2f(bf16_t b) { return __uint_as_float((unsigned)b << 16); }
__device__ __forceinline__ float fsilu(float x) { return x * __builtin_amdgcn_rcpf(1.f + __builtin_amdgcn_exp2f(-x * LOG2E)); }
__device__ __forceinline__ float fsigm(float x) { return __builtin_amdgcn_rcpf(1.f + __builtin_amdgcn_exp2f(-x * LOG2E)); }

struct Args {
    const float* x; const float* norm_mix; const float* w_in; const float* sinks; const float* conv_w; const float* w_branch; const float* b_gate; const float* w_out;
    const float* norm_ffn; const float* w_g; const float* w_u; const float* w_d; const float* norm_final;
    float* out; unsigned char* ws; int ph_lo, ph_hi;
};
namespace pg8 {
constexpr int BM = 256, BK = 64, HALF = 128, HTB = HALF * BK * 2  , STAGE_BYTES = 8 * HTB, NXCD = 8, WGM = 8;

__host__ __device__ __forceinline__ int lds_byte(int r, int c) { const int st = (r >> 4) * 2 + (c >> 5), rr = r & 15, cc = c & 31, ob = rr * 64 + cc * 2; return st * 1024 + (ob ^ (((ob >> 9) & 1) << 5)); }
__host__ __device__ __forceinline__ void stage_rc(int b, int& R, int& C) { const int st = b / 1024, sb = b % 1024, swz = sb ^ (((sb >> 9) & 1) << 5); R = (st >> 1) * 16 + swz / 64; C = (st & 1) * 32 + (swz % 64) / 2; }
__host__ __device__ __forceinline__ int perm32(int rho) { const int n = rho >> 4, i = rho & 15; return 8 * (i >> 2) + 4 * n + (i & 3); }

struct Unit { const char* A; const char* B; int nt, pm, pn, kind, aux; };

__device__ __forceinline__ void tile_of(int L, int nM, int nN, int& pm, int& pn) {
    const int nwg = nM * nN; int wgid = L;
    { const int q = nwg / NXCD, r = nwg % NXCD, xcd = wgid % NXCD, off = wgid / NXCD; wgid = (xcd < r ? xcd * (q + 1) : r * (q + 1) + (xcd - r) * q) + off; }
    const int nig = WGM * nN, gid = wgid / nig, fm = gid * WGM, gsz = (nM - fm) < WGM ? (nM - fm) : WGM;
    pm = fm + ((wgid % nig) % gsz); pn = (wgid % nig) / gsz;
}

template <class Epi, class Sched>
__device__ __forceinline__ void gemm_phase(LAS unsigned char* lds, const int lda, const int ldb, const Sched& S, const Epi& E, const int tid) {
    const int wid = __builtin_amdgcn_readfirstlane(tid >> 6), lane = tid & 63, wr = wid >> 2, wc = wid & 3, fr = lane & 15, fq = lane >> 4;
    unsigned voffA[2], voffB[2];
#pragma unroll
    for (int i = 0; i < 2; ++i) { int R, C; stage_rc(tid * 16 + i * 8192, R, C); const int Rb = (R & ~31) + perm32(R & 31);
        voffA[i] = (unsigned)(R * lda + C) * 2u; voffB[i] = (unsigned)(Rb * ldb + C) * 2u; }
    const size_t kstep = (size_t)(BK * 2);
    const size_t hstepA = (size_t)HALF * lda * 2, hstepB = (size_t)HALF * ldb * 2;
    const unsigned ldsw = (unsigned)wid * 1024u;
    const int aoff = lds_byte(wr * 64 + fr, fq * 8), boff = lds_byte(wc * 32 + fr, fq * 8);
#define PG8_SA(b, h) (((b) * 2 + (h)) * HTB)
#define PG8_SB(b, h) ((4 + (b) * 2 + (h)) * HTB)
#define PG8_STAGE(bufoff, gbase, voff) do { _Pragma("unroll") for (int _i = 0; _i < 2; ++_i) \
        __builtin_amdgcn_global_load_lds((const unsigned*)((const char*)(gbase) + (voff)[_i]), (LAS unsigned*)(lds + (bufoff) + ldsw + _i * 8192), 16, 0, 0); } while (0)
#define PG8_LDA(dst, b, h) do { _Pragma("unroll") for (int m = 0; m < 4; ++m) _Pragma("unroll") for (int k = 0; k < 2; ++k) dst[m][k] = *(const LAS bf16x8*)(lds + PG8_SA(b, h) + aoff + m * 2048 + k * 1024); } while (0)
#define PG8_LDB(dst, b, h) do { _Pragma("unroll") for (int n = 0; n < 2; ++n) _Pragma("unroll") for (int k = 0; k < 2; ++k) dst[n][k] = *(const LAS bf16x8*)(lds + PG8_SB(b, h) + boff + n * 2048 + k * 1024); } while (0)
#define PG8_MMA(ai, bj, At, Bt) do { __builtin_amdgcn_s_setprio(1); _Pragma("unroll") for (int m = 0; m < 4; ++m) _Pragma("unroll") for (int n = 0; n < 2; ++n) _Pragma("unroll") for (int k = 0; k < 2; ++k) \
        acc[ai][bj][m][n] = __builtin_amdgcn_mfma_f32_16x16x32_bf16(Bt[n][k], At[m][k], acc[ai][bj][m][n], 0, 0, 0); __builtin_amdgcn_s_setprio(0); } while (0)
#define PG8_WAIT_V(n) asm volatile("s_waitcnt vmcnt(" #n ")" ::: "memory")
#define PG8_WAIT_L(n) asm volatile("s_waitcnt lgkmcnt(" #n ")" ::: "memory")
#define PG8_BAR __builtin_amdgcn_s_barrier()
#define PG8_SCHED __builtin_amdgcn_sched_barrier(0)
    Unit cur, nxt; int ui = 0;
    if (!S.next(0, cur)) return;
    f32x4 acc[2][2][4][2];
#pragma unroll
    for (int a = 0; a < 2; ++a)
#pragma unroll
        for (int b = 0; b < 2; ++b)
#pragma unroll
            for (int m = 0; m < 4; ++m)
#pragma unroll
                for (int n = 0; n < 2; ++n) acc[a][b][m][n] = (f32x4){0.f, 0.f, 0.f, 0.f};
    bf16x8 At[4][2], B0[2][2], B1[2][2];
    const char* cA = cur.A; const char* cB = cur.B;
    PG8_STAGE(PG8_SB(0, 0), cB, voffB); PG8_STAGE(PG8_SB(0, 1), cB + hstepB, voffB); PG8_STAGE(PG8_SA(0, 0), cA, voffA); PG8_STAGE(PG8_SA(0, 1), cA + hstepA, voffA);
    if (wr == 1) PG8_BAR;
    PG8_WAIT_V(2); PG8_BAR;
    PG8_STAGE(PG8_SB(1, 0), cB + kstep, voffB); PG8_STAGE(PG8_SA(1, 0), cA + kstep, voffA); PG8_STAGE(PG8_SB(1, 1), cB + hstepB + kstep, voffB);
    PG8_WAIT_V(6); PG8_BAR;
    for (;;) {
        const bool has_next = S.next(ui + 1, nxt);
        const char* nA = has_next ? nxt.A : cA; const char* nB = has_next ? nxt.B : cB;
        const int nt = cur.nt;
        for (int t = 0; t < nt; t += 2) {
            const bool last = (t == nt - 2);
            const char* a1 = cA + (size_t)(t + 1) * kstep;
            const char* a2 = last ? nA : cA + (size_t)(t + 2) * kstep; const char* b2 = last ? nB : cB + (size_t)(t + 2) * kstep;
            const char* a3 = a2 + kstep; const char* b3 = b2 + kstep;
            PG8_LDB(B0, 0, 0); PG8_LDB(B1, 0, 1); PG8_SCHED; PG8_LDA(At, 0, 0); PG8_STAGE(PG8_SA(1, 1), a1 + hstepA, voffA);
            PG8_WAIT_V(8); PG8_WAIT_L(0); PG8_BAR; PG8_MMA(0, 0, At, B0); PG8_MMA(0, 1, At, B1); PG8_BAR; PG8_SCHED;
            PG8_LDA(At, 0, 1); PG8_STAGE(PG8_SB(0, 0), b2, voffB); PG8_STAGE(PG8_SB(0, 1), b2 + hstepB, voffB); PG8_STAGE(PG8_SA(0, 0), a2, voffA);
            PG8_WAIT_V(8); PG8_WAIT_L(0); PG8_BAR; PG8_MMA(1, 0, At, B0); PG8_MMA(1, 1, At, B1); PG8_BAR; PG8_SCHED;
            PG8_LDB(B0, 1, 0); PG8_LDB(B1, 1, 1); PG8_SCHED; PG8_LDA(At, 1, 0); PG8_STAGE(PG8_SA(0, 1), a2 + hstepA, voffA);
            PG8_WAIT_V(8); PG8_WAIT_L(0); PG8_BAR; PG8_MMA(0, 0, At, B0); PG8_MMA(0, 1, At, B1); PG8_BAR; PG8_SCHED;
            PG8_LDA(At, 1, 1); PG8_STAGE(PG8_SB(1, 0), b3, voffB); PG8_STAGE(PG8_SB(1, 1), b3 + hstepB, voffB); PG8_STAGE(PG8_SA(1, 0), a3, voffA);
            PG8_WAIT_V(8); PG8_WAIT_L(0); PG8_BAR; PG8_MMA(1, 0, At, B0); PG8_MMA(1, 1, At, B1); PG8_BAR; PG8_SCHED;
        }
        if (wr == 0) PG8_BAR;
        E(acc, cur, wr, wc, fr, fq, tid);
        if (!has_next) break;
#pragma unroll
        for (int a = 0; a < 2; ++a)
#pragma unroll
            for (int b = 0; b < 2; ++b)
#pragma unroll
                for (int m = 0; m < 4; ++m)
#pragma unroll
                    for (int n = 0; n < 2; ++n) acc[a][b][m][n] = (f32x4){0.f, 0.f, 0.f, 0.f};
        cur = nxt; cA = nA; cB = nB; ++ui;
        if (wr == 1) PG8_BAR;
    }
    PG8_WAIT_V(0);
    PG8_BAR;
#undef PG8_SA
#undef PG8_SB
#undef PG8_STAGE
#undef PG8_LDA
#undef PG8_LDB
#undef PG8_MMA
#undef PG8_WAIT_V
#undef PG8_WAIT_L
#undef PG8_BAR
#undef PG8_SCHED
}
}
namespace pg8 {
#ifndef EPIC_TEST
#define EPIC_TEST(x) (x)
#endif
__device__ __forceinline__ float row_rstd(const float* ss, int row) {
    const f32x4* p = (const f32x4*)(ss + (size_t)row * 16); const f32x4 a = p[0], b = p[1], c = p[2], d = p[3];
    const float s = ((a[0] + a[1]) + (a[2] + a[3])) + ((b[0] + b[1]) + (b[2] + b[3])) + (((c[0] + c[1]) + (c[2] + c[3])) + ((d[0] + d[1]) + (d[2] + d[3])));
    return rsqrtf(s * (1.f / DM) + EPS);
}
enum { K_IN = 0, K_GATE = 1, K_BRANCH = 2, K_RES = 3, K_GU = 4 };

__device__ __forceinline__ f32x4 rot4(f32x4 v, f32x4 t) { return (f32x4){v[0] * t[0] - v[1] * t[1], v[1] * t[0] + v[0] * t[1], v[2] * t[2] - v[3] * t[3], v[3] * t[2] + v[2] * t[3]}; }

struct EpiIn {
    bf16_t* P; const float* ss; const f32x4* tabA; const f32x4* tabR;
    __device__ __forceinline__ void operator()(const f32x4 (&acc)[2][2][4][2], const Unit& u, int wr, int wc, int fr, int fq, int tid) const {
        asm volatile("" : "+v"(fr), "+v"(fq));
        const int pn = u.pn;
        const int cw = wc * 32 + 8 * fq;
        const int p0 = (wc & 1) * 32 + 8 * fq;
#pragma unroll
        for (int ai = 0; ai < 2; ++ai)
#pragma unroll
            for (int m = 0; m < 4; ++m) {
                const int row = u.pm * 256 + ai * 128 + wr * 64 + m * 16 + fr;
                const float rstd = row_rstd(ss, row);
                const int pos = row & (SEQ - 1);
#pragma unroll
                for (int bj = 0; bj < 2; ++bj) {
                    f32x4 v0 = acc[ai][bj][m][0] * rstd, v1 = acc[ai][bj][m][1] * rstd;
                    const int gc = pn * 256 + bj * 128 + cw;
                    if (pn >= 11) {
                        u32x2 w; w.x = pk2(v0[0] * v0[1], v0[2] * v0[3]); w.y = pk2(v1[0] * v1[1], v1[2] * v1[3]);
                        *(u32x2*)(P + (size_t)row * PW + 2816 + ((gc - 2816) >> 1)) = w;
                    } else {
                        if (pn < 2 || (pn == 2 && bj == 0)) {
                            if (p0 < 16) {
                                const f32x4 t0 = tabA[pos * 4 + (p0 >> 2)], t1 = tabA[pos * 4 + (p0 >> 2) + 1];
                                v0 = rot4(v0, t0); v1 = rot4(v1, t1);
                            }
                            if (pn < 2) { v0 = v0 * QSCALE; v1 = v1 * QSCALE; }
                        } else if (pn == 3 || pn == 4) {
                            const f32x4 t0 = tabR[pos * 16 + (p0 >> 2)], t1 = tabR[pos * 16 + (p0 >> 2) + 1];
                            v0 = rot4(v0, t0); v1 = rot4(v1, t1);
                            if (pn == 4) { v0 = v0 * 0.125f; v1 = v1 * 0.125f; }
                        } else if (pn == 7 || pn == 8) {
#pragma unroll
                            for (int j = 0; j < 4; ++j) { v0[j] = fsilu(v0[j]); v1[j] = fsilu(v1[j]); }
                        }
                        u32x4 w; w.x = pk2(v0[0], v0[1]); w.y = pk2(v0[2], v0[3]); w.z = pk2(v1[0], v1[1]); w.w = pk2(v1[2], v1[3]);
                        *(u32x4*)(P + (size_t)row * PW + gc) = w;
                    }
                }
            }
    }
};

struct EpiC {
    const float* ss; const float* bg; u32x4* Gs; f32x4* macc; bf16_t* mb;
    __device__ __forceinline__ void operator()(const f32x4 (&acc)[2][2][4][2], const Unit& u, int wr, int wc, int fr, int fq, int tid) const {
        asm volatile("" : "+v"(fr), "+v"(fq), "+v"(tid));
        const int cw = u.pn * 256 + wc * 32 + 8 * fq;
        if (EPIC_TEST(u.kind == K_GATE)) {
            const float* b = bg + u.aux * DM + cw;
#pragma unroll
            for (int ai = 0; ai < 2; ++ai)
#pragma unroll
                for (int m = 0; m < 4; ++m) {
                    const int row = u.pm * 256 + ai * 128 + wr * 64 + m * 16 + fr;
                    const float rstd = row_rstd(ss, row);
#pragma unroll
                    for (int bj = 0; bj < 2; ++bj) {
                        f32x4 v0 = acc[ai][bj][m][0] * rstd + *(const f32x4*)(b + bj * 128), v1 = acc[ai][bj][m][1] * rstd + *(const f32x4*)(b + bj * 128 + 4);
#pragma unroll
                        for (int j = 0; j < 4; ++j) { v0[j] = fsigm(v0[j]); v1[j] = fsigm(v1[j]); }
                        u32x4 w; w.x = pk2(v0[0], v0[1]); w.y = pk2(v0[2], v0[3]); w.z = pk2(v1[0], v1[1]); w.w = pk2(v1[2], v1[3]);
                        Gs[((ai * 4 + m) * 2 + bj) * 512 + tid] = w;
                    }
                    asm volatile("" ::: "memory");
                }
        } else {
            const int br = u.aux;
#pragma unroll
            for (int ai = 0; ai < 2; ++ai)
#pragma unroll
                for (int m = 0; m < 4; ++m) {
                    const int row = u.pm * 256 + ai * 128 + wr * 64 + m * 16 + fr;
#pragma unroll
                    for (int bj = 0; bj < 2; ++bj) {
                        const int idx = (ai * 4 + m) * 2 + bj;
                        const u32x4 g = Gs[idx * 512 + tid];
                        f32x4 v0 = acc[ai][bj][m][0] * (f32x4){bflo(g.x), bfhi(g.x), bflo(g.y), bfhi(g.y)};
                        f32x4 v1 = acc[ai][bj][m][1] * (f32x4){bflo(g.z), bfhi(g.z), bflo(g.w), bfhi(g.w)};
                        if (br > 0) { v0 = v0 + macc[(idx * 2) * 512 + tid]; v1 = v1 + macc[(idx * 2 + 1) * 512 + tid]; }
                        if (br < 2) { macc[(idx * 2) * 512 + tid] = v0; macc[(idx * 2 + 1) * 512 + tid] = v1; }
                        else { u32x4 w; w.x = pk2(v0[0], v0[1]); w.y = pk2(v0[2], v0[3]); w.z = pk2(v1[0], v1[1]); w.w = pk2(v1[2], v1[3]);
                               *(u32x4*)(mb + (size_t)row * DM + bj * 128 + cw) = w; }
                    }
                    asm volatile("" ::: "memory");
                }
        }
    }
};

struct EpiRes {
    const float* rin; float* H; bf16_t* hb; float* ssout;
    __device__ __forceinline__ void operator()(const f32x4 (&acc)[2][2][4][2], const Unit& u, int wr, int wc, int fr, int fq, int tid) const {
        asm volatile("" : "+v"(fr), "+v"(fq));
        const int cw = u.pn * 256 + wc * 32 + 8 * fq;
#pragma unroll
        for (int ai = 0; ai < 2; ++ai)
#pragma unroll
            for (int m = 0; m < 4; ++m) {
                const int row = u.pm * 256 + ai * 128 + wr * 64 + m * 16 + fr;
                float s = 0.f;
#pragma unroll
                for (int bj = 0; bj < 2; ++bj) {
                    const size_t o = (size_t)row * DM + bj * 128 + cw;
                    const f32x4 v0 = acc[ai][bj][m][0] + *(const f32x4*)(rin + o), v1 = acc[ai][bj][m][1] + *(const f32x4*)(rin + o + 4);
                    *(f32x4*)(H + o) = v0; *(f32x4*)(H + o + 4) = v1;
                    u32x4 w; w.x = pk2(v0[0], v0[1]); w.y = pk2(v0[2], v0[3]); w.z = pk2(v1[0], v1[1]); w.w = pk2(v1[2], v1[3]);
                    *(u32x4*)(hb + (size_t)row * XW + bj * 128 + cw) = w;
                    s += (v0[0] * v0[0] + v0[1] * v0[1]) + (v0[2] * v0[2] + v0[3] * v0[3]) + (v1[0] * v1[0] + v1[1] * v1[1]) + (v1[2] * v1[2] + v1[3] * v1[3]);
                }
                s += __shfl_xor(s, 16); s += __shfl_xor(s, 32);
                if (fq == 0) ssout[(size_t)row * 16 + u.pn * 4 + wc] = s;
            }
    }
};

struct EpiGU {
    const float* ss; bf16_t* ff;
    __device__ __forceinline__ void operator()(const f32x4 (&acc)[2][2][4][2], const Unit& u, int wr, int wc, int fr, int fq, int tid) const {
        asm volatile("" : "+v"(fr), "+v"(fq));
        const int cj = u.pn * 128 + wc * 16 + 4 * fq;
#pragma unroll
        for (int ai = 0; ai < 2; ++ai)
#pragma unroll
            for (int m = 0; m < 4; ++m) {
                const int row = u.pm * 256 + ai * 128 + wr * 64 + m * 16 + fr;
                const float rstd = row_rstd(ss, row);
#pragma unroll
                for (int bj = 0; bj < 2; ++bj) {
                    const f32x4 v0 = acc[ai][bj][m][0] * rstd, v1 = acc[ai][bj][m][1] * rstd;
                    u32x2 w; w.x = pk2(fsilu(v0[0]) * v0[1], fsilu(v0[2]) * v0[3]); w.y = pk2(fsilu(v1[0]) * v1[1], fsilu(v1[2]) * v1[3]);
                    *(u32x2*)(ff + (size_t)row * DFF + bj * 64 + cj) = w;
                }
            }
    }
};

struct SchedPlain {
    const char* A; const char* B; int lda, ldb, nt, nM, nN, G, c, kind;
    __device__ __forceinline__ bool next(int i, Unit& u) const {
        const int L = i * G + c; if (L >= nM * nN) return false;
        tile_of(L, nM, nN, u.pm, u.pn);
        u.A = A + (size_t)u.pm * 256 * lda * 2; u.B = B + (size_t)u.pn * 256 * ldb * 2; u.nt = nt; u.kind = kind; u.aux = 0; return true;
    }
};
struct SchedC {
    const char* X; const char* Wc; int G, c;
    __device__ __forceinline__ bool next(int i, Unit& u) const {
        const int j = i / 6, sub = i - 6 * j, L = j * G + c; if (L >= 64 * 4) return false;
        tile_of(L, 64, 4, u.pm, u.pn);
        const int br = sub >> 1; const bool gate = !(sub & 1);
        u.A = X + (size_t)u.pm * 256 * XW * 2 + (gate ? 0 : (1024 + 512 * br) * 2);
        u.B = Wc + (size_t)br * (1024 * KC * 2) + (size_t)u.pn * 256 * KC * 2 + (gate ? 0 : 1024 * 2);
        u.nt = gate ? 16 : 8; u.kind = gate ? K_GATE : K_BRANCH; u.aux = br; return true;
    }
};
}
__device__ const double INV_A[8] = {0.15915494309189535, 0.03086376340470123, 0.005985185712713705, 0.001160663641240061, 0.00022507907903927653, 4.364795279280289e-05, 8.464330808241401e-06, 1.6414262627950345e-06};
__device__ const double INV_R[32] = {0.15915494309189535, 0.11934937021124886, 0.08949940160889101, 0.06711508300522726, 0.050329212104487035, 0.03774158471741977, 0.0283021958306234, 0.02122365276477766,
    0.015915494309189534, 0.011934937021124886, 0.008949940160889102, 0.006711508300522725, 0.005032921210448704, 0.003774158471741977, 0.00283021958306234, 0.0021223652764777662,
    0.0015915494309189536, 0.0011934937021124885, 0.0008949940160889102, 0.0006711508300522726, 0.0005032921210448703, 0.00037741584717419774, 0.00028302195830623395, 0.0002122365276477766,
    0.00015915494309189535, 0.00011934937021124886, 8.949940160889102e-05, 6.711508300522725e-05, 5.0329212104487035e-05, 3.774158471741978e-05, 2.8302195830623396e-05, 2.122365276477766e-05};
__device__ __forceinline__ float lg_gamma(int h) { return h == 0 ? -0.04580368961312479f : h == 1 ? -0.02272007650008353f : h == 2 ? -0.011315313227834146f : -0.005646563141142062f; }
__device__ __forceinline__ float ex2(float x) { return __builtin_amdgcn_exp2f(x); }
__device__ __forceinline__ float wave_sum(float v) {
#pragma unroll
    for (int o = 1; o < 64; o <<= 1) v += __shfl_xor(v, o);
    return v;
}
#define LDS_WAIT() asm volatile("s_waitcnt lgkmcnt(0)" ::: "memory")

__device__ __forceinline__ int src_in(int n) {
    if (n < 640) { const int p = n & 63; return (p < 16) ? (n & ~63) + ((p & 1) ? 8 + (p >> 1) : (p >> 1)) : n; }
    if (n < 768) return n;
    if (n < 1280) { const int p = n & 63; return (n & ~63) + ((p & 1) ? 32 + (p >> 1) : (p >> 1)); }
    if (n < 2816) return n;
    const int j = (n - 2816) >> 1; return (n & 1) ? 3328 + j : 2816 + j;
}
__device__ __forceinline__ void cvt_item(const float* wcol, size_t ldw, const float* scale, bf16_t* dst, int ld, int k0, LAS float* scr, int lane) {
#pragma unroll 8
    for (int i = 0; i < 32; ++i) { const int kk = 2 * i + (lane >> 5); float v = wcol[(size_t)(k0 + kk) * ldw]; if (scale) v *= scale[k0 + kk]; scr[kk * 33 + (lane & 31)] = v; }
    LDS_WAIT(); asm volatile("" ::: "memory");
    const int c = lane & 7;
#pragma unroll
    for (int j = 0; j < 4; ++j) { const int n = (lane >> 3) + 8 * j; const LAS float* s = scr + (8 * c) * 33 + n;
        u32x4 o; o.x = pk2(s[0 * 33], s[1 * 33]); o.y = pk2(s[2 * 33], s[3 * 33]); o.z = pk2(s[4 * 33], s[5 * 33]); o.w = pk2(s[6 * 33], s[7 * 33]);
        *(u32x4*)(dst + (size_t)n * ld + k0 + 8 * c) = o; }
    LDS_WAIT(); asm volatile("" ::: "memory");
}
constexpr int CV_J0 = 1920, CV_J1 = 1536, CV_J2 = 768, CV_J3 = 512, CV_J4 = 2816, CV_J5 = 1408, CV_PER_LAYER = CV_J0 + CV_J1 + CV_J2 + CV_J3 + CV_J4 + CV_J5;
__device__ __forceinline__ void phase_prologue(const Args& a, LAS unsigned char* lds, int G, const int tid) {
    const int lane = tid & 63, wave = tid >> 6;
    const int gw = blockIdx.x * 8 + wave, NGW = G * 8;
    LAS float* scr = (LAS float*)(lds + wave * 16384);
    const int ln = lane & 31;
    for (int it = gw; it < DEPTH * CV_PER_LAYER; it += NGW) {
        const int l = it / CV_PER_LAYER; int r = it - l * CV_PER_LAYER;
        bf16_t* Wl = (bf16_t*)(a.ws + WS_W + (size_t)l * WL_SIZE);
        if (r < CV_J0) { const int kb = r / 120, nb = r % 120, n = nb * 32 + ln;
            cvt_item(a.w_in + (size_t)l * DM * DIN + src_in(n), DIN, a.norm_mix + l * DM, Wl + WL_IN / 2 + (size_t)nb * 32 * DM, DM, kb * 64, scr, lane); continue; } r -= CV_J0;
        if (r < CV_J1) { const int kb = r / 96, nb = r % 96, n = nb * 32 + ln;
            cvt_item(a.w_in + (size_t)l * DM * DIN + 3840 + n, DIN, a.norm_mix + l * DM, Wl + WL_C / 2 + (size_t)nb * 32 * KC, KC, kb * 64, scr, lane); continue; } r -= CV_J1;
        if (r < CV_J2) { const int kb = r / 96, nb = r % 96, n = nb * 32 + ln, i = n >> 10;
            cvt_item(a.w_branch + ((size_t)(l * 3 + i) * 512) * DM + (n & 1023), DM, nullptr, Wl + WL_C / 2 + (size_t)nb * 32 * KC + 1024, KC, kb * 64, scr, lane); continue; } r -= CV_J2;
        if (r < CV_J3) { const int kb = r / 32, nb = r % 32, n = nb * 32 + ln;
            cvt_item(a.w_out + (size_t)l * DM * DM + n, DM, nullptr, Wl + WL_OUT / 2 + (size_t)nb * 32 * DM, DM, kb * 64, scr, lane); continue; } r -= CV_J3;
        if (r < CV_J4) { const int kb = r / 176, nb = r % 176, n = nb * 32 + ln;
            cvt_item(((n & 1) ? a.w_u : a.w_g) + (size_t)l * DM * DFF + (n >> 1), DFF, a.norm_ffn + l * DM, Wl + WL_GU / 2 + (size_t)nb * 32 * DM, DM, kb * 64, scr, lane); continue; } r -= CV_J4;
        { const int kb = r / 32, nb = r % 32, n = nb * 32 + ln;
            cvt_item(a.w_d + (size_t)l * DFF * DM + n, DM, nullptr, Wl + WL_D / 2 + (size_t)nb * 32 * DFF, DFF, kb * 64, scr, lane); }
    }
    bf16_t* X = (bf16_t*)(a.ws + WS_X); float* ss = (float*)(a.ws + WS_SS);
    for (int row = gw; row < M; row += NGW) {
        const f32x4* xr = (const f32x4*)(a.x + (size_t)row * DM) + lane; float s = 0.f;
#pragma unroll
        for (int j = 0; j < 4; ++j) { const f32x4 v = xr[64 * j]; s += (v[0] * v[0] + v[1] * v[1]) + (v[2] * v[2] + v[3] * v[3]);
            u32x2 w; w.x = pk2(v[0], v[1]); w.y = pk2(v[2], v[3]); *(u32x2*)(X + (size_t)row * XW + (64 * j + lane) * 4) = w; }
        s = wave_sum(s); if (lane < 16) ss[(size_t)row * 16 + lane] = (lane == 0) ? s : 0.f;
    }
    const int gt = blockIdx.x * 512 + tid, NT = G * 512;
    f32x2* tabA = (f32x2*)(a.ws + WS_TABA); f32x2* tabR = (f32x2*)(a.ws + WS_TABR);
    for (int i = gt; i < SEQ * 8; i += NT) { double rev = (double)(i >> 3) * INV_A[i & 7]; rev -= __builtin_floor(rev); const float r = (float)rev; tabA[i] = (f32x2){__builtin_amdgcn_cosf(r), __builtin_amdgcn_sinf(r)}; }
    for (int i = gt; i < SEQ * 32; i += NT) { double rev = (double)(i >> 5) * INV_R[i & 31]; rev -= __builtin_floor(rev); const float r = (float)rev; tabR[i] = (f32x2){__builtin_amdgcn_cosf(r), __builtin_amdgcn_sinf(r)}; }
}

__device__ __forceinline__ void attn_naive(LAS unsigned char* lds, const bf16_t* P, bf16_t* X, const float* sinks, int unit, const int tid) {
    const int b = unit >> 5, n = (unit >> 1) & 15, g = unit & 1;
    LAS bf16_t* Ks = (LAS bf16_t*)lds; LAS bf16_t* Vs = Ks + 256 * 72;
    const long row0 = (long)b * SEQ + n * 128 - 128;
    for (int c = tid; c < 2048; c += 512) {
        const int key = c >> 3, ch = c & 7; u32x4 kv = {0u, 0u, 0u, 0u}, vv = {0u, 0u, 0u, 0u};
        if (n > 0 || key >= 128) { const bf16_t* src = P + (size_t)(row0 + key) * PW + g * 64 + ch * 8; kv = *(const u32x4*)(src + 512); vv = *(const u32x4*)(src + 640); }
        *(LAS u32x4*)(Ks + key * 72 + ch * 8) = kv; *(LAS u32x4*)(Vs + key * 72 + ch * 8) = vv;
    }
    __syncthreads();
    const int r = tid & 127, hq = g * 4 + (tid >> 7);
    const size_t qrow = (size_t)b * SEQ + n * 128 + r;
    float q[64], o[64];
    { const u32x4* qp = (const u32x4*)(P + qrow * PW + hq * 64);
#pragma unroll
      for (int c = 0; c < 8; ++c) { const u32x4 w = qp[c]; q[8 * c] = bflo(w.x); q[8 * c + 1] = bfhi(w.x); q[8 * c + 2] = bflo(w.y); q[8 * c + 3] = bfhi(w.y); q[8 * c + 4] = bflo(w.z); q[8 * c + 5] = bfhi(w.z); q[8 * c + 6] = bflo(w.w); q[8 * c + 7] = bfhi(w.w); } }
#pragma unroll
    for (int d = 0; d < 64; ++d) o[d] = 0.f;
    float mx = sinks[hq] * LOG2E, l = 1.f;
    for (int j = 0; j < 128; ++j) {
        const int kt = r + 1 + j; const bool valid = (n > 0) || (kt >= 128);
        const LAS u32x4* kp = (const LAS u32x4*)(Ks + kt * 72);
        float s = 0.f;
#pragma unroll
        for (int c = 0; c < 8; ++c) { const u32x4 w = kp[c];
            s += q[8 * c] * bflo(w.x) + q[8 * c + 1] * bfhi(w.x) + q[8 * c + 2] * bflo(w.y) + q[8 * c + 3] * bfhi(w.y) + q[8 * c + 4] * bflo(w.z) + q[8 * c + 5] * bfhi(w.z) + q[8 * c + 6] * bflo(w.w) + q[8 * c + 7] * bfhi(w.w); }
        s = valid ? s : -INFINITY;
        const float mn = fmaxf(mx, s), sc = ex2(mx - mn), p = ex2(s - mn);
        l = l * sc + p; mx = mn;
        const LAS u32x4* vp = (const LAS u32x4*)(Vs + kt * 72);
#pragma unroll
        for (int c = 0; c < 8; ++c) { const u32x4 w = vp[c];
            o[8 * c] = o[8 * c] * sc + p * bflo(w.x); o[8 * c + 1] = o[8 * c + 1] * sc + p * bfhi(w.x); o[8 * c + 2] = o[8 * c + 2] * sc + p * bflo(w.y); o[8 * c + 3] = o[8 * c + 3] * sc + p * bfhi(w.y);
            o[8 * c + 4] = o[8 * c + 4] * sc + p * bflo(w.z); o[8 * c + 5] = o[8 * c + 5] * sc + p * bfhi(w.z); o[8 * c + 6] = o[8 * c + 6] * sc + p * bflo(w.w); o[8 * c + 7] = o[8 * c + 7] * sc + p * bfhi(w.w); }
    }
    const float il = 1.f / l;
    u32x4* op = (u32x4*)(X + qrow * XW + 1024 + hq * 64);
#pragma unroll
    for (int c = 0; c < 8; ++c) { u32x4 w; w.x = pk2(o[8 * c] * il, o[8 * c + 1] * il); w.y = pk2(o[8 * c + 2] * il, o[8 * c + 3] * il); w.z = pk2(o[8 * c + 4] * il, o[8 * c + 5] * il); w.w = pk2(o[8 * c + 6] * il, o[8 * c + 7] * il); op[c] = w; }
    __syncthreads();
}

__device__ __forceinline__ void kv_naive(LAS unsigned char* lds, const bf16_t* P, float* kv, int unit, const int tid) {
    const int b = unit >> 6, h = (unit >> 4) & 3, n = unit & 15;
    LAS float* kz = (LAS float*)lds; LAS float* vs = kz + 128 * 64;
    const size_t rowc = (size_t)b * SEQ + n * 128; const float lg = lg_gamma(h);
    for (int i = tid; i < 128 * 8; i += 512) { const int tok = i >> 3, ch = i & 7; const u32x4 w = *(const u32x4*)(P + (rowc + tok) * PW + 1024 + h * 64 + ch * 8); const float z = ex2((float)(127 - tok) * lg);
        LAS float* d = kz + tok * 64 + ch * 8; d[0] = bflo(w.x) * z; d[1] = bfhi(w.x) * z; d[2] = bflo(w.y) * z; d[3] = bfhi(w.y) * z; d[4] = bflo(w.z) * z; d[5] = bfhi(w.z) * z; d[6] = bflo(w.w) * z; d[7] = bfhi(w.w) * z; }
    for (int i = tid; i < 128 * 16; i += 512) { const int tok = i >> 4, ch = i & 15; const u32x4 w = *(const u32x4*)(P + (rowc + tok) * PW + 1280 + h * 128 + ch * 8);
        LAS float* d = vs + tok * 128 + ch * 8; d[0] = bflo(w.x); d[1] = bfhi(w.x); d[2] = bflo(w.y); d[3] = bfhi(w.y); d[4] = bflo(w.z); d[5] = bfhi(w.z); d[6] = bflo(w.w); d[7] = bfhi(w.w); }
    __syncthreads();
    const int e = tid & 127, d0 = (tid >> 7) * 16;
    float acc[16];
#pragma unroll
    for (int dd = 0; dd < 16; ++dd) acc[dd] = 0.f;
    for (int tok = 0; tok < 128; ++tok) { const float vv = vs[tok * 128 + e];
#pragma unroll
        for (int dd = 0; dd < 16; ++dd) acc[dd] += kz[tok * 64 + d0 + dd] * vv; }
#pragma unroll
    for (int dd = 0; dd < 16; ++dd) kv[((size_t)unit * 64 + d0 + dd) * 128 + e] = acc[dd];
    __syncthreads();
}

__device__ __forceinline__ void ret_naive(LAS unsigned char* lds, const bf16_t* P, const float* kv, bf16_t* X, int unit, const int tid) {
    const int b = unit >> 6, h = (unit >> 4) & 3, n = unit & 15;
    LAS float* St = (LAS float*)lds;
    LAS bf16_t* qs = (LAS bf16_t*)(lds + 32768);
    LAS bf16_t* ks = (LAS bf16_t*)(lds + 49152);
    LAS bf16_t* vs = (LAS bf16_t*)(lds + 65536);
    const size_t rowc = (size_t)b * SEQ + n * 128; const float lg = lg_gamma(h);
    { const int e = tid & 127, d0 = (tid >> 7) * 16; float s[16];
#pragma unroll
      for (int dd = 0; dd < 16; ++dd) s[dd] = 0.f;
      for (int j = 0; j < n; ++j) { const float w = ex2((float)((n - 1 - j) * 128) * lg); const float* kj = kv + ((size_t)(unit - n + j) * 64 + d0) * 128 + e;
#pragma unroll
          for (int dd = 0; dd < 16; ++dd) s[dd] += w * kj[dd * 128]; }
#pragma unroll
      for (int dd = 0; dd < 16; ++dd) St[(d0 + dd) * 128 + e] = s[dd]; }
    for (int i = tid; i < 128 * 8; i += 512) { const int tok = i >> 3, ch = i & 7; const bf16_t* src = P + (rowc + tok) * PW + h * 64 + ch * 8;
        *(LAS u32x4*)(qs + tok * 64 + ch * 8) = *(const u32x4*)(src + 768); *(LAS u32x4*)(ks + tok * 64 + ch * 8) = *(const u32x4*)(src + 1024); }
    for (int i = tid; i < 128 * 16; i += 512) { const int tok = i >> 4, ch = i & 15; *(LAS u32x4*)(vs + tok * 128 + ch * 8) = *(const u32x4*)(P + (rowc + tok) * PW + 1280 + h * 128 + ch * 8); }
    __syncthreads();
    const int r = tid >> 2, e0 = (tid & 3) * 32;
    float q[64], y[32];
    { const LAS u32x4* qp = (const LAS u32x4*)(qs + r * 64);
#pragma unroll
      for (int c = 0; c < 8; ++c) { const u32x4 w = qp[c]; q[8 * c] = bflo(w.x); q[8 * c + 1] = bfhi(w.x); q[8 * c + 2] = bflo(w.y); q[8 * c + 3] = bfhi(w.y); q[8 * c + 4] = bflo(w.z); q[8 * c + 5] = bfhi(w.z); q[8 * c + 6] = bflo(w.w); q[8 * c + 7] = bfhi(w.w); } }
#pragma unroll
    for (int ee = 0; ee < 32; ++ee) y[ee] = 0.f;
#pragma unroll 2
    for (int d = 0; d < 64; ++d) { const float qd = bf2f(qs[r * 64 + d]); const LAS f32x4* sp = (const LAS f32x4*)(St + d * 128 + e0);
#pragma unroll
        for (int c = 0; c < 8; ++c) { const f32x4 sv = sp[c]; y[4 * c] += qd * sv[0]; y[4 * c + 1] += qd * sv[1]; y[4 * c + 2] += qd * sv[2]; y[4 * c + 3] += qd * sv[3]; } }
    { const float xi = ex2((float)(r + 1) * lg);
#pragma unroll
      for (int ee = 0; ee < 32; ++ee) y[ee] *= xi; }
    const int rmax = (tid | 63) >> 2;
    for (int kk = 0; kk <= rmax; ++kk) {
        const LAS u32x4* kp = (const LAS u32x4*)(ks + kk * 64);
        float s = 0.f;
#pragma unroll
        for (int c = 0; c < 8; ++c) { const u32x4 w = kp[c];
            s += q[8 * c] * bflo(w.x) + q[8 * c + 1] * bfhi(w.x) + q[8 * c + 2] * bflo(w.y) + q[8 * c + 3] * bfhi(w.y) + q[8 * c + 4] * bflo(w.z) + q[8 * c + 5] * bfhi(w.z) + q[8 * c + 6] * bflo(w.w) + q[8 * c + 7] * bfhi(w.w); }
        const float aw = (kk <= r) ? s * ex2((float)(r - kk) * lg) : 0.f;
        const LAS u32x4* vp = (const LAS u32x4*)(vs + kk * 128 + e0);
#pragma unroll
        for (int c = 0; c < 4; ++c) { const u32x4 w = vp[c];
            y[8 * c] += aw * bflo(w.x); y[8 * c + 1] += aw * bfhi(w.x); y[8 * c + 2] += aw * bflo(w.y); y[8 * c + 3] += aw * bfhi(w.y); y[8 * c + 4] += aw * bflo(w.z); y[8 * c + 5] += aw * bfhi(w.z); y[8 * c + 6] += aw * bflo(w.w); y[8 * c + 7] += aw * bfhi(w.w); }
    }
    float sq = 0.f;
#pragma unroll
    for (int ee = 0; ee < 32; ++ee) sq += y[ee] * y[ee];
    sq += __shfl_xor(sq, 1); sq += __shfl_xor(sq, 2);
    const float rs = rsqrtf(sq * (1.f / 128.f) + EPS);
    const u32x4* gp = (const u32x4*)(P + (rowc + r) * PW + 1792 + h * 128 + e0);
    u32x4* op = (u32x4*)(X + (rowc + r) * XW + 1536 + h * 128 + e0);
#pragma unroll
    for (int c = 0; c < 4; ++c) { const u32x4 gw = gp[c]; u32x4 w;
        w.x = pk2(y[8 * c] * rs * bflo(gw.x), y[8 * c + 1] * rs * bfhi(gw.x)); w.y = pk2(y[8 * c + 2] * rs * bflo(gw.y), y[8 * c + 3] * rs * bfhi(gw.y));
        w.z = pk2(y[8 * c + 4] * rs * bflo(gw.z), y[8 * c + 5] * rs * bfhi(gw.z)); w.w = pk2(y[8 * c + 6] * rs * bflo(gw.w), y[8 * c + 7] * rs * bfhi(gw.w)); op[c] = w; }
    __syncthreads();
}

__device__ __forceinline__ void conv_all(const bf16_t* P, const float* cw, bf16_t* X, int G, const int tid) {
    const int gt = blockIdx.x * 512 + tid, NT = G * 512;
    for (int i = gt; i < M * 64; i += NT) {
        const int row = i >> 6, ch = i & 63, t = row & (SEQ - 1);
        const bf16_t* p = P + (size_t)row * PW + ch * 8;
        const u32x4 cb = *(const u32x4*)(p + 2304), u0 = *(const u32x4*)(p + 2816);
        u32x4 u1 = {0u, 0u, 0u, 0u}, u2 = {0u, 0u, 0u, 0u};
        if (t >= 1) u1 = *(const u32x4*)(p + 2816 - PW);
        if (t >= 2) u2 = *(const u32x4*)(p + 2816 - 2 * PW);
        const f32x4 w0a = *(const f32x4*)(cw + ch * 8), w0b = *(const f32x4*)(cw + ch * 8 + 4), w1a = *(const f32x4*)(cw + 512 + ch * 8), w1b = *(const f32x4*)(cw + 512 + ch * 8 + 4),
                    w2a = *(const f32x4*)(cw + 1024 + ch * 8), w2b = *(const f32x4*)(cw + 1024 + ch * 8 + 4);
        u32x4 o;
        o.x = pk2(bflo(cb.x) * (w0a[0] * bflo(u2.x) + w1a[0] * bflo(u1.x) + w2a[0] * bflo(u0.x)), bfhi(cb.x) * (w0a[1] * bfhi(u2.x) + w1a[1] * bfhi(u1.x) + w2a[1] * bfhi(u0.x)));
        o.y = pk2(bflo(cb.y) * (w0a[2] * bflo(u2.y) + w1a[2] * bflo(u1.y) + w2a[2] * bflo(u0.y)), bfhi(cb.y) * (w0a[3] * bfhi(u2.y) + w1a[3] * bfhi(u1.y) + w2a[3] * bfhi(u0.y)));
        o.z = pk2(bflo(cb.z) * (w0b[0] * bflo(u2.z) + w1b[0] * bflo(u1.z) + w2b[0] * bflo(u0.z)), bfhi(cb.z) * (w0b[1] * bfhi(u2.z) + w1b[1] * bfhi(u1.z) + w2b[1] * bfhi(u0.z)));
        o.w = pk2(bflo(cb.w) * (w0b[2] * bflo(u2.w) + w1b[2] * bflo(u1.w) + w2b[2] * bflo(u0.w)), bfhi(cb.w) * (w0b[3] * bfhi(u2.w) + w1b[3] * bfhi(u1.w) + w2b[3] * bfhi(u0.w)));
        *(u32x4*)(X + (size_t)row * XW + 2048 + ch * 8) = o;
    }
}

__device__ __forceinline__ void final_norm(float* H, const float* ss, const float* g, int G, const int tid) {
    const int lane = tid & 63, gw = blockIdx.x * 8 + (tid >> 6), NGW = G * 8;
    for (int row = gw; row < M; row += NGW) {
        const float rstd = pg8::row_rstd(ss, row);
        f32x4* hr = (f32x4*)(H + (size_t)row * DM) + lane; const f32x4* gr = (const f32x4*)g + lane;
#pragma unroll
        for (int j = 0; j < 4; ++j) hr[64 * j] = hr[64 * j] * rstd * gr[64 * j];
    }
}
#define XB_TMO      128
#define XB_XCNT(j)  (256  + 64 * (j))
#define XB_XSUB(j)  (1280 + 64 * (j))
#define XB_XGEN(j)  (2304 + 64 * (j))
#define XB_TOP      3328
#define XB_TOPGEN   3392
#define XCD_BAR_WORDS 3456
#define XB_SPIN_CAP (1u << 18)
__device__ __forceinline__ unsigned xb_ld(unsigned* p)              { return __hip_atomic_load(p, __ATOMIC_RELAXED, __HIP_MEMORY_SCOPE_AGENT); }
__device__ __forceinline__ unsigned xb_add(unsigned* p, unsigned v) { return __hip_atomic_fetch_add(p, v, __ATOMIC_RELAXED, __HIP_MEMORY_SCOPE_AGENT); }
__device__ __forceinline__ unsigned xb_xcc_id() { return (unsigned)__builtin_amdgcn_s_getreg((3 << 11) | 20) & 0xFu; }
#define XB_SPIN(cond, bar) do { unsigned _sp = 0; while (cond) { __builtin_amdgcn_s_sleep(1); \
    if ((++_sp & 255u) == 0u) { if (xb_ld(&(bar)[XB_TMO])) break; if (_sp > XB_SPIN_CAP) { atomicAdd(&(bar)[XB_TMO], 1u); break; } } } } while (0)
struct XcdBarrier { unsigned* bar; unsigned x; volatile LAS unsigned* st; };
__device__ __forceinline__ XcdBarrier xcd_barrier_post(unsigned* bar, volatile LAS unsigned* st) {
    XcdBarrier b; b.bar = bar; b.x = xb_xcc_id(); b.st = st;
    if (threadIdx.x == 0) (void)xb_add(&bar[XB_XCNT(b.x)], 1u);
    return b;
}
__device__ __forceinline__ void xcd_barrier_complete(unsigned* bar, unsigned x, unsigned& nloc, unsigned& nx) {
    const unsigned G = gridDim.x * gridDim.y * gridDim.z;
    unsigned sum, cnt, mine, sp = 0u;
    for (;;) {
        sum = 0u; cnt = 0u; mine = 0u;
#pragma unroll
        for (unsigned j = 0; j < 16; ++j) { const unsigned c = xb_ld(&bar[XB_XCNT(j)]); sum += c; cnt += (c > 0u) ? 1u : 0u; mine = (j == x) ? c : mine; }
        if (sum == G) break;
        __builtin_amdgcn_s_sleep(1);
        if ((++sp & 255u) == 0u) { if (xb_ld(&bar[XB_TMO])) break; if (sp > XB_SPIN_CAP) { atomicAdd(&bar[XB_TMO], 1u); break; } }
    }
    nloc = mine > 0u ? mine : 1u; nx = cnt > 0u ? cnt : 1u;
}
__device__ __forceinline__ void xcd_barrier(const XcdBarrier& b) {
    asm volatile("s_waitcnt vmcnt(0)" ::: "memory");
    __syncthreads();
    if (threadIdx.x == 0) {
        unsigned* bar = b.bar;
        __builtin_amdgcn_s_waitcnt(0);
        unsigned nloc = b.st[0], nx = b.st[1];
        if (nloc == 0u) { xcd_barrier_complete(bar, b.x, nloc, nx); b.st[0] = nloc; b.st[1] = nx; }
        const unsigned old = xb_add(&bar[XB_XSUB(b.x)], 1u);
        const unsigned gen = old / nloc;
        if (old + 1u == (gen + 1u) * nloc) {
            __builtin_amdgcn_fence(__ATOMIC_RELEASE, "agent");
            asm volatile("s_waitcnt vmcnt(0)" ::: "memory");
            const unsigned og = xb_add(&bar[XB_TOP], 1u);
            const unsigned tg = og / nx;
            if (og + 1u == (tg + 1u) * nx) xb_add(&bar[XB_TOPGEN], 1u);
            else XB_SPIN(xb_ld(&bar[XB_TOPGEN]) == tg, bar);
            __builtin_amdgcn_fence(__ATOMIC_ACQUIRE, "agent");
            xb_add(&bar[XB_XGEN(b.x)], 1u);
            asm volatile("s_waitcnt vmcnt(0)" ::: "memory");
        } else {
            XB_SPIN(xb_ld(&bar[XB_XGEN(b.x)]) == gen, bar);
            __builtin_amdgcn_fence(__ATOMIC_ACQUIRE, "agent");
            asm volatile("s_waitcnt vmcnt(0)" ::: "memory");
        }
    }
    __syncthreads();
}

constexpr int NPH = 30;
#ifndef PHM
#define PHM 0x1ff
#endif
__global__ void __launch_bounds__(512, 2) mk_fwd(Args a) {
    extern __shared__ __attribute__((aligned(16))) unsigned char lds_raw[];
    LAS unsigned char* lds = (LAS unsigned char*)lds_raw;
    const int G = gridDim.x, c = blockIdx.x;
    volatile LAS unsigned* MISC = (volatile LAS unsigned*)(lds + MISC_OFF);
    if (threadIdx.x < 32) MISC[threadIdx.x] = 0u;
    __syncthreads();
    unsigned* ctl = (unsigned*)(a.ws + WS_CTL);
    XcdBarrier bar; bar.bar = ctl + 4096; bar.x = 0; bar.st = nullptr;
    const bool multi = (a.ph_hi - a.ph_lo) > 1;
    if (multi) bar = xcd_barrier_post(ctl + 4096, MISC + 8);

    bf16_t* X = (bf16_t*)(a.ws + WS_X); bf16_t* P = (bf16_t*)(a.ws + WS_P); float* ss = (float*)(a.ws + WS_SS);
    float* kvb = (float*)(a.ws + WS_KV);
    for (int ph = a.ph_lo; ph < a.ph_hi; ++ph) {
        int tid = threadIdx.x; asm volatile("" : "+v"(tid));
        if (ph == 0) { if (PHM & 1) phase_prologue(a, lds, G, tid); }
        else if (ph == NPH - 1) { if (PHM & 2) final_norm(a.out, ss + (size_t)8 * M * 16, a.norm_final, G, tid); }
        else {
            const int l = (ph - 1) / 7, sub = (ph - 1) % 7;
            const char* Wl = (const char*)(a.ws + WS_W + (size_t)l * WL_SIZE);
            if (sub == 0 && (PHM & 4)) {
                pg8::SchedPlain S{(const char*)X, Wl + WL_IN, XW, DM, DM / 64, M / 256, NIN / 256, G, c, pg8::K_IN};
                pg8::EpiIn E{P, ss + (size_t)(2 * l) * M * 16, (const f32x4*)(a.ws + WS_TABA), (const f32x4*)(a.ws + WS_TABR)};
                pg8::gemm_phase(lds, XW, DM, S, E, tid);
            } else if (sub == 1 && (PHM & 8)) {
                for (int u = c; u < 256; u += G) attn_naive(lds, P, X, a.sinks + l * 8, u, tid);
                for (int u = c; u < 512; u += G) kv_naive(lds, P, kvb, u, tid);
                conv_all(P, a.conv_w + l * 3 * 512, X, G, tid);
            } else if (sub == 2 && (PHM & 16)) {
                for (int u = c; u < 512; u += G) ret_naive(lds, P, kvb, X, u, tid);
            } else if (sub == 3 && (PHM & 32)) {
                pg8::SchedC S{(const char*)X, Wl + WL_C, G, c};
                pg8::EpiC E{ss + (size_t)(2 * l) * M * 16, a.b_gate + l * 3 * DM, (u32x4*)(a.ws + WS_GS) + (size_t)c * 8192, (f32x4*)(a.ws + WS_MACC) + (size_t)c * 16384, (bf16_t*)(a.ws + WS_MB)};
                pg8::gemm_phase(lds, XW, KC, S, E, tid);
            } else if (sub == 4 && (PHM & 64)) {
                pg8::SchedPlain S{(const char*)(a.ws + WS_MB), Wl + WL_OUT, DM, DM, DM / 64, M / 256, DM / 256, G, c, pg8::K_RES};
                pg8::EpiRes E{l == 0 ? a.x : a.out, a.out, X, ss + (size_t)(2 * l + 1) * M * 16};
                pg8::gemm_phase(lds, DM, DM, S, E, tid);
            } else if (sub == 5 && (PHM & 128)) {
                pg8::SchedPlain S{(const char*)X, Wl + WL_GU, XW, DM, DM / 64, M / 256, NGU / 256, G, c, pg8::K_GU};
                pg8::EpiGU E{ss + (size_t)(2 * l + 1) * M * 16, (bf16_t*)(a.ws + WS_FF)};
                pg8::gemm_phase(lds, XW, DM, S, E, tid);
            } else if (sub == 6 && (PHM & 256)) {
                pg8::SchedPlain S{(const char*)(a.ws + WS_FF), Wl + WL_D, DFF, DFF, DFF / 64, M / 256, DM / 256, G, c, pg8::K_RES};
                pg8::EpiRes E{a.out, a.out, X, ss + (size_t)(2 * l + 2) * M * 16};
                pg8::gemm_phase(lds, DFF, DFF, S, E, tid);
            }
        }
        if (ph + 1 < a.ph_hi) xcd_barrier(bar);
    }
}

#ifndef MK_SINGLE
#define MK_SINGLE 0
#endif
extern "C" void kernel_launch(void* const* d_in, const int* in_sizes, int n_in, void* d_out, int out_size, void* d_ws, size_t ws_size, hipStream_t stream) {
    static int grid = 0;
    if (grid == 0) {
        if (n_in != 13 || out_size != M * DM || ws_size < WS_END) { fprintf(stderr, "kernel_launch: unexpected shapes (n_in %d, out %d, ws %zu)\n", n_in, out_size, ws_size); grid = -1; return; }
        int dev = 0, cus = 0, per_cu = 0;
        if (hipGetDevice(&dev) != hipSuccess || hipDeviceGetAttribute(&cus, hipDeviceAttributeMultiprocessorCount, dev) != hipSuccess) { grid = -1; return; }
        if (hipFuncSetAttribute((const void*)mk_fwd, hipFuncAttributeMaxDynamicSharedMemorySize, LDS_BYTES) != hipSuccess) { fprintf(stderr, "kernel_launch: hipFuncSetAttribute failed\n"); grid = -1; return; }
        if (hipOccupancyMaxActiveBlocksPerMultiprocessor(&per_cu, (const void*)mk_fwd, 512, LDS_BYTES) != hipSuccess || per_cu < 1) { fprintf(stderr, "kernel_launch: occupancy query says %d\n", per_cu); per_cu = 1; }
        (void)hipGetLastError();
        grid = cus;
        if (grid > 256) grid = 256;
    }
    if (grid < 0) return;
    (void)hipMemsetAsync((char*)d_ws + WS_CTL, 0, CTL_ZERO_BYTES, stream);
    Args a{};
    a.x = (const float*)d_in[0]; a.norm_mix = (const float*)d_in[1]; a.w_in = (const float*)d_in[2]; a.sinks = (const float*)d_in[3]; a.conv_w = (const float*)d_in[4];
    a.w_branch = (const float*)d_in[5]; a.b_gate = (const float*)d_in[6]; a.w_out = (const float*)d_in[7]; a.norm_ffn = (const float*)d_in[8];
    a.w_g = (const float*)d_in[9]; a.w_u = (const float*)d_in[10]; a.w_d = (const float*)d_in[11]; a.norm_final = (const float*)d_in[12];
    a.out = (float*)d_out; a.ws = (unsigned char*)d_ws;
#if MK_SINGLE
    a.ph_lo = 0; a.ph_hi = NPH;
    hipLaunchKernelGGL(mk_fwd, dim3(grid), dim3(512), LDS_BYTES, stream, a);
#else
    for (int ph = 0; ph < NPH; ++ph) { a.ph_lo = ph; a.ph_hi = ph + 1; hipLaunchKernelGGL(mk_fwd, dim3(grid), dim3(512), LDS_BYTES, stream, a); }
#endif
}
```

```cpp
#include <hip/hip_runtime.h>
#include <cstdio>
#include <cstdint>

#define LAS __attribute__((address_space(3)))
#define GAS __attribute__((address_space(1)))
typedef unsigned short bf16_t;
typedef short bf16x8 __attribute__((ext_vector_type(8)));
typedef float f32x4 __attribute__((ext_vector_type(4)));
typedef float f32x2 __attribute__((ext_vector_type(2)));
typedef unsigned u32x4 __attribute__((ext_vector_type(4)));
typedef unsigned u32x2 __attribute__((ext_vector_type(2)));
typedef __bf16 bf16x2_t __attribute__((ext_vector_type(2)));

constexpr int BATCH = 8, SEQ = 2048, DM = 1024, M = BATCH * SEQ, DEPTH = 4, DFF = 2816, DIN = 6912;
constexpr int PW = 3328;
constexpr int XW = 2560;
constexpr int NIN = 3840;
constexpr int NGU = 2 * DFF;
constexpr int KC = 1536;
constexpr float EPS = 1e-6f;
constexpr float LOG2E = 1.4426950408889634f;
constexpr float QSCALE = 0.18033688011112042f;

constexpr size_t MiB = 1u << 20;
constexpr size_t WS_CTL = 0, CTL_ZERO_BYTES = 65536;
constexpr size_t WS_SS = 376 * MiB;
constexpr size_t WS_TABA = 2 * MiB;
constexpr size_t WS_TABR = 2 * MiB + 131072;
constexpr size_t WS_W = 4 * MiB;
constexpr size_t WL_IN = 0, WL_C = 7864320, WL_OUT = 17301504, WL_GU = 19398656, WL_D = 30932992, WL_SIZE = 36700160;
constexpr size_t WS_X = 144 * MiB;
constexpr size_t WS_P = 224 * MiB;
constexpr size_t WS_MACC = WS_P, WS_MB = WS_P + 64 * MiB, WS_FF = WS_P;
constexpr size_t WS_GS = 328 * MiB;
constexpr size_t WS_KV = 360 * MiB;
constexpr size_t WS_END = 386 * MiB;
static_assert(WS_W + DEPTH * WL_SIZE <= WS_X, "weights");
static_assert((size_t)M * XW * 2 <= 80 * MiB && (size_t)M * PW * 2 <= 104 * MiB && (size_t)M * DFF * 2 <= 104 * MiB, "buffers");

constexpr int RING_BYTES = 131072, LDS_BYTES = 147456, MISC_OFF = RING_BYTES + 320;

__device__ __forceinline__ unsigned pk2(float lo, float hi) { f32x2 v = {lo, hi}; bf16x2_t b = __builtin_convertvector(v, bf16x2_t); return __builtin_bit_cast(unsigned, b); }
__device__ __forceinline__ float bflo(unsigned u) { return __uint_as_float(u << 16); }
__device__ __forceinline__ float bfhi(unsigned u) { return __uint_as_float(u & 0xffff0000u); }
__device__ __forceinline__ float bf2f(bf16_t b) { return __uint_as_float((unsigned)b << 16); }
__device__ __forceinline__ float fsilu(float x) { return x * __builtin_amdgcn_rcpf(1.f + __builtin_amdgcn_exp2f(-x * LOG2E)); }
__device__ __forceinline__ float fsigm(float x) { return __builtin_amdgcn_rcpf(1.f + __builtin_amdgcn_exp2f(-x * LOG2E)); }

struct Args {
    const float* x; const float* norm_mix; const float* w_in; const float* sinks; const float* conv_w; const float* w_branch; const float* b_gate; const float* w_out;
    const float* norm_ffn; const float* w_g; const float* w_u; const float* w_d; const float* norm_final;
    float* out; unsigned char* ws; int ph_lo, ph_hi;
};
#define MK_SINGLE 1
namespace pg8 {
constexpr int BM = 256, BK = 64, HALF = 128, HTB = HALF * BK * 2  , STAGE_BYTES = 8 * HTB, NXCD = 8, WGM = 8;

__host__ __device__ __forceinline__ int lds_byte(int r, int c) { const int st = (r >> 4) * 2 + (c >> 5), rr = r & 15, cc = c & 31, ob = rr * 64 + cc * 2; return st * 1024 + (ob ^ (((ob >> 9) & 1) << 5)); }
__host__ __device__ __forceinline__ void stage_rc(int b, int& R, int& C) { const int st = b / 1024, sb = b % 1024, swz = sb ^ (((sb >> 9) & 1) << 5); R = (st >> 1) * 16 + swz / 64; C = (st & 1) * 32 + (swz % 64) / 2; }
__host__ __device__ __forceinline__ int perm32(int rho) { const int n = rho >> 4, i = rho & 15; return 8 * (i >> 2) + 4 * n + (i & 3); }

struct Unit { const char* A; const char* B; int nt, pm, pn, kind, aux; };

__device__ __forceinline__ void tile_of(int L, int nM, int nN, int& pm, int& pn) {
    const int nwg = nM * nN; int wgid = L;
    { const int q = nwg / NXCD, r = nwg % NXCD, xcd = wgid % NXCD, off = wgid / NXCD; wgid = (xcd < r ? xcd * (q + 1) : r * (q + 1) + (xcd - r) * q) + off; }
    const int nig = WGM * nN, gid = wgid / nig, fm = gid * WGM, gsz = (nM - fm) < WGM ? (nM - fm) : WGM;
    pm = fm + ((wgid % nig) % gsz); pn = (wgid % nig) / gsz;
}

template <class Epi, class Sched>
__device__ __forceinline__ void gemm_phase(LAS unsigned char* lds, const int lda, const int ldb, const Sched& S, const Epi& E, const int tid) {
    const int wid = __builtin_amdgcn_readfirstlane(tid >> 6), lane = tid & 63, wr = wid >> 2, wc = wid & 3, fr = lane & 15, fq = lane >> 4;
    unsigned voffA[2], voffB[2];
#pragma unroll
    for (int i = 0; i < 2; ++i) { int R, C; stage_rc(tid * 16 + i * 8192, R, C); const int Rb = (R & ~31) + perm32(R & 31);
        voffA[i] = (unsigned)(R * lda + C) * 2u; voffB[i] = (unsigned)(Rb * ldb + C) * 2u; }
    const size_t kstep = (size_t)(BK * 2);
    const size_t hstepA = (size_t)HALF * lda * 2, hstepB = (size_t)HALF * ldb * 2;
    const unsigned ldsw = (unsigned)wid * 1024u;
    const int aoff = lds_byte(wr * 64 + fr, fq * 8), boff = lds_byte(wc * 32 + fr, fq * 8);
#define PG8_SA(b, h) (((b) * 2 + (h)) * HTB)
#define PG8_SB(b, h) ((4 + (b) * 2 + (h)) * HTB)
#define PG8_STAGE(bufoff, gbase, voff) do { _Pragma("unroll") for (int _i = 0; _i < 2; ++_i) \
        __builtin_amdgcn_global_load_lds((const unsigned*)((const char*)(gbase) + (voff)[_i]), (LAS unsigned*)(lds + (bufoff) + ldsw + _i * 8192), 16, 0, 0); } while (0)
#define PG8_LDA(dst, b, h) do { _Pragma("unroll") for (int m = 0; m < 4; ++m) _Pragma("unroll") for (int k = 0; k < 2; ++k) dst[m][k] = *(const LAS bf16x8*)(lds + PG8_SA(b, h) + aoff + m * 2048 + k * 1024); } while (0)
#define PG8_LDB(dst, b, h) do { _Pragma("unroll") for (int n = 0; n < 2; ++n) _Pragma("unroll") for (int k = 0; k < 2; ++k) dst[n][k] = *(const LAS bf16x8*)(lds + PG8_SB(b, h) + boff + n * 2048 + k * 1024); } while (0)
#define PG8_MMA(ai, bj, At, Bt) do { __builtin_amdgcn_s_setprio(1); _Pragma("unroll") for (int m = 0; m < 4; ++m) _Pragma("unroll") for (int n = 0; n < 2; ++n) _Pragma("unroll") for (int k = 0; k < 2; ++k) \
        acc[ai][bj][m][n] = __builtin_amdgcn_mfma_f32_16x16x32_bf16(Bt[n][k], At[m][k], acc[ai][bj][m][n], 0, 0, 0); __builtin_amdgcn_s_setprio(0); } while (0)
#define PG8_WAIT_V(n) asm volatile("s_waitcnt vmcnt(" #n ")" ::: "memory")
#define PG8_WAIT_L(n) asm volatile("s_waitcnt lgkmcnt(" #n ")" ::: "memory")
#define PG8_BAR __builtin_amdgcn_s_barrier()
#define PG8_SCHED __builtin_amdgcn_sched_barrier(0)
    Unit cur, nxt; int ui = 0;
    if (!S.next(0, cur)) return;
    f32x4 acc[2][2][4][2];
#pragma unroll
    for (int a = 0; a < 2; ++a)
#pragma unroll
        for (int b = 0; b < 2; ++b)
#pragma unroll
            for (int m = 0; m < 4; ++m)
#pragma unroll
                for (int n = 0; n < 2; ++n) acc[a][b][m][n] = (f32x4){0.f, 0.f, 0.f, 0.f};
    bf16x8 At[4][2], B0[2][2], B1[2][2];
    const char* cA = cur.A; const char* cB = cur.B;
    PG8_STAGE(PG8_SB(0, 0), cB, voffB); PG8_STAGE(PG8_SB(0, 1), cB + hstepB, voffB); PG8_STAGE(PG8_SA(0, 0), cA, voffA); PG8_STAGE(PG8_SA(0, 1), cA + hstepA, voffA);
    if (wr == 1) PG8_BAR;
    PG8_WAIT_V(2); PG8_BAR;
    PG8_STAGE(PG8_SB(1, 0), cB + kstep, voffB); PG8_STAGE(PG8_SA(1, 0), cA + kstep, voffA); PG8_STAGE(PG8_SB(1, 1), cB + hstepB + kstep, voffB);
    PG8_WAIT_V(6); PG8_BAR;
    for (;;) {
        const bool has_next = S.next(ui + 1, nxt);
        const char* nA = has_next ? nxt.A : cA; const char* nB = has_next ? nxt.B : cB;
        const int nt = cur.nt;
        for (int t = 0; t < nt; t += 2) {
            const bool last = (t == nt - 2);
            const char* a1 = cA + (size_t)(t + 1) * kstep;
            const char* a2 = last ? nA : cA + (size_t)(t + 2) * kstep; const char* b2 = last ? nB : cB + (size_t)(t + 2) * kstep;
            const char* a3 = a2 + kstep; const char* b3 = b2 + kstep;
            PG8_LDB(B0, 0, 0); PG8_LDB(B1, 0, 1); PG8_SCHED; PG8_LDA(At, 0, 0); PG8_STAGE(PG8_SA(1, 1), a1 + hstepA, voffA);
            PG8_WAIT_V(8); PG8_WAIT_L(0); PG8_BAR; PG8_MMA(0, 0, At, B0); PG8_MMA(0, 1, At, B1); PG8_BAR; PG8_SCHED;
            PG8_LDA(At, 0, 1); PG8_STAGE(PG8_SB(0, 0), b2, voffB); PG8_STAGE(PG8_SB(0, 1), b2 + hstepB, voffB); PG8_STAGE(PG8_SA(0, 0), a2, voffA);
            PG8_WAIT_V(8); PG8_WAIT_L(0); PG8_BAR; PG8_MMA(1, 0, At, B0); PG8_MMA(1, 1, At, B1); PG8_BAR; PG8_SCHED;
            PG8_LDB(B0, 1, 0); PG8_LDB(B1, 1, 1); PG8_SCHED; PG8_LDA(At, 1, 0); PG8_STAGE(PG8_SA(0, 1), a2 + hstepA, voffA);
            PG8_WAIT_V(8); PG8_WAIT_L(0); PG8_BAR; PG8_MMA(0, 0, At, B0); PG8_MMA(0, 1, At, B1); PG8_BAR; PG8_SCHED;
            PG8_LDA(At, 1, 1); PG8_STAGE(PG8_SB(1, 0), b3, voffB); PG8_STAGE(PG8_SB(1, 1), b3 + hstepB, voffB); PG8_STAGE(PG8_SA(1, 0), a3, voffA);
            PG8_WAIT_V(8); PG8_WAIT_L(0); PG8_BAR; PG8_MMA(1, 0, At, B0); PG8_MMA(1, 1, At, B1); PG8_BAR; PG8_SCHED;
        }
        if (wr == 0) PG8_BAR;
        E(acc, cur, wr, wc, fr, fq, tid);
        if (!has_next) break;
#pragma unroll
        for (int a = 0; a < 2; ++a)
#pragma unroll
            for (int b = 0; b < 2; ++b)
#pragma unroll
                for (int m = 0; m < 4; ++m)
#pragma unroll
                    for (int n = 0; n < 2; ++n) acc[a][b][m][n] = (f32x4){0.f, 0.f, 0.f, 0.f};
        cur = nxt; cA = nA; cB = nB; ++ui;
        if (wr == 1) PG8_BAR;
    }
    PG8_WAIT_V(0);
    PG8_BAR;
#undef PG8_SA
#undef PG8_SB
#undef PG8_STAGE
#undef PG8_LDA
#undef PG8_LDB
#undef PG8_MMA
#undef PG8_WAIT_V
#undef PG8_WAIT_L
#undef PG8_BAR
#undef PG8_SCHED
}
}
namespace pg8 {
#ifndef EPIC_TEST
#define EPIC_TEST(x) (x)
#endif
__device__ __forceinline__ float row_rstd(const float* ss, int row) {
    const f32x4* p = (const f32x4*)(ss + (size_t)row * 16); const f32x4 a = p[0], b = p[1], c = p[2], d = p[3];
    const float s = ((a[0] + a[1]) + (a[2] + a[3])) + ((b[0] + b[1]) + (b[2] + b[3])) + (((c[0] + c[1]) + (c[2] + c[3])) + ((d[0] + d[1]) + (d[2] + d[3])));
    return rsqrtf(s * (1.f / DM) + EPS);
}
enum { K_IN = 0, K_GATE = 1, K_BRANCH = 2, K_RES = 3, K_GU = 4 };

__device__ __forceinline__ f32x4 rot4(f32x4 v, f32x4 t) { return (f32x4){v[0] * t[0] - v[1] * t[1], v[1] * t[0] + v[0] * t[1], v[2] * t[2] - v[3] * t[3], v[3] * t[2] + v[2] * t[3]}; }

struct EpiIn {
    bf16_t* P; const float* ss; const f32x4* tabA; const f32x4* tabR;
    __device__ __forceinline__ void operator()(const f32x4 (&acc)[2][2][4][2], const Unit& u, int wr, int wc, int fr, int fq, int tid) const {
        asm volatile("" : "+v"(fr), "+v"(fq));
        const int pn = u.pn;
        const int cw = wc * 32 + 8 * fq;
        const int p0 = (wc & 1) * 32 + 8 * fq;
#pragma unroll
        for (int ai = 0; ai < 2; ++ai)
#pragma unroll
            for (int m = 0; m < 4; ++m) {
                const int row = u.pm * 256 + ai * 128 + wr * 64 + m * 16 + fr;
                const float rstd = row_rstd(ss, row);
                const int pos = row & (SEQ - 1);
#pragma unroll
                for (int bj = 0; bj < 2; ++bj) {
                    f32x4 v0 = acc[ai][bj][m][0] * rstd, v1 = acc[ai][bj][m][1] * rstd;
                    const int gc = pn * 256 + bj * 128 + cw;
                    if (pn >= 11) {
                        u32x2 w; w.x = pk2(v0[0] * v0[1], v0[2] * v0[3]); w.y = pk2(v1[0] * v1[1], v1[2] * v1[3]);
                        *(u32x2*)(P + (size_t)row * PW + 2816 + ((gc - 2816) >> 1)) = w;
                    } else {
                        if (pn < 2 || (pn == 2 && bj == 0)) {
                            if (p0 < 16) {
                                const f32x4 t0 = tabA[pos * 4 + (p0 >> 2)], t1 = tabA[pos * 4 + (p0 >> 2) + 1];
                                v0 = rot4(v0, t0); v1 = rot4(v1, t1);
                            }
                            if (pn < 2) { v0 = v0 * QSCALE; v1 = v1 * QSCALE; }
                        } else if (pn == 3 || pn == 4) {
                            const f32x4 t0 = tabR[pos * 16 + (p0 >> 2)], t1 = tabR[pos * 16 + (p0 >> 2) + 1];
                            v0 = rot4(v0, t0); v1 = rot4(v1, t1);
                            if (pn == 4) { v0 = v0 * 0.125f; v1 = v1 * 0.125f; }
                        } else if (pn == 7 || pn == 8) {
#pragma unroll
                            for (int j = 0; j < 4; ++j) { v0[j] = fsilu(v0[j]); v1[j] = fsilu(v1[j]); }
                        }
                        u32x4 w; w.x = pk2(v0[0], v0[1]); w.y = pk2(v0[2], v0[3]); w.z = pk2(v1[0], v1[1]); w.w = pk2(v1[2], v1[3]);
                        *(u32x4*)(P + (size_t)row * PW + gc) = w;
                    }
                }
            }
    }
};

struct EpiC {
    const float* ss; const float* bg; u32x4* Gs; f32x4* macc; bf16_t* mb;
    __device__ __forceinline__ void operator()(const f32x4 (&acc)[2][2][4][2], const Unit& u, int wr, int wc, int fr, int fq, int tid) const {
        asm volatile("" : "+v"(fr), "+v"(fq), "+v"(tid));
        const int cw = u.pn * 256 + wc * 32 + 8 * fq;
        if (EPIC_TEST(u.kind == K_GATE)) {
            const float* b = bg + u.aux * DM + cw;
#pragma unroll
            for (int ai = 0; ai < 2; ++ai)
#pragma unroll
                for (int m = 0; m < 4; ++m) {
                    const int row = u.pm * 256 + ai * 128 + wr * 64 + m * 16 + fr;
                    const float rstd = row_rstd(ss, row);
#pragma unroll
                    for (int bj = 0; bj < 2; ++bj) {
                        f32x4 v0 = acc[ai][bj][m][0] * rstd + *(const f32x4*)(b + bj * 128), v1 = acc[ai][bj][m][1] * rstd + *(const f32x4*)(b + bj * 128 + 4);
#pragma unroll
                        for (int j = 0; j < 4; ++j) { v0[j] = fsigm(v0[j]); v1[j] = fsigm(v1[j]); }
                        u32x4 w; w.x = pk2(v0[0], v0[1]); w.y = pk2(v0[2], v0[3]); w.z = pk2(v1[0], v1[1]); w.w = pk2(v1[2], v1[3]);
                        Gs[((ai * 4 + m) * 2 + bj) * 512 + tid] = w;
                    }
                    asm volatile("" ::: "memory");
                }
        } else {
            const int br = u.aux;
#pragma unroll
            for (int ai = 0; ai < 2; ++ai)
#pragma unroll
                for (int m = 0; m < 4; ++m) {
                    const int row = u.pm * 256 + ai * 128 + wr * 64 + m * 16 + fr;
#pragma unroll
                    for (int bj = 0; bj < 2; ++bj) {
                        const int idx = (ai * 4 + m) * 2 + bj;
                        const u32x4 g = Gs[idx * 512 + tid];
                        f32x4 v0 = acc[ai][bj][m][0] * (f32x4){bflo(g.x), bfhi(g.x), bflo(g.y), bfhi(g.y)};
                        f32x4 v1 = acc[ai][bj][m][1] * (f32x4){bflo(g.z), bfhi(g.z), bflo(g.w), bfhi(g.w)};
                        if (br > 0) { v0 = v0 + macc[(idx * 2) * 512 + tid]; v1 = v1 + macc[(idx * 2 + 1) * 512 + tid]; }
                        if (br < 2) { macc[(idx * 2) * 512 + tid] = v0; macc[(idx * 2 + 1) * 512 + tid] = v1; }
                        else { u32x4 w; w.x = pk2(v0[0], v0[1]); w.y = pk2(v0[2], v0[3]); w.z = pk2(v1[0], v1[1]); w.w = pk2(v1[2], v1[3]);
                               *(u32x4*)(mb + (size_t)row * DM + bj * 128 + cw) = w; }
                    }
                    asm volatile("" ::: "memory");
                }
        }
    }
};

struct EpiRes {
    const float* rin; float* H; bf16_t* hb; float* ssout;
    __device__ __forceinline__ void operator()(const f32x4 (&acc)[2][2][4][2], const Unit& u, int wr, int wc, int fr, int fq, int tid) const {
        asm volatile("" : "+v"(fr), "+v"(fq));
        const int cw = u.pn * 256 + wc * 32 + 8 * fq;
#pragma unroll
        for (int ai = 0; ai < 2; ++ai)
#pragma unroll
            for (int m = 0; m < 4; ++m) {
                const int row = u.pm * 256 + ai * 128 + wr * 64 + m * 16 + fr;
                float s = 0.f;
#pragma unroll
                for (int bj = 0; bj < 2; ++bj) {
                    const size_t o = (size_t)row * DM + bj * 128 + cw;
                    const f32x4 v0 = acc[ai][bj][m][0] + *(const f32x4*)(rin + o), v1 = acc[ai][bj][m][1] + *(const f32x4*)(rin + o + 4);
                    *(f32x4*)(H + o) = v0; *(f32x4*)(H + o + 4) = v1;
                    u32x4 w; w.x = pk2(v0[0], v0[1]); w.y = pk2(v0[2], v0[3]); w.z = pk2(v1[0], v1[1]); w.w = pk2(v1[2], v1[3]);
                    *(u32x4*)(hb + (size_t)row * XW + bj * 128 + cw) = w;
                    s += (v0[0] * v0[0] + v0[1] * v0[1]) + (v0[2] * v0[2] + v0[3] * v0[3]) + (v1[0] * v1[0] + v1[1] * v1[1]) + (v1[2] * v1[2] + v1[3] * v1[3]);
                }
                s += __shfl_xor(s, 16); s += __shfl_xor(s, 32);
                if (fq == 0) ssout[(size_t)row * 16 + u.pn * 4 + wc] = s;
            }
    }
};

struct EpiGU {
    const float* ss; bf16_t* ff;
    __device__ __forceinline__ void operator()(const f32x4 (&acc)[2][2][4][2], const Unit& u, int wr, int wc, int fr, int fq, int tid) const {
        asm volatile("" : "+v"(fr), "+v"(fq));
        const int cj = u.pn * 128 + wc * 16 + 4 * fq;
#pragma unroll
        for (int ai = 0; ai < 2; ++ai)
#pragma unroll
            for (int m = 0; m < 4; ++m) {
                const int row = u.pm * 256 + ai * 128 + wr * 64 + m * 16 + fr;
                const float rstd = row_rstd(ss, row);
#pragma unroll
                for (int bj = 0; bj < 2; ++bj) {
                    const f32x4 v0 = acc[ai][bj][m][0] * rstd, v1 = acc[ai][bj][m][1] * rstd;
                    u32x2 w; w.x = pk2(fsilu(v0[0]) * v0[1], fsilu(v0[2]) * v0[3]); w.y = pk2(fsilu(v1[0]) * v1[1], fsilu(v1[2]) * v1[3]);
                    *(u32x2*)(ff + (size_t)row * DFF + bj * 64 + cj) = w;
                }
            }
    }
};

struct SchedPlain {
    const char* A; const char* B; int lda, ldb, nt, nM, nN, G, c, kind;
    __device__ __forceinline__ bool next(int i, Unit& u) const {
        const int L = i * G + c; if (L >= nM * nN) return false;
        tile_of(L, nM, nN, u.pm, u.pn);
        u.A = A + (size_t)u.pm * 256 * lda * 2; u.B = B + (size_t)u.pn * 256 * ldb * 2; u.nt = nt; u.kind = kind; u.aux = 0; return true;
    }
};
struct SchedC {
    const char* X; const char* Wc; int G, c;
    __device__ __forceinline__ bool next(int i, Unit& u) const {
        const int j = i / 6, sub = i - 6 * j, L = j * G + c; if (L >= 64 * 4) return false;
        tile_of(L, 64, 4, u.pm, u.pn);
        const int br = sub >> 1; const bool gate = !(sub & 1);
        u.A = X + (size_t)u.pm * 256 * XW * 2 + (gate ? 0 : (1024 + 512 * br) * 2);
        u.B = Wc + (size_t)br * (1024 * KC * 2) + (size_t)u.pn * 256 * KC * 2 + (gate ? 0 : 1024 * 2);
        u.nt = gate ? 16 : 8; u.kind = gate ? K_GATE : K_BRANCH; u.aux = br; return true;
    }
};
}
__device__ const double INV_A[8] = {0.15915494309189535, 0.03086376340470123, 0.005985185712713705, 0.001160663641240061, 0.00022507907903927653, 4.364795279280289e-05, 8.464330808241401e-06, 1.6414262627950345e-06};
__device__ const double INV_R[32] = {0.15915494309189535, 0.11934937021124886, 0.08949940160889101, 0.06711508300522726, 0.050329212104487035, 0.03774158471741977, 0.0283021958306234, 0.02122365276477766,
    0.015915494309189534, 0.011934937021124886, 0.008949940160889102, 0.006711508300522725, 0.005032921210448704, 0.003774158471741977, 0.00283021958306234, 0.0021223652764777662,
    0.0015915494309189536, 0.0011934937021124885, 0.0008949940160889102, 0.0006711508300522726, 0.0005032921210448703, 0.00037741584717419774, 0.00028302195830623395, 0.0002122365276477766,
    0.00015915494309189535, 0.00011934937021124886, 8.949940160889102e-05, 6.711508300522725e-05, 5.0329212104487035e-05, 3.774158471741978e-05, 2.8302195830623396e-05, 2.122365276477766e-05};
__device__ __forceinline__ float lg_gamma(int h) { return h == 0 ? -0.04580368961312479f : h == 1 ? -0.02272007650008353f : h == 2 ? -0.011315313227834146f : -0.005646563141142062f; }
__device__ __forceinline__ float ex2(float x) { return __builtin_amdgcn_exp2f(x); }
__device__ __forceinline__ float wave_sum(float v) {
#pragma unroll
    for (int o = 1; o < 64; o <<= 1) v += __shfl_xor(v, o);
    return v;
}
#define LDS_WAIT() asm volatile("s_waitcnt lgkmcnt(0)" ::: "memory")

__device__ __forceinline__ int src_in(int n) {
    if (n < 640) { const int p = n & 63; return (p < 16) ? (n & ~63) + ((p & 1) ? 8 + (p >> 1) : (p >> 1)) : n; }
    if (n < 768) return n;
    if (n < 1280) { const int p = n & 63; return (n & ~63) + ((p & 1) ? 32 + (p >> 1) : (p >> 1)); }
    if (n < 2816) return n;
    const int j = (n - 2816) >> 1; return (n & 1) ? 3328 + j : 2816 + j;
}
__device__ __forceinline__ void cvt_item(const float* wcol, size_t ldw, const float* scale, bf16_t* dst, int ld, int k0, LAS float* scr, int lane) {
#pragma unroll 8
    for (int i = 0; i < 32; ++i) { const int kk = 2 * i + (lane >> 5); float v = wcol[(size_t)(k0 + kk) * ldw]; if (scale) v *= scale[k0 + kk]; scr[kk * 33 + (lane & 31)] = v; }
    LDS_WAIT(); asm volatile("" ::: "memory");
    const int c = lane & 7;
#pragma unroll
    for (int j = 0; j < 4; ++j) { const int n = (lane >> 3) + 8 * j; const LAS float* s = scr + (8 * c) * 33 + n;
        u32x4 o; o.x = pk2(s[0 * 33], s[1 * 33]); o.y = pk2(s[2 * 33], s[3 * 33]); o.z = pk2(s[4 * 33], s[5 * 33]); o.w = pk2(s[6 * 33], s[7 * 33]);
        *(u32x4*)(dst + (size_t)n * ld + k0 + 8 * c) = o; }
    LDS_WAIT(); asm volatile("" ::: "memory");
}
constexpr int CV_J0 = 1920, CV_J1 = 1536, CV_J2 = 768, CV_J3 = 512, CV_J4 = 2816, CV_J5 = 1408, CV_PER_LAYER = CV_J0 + CV_J1 + CV_J2 + CV_J3 + CV_J4 + CV_J5;
__device__ __forceinline__ void phase_prologue(const Args& a, LAS unsigned char* lds, int G, const int tid) {
    const int lane = tid & 63, wave = tid >> 6;
    const int gw = blockIdx.x * 8 + wave, NGW = G * 8;
    LAS float* scr = (LAS float*)(lds + wave * 16384);
    const int ln = lane & 31;
    for (int it = gw; it < DEPTH * CV_PER_LAYER; it += NGW) {
        const int l = it / CV_PER_LAYER; int r = it - l * CV_PER_LAYER;
        bf16_t* Wl = (bf16_t*)(a.ws + WS_W + (size_t)l * WL_SIZE);
        if (r < CV_J0) { const int kb = r / 120, nb = r % 120, n = nb * 32 + ln;
            cvt_item(a.w_in + (size_t)l * DM * DIN + src_in(n), DIN, a.norm_mix + l * DM, Wl + WL_IN / 2 + (size_t)nb * 32 * DM, DM, kb * 64, scr, lane); continue; } r -= CV_J0;
        if (r < CV_J1) { const int kb = r / 96, nb = r % 96, n = nb * 32 + ln;
            cvt_item(a.w_in + (size_t)l * DM * DIN + 3840 + n, DIN, a.norm_mix + l * DM, Wl + WL_C / 2 + (size_t)nb * 32 * KC, KC, kb * 64, scr, lane); continue; } r -= CV_J1;
        if (r < CV_J2) { const int kb = r / 96, nb = r % 96, n = nb * 32 + ln, i = n >> 10;
            cvt_item(a.w_branch + ((size_t)(l * 3 + i) * 512) * DM + (n & 1023), DM, nullptr, Wl + WL_C / 2 + (size_t)nb * 32 * KC + 1024, KC, kb * 64, scr, lane); continue; } r -= CV_J2;
        if (r < CV_J3) { const int kb = r / 32, nb = r % 32, n = nb * 32 + ln;
            cvt_item(a.w_out + (size_t)l * DM * DM + n, DM, nullptr, Wl + WL_OUT / 2 + (size_t)nb * 32 * DM, DM, kb * 64, scr, lane); continue; } r -= CV_J3;
        if (r < CV_J4) { const int kb = r / 176, nb = r % 176, n = nb * 32 + ln;
            cvt_item(((n & 1) ? a.w_u : a.w_g) + (size_t)l * DM * DFF + (n >> 1), DFF, a.norm_ffn + l * DM, Wl + WL_GU / 2 + (size_t)nb * 32 * DM, DM, kb * 64, scr, lane); continue; } r -= CV_J4;
        { const int kb = r / 32, nb = r % 32, n = nb * 32 + ln;
            cvt_item(a.w_d + (size_t)l * DFF * DM + n, DM, nullptr, Wl + WL_D / 2 + (size_t)nb * 32 * DFF, DFF, kb * 64, scr, lane); }
    }
    bf16_t* X = (bf16_t*)(a.ws + WS_X); float* ss = (float*)(a.ws + WS_SS);
    for (int row = gw; row < M; row += NGW) {
        const f32x4* xr = (const f32x4*)(a.x + (size_t)row * DM) + lane; float s = 0.f;
#pragma unroll
        for (int j = 0; j < 4; ++j) { const f32x4 v = xr[64 * j]; s += (v[0] * v[0] + v[1] * v[1]) + (v[2] * v[2] + v[3] * v[3]);
            u32x2 w; w.x = pk2(v[0], v[1]); w.y = pk2(v[2], v[3]); *(u32x2*)(X + (size_t)row * XW + (64 * j + lane) * 4) = w; }
        s = wave_sum(s); if (lane < 16) ss[(size_t)row * 16 + lane] = (lane == 0) ? s : 0.f;
    }
    const int gt = blockIdx.x * 512 + tid, NT = G * 512;
    f32x2* tabA = (f32x2*)(a.ws + WS_TABA); f32x2* tabR = (f32x2*)(a.ws + WS_TABR);
    for (int i = gt; i < SEQ * 8; i += NT) { double rev = (double)(i >> 3) * INV_A[i & 7]; rev -= __builtin_floor(rev); const float r = (float)rev; tabA[i] = (f32x2){__builtin_amdgcn_cosf(r), __builtin_amdgcn_sinf(r)}; }
    for (int i = gt; i < SEQ * 32; i += NT) { double rev = (double)(i >> 5) * INV_R[i & 31]; rev -= __builtin_floor(rev); const float r = (float)rev; tabR[i] = (f32x2){__builtin_amdgcn_cosf(r), __builtin_amdgcn_sinf(r)}; }
}

__device__ __forceinline__ void attn_naive(LAS unsigned char* lds, const bf16_t* P, bf16_t* X, const float* sinks, int unit, const int tid) {
    const int b = unit >> 5, n = (unit >> 1) & 15, g = unit & 1;
    LAS bf16_t* Ks = (LAS bf16_t*)lds; LAS bf16_t* Vs = Ks + 256 * 72;
    const long row0 = (long)b * SEQ + n * 128 - 128;
    for (int c = tid; c < 2048; c += 512) {
        const int key = c >> 3, ch = c & 7; u32x4 kv = {0u, 0u, 0u, 0u}, vv = {0u, 0u, 0u, 0u};
        if (n > 0 || key >= 128) { const bf16_t* src = P + (size_t)(row0 + key) * PW + g * 64 + ch * 8; kv = *(const u32x4*)(src + 512); vv = *(const u32x4*)(src + 640); }
        *(LAS u32x4*)(Ks + key * 72 + ch * 8) = kv; *(LAS u32x4*)(Vs + key * 72 + ch * 8) = vv;
    }
    __syncthreads();
    const int r = tid & 127, hq = g * 4 + (tid >> 7);
    const size_t qrow = (size_t)b * SEQ + n * 128 + r;
    float q[64], o[64];
    { const u32x4* qp = (const u32x4*)(P + qrow * PW + hq * 64);
#pragma unroll
      for (int c = 0; c < 8; ++c) { const u32x4 w = qp[c]; q[8 * c] = bflo(w.x); q[8 * c + 1] = bfhi(w.x); q[8 * c + 2] = bflo(w.y); q[8 * c + 3] = bfhi(w.y); q[8 * c + 4] = bflo(w.z); q[8 * c + 5] = bfhi(w.z); q[8 * c + 6] = bflo(w.w); q[8 * c + 7] = bfhi(w.w); } }
#pragma unroll
    for (int d = 0; d < 64; ++d) o[d] = 0.f;
    float mx = sinks[hq] * LOG2E, l = 1.f;
    for (int j = 0; j < 128; ++j) {
        const int kt = r + 1 + j; const bool valid = (n > 0) || (kt >= 128);
        const LAS u32x4* kp = (const LAS u32x4*)(Ks + kt * 72);
        float s = 0.f;
#pragma unroll
        for (int c = 0; c < 8; ++c) { const u32x4 w = kp[c];
            s += q[8 * c] * bflo(w.x) + q[8 * c + 1] * bfhi(w.x) + q[8 * c + 2] * bflo(w.y) + q[8 * c + 3] * bfhi(w.y) + q[8 * c + 4] * bflo(w.z) + q[8 * c + 5] * bfhi(w.z) + q[8 * c + 6] * bflo(w.w) + q[8 * c + 7] * bfhi(w.w); }
        s = valid ? s : -INFINITY;
        const float mn = fmaxf(mx, s), sc = ex2(mx - mn), p = ex2(s - mn);
        l = l * sc + p; mx = mn;
        const LAS u32x4* vp = (const LAS u32x4*)(Vs + kt * 72);
#pragma unroll
        for (int c = 0; c < 8; ++c) { const u32x4 w = vp[c];
            o[8 * c] = o[8 * c] * sc + p * bflo(w.x); o[8 * c + 1] = o[8 * c + 1] * sc + p * bfhi(w.x); o[8 * c + 2] = o[8 * c + 2] * sc + p * bflo(w.y); o[8 * c + 3] = o[8 * c + 3] * sc + p * bfhi(w.y);
            o[8 * c + 4] = o[8 * c + 4] * sc + p * bflo(w.z); o[8 * c + 5] = o[8 * c + 5] * sc + p * bfhi(w.z); o[8 * c + 6] = o[8 * c + 6] * sc + p * bflo(w.w); o[8 * c + 7] = o[8 * c + 7] * sc + p * bfhi(w.w); }
    }
    const float il = 1.f / l;
    u32x4* op = (u32x4*)(X + qrow * XW + 1024 + hq * 64);
#pragma unroll
    for (int c = 0; c < 8; ++c) { u32x4 w; w.x = pk2(o[8 * c] * il, o[8 * c + 1] * il); w.y = pk2(o[8 * c + 2] * il, o[8 * c + 3] * il); w.z = pk2(o[8 * c + 4] * il, o[8 * c + 5] * il); w.w = pk2(o[8 * c + 6] * il, o[8 * c + 7] * il); op[c] = w; }
    __syncthreads();
}

__device__ __forceinline__ void kv_naive(LAS unsigned char* lds, const bf16_t* P, float* kv, int unit, const int tid) {
    const int b = unit >> 6, h = (unit >> 4) & 3, n = unit & 15;
    LAS float* kz = (LAS float*)lds; LAS float* vs = kz + 128 * 64;
    const size_t rowc = (size_t)b * SEQ + n * 128; const float lg = lg_gamma(h);
    for (int i = tid; i < 128 * 8; i += 512) { const int tok = i >> 3, ch = i & 7; const u32x4 w = *(const u32x4*)(P + (rowc + tok) * PW + 1024 + h * 64 + ch * 8); const float z = ex2((float)(127 - tok) * lg);
        LAS float* d = kz + tok * 64 + ch * 8; d[0] = bflo(w.x) * z; d[1] = bfhi(w.x) * z; d[2] = bflo(w.y) * z; d[3] = bfhi(w.y) * z; d[4] = bflo(w.z) * z; d[5] = bfhi(w.z) * z; d[6] = bflo(w.w) * z; d[7] = bfhi(w.w) * z; }
    for (int i = tid; i < 128 * 16; i += 512) { const int tok = i >> 4, ch = i & 15; const u32x4 w = *(const u32x4*)(P + (rowc + tok) * PW + 1280 + h * 128 + ch * 8);
        LAS float* d = vs + tok * 128 + ch * 8; d[0] = bflo(w.x); d[1] = bfhi(w.x); d[2] = bflo(w.y); d[3] = bfhi(w.y); d[4] = bflo(w.z); d[5] = bfhi(w.z); d[6] = bflo(w.w); d[7] = bfhi(w.w); }
    __syncthreads();
    const int e = tid & 127, d0 = (tid >> 7) * 16;
    float acc[16];
#pragma unroll
    for (int dd = 0; dd < 16; ++dd) acc[dd] = 0.f;
    for (int tok = 0; tok < 128; ++tok) { const float vv = vs[tok * 128 + e];
#pragma unroll
        for (int dd = 0; dd < 16; ++dd) acc[dd] += kz[tok * 64 + d0 + dd] * vv; }
#pragma unroll
    for (int dd = 0; dd < 16; ++dd) kv[((size_t)unit * 64 + d0 + dd) * 128 + e] = acc[dd];
    __syncthreads();
}

__device__ __forceinline__ void ret_naive(LAS unsigned char* lds, const bf16_t* P, const float* kv, bf16_t* X, int unit, const int tid) {
    const int b = unit >> 6, h = (unit >> 4) & 3, n = unit & 15;
    LAS float* St = (LAS float*)lds;
    LAS bf16_t* qs = (LAS bf16_t*)(lds + 32768);
    LAS bf16_t* ks = (LAS bf16_t*)(lds + 49152);
    LAS bf16_t* vs = (LAS bf16_t*)(lds + 65536);
    const size_t rowc = (size_t)b * SEQ + n * 128; const float lg = lg_gamma(h);
    { const int e = tid & 127, d0 = (tid >> 7) * 16; float s[16];
#pragma unroll
      for (int dd = 0; dd < 16; ++dd) s[dd] = 0.f;
      for (int j = 0; j < n; ++j) { const float w = ex2((float)((n - 1 - j) * 128) * lg); const float* kj = kv + ((size_t)(unit - n + j) * 64 + d0) * 128 + e;
#pragma unroll
          for (int dd = 0; dd < 16; ++dd) s[dd] += w * kj[dd * 128]; }
#pragma unroll
      for (int dd = 0; dd < 16; ++dd) St[(d0 + dd) * 128 + e] = s[dd]; }
    for (int i = tid; i < 128 * 8; i += 512) { const int tok = i >> 3, ch = i & 7; const bf16_t* src = P + (rowc + tok) * PW + h * 64 + ch * 8;
        *(LAS u32x4*)(qs + tok * 64 + ch * 8) = *(const u32x4*)(src + 768); *(LAS u32x4*)(ks + tok * 64 + ch * 8) = *(const u32x4*)(src + 1024); }
    for (int i = tid; i < 128 * 16; i += 512) { const int tok = i >> 4, ch = i & 15; *(LAS u32x4*)(vs + tok * 128 + ch * 8) = *(const u32x4*)(P + (rowc + tok) * PW + 1280 + h * 128 + ch * 8); }
    __syncthreads();
    const int r = tid >> 2, e0 = (tid & 3) * 32;
    float q[64], y[32];
    { const LAS u32x4* qp = (const LAS u32x4*)(qs + r * 64);
#pragma unroll
      for (int c = 0; c < 8; ++c) { const u32x4 w = qp[c]; q[8 * c] = bflo(w.x); q[8 * c + 1] = bfhi(w.x); q[8 * c + 2] = bflo(w.y); q[8 * c + 3] = bfhi(w.y); q[8 * c + 4] = bflo(w.z); q[8 * c + 5] = bfhi(w.z); q[8 * c + 6] = bflo(w.w); q[8 * c + 7] = bfhi(w.w); } }
#pragma unroll
    for (int ee = 0; ee < 32; ++ee) y[ee] = 0.f;
#pragma unroll 2
    for (int d = 0; d < 64; ++d) { const float qd = bf2f(qs[r * 64 + d]); const LAS f32x4* sp = (const LAS f32x4*)(St + d * 128 + e0);
#pragma unroll
        for (int c = 0; c < 8; ++c) { const f32x4 sv = sp[c]; y[4 * c] += qd * sv[0]; y[4 * c + 1] += qd * sv[1]; y[4 * c + 2] += qd * sv[2]; y[4 * c + 3] += qd * sv[3]; } }
    { const float xi = ex2((float)(r + 1) * lg);
#pragma unroll
      for (int ee = 0; ee < 32; ++ee) y[ee] *= xi; }
    const int rmax = (tid | 63) >> 2;
    for (int kk = 0; kk <= rmax; ++kk) {
        const LAS u32x4* kp = (const LAS u32x4*)(ks + kk * 64);
        float s = 0.f;
#pragma unroll
        for (int c = 0; c < 8; ++c) { const u32x4 w = kp[c];
            s += q[8 * c] * bflo(w.x) + q[8 * c + 1] * bfhi(w.x) + q[8 * c + 2] * bflo(w.y) + q[8 * c + 3] * bfhi(w.y) + q[8 * c + 4] * bflo(w.z) + q[8 * c + 5] * bfhi(w.z) + q[8 * c + 6] * bflo(w.w) + q[8 * c + 7] * bfhi(w.w); }
        const float aw = (kk <= r) ? s * ex2((float)(r - kk) * lg) : 0.f;
        const LAS u32x4* vp = (const LAS u32x4*)(vs + kk * 128 + e0);
#pragma unroll
        for (int c = 0; c < 4; ++c) { const u32x4 w = vp[c];
            y[8 * c] += aw * bflo(w.x); y[8 * c + 1] += aw * bfhi(w.x); y[8 * c + 2] += aw * bflo(w.y); y[8 * c + 3] += aw * bfhi(w.y); y[8 * c + 4] += aw * bflo(w.z); y[8 * c + 5] += aw * bfhi(w.z); y[8 * c + 6] += aw * bflo(w.w); y[8 * c + 7] += aw * bfhi(w.w); }
    }
    float sq = 0.f;
#pragma unroll
    for (int ee = 0; ee < 32; ++ee) sq += y[ee] * y[ee];
    sq += __shfl_xor(sq, 1); sq += __shfl_xor(sq, 2);
    const float rs = rsqrtf(sq * (1.f / 128.f) + EPS);
    const u32x4* gp = (const u32x4*)(P + (rowc + r) * PW + 1792 + h * 128 + e0);
    u32x4* op = (u32x4*)(X + (rowc + r) * XW + 1536 + h * 128 + e0);
#pragma unroll
    for (int c = 0; c < 4; ++c) { const u32x4 gw = gp[c]; u32x4 w;
        w.x = pk2(y[8 * c] * rs * bflo(gw.x), y[8 * c + 1] * rs * bfhi(gw.x)); w.y = pk2(y[8 * c + 2] * rs * bflo(gw.y), y[8 * c + 3] * rs * bfhi(gw.y));
        w.z = pk2(y[8 * c + 4] * rs * bflo(gw.z), y[8 * c + 5] * rs * bfhi(gw.z)); w.w = pk2(y[8 * c + 6] * rs * bflo(gw.w), y[8 * c + 7] * rs * bfhi(gw.w)); op[c] = w; }
    __syncthreads();
}

__device__ __forceinline__ void conv_all(const bf16_t* P, const float* cw, bf16_t* X, int G, const int tid) {
    const int gt = blockIdx.x * 512 + tid, NT = G * 512;
    for (int i = gt; i < M * 64; i += NT) {
        const int row = i >> 6, ch = i & 63, t = row & (SEQ - 1);
        const bf16_t* p = P + (size_t)row * PW + ch * 8;
        const u32x4 cb = *(const u32x4*)(p + 2304), u0 = *(const u32x4*)(p + 2816);
        u32x4 u1 = {0u, 0u, 0u, 0u}, u2 = {0u, 0u, 0u, 0u};
        if (t >= 1) u1 = *(const u32x4*)(p + 2816 - PW);
        if (t >= 2) u2 = *(const u32x4*)(p + 2816 - 2 * PW);
        const f32x4 w0a = *(const f32x4*)(cw + ch * 8), w0b = *(const f32x4*)(cw + ch * 8 + 4), w1a = *(const f32x4*)(cw + 512 + ch * 8), w1b = *(const f32x4*)(cw + 512 + ch * 8 + 4),
                    w2a = *(const f32x4*)(cw + 1024 + ch * 8), w2b = *(const f32x4*)(cw + 1024 + ch * 8 + 4);
        u32x4 o;
        o.x = pk2(bflo(cb.x) * (w0a[0] * bflo(u2.x) + w1a[0] * bflo(u1.x) + w2a[0] * bflo(u0.x)), bfhi(cb.x) * (w0a[1] * bfhi(u2.x) + w1a[1] * bfhi(u1.x) + w2a[1] * bfhi(u0.x)));
        o.y = pk2(bflo(cb.y) * (w0a[2] * bflo(u2.y) + w1a[2] * bflo(u1.y) + w2a[2] * bflo(u0.y)), bfhi(cb.y) * (w0a[3] * bfhi(u2.y) + w1a[3] * bfhi(u1.y) + w2a[3] * bfhi(u0.y)));
        o.z = pk2(bflo(cb.z) * (w0b[0] * bflo(u2.z) + w1b[0] * bflo(u1.z) + w2b[0] * bflo(u0.z)), bfhi(cb.z) * (w0b[1] * bfhi(u2.z) + w1b[1] * bfhi(u1.z) + w2b[1] * bfhi(u0.z)));
        o.w = pk2(bflo(cb.w) * (w0b[2] * bflo(u2.w) + w1b[2] * bflo(u1.w) + w2b[2] * bflo(u0.w)), bfhi(cb.w) * (w0b[3] * bfhi(u2.w) + w1b[3] * bfhi(u1.w) + w2b[3] * bfhi(u0.w)));
        *(u32x4*)(X + (size_t)row * XW + 2048 + ch * 8) = o;
    }
}

__device__ __forceinline__ void final_norm(float* H, const float* ss, const float* g, int G, const int tid) {
    const int lane = tid & 63, gw = blockIdx.x * 8 + (tid >> 6), NGW = G * 8;
    for (int row = gw; row < M; row += NGW) {
        const float rstd = pg8::row_rstd(ss, row);
        f32x4* hr = (f32x4*)(H + (size_t)row * DM) + lane; const f32x4* gr = (const f32x4*)g + lane;
#pragma unroll
        for (int j = 0; j < 4; ++j) hr[64 * j] = hr[64 * j] * rstd * gr[64 * j];
    }
}
typedef float f32x16 __attribute__((ext_vector_type(16)));
#define MFMA32(a, b, c) __builtin_amdgcn_mfma_f32_32x32x16_bf16((a), (b), (c), 0, 0, 0)
__device__ __forceinline__ int crow(int i, int hh) { return (i & 3) + 8 * (i >> 2) + 4 * hh; }
__device__ __forceinline__ bf16x8 pack8(const f32x16& v, int s) {
    u32x4 t; t.x = pk2(v[8 * s], v[8 * s + 1]); t.y = pk2(v[8 * s + 2], v[8 * s + 3]); t.z = pk2(v[8 * s + 4], v[8 * s + 5]); t.w = pk2(v[8 * s + 6], v[8 * s + 7]);
    return __builtin_bit_cast(bf16x8, t);
}
__device__ __forceinline__ bf16x8 join8(u32x2 a, u32x2 b) { u32x4 t = {a.x, a.y, b.x, b.y}; return __builtin_bit_cast(bf16x8, t); }
__device__ __forceinline__ void tr_store8(LAS unsigned* T32, int pitch32, int c0, int p, u32x4 w0, u32x4 w1) {
    LAS unsigned* t = T32 + c0 * pitch32 + p;
    t[0 * pitch32] = (w0.x & 0xffffu) | (w1.x << 16); t[1 * pitch32] = (w0.x >> 16) | (w1.x & 0xffff0000u);
    t[2 * pitch32] = (w0.y & 0xffffu) | (w1.y << 16); t[3 * pitch32] = (w0.y >> 16) | (w1.y & 0xffff0000u);
    t[4 * pitch32] = (w0.z & 0xffffu) | (w1.z << 16); t[5 * pitch32] = (w0.z >> 16) | (w1.z & 0xffff0000u);
    t[6 * pitch32] = (w0.w & 0xffffu) | (w1.w << 16); t[7 * pitch32] = (w0.w >> 16) | (w1.w & 0xffff0000u);
}

__device__ __forceinline__ void attn_mfma(LAS unsigned char* lds, const bf16_t* P, bf16_t* X, const float* sinks, int unit, const int tid) {
    const int lane = tid & 63, wid = __builtin_amdgcn_readfirstlane(tid >> 6), r32 = lane & 31, hh = lane >> 5;
    const int b = unit >> 5, n = (unit >> 1) & 15, g = unit & 1;
    LAS bf16_t* Ks = (LAS bf16_t*)lds;
    LAS bf16_t* Vt = Ks + 256 * 72;
    const long row0 = (long)b * SEQ + n * 128 - 128;
    for (int c = tid; c < 2048; c += 512) {
        const int key = c >> 3, ch = c & 7; u32x4 kv = {0u, 0u, 0u, 0u};
        if (n > 0 || key >= 128) kv = *(const u32x4*)(P + (size_t)(row0 + key) * PW + 512 + g * 64 + ch * 8);
        *(LAS u32x4*)(Ks + key * 72 + ch * 8) = kv;
    }
    for (int it = tid; it < 1024; it += 512) {
        const int kp = it & 127, ch = it >> 7; u32x4 w0 = {0u, 0u, 0u, 0u}, w1 = {0u, 0u, 0u, 0u};
        if (n > 0 || kp >= 64) { const bf16_t* src = P + (size_t)(row0 + 2 * kp) * PW + 640 + g * 64 + ch * 8; w0 = *(const u32x4*)src; w1 = *(const u32x4*)(src + PW); }
        tr_store8((LAS unsigned*)Vt, 130, ch * 8, kp, w0, w1);
    }
    __syncthreads();
    const int hq = g * 4 + (wid >> 1);
    const float sink2 = sinks[hq] * LOG2E;
    for (int pass = 0; pass < 2; ++pass) {
        const int r0 = (wid & 1) * 64 + pass * 32;
        const size_t qrow = (size_t)b * SEQ + n * 128 + r0 + r32;
        bf16x8 qf[4];
        { const bf16_t* qp = P + qrow * PW + hq * 64 + 8 * hh;
#pragma unroll
          for (int s = 0; s < 4; ++s) qf[s] = *(const bf16x8*)(qp + 16 * s); }
        f32x16 S[5];
#pragma unroll
        for (int j = 0; j < 5; ++j) {
#pragma unroll
            for (int i = 0; i < 16; ++i) S[j][i] = 0.f;
            const LAS bf16_t* kp = Ks + (r0 + 32 * j + r32) * 72 + 8 * hh;
#pragma unroll
            for (int s = 0; s < 4; ++s) S[j] = MFMA32(*(const LAS bf16x8*)(kp + 16 * s), qf[s], S[j]);
        }
#pragma unroll
        for (int i = 0; i < 16; ++i) { const int c = crow(i, hh); if (c <= r32) S[0][i] = -INFINITY; if (c > r32) S[4][i] = -INFINITY; }
        if (n == 0) {
#pragma unroll
            for (int j = 0; j < 4; ++j) if (r0 + 32 * j < 128) {
#pragma unroll
                for (int i = 0; i < 16; ++i) S[j][i] = -INFINITY; }
        }
        float mx = sink2;
#pragma unroll
        for (int j = 0; j < 5; ++j)
#pragma unroll
            for (int i = 0; i < 16; ++i) mx = fmaxf(mx, S[j][i]);
        mx = fmaxf(mx, __shfl_xor(mx, 32));
        float l = 0.f;
#pragma unroll
        for (int j = 0; j < 5; ++j)
#pragma unroll
            for (int i = 0; i < 16; ++i) { const float p = ex2(S[j][i] - mx); S[j][i] = p; l += p; }
        l += __shfl_xor(l, 32);
        l += ex2(sink2 - mx);
        f32x16 o[2];
#pragma unroll
        for (int i = 0; i < 16; ++i) { o[0][i] = 0.f; o[1][i] = 0.f; }
#pragma unroll
        for (int j = 0; j < 5; ++j)
#pragma unroll
            for (int s = 0; s < 2; ++s) {
                const bf16x8 pf = pack8(S[j], s);
#pragma unroll
                for (int dt = 0; dt < 2; ++dt) {
                    const LAS bf16_t* vp = Vt + (32 * dt + r32) * 260 + r0 + 32 * j + 16 * s + 4 * hh;
                    o[dt] = MFMA32(join8(*(const LAS u32x2*)vp, *(const LAS u32x2*)(vp + 8)), pf, o[dt]);
                }
            }
        const float il = 1.f / l;
        bf16_t* op = X + qrow * XW + 1024 + hq * 64 + 4 * hh;
#pragma unroll
        for (int dt = 0; dt < 2; ++dt)
#pragma unroll
            for (int g4 = 0; g4 < 4; ++g4) { u32x2 w; w.x = pk2(o[dt][4 * g4] * il, o[dt][4 * g4 + 1] * il); w.y = pk2(o[dt][4 * g4 + 2] * il, o[dt][4 * g4 + 3] * il);
                *(u32x2*)(op + 32 * dt + 8 * g4) = w; }
    }
    __syncthreads();
}

__device__ __forceinline__ void kv_mfma(LAS unsigned char* lds, const bf16_t* P, float* kvT, int unit, const int tid) {
    const int lane = tid & 63, wid = __builtin_amdgcn_readfirstlane(tid >> 6), r32 = lane & 31, hh = lane >> 5;
    const int b = unit >> 6, h = (unit >> 4) & 3, n = unit & 15;
    LAS bf16_t* Kt = (LAS bf16_t*)lds;
    LAS bf16_t* Vt = Kt + 64 * 136;
    const size_t rowc = (size_t)b * SEQ + n * 128; const float lg = lg_gamma(h);
    { const int tp = tid & 63, ch = tid >> 6;
      const bf16_t* src = P + (rowc + 2 * tp) * PW + 1024 + h * 64 + ch * 8; const u32x4 w0 = *(const u32x4*)src, w1 = *(const u32x4*)(src + PW);
      const float z0 = ex2((float)(127 - 2 * tp) * lg), z1 = ex2((float)(126 - 2 * tp) * lg);
      LAS unsigned* t = (LAS unsigned*)Kt + (ch * 8) * 68 + tp;
      t[0 * 68] = pk2(bflo(w0.x) * z0, bflo(w1.x) * z1); t[1 * 68] = pk2(bfhi(w0.x) * z0, bfhi(w1.x) * z1); t[2 * 68] = pk2(bflo(w0.y) * z0, bflo(w1.y) * z1); t[3 * 68] = pk2(bfhi(w0.y) * z0, bfhi(w1.y) * z1);
      t[4 * 68] = pk2(bflo(w0.z) * z0, bflo(w1.z) * z1); t[5 * 68] = pk2(bfhi(w0.z) * z0, bfhi(w1.z) * z1); t[6 * 68] = pk2(bflo(w0.w) * z0, bflo(w1.w) * z1); t[7 * 68] = pk2(bfhi(w0.w) * z0, bfhi(w1.w) * z1); }
    for (int it = tid; it < 1024; it += 512) {
        const int tp = it & 63, ch = it >> 6; const bf16_t* src = P + (rowc + 2 * tp) * PW + 1280 + h * 128 + ch * 8;
        tr_store8((LAS unsigned*)Vt, 68, ch * 8, tp, *(const u32x4*)src, *(const u32x4*)(src + PW));
    }
    __syncthreads();
    const int et = wid >> 1, dt = wid & 1;
    f32x16 acc;
#pragma unroll
    for (int i = 0; i < 16; ++i) acc[i] = 0.f;
    const LAS bf16_t* ap = Vt + (32 * et + r32) * 136 + 8 * hh; const LAS bf16_t* bp = Kt + (32 * dt + r32) * 136 + 8 * hh;
#pragma unroll
    for (int s = 0; s < 8; ++s) acc = MFMA32(*(const LAS bf16x8*)(ap + 16 * s), *(const LAS bf16x8*)(bp + 16 * s), acc);
    float* o = kvT + ((size_t)unit * 128 + 32 * et) * 64 + 32 * dt + r32;
#pragma unroll
    for (int i = 0; i < 16; ++i) o[crow(i, hh) * 64] = acc[i];
    __syncthreads();
}

__device__ __forceinline__ void ret_mfma(LAS unsigned char* lds, const bf16_t* P, const float* kvT, bf16_t* X, int unit, const int tid) {
    const int lane = tid & 63, wid = __builtin_amdgcn_readfirstlane(tid >> 6), r32 = lane & 31, hh = lane >> 5;
    const int b = unit >> 6, h = (unit >> 4) & 3, n = unit & 15;
    LAS bf16_t* St = (LAS bf16_t*)lds;
    LAS bf16_t* Ks = St + 128 * 72;
    LAS bf16_t* Vt = Ks + 128 * 72;
    LAS float* ssq = (LAS float*)(Vt + 128 * 136);
    const size_t rowc = (size_t)b * SEQ + n * 128; const float lg = lg_gamma(h);
    { const int e = tid >> 2, d0 = (tid & 3) * 16; f32x4 s[4];
#pragma unroll
      for (int k = 0; k < 4; ++k) s[k] = (f32x4){0.f, 0.f, 0.f, 0.f};
      for (int j = 0; j < n; ++j) { const float w = ex2((float)((n - 1 - j) * 128) * lg); const f32x4* kj = (const f32x4*)(kvT + ((size_t)(unit - n + j) * 128 + e) * 64 + d0);
#pragma unroll
          for (int k = 0; k < 4; ++k) s[k] = s[k] + kj[k] * w; }
      u32x4 w0, w1; w0.x = pk2(s[0][0], s[0][1]); w0.y = pk2(s[0][2], s[0][3]); w0.z = pk2(s[1][0], s[1][1]); w0.w = pk2(s[1][2], s[1][3]);
      w1.x = pk2(s[2][0], s[2][1]); w1.y = pk2(s[2][2], s[2][3]); w1.z = pk2(s[3][0], s[3][1]); w1.w = pk2(s[3][2], s[3][3]);
      *(LAS u32x4*)(St + e * 72 + d0) = w0; *(LAS u32x4*)(St + e * 72 + d0 + 8) = w1; }
    for (int c = tid; c < 1024; c += 512) { const int key = c >> 3, ch = c & 7; *(LAS u32x4*)(Ks + key * 72 + ch * 8) = *(const u32x4*)(P + (rowc + key) * PW + 1024 + h * 64 + ch * 8); }
    for (int it = tid; it < 1024; it += 512) {
        const int tp = it & 63, ch = it >> 6; const bf16_t* src = P + (rowc + 2 * tp) * PW + 1280 + h * 128 + ch * 8;
        tr_store8((LAS unsigned*)Vt, 68, ch * 8, tp, *(const u32x4*)src, *(const u32x4*)(src + PW));
    }
    __syncthreads();
    const int rb = wid >> 1, eh = wid & 1;
    const size_t qrow = rowc + 32 * rb + r32;
    bf16x8 qf[4];
    { const bf16_t* qp = P + qrow * PW + 768 + h * 64 + 8 * hh;
#pragma unroll
      for (int s = 0; s < 4; ++s) qf[s] = *(const bf16x8*)(qp + 16 * s); }
    f32x16 o[2];
#pragma unroll
    for (int i = 0; i < 16; ++i) { o[0][i] = 0.f; o[1][i] = 0.f; }
#pragma unroll
    for (int et = 0; et < 2; ++et) { const LAS bf16_t* sp = St + (64 * eh + 32 * et + r32) * 72 + 8 * hh;
#pragma unroll
        for (int s = 0; s < 4; ++s) o[et] = MFMA32(*(const LAS bf16x8*)(sp + 16 * s), qf[s], o[et]); }
    { const float xi = ex2((float)(32 * rb + r32 + 1) * lg);
#pragma unroll
      for (int i = 0; i < 16; ++i) { o[0][i] *= xi; o[1][i] *= xi; } }
    for (int kt = 0; kt <= rb; ++kt) {
        f32x16 S;
#pragma unroll
        for (int i = 0; i < 16; ++i) S[i] = 0.f;
        const LAS bf16_t* kp = Ks + (32 * kt + r32) * 72 + 8 * hh;
#pragma unroll
        for (int s = 0; s < 4; ++s) S = MFMA32(*(const LAS bf16x8*)(kp + 16 * s), qf[s], S);
#pragma unroll
        for (int i = 0; i < 16; ++i) { const int diff = 32 * (rb - kt) + r32 - crow(i, hh); S[i] = diff >= 0 ? S[i] * ex2((float)diff * lg) : 0.f; }
#pragma unroll
        for (int s = 0; s < 2; ++s) {
            const bf16x8 pf = pack8(S, s);
#pragma unroll
            for (int et = 0; et < 2; ++et) {
                const LAS bf16_t* vp = Vt + (64 * eh + 32 * et + r32) * 136 + 32 * kt + 16 * s + 4 * hh;
                o[et] = MFMA32(join8(*(const LAS u32x2*)vp, *(const LAS u32x2*)(vp + 8)), pf, o[et]);
            }
        }
    }
    float sq = 0.f;
#pragma unroll
    for (int i = 0; i < 16; ++i) sq += o[0][i] * o[0][i] + o[1][i] * o[1][i];
    sq += __shfl_xor(sq, 32);
    if (hh == 0) ssq[eh * 128 + 32 * rb + r32] = sq;
    __syncthreads();
    const float rs = rsqrtf((ssq[32 * rb + r32] + ssq[128 + 32 * rb + r32]) * (1.f / 128.f) + EPS);
    const bf16_t* gp = P + qrow * PW + 1792 + h * 128 + 64 * eh + 4 * hh;
    bf16_t* op = X + qrow * XW + 1536 + h * 128 + 64 * eh + 4 * hh;
#pragma unroll
    for (int et = 0; et < 2; ++et)
#pragma unroll
        for (int g4 = 0; g4 < 4; ++g4) { const u32x2 gw = *(const u32x2*)(gp + 32 * et + 8 * g4); u32x2 w;
            w.x = pk2(o[et][4 * g4] * rs * bflo(gw.x), o[et][4 * g4 + 1] * rs * bfhi(gw.x)); w.y = pk2(o[et][4 * g4 + 2] * rs * bflo(gw.y), o[et][4 * g4 + 3] * rs * bfhi(gw.y));
            *(u32x2*)(op + 32 * et + 8 * g4) = w; }
    __syncthreads();
}
#define XB_TMO      128
#define XB_XCNT(j)  (256  + 64 * (j))
#define XB_XSUB(j)  (1280 + 64 * (j))
#define XB_XGEN(j)  (2304 + 64 * (j))
#define XB_TOP      3328
#define XB_TOPGEN   3392
#define XCD_BAR_WORDS 3456
#define XB_SPIN_CAP (1u << 18)
__device__ __forceinline__ unsigned xb_ld(unsigned* p)              { return __hip_atomic_load(p, __ATOMIC_RELAXED, __HIP_MEMORY_SCOPE_AGENT); }
__device__ __forceinline__ unsigned xb_add(unsigned* p, unsigned v) { return __hip_atomic_fetch_add(p, v, __ATOMIC_RELAXED, __HIP_MEMORY_SCOPE_AGENT); }
__device__ __forceinline__ unsigned xb_xcc_id() { return (unsigned)__builtin_amdgcn_s_getreg((3 << 11) | 20) & 0xFu; }
#define XB_SPIN(cond, bar) do { unsigned _sp = 0; while (cond) { __builtin_amdgcn_s_sleep(1); \
    if ((++_sp & 255u) == 0u) { if (xb_ld(&(bar)[XB_TMO])) break; if (_sp > XB_SPIN_CAP) { atomicAdd(&(bar)[XB_TMO], 1u); break; } } } } while (0)
struct XcdBarrier { unsigned* bar; unsigned x; volatile LAS unsigned* st; };
__device__ __forceinline__ XcdBarrier xcd_barrier_post(unsigned* bar, volatile LAS unsigned* st) {
    XcdBarrier b; b.bar = bar; b.x = xb_xcc_id(); b.st = st;
    if (threadIdx.x == 0) (void)xb_add(&bar[XB_XCNT(b.x)], 1u);
    return b;
}
__device__ __forceinline__ void xcd_barrier_complete(unsigned* bar, unsigned x, unsigned& nloc, unsigned& nx) {
    const unsigned G = gridDim.x * gridDim.y * gridDim.z;
    unsigned sum, cnt, mine, sp = 0u;
    for (;;) {
        sum = 0u; cnt = 0u; mine = 0u;
#pragma unroll
        for (unsigned j = 0; j < 16; ++j) { const unsigned c = xb_ld(&bar[XB_XCNT(j)]); sum += c; cnt += (c > 0u) ? 1u : 0u; mine = (j == x) ? c : mine; }
        if (sum == G) break;
        __builtin_amdgcn_s_sleep(1);
        if ((++sp & 255u) == 0u) { if (xb_ld(&bar[XB_TMO])) break; if (sp > XB_SPIN_CAP) { atomicAdd(&bar[XB_TMO], 1u); break; } }
    }
    nloc = mine > 0u ? mine : 1u; nx = cnt > 0u ? cnt : 1u;
}
__device__ __forceinline__ void xcd_barrier(const XcdBarrier& b) {
    asm volatile("s_waitcnt vmcnt(0)" ::: "memory");
    __syncthreads();
    if (threadIdx.x == 0) {
        unsigned* bar = b.bar;
        __builtin_amdgcn_s_waitcnt(0);
        unsigned nloc = b.st[0], nx = b.st[1];
        if (nloc == 0u) { xcd_barrier_complete(bar, b.x, nloc, nx); b.st[0] = nloc; b.st[1] = nx; }
        const unsigned old = xb_add(&bar[XB_XSUB(b.x)], 1u);
        const unsigned gen = old / nloc;
        if (old + 1u == (gen + 1u) * nloc) {
            __builtin_amdgcn_fence(__ATOMIC_RELEASE, "agent");
            asm volatile("s_waitcnt vmcnt(0)" ::: "memory");
            const unsigned og = xb_add(&bar[XB_TOP], 1u);
            const unsigned tg = og / nx;
            if (og + 1u == (tg + 1u) * nx) xb_add(&bar[XB_TOPGEN], 1u);
            else XB_SPIN(xb_ld(&bar[XB_TOPGEN]) == tg, bar);
            __builtin_amdgcn_fence(__ATOMIC_ACQUIRE, "agent");
            xb_add(&bar[XB_XGEN(b.x)], 1u);
            asm volatile("s_waitcnt vmcnt(0)" ::: "memory");
        } else {
            XB_SPIN(xb_ld(&bar[XB_XGEN(b.x)]) == gen, bar);
            __builtin_amdgcn_fence(__ATOMIC_ACQUIRE, "agent");
            asm volatile("s_waitcnt vmcnt(0)" ::: "memory");
        }
    }
    __syncthreads();
}

constexpr int NPH = 30;
#ifndef PHM
#define PHM 0x1ff
#endif
#ifndef MIX_NAIVE
#define MIX_NAIVE 0
#endif
#ifndef DBLM
#define DBLM 0
#endif
__global__ void __launch_bounds__(512, 2) mk_fwd(Args a) {
    extern __shared__ __attribute__((aligned(16))) unsigned char lds_raw[];
    LAS unsigned char* lds = (LAS unsigned char*)lds_raw;
    const int G = gridDim.x, c = blockIdx.x;
    volatile LAS unsigned* MISC = (volatile LAS unsigned*)(lds + MISC_OFF);
    if (threadIdx.x < 32) MISC[threadIdx.x] = 0u;
    __syncthreads();
    unsigned* ctl = (unsigned*)(a.ws + WS_CTL);
    XcdBarrier bar; bar.bar = ctl + 4096; bar.x = 0; bar.st = nullptr;
    const bool multi = (a.ph_hi - a.ph_lo) > 1;
    if (multi) bar = xcd_barrier_post(ctl + 4096, MISC + 8);

    bf16_t* X = (bf16_t*)(a.ws + WS_X); bf16_t* P = (bf16_t*)(a.ws + WS_P); float* ss = (float*)(a.ws + WS_SS);
    float* kvb = (float*)(a.ws + WS_KV);
    for (int ph = a.ph_lo; ph < a.ph_hi; ++ph) {
        const int kind_ = (ph == 0) ? 0 : (ph == NPH - 1) ? 1 : 2 + (ph - 1) % 7;
        for (int rep_ = 0; rep_ < (((DBLM >> kind_) & 1) ? 2 : 1); ++rep_) {
        if (rep_) __syncthreads();
        int tid = threadIdx.x; asm volatile("" : "+v"(tid));
        if (ph == 0) { if (PHM & 1) phase_prologue(a, lds, G, tid); }
        else if (ph == NPH - 1) { if (PHM & 2) final_norm(a.out, ss + (size_t)8 * M * 16, a.norm_final, G, tid); }
        else {
            const int l = (ph - 1) / 7, sub = (ph - 1) % 7;
            const char* Wl = (const char*)(a.ws + WS_W + (size_t)l * WL_SIZE);
            if (sub == 0 && (PHM & 4)) {
                pg8::SchedPlain S{(const char*)X, Wl + WL_IN, XW, DM, DM / 64, M / 256, NIN / 256, G, c, pg8::K_IN};
                pg8::EpiIn E{P, ss + (size_t)(2 * l) * M * 16, (const f32x4*)(a.ws + WS_TABA), (const f32x4*)(a.ws + WS_TABR)};
                pg8::gemm_phase(lds, XW, DM, S, E, tid);
            } else if (sub == 1 && (PHM & 8)) {
#if MIX_NAIVE & 1
                for (int u = c; u < 256; u += G) attn_naive(lds, P, X, a.sinks + l * 8, u, tid);
#else
                for (int u = c; u < 256; u += G) attn_mfma(lds, P, X, a.sinks + l * 8, u, tid);
#endif
#if MIX_NAIVE & 2
                for (int u = c; u < 512; u += G) kv_naive(lds, P, kvb, u, tid);
#else
                for (int u = c; u < 512; u += G) kv_mfma(lds, P, kvb, u, tid);
#endif
                conv_all(P, a.conv_w + l * 3 * 512, X, G, tid);
            } else if (sub == 2 && (PHM & 16)) {
#if MIX_NAIVE & 2
                for (int u = c; u < 512; u += G) ret_naive(lds, P, kvb, X, u, tid);
#else
                for (int u = c; u < 512; u += G) ret_mfma(lds, P, kvb, X, u, tid);
#endif
            } else if (sub == 3 && (PHM & 32)) {
                pg8::SchedC S{(const char*)X, Wl + WL_C, G, c};
                pg8::EpiC E{ss + (size_t)(2 * l) * M * 16, a.b_gate + l * 3 * DM, (u32x4*)(a.ws + WS_GS) + (size_t)c * 8192, (f32x4*)(a.ws + WS_MACC) + (size_t)c * 16384, (bf16_t*)(a.ws + WS_MB)};
                pg8::gemm_phase(lds, XW, KC, S, E, tid);
            } else if (sub == 4 && (PHM & 64)) {
                pg8::SchedPlain S{(const char*)(a.ws + WS_MB), Wl + WL_OUT, DM, DM, DM / 64, M / 256, DM / 256, G, c, pg8::K_RES};
                pg8::EpiRes E{l == 0 ? a.x : a.out, a.out, X, ss + (size_t)(2 * l + 1) * M * 16};
                pg8::gemm_phase(lds, DM, DM, S, E, tid);
            } else if (sub == 5 && (PHM & 128)) {
                pg8::SchedPlain S{(const char*)X, Wl + WL_GU, XW, DM, DM / 64, M / 256, NGU / 256, G, c, pg8::K_GU};
                pg8::EpiGU E{ss + (size_t)(2 * l + 1) * M * 16, (bf16_t*)(a.ws + WS_FF)};
                pg8::gemm_phase(lds, XW, DM, S, E, tid);
            } else if (sub == 6 && (PHM & 256)) {
                pg8::SchedPlain S{(const char*)(a.ws + WS_FF), Wl + WL_D, DFF, DFF, DFF / 64, M / 256, DM / 256, G, c, pg8::K_RES};
                pg8::EpiRes E{a.out, a.out, X, ss + (size_t)(2 * l + 2) * M * 16};
                pg8::gemm_phase(lds, DFF, DFF, S, E, tid);
            }
        }
        }
        if (ph + 1 < a.ph_hi) xcd_barrier(bar);
    }
}

#ifndef MK_SINGLE
#define MK_SINGLE 0
#endif
extern "C" void kernel_launch(void* const* d_in, const int* in_sizes, int n_in, void* d_out, int out_size, void* d_ws, size_t ws_size, hipStream_t stream) {
    static int grid = 0;
    if (grid == 0) {
        if (n_in != 13 || out_size != M * DM || ws_size < WS_END) { fprintf(stderr, "kernel_launch: unexpected shapes (n_in %d, out %d, ws %zu)\n", n_in, out_size, ws_size); grid = -1; return; }
        int dev = 0, cus = 0, per_cu = 0;
        if (hipGetDevice(&dev) != hipSuccess || hipDeviceGetAttribute(&cus, hipDeviceAttributeMultiprocessorCount, dev) != hipSuccess) { grid = -1; return; }
        if (hipFuncSetAttribute((const void*)mk_fwd, hipFuncAttributeMaxDynamicSharedMemorySize, LDS_BYTES) != hipSuccess) { fprintf(stderr, "kernel_launch: hipFuncSetAttribute failed\n"); grid = -1; return; }
        if (hipOccupancyMaxActiveBlocksPerMultiprocessor(&per_cu, (const void*)mk_fwd, 512, LDS_BYTES) != hipSuccess || per_cu < 1) { fprintf(stderr, "kernel_launch: occupancy query says %d\n", per_cu); per_cu = 1; }
        (void)hipGetLastError();
        grid = cus;
        if (grid > 256) grid = 256;
    }
    if (grid < 0) return;
    (void)hipMemsetAsync((char*)d_ws + WS_CTL, 0, CTL_ZERO_BYTES, stream);
    Args a{};
    a.x = (const float*)d_in[0]; a.norm_mix = (const float*)d_in[1]; a.w_in = (const float*)d_in[2]; a.sinks = (const float*)d_in[3]; a.conv_w = (const float*)d_in[4];
    a.w_branch = (const float*)d_in[5]; a.b_gate = (const float*)d_in[6]; a.w_out = (const float*)d_in[7]; a.norm_ffn = (const float*)d_in[8];
    a.w_g = (const float*)d_in[9]; a.w_u = (const float*)d_in[10]; a.w_d = (const float*)d_in[11]; a.norm_final = (const float*)d_in[12];
    a.out = (float*)d_out; a.ws = (unsigned char*)d_ws;
#if MK_SINGLE
    a.ph_lo = 0; a.ph_hi = NPH;
    hipLaunchKernelGGL(mk_fwd, dim3(grid), dim3(512), LDS_BYTES, stream, a);
#else
    for (int ph = 0; ph < NPH; ++ph) { a.ph_lo = ph; a.ph_hi = ph + 1; hipLaunchKernelGGL(mk_fwd, dim3(grid), dim3(512), LDS_BYTES, stream, a); }
#endif
}
```

```cpp
#include <hip/hip_runtime.h>
#include <cstdio>
#include <cstdint>

#define LAS __attribute__((address_space(3)))
#define GAS __attribute__((address_space(1)))
typedef unsigned short bf16_t;
typedef short bf16x8 __attribute__((ext_vector_type(8)));
typedef float f32x4 __attribute__((ext_vector_type(4)));
typedef float f32x2 __attribute__((ext_vector_type(2)));
typedef unsigned u32x4 __attribute__((ext_vector_type(4)));
typedef unsigned u32x2 __attribute__((ext_vector_type(2)));
typedef __bf16 bf16x2_t __attribute__((ext_vector_type(2)));

constexpr int BATCH = 8, SEQ = 2048, DM = 1024, M = BATCH * SEQ, DEPTH = 4, DFF = 2816, DIN = 6912;
constexpr int PW = 3328;
constexpr int XW = 2560;
constexpr int NIN = 3840;
constexpr int NGU = 2 * DFF;
constexpr int KC = 1536;
constexpr float EPS = 1e-6f;
constexpr float LOG2E = 1.4426950408889634f;
constexpr float QSCALE = 0.18033688011112042f;

constexpr size_t MiB = 1u << 20;
constexpr size_t WS_CTL = 0, CTL_ZERO_BYTES = 65536;
constexpr size_t WS_SS = 388 * MiB;
constexpr size_t WS_TABA = 2 * MiB;
constexpr size_t WS_TABR = 2 * MiB + 131072;
constexpr size_t WS_W = 4 * MiB;
constexpr size_t WL_IN = 0, WL_C = 7864320, WL_B = 17301504, WL_OUT = 20447232, WL_GU = 22544384, WL_D = 34078720, WL_SIZE = 39845888;
constexpr size_t WS_X = 156 * MiB;
constexpr size_t WS_P = 236 * MiB;
constexpr size_t WS_MACC = WS_P, WS_MB = WS_P + 64 * MiB, WS_FF = WS_P;
constexpr size_t WS_GS = 340 * MiB;
constexpr size_t WS_KV = 372 * MiB;
constexpr size_t WS_END = 398 * MiB;
static_assert(WS_W + DEPTH * WL_SIZE <= WS_X, "weights");
static_assert((size_t)M * XW * 2 <= 80 * MiB && (size_t)M * PW * 2 <= 104 * MiB && (size_t)M * DFF * 2 <= 104 * MiB, "buffers");

constexpr int RING_BYTES = 131072, LDS_BYTES = 147456, MISC_OFF = RING_BYTES + 320;

__device__ __forceinline__ unsigned pk2(float lo, float hi) { f32x2 v = {lo, hi}; bf16x2_t b = __builtin_convertvector(v, bf16x2_t); return __builtin_bit_cast(unsigned, b); }
__device__ __forceinline__ float bflo(unsigned u) { return __uint_as_float(u << 16); }
__device__ __forceinline__ float bfhi(unsigned u) { return __uint_as_float(u & 0xffff0000u); }
__device__ __forceinline__ float bf2f(bf16_t b) { return __uint_as_float((unsigned)b << 16); }
__device__ __forceinline__ float fsilu(float x) { return x * __builtin_amdgcn_rcpf(1.f + __builtin_amdgcn_exp2f(-x * LOG2E)); }
__device__ __forceinline__ float fsigm(float x) { return __builtin_amdgcn_rcpf(1.f + __builtin_amdgcn_exp2f(-x * LOG2E)); }

struct Args {
    const float* x; const float* norm_mix; const float* w_in; const float* sinks; const float* conv_w; const float* w_branch; const float* b_gate; const float* w_out;
    const float* norm_ffn; const float* w_g; const float* w_u; const float* w_d; const float* norm_final;
    float* out; unsigned char* ws; int ph_lo, ph_hi;
};
#define MK_SINGLE 1
#ifndef DBL_EPI
#define DBL_EPI 0
#endif
namespace pg8 {
constexpr int BM = 256, BK = 64, HALF = 128, HTB = HALF * BK * 2  , STAGE_BYTES = 8 * HTB, NXCD = 8, WGM = 8;

__host__ __device__ __forceinline__ int lds_byte(int r, int c) { const int st = (r >> 4) * 2 + (c >> 5), rr = r & 15, cc = c & 31, ob = rr * 64 + cc * 2; return st * 1024 + (ob ^ (((ob >> 9) & 1) << 5)); }
__host__ __device__ __forceinline__ void stage_rc(int b, int& R, int& C) { const int st = b / 1024, sb = b % 1024, swz = sb ^ (((sb >> 9) & 1) << 5); R = (st >> 1) * 16 + swz / 64; C = (st & 1) * 32 + (swz % 64) / 2; }
__host__ __device__ __forceinline__ int perm32(int rho) { const int n = rho >> 4, i = rho & 15; return 8 * (i >> 2) + 4 * n + (i & 3); }

struct Unit { const char* A; const char* B; int nt, pm, pn, kind, aux; };

__device__ __forceinline__ void tile_of(int L, int nM, int nN, int& pm, int& pn) {
    const int nwg = nM * nN; int wgid = L;
    { const int q = nwg / NXCD, r = nwg % NXCD, xcd = wgid % NXCD, off = wgid / NXCD; wgid = (xcd < r ? xcd * (q + 1) : r * (q + 1) + (xcd - r) * q) + off; }
    const int nig = WGM * nN, gid = wgid / nig, fm = gid * WGM, gsz = (nM - fm) < WGM ? (nM - fm) : WGM;
    pm = fm + ((wgid % nig) % gsz); pn = (wgid % nig) / gsz;
}

template <class Epi, class Sched>
__device__ __forceinline__ void gemm_phase(LAS unsigned char* lds, const int lda, const int ldb, const Sched& S, const Epi& E, const int tid) {
    const int wid = __builtin_amdgcn_readfirstlane(tid >> 6), lane = tid & 63, wr = wid >> 2, wc = wid & 3, fr = lane & 15, fq = lane >> 4;
    unsigned voffA[2], voffB[2];
#pragma unroll
    for (int i = 0; i < 2; ++i) { int R, C; stage_rc(tid * 16 + i * 8192, R, C); const int Rb = (R & ~31) + perm32(R & 31);
        voffA[i] = (unsigned)(R * lda + C) * 2u; voffB[i] = (unsigned)(Rb * ldb + C) * 2u; }
    const size_t kstep = (size_t)(BK * 2);
    const size_t hstepA = (size_t)HALF * lda * 2, hstepB = (size_t)HALF * ldb * 2;
    const unsigned ldsw = (unsigned)wid * 1024u;
    const int aoff = lds_byte(wr * 64 + fr, fq * 8), boff = lds_byte(wc * 32 + fr, fq * 8);
#define PG8_SA(b, h) (((b) * 2 + (h)) * HTB)
#define PG8_SB(b, h) ((4 + (b) * 2 + (h)) * HTB)
#define PG8_STAGE(bufoff, gbase, voff) do { _Pragma("unroll") for (int _i = 0; _i < 2; ++_i) \
        __builtin_amdgcn_global_load_lds((const unsigned*)((const char*)(gbase) + (voff)[_i]), (LAS unsigned*)(lds + (bufoff) + ldsw + _i * 8192), 16, 0, 0); } while (0)
#define PG8_LDA(dst, b, h) do { _Pragma("unroll") for (int m = 0; m < 4; ++m) _Pragma("unroll") for (int k = 0; k < 2; ++k) dst[m][k] = *(const LAS bf16x8*)(lds + PG8_SA(b, h) + aoff + m * 2048 + k * 1024); } while (0)
#define PG8_LDB(dst, b, h) do { _Pragma("unroll") for (int n = 0; n < 2; ++n) _Pragma("unroll") for (int k = 0; k < 2; ++k) dst[n][k] = *(const LAS bf16x8*)(lds + PG8_SB(b, h) + boff + n * 2048 + k * 1024); } while (0)
#define PG8_MMA(ai, bj, At, Bt) do { __builtin_amdgcn_s_setprio(1); _Pragma("unroll") for (int m = 0; m < 4; ++m) _Pragma("unroll") for (int n = 0; n < 2; ++n) _Pragma("unroll") for (int k = 0; k < 2; ++k) \
        acc[ai][bj][m][n] = __builtin_amdgcn_mfma_f32_16x16x32_bf16(Bt[n][k], At[m][k], acc[ai][bj][m][n], 0, 0, 0); __builtin_amdgcn_s_setprio(0); } while (0)
#define PG8_WAIT_V(n) asm volatile("s_waitcnt vmcnt(" #n ")" ::: "memory")
#define PG8_WAIT_L(n) asm volatile("s_waitcnt lgkmcnt(" #n ")" ::: "memory")
#define PG8_BAR __builtin_amdgcn_s_barrier()
#define PG8_SCHED __builtin_amdgcn_sched_barrier(0)
    Unit cur, nxt; int ui = 0;
    if (!S.next(0, cur)) return;
    f32x4 acc[2][2][4][2];
#pragma unroll
    for (int a = 0; a < 2; ++a)
#pragma unroll
        for (int b = 0; b < 2; ++b)
#pragma unroll
            for (int m = 0; m < 4; ++m)
#pragma unroll
                for (int n = 0; n < 2; ++n) acc[a][b][m][n] = (f32x4){0.f, 0.f, 0.f, 0.f};
    bf16x8 At[4][2], B0[2][2], B1[2][2];
    const char* cA = cur.A; const char* cB = cur.B;
    PG8_STAGE(PG8_SB(0, 0), cB, voffB); PG8_STAGE(PG8_SB(0, 1), cB + hstepB, voffB); PG8_STAGE(PG8_SA(0, 0), cA, voffA); PG8_STAGE(PG8_SA(0, 1), cA + hstepA, voffA);
    if (wr == 1) PG8_BAR;
    PG8_WAIT_V(2); PG8_BAR;
    PG8_STAGE(PG8_SB(1, 0), cB + kstep, voffB); PG8_STAGE(PG8_SA(1, 0), cA + kstep, voffA); PG8_STAGE(PG8_SB(1, 1), cB + hstepB + kstep, voffB);
    PG8_WAIT_V(6); PG8_BAR;
    for (;;) {
        const bool has_next = S.next(ui + 1, nxt);
        const char* nA = has_next ? nxt.A : cA; const char* nB = has_next ? nxt.B : cB;
        const int nt = cur.nt;
        for (int t = 0; t < nt; t += 2) {
            const bool last = (t == nt - 2);
            if constexpr (Epi::HAS_HOOK) E.hook(acc, cur, t, wid);
            const char* a1 = cA + (size_t)(t + 1) * kstep;
            const char* a2 = last ? nA : cA + (size_t)(t + 2) * kstep; const char* b2 = last ? nB : cB + (size_t)(t + 2) * kstep;
            const char* a3 = a2 + kstep; const char* b3 = b2 + kstep;
            PG8_LDB(B0, 0, 0); PG8_LDB(B1, 0, 1); PG8_SCHED; PG8_LDA(At, 0, 0); PG8_STAGE(PG8_SA(1, 1), a1 + hstepA, voffA);
            PG8_WAIT_V(8); PG8_WAIT_L(0); PG8_BAR; PG8_MMA(0, 0, At, B0); PG8_MMA(0, 1, At, B1); PG8_BAR; PG8_SCHED;
            PG8_LDA(At, 0, 1); PG8_STAGE(PG8_SB(0, 0), b2, voffB); PG8_STAGE(PG8_SB(0, 1), b2 + hstepB, voffB); PG8_STAGE(PG8_SA(0, 0), a2, voffA);
            PG8_WAIT_V(8); PG8_WAIT_L(0); PG8_BAR; PG8_MMA(1, 0, At, B0); PG8_MMA(1, 1, At, B1); PG8_BAR; PG8_SCHED;
            PG8_LDB(B0, 1, 0); PG8_LDB(B1, 1, 1); PG8_SCHED; PG8_LDA(At, 1, 0); PG8_STAGE(PG8_SA(0, 1), a2 + hstepA, voffA);
            PG8_WAIT_V(8); PG8_WAIT_L(0); PG8_BAR; PG8_MMA(0, 0, At, B0); PG8_MMA(0, 1, At, B1); PG8_BAR; PG8_SCHED;
            PG8_LDA(At, 1, 1); PG8_STAGE(PG8_SB(1, 0), b3, voffB); PG8_STAGE(PG8_SB(1, 1), b3 + hstepB, voffB); PG8_STAGE(PG8_SA(1, 0), a3, voffA);
            PG8_WAIT_V(8); PG8_WAIT_L(0); PG8_BAR; PG8_MMA(1, 0, At, B0); PG8_MMA(1, 1, At, B1); PG8_BAR; PG8_SCHED;
        }
        if (wr == 0) PG8_BAR;
#if DBL_EPI
        if (E.dbl(cur)) { E(acc, cur, wid, false); asm volatile("" ::: "memory"); }
#endif
        E(acc, cur, wid, true);
        if (!has_next) break;
        cur = nxt; cA = nA; cB = nB; ++ui;
        if (wr == 1) PG8_BAR;
    }
    PG8_WAIT_V(0);
    PG8_BAR;
#undef PG8_SA
#undef PG8_SB
#undef PG8_STAGE
#undef PG8_LDA
#undef PG8_LDB
#undef PG8_MMA
#undef PG8_WAIT_V
#undef PG8_WAIT_L
#undef PG8_BAR
#undef PG8_SCHED
}
}
namespace pg8 {
#ifndef EPIC_TEST
#define EPIC_TEST(x) (x)
#endif
__device__ __forceinline__ float row_rstd(const float* ss, int row) {
    const f32x4* p = (const f32x4*)(ss + (size_t)row * 16); const f32x4 a = p[0], b = p[1], c = p[2], d = p[3];
    const float s = ((a[0] + a[1]) + (a[2] + a[3])) + ((b[0] + b[1]) + (b[2] + b[3])) + (((c[0] + c[1]) + (c[2] + c[3])) + ((d[0] + d[1]) + (d[2] + d[3])));
    return rsqrtf(s * (1.f / DM) + EPS);
}
#ifndef USE_NT
#define USE_NT 0
#endif
#if USE_NT
#define NT_STORE(p, v) __builtin_nontemporal_store((v), (p))
#else
#define NT_STORE(p, v) (*(p) = (v))
#endif
#define EPI_LANE() const int lane_ = (int)__builtin_amdgcn_mbcnt_hi(~0u, __builtin_amdgcn_mbcnt_lo(~0u, 0u)); const int wr = wid >> 2, wc = wid & 3, fr = lane_ & 15, fq = lane_ >> 4, tid = wid * 64 + lane_; (void)wr; (void)wc; (void)fr; (void)fq; (void)tid
enum { K_IN = 0, K_GATE = 1, K_BRANCH = 2, K_RES = 3, K_GU = 4 };

__device__ __forceinline__ f32x4 rot4(f32x4 v, f32x4 t) { return (f32x4){v[0] * t[0] - v[1] * t[1], v[1] * t[0] + v[0] * t[1], v[2] * t[2] - v[3] * t[3], v[3] * t[2] + v[2] * t[3]}; }

struct EpiIn {
    static constexpr bool HAS_HOOK = false;
    __device__ __forceinline__ bool dbl(const Unit&) const { return (DBL_EPI & 1) != 0; }
    bf16_t* P; const float* ss; const f32x4* tabA; const f32x4* tabR;
    __device__ __forceinline__ void operator()(f32x4 (&acc)[2][2][4][2], const Unit& u, int wid, const bool zacc) const {
        EPI_LANE();
        const int pn = u.pn;
        const int cw = wc * 32 + 8 * fq;
        const int p0 = (wc & 1) * 32 + 8 * fq;
#pragma unroll
        for (int ai = 0; ai < 2; ++ai)
#pragma unroll
            for (int m = 0; m < 4; ++m) {
                const int row = u.pm * 256 + ai * 128 + wr * 64 + m * 16 + fr;
                const float rstd = row_rstd(ss, row);
                const int pos = row & (SEQ - 1);
#pragma unroll
                for (int bj = 0; bj < 2; ++bj) {
                    f32x4 v0 = acc[ai][bj][m][0] * rstd, v1 = acc[ai][bj][m][1] * rstd;
                    const int gc = pn * 256 + bj * 128 + cw;
                    if (pn >= 11) {
                        u32x2 w; w.x = pk2(v0[0] * v0[1], v0[2] * v0[3]); w.y = pk2(v1[0] * v1[1], v1[2] * v1[3]);
                        NT_STORE((u32x2*)(P + (size_t)row * PW + 2816 + ((gc - 2816) >> 1)), w);
                    } else {
                        if (pn < 2 || (pn == 2 && bj == 0)) {
                            if (p0 < 16) {
                                const f32x4 t0 = tabA[pos * 4 + (p0 >> 2)], t1 = tabA[pos * 4 + (p0 >> 2) + 1];
                                v0 = rot4(v0, t0); v1 = rot4(v1, t1);
                            }
                            if (pn < 2) { v0 = v0 * QSCALE; v1 = v1 * QSCALE; }
                        } else if (pn == 3 || pn == 4) {
                            const f32x4 t0 = tabR[pos * 16 + (p0 >> 2)], t1 = tabR[pos * 16 + (p0 >> 2) + 1];
                            v0 = rot4(v0, t0); v1 = rot4(v1, t1);
                            if (pn == 4) { v0 = v0 * 0.125f; v1 = v1 * 0.125f; }
                        } else if (pn == 7 || pn == 8) {
#pragma unroll
                            for (int j = 0; j < 4; ++j) { v0[j] = fsilu(v0[j]); v1[j] = fsilu(v1[j]); }
                        }
                        u32x4 w; w.x = pk2(v0[0], v0[1]); w.y = pk2(v0[2], v0[3]); w.z = pk2(v1[0], v1[1]); w.w = pk2(v1[2], v1[3]);
                        NT_STORE((u32x4*)(P + (size_t)row * PW + gc), w);
                    }
                    if (zacc) { acc[ai][bj][m][0] = (f32x4){0.f, 0.f, 0.f, 0.f}; acc[ai][bj][m][1] = (f32x4){0.f, 0.f, 0.f, 0.f}; }
                }
            }
    }
};

struct EpiC {
    static constexpr bool HAS_HOOK = true;
    __device__ __forceinline__ bool dbl(const Unit&) const { return false; }
    const float* ss; const float* bg; u32x4* G0; u32x4* G12; bf16_t* mb;
    __device__ __forceinline__ u32x4* gbuf(int br) const { return br == 0 ? G0 : G12 + (size_t)(br - 1) * 8192; }
    __device__ __forceinline__ void hook(f32x4 (&acc)[2][2][4][2], const Unit& u, int t, int wid) const {
        if (u.kind != K_BRANCH || (t != 8 && t != 16)) return;
        EPI_LANE();
        const int br = (t >> 3) - 1;
        const u32x4* Ga = gbuf(br); const u32x4* Gb = gbuf(br + 1);
#pragma unroll
        for (int ai = 0; ai < 2; ++ai)
#pragma unroll
            for (int m = 0; m < 4; ++m) {
#pragma unroll
                for (int bj = 0; bj < 2; ++bj) {
                    const int idx = (ai * 4 + m) * 2 + bj;
                    const u32x4 ga = Ga[(unsigned)(idx * 512 + tid)], gb = Gb[(unsigned)(idx * 512 + tid)];
                    f32x4 d0 = (f32x4){bflo(gb.x), bfhi(gb.x), bflo(gb.y), bfhi(gb.y)}, d1 = (f32x4){bflo(gb.z), bfhi(gb.z), bflo(gb.w), bfhi(gb.w)};
#pragma unroll
                    for (int j = 0; j < 4; ++j) { d0[j] = __builtin_amdgcn_rcpf(fmaxf(d0[j], 1e-30f)); d1[j] = __builtin_amdgcn_rcpf(fmaxf(d1[j], 1e-30f)); }
                    acc[ai][bj][m][0] = acc[ai][bj][m][0] * ((f32x4){bflo(ga.x), bfhi(ga.x), bflo(ga.y), bfhi(ga.y)} * d0);
                    acc[ai][bj][m][1] = acc[ai][bj][m][1] * ((f32x4){bflo(ga.z), bfhi(ga.z), bflo(ga.w), bfhi(ga.w)} * d1);
                }
                asm volatile("" ::: "memory");
            }
    }
    __device__ __forceinline__ void operator()(f32x4 (&acc)[2][2][4][2], const Unit& u, int wid, const bool zacc) const {
        EPI_LANE();
        const int cw = u.pn * 256 + wc * 32 + 8 * fq;
        if (EPIC_TEST(u.kind == K_GATE)) {
            const int br = u.aux;
            const float* b = bg + br * DM + cw; u32x4* Gw = gbuf(br);
#pragma unroll
            for (int ai = 0; ai < 2; ++ai)
#pragma unroll
                for (int m = 0; m < 4; ++m) {
                    const int row = u.pm * 256 + ai * 128 + wr * 64 + m * 16 + fr;
                    const float rstd = row_rstd(ss, row);
#pragma unroll
                    for (int bj = 0; bj < 2; ++bj) {
                        f32x4 v0 = acc[ai][bj][m][0] * rstd + *(const f32x4*)(b + bj * 128), v1 = acc[ai][bj][m][1] * rstd + *(const f32x4*)(b + bj * 128 + 4);
#pragma unroll
                        for (int j = 0; j < 4; ++j) { v0[j] = fsigm(v0[j]); v1[j] = fsigm(v1[j]); }
                        u32x4 w; w.x = pk2(v0[0], v0[1]); w.y = pk2(v0[2], v0[3]); w.z = pk2(v1[0], v1[1]); w.w = pk2(v1[2], v1[3]);
                        Gw[(unsigned)(((ai * 4 + m) * 2 + bj) * 512 + tid)] = w;
                        if (zacc) { acc[ai][bj][m][0] = (f32x4){0.f, 0.f, 0.f, 0.f}; acc[ai][bj][m][1] = (f32x4){0.f, 0.f, 0.f, 0.f}; }
                    }
                    asm volatile("" ::: "memory");
                }
        } else {
            const u32x4* Ga = gbuf(2);
#pragma unroll
            for (int ai = 0; ai < 2; ++ai)
#pragma unroll
                for (int m = 0; m < 4; ++m) {
                    const int row = u.pm * 256 + ai * 128 + wr * 64 + m * 16 + fr;
#pragma unroll
                    for (int bj = 0; bj < 2; ++bj) {
                        const int idx = (ai * 4 + m) * 2 + bj;
                        const u32x4 g = Ga[(unsigned)(idx * 512 + tid)];
                        const f32x4 v0 = acc[ai][bj][m][0] * (f32x4){bflo(g.x), bfhi(g.x), bflo(g.y), bfhi(g.y)};
                        const f32x4 v1 = acc[ai][bj][m][1] * (f32x4){bflo(g.z), bfhi(g.z), bflo(g.w), bfhi(g.w)};
                        u32x4 w; w.x = pk2(v0[0], v0[1]); w.y = pk2(v0[2], v0[3]); w.z = pk2(v1[0], v1[1]); w.w = pk2(v1[2], v1[3]);
                        *(u32x4*)(mb + (size_t)row * DM + bj * 128 + cw) = w;
                        if (zacc) { acc[ai][bj][m][0] = (f32x4){0.f, 0.f, 0.f, 0.f}; acc[ai][bj][m][1] = (f32x4){0.f, 0.f, 0.f, 0.f}; }
                    }
                    asm volatile("" ::: "memory");
                }
        }
    }
};

struct EpiRes {
    static constexpr bool HAS_HOOK = false;
    __device__ __forceinline__ bool dbl(const Unit&) const { return (DBL_EPI & 4) != 0 && rin != H; }
    const float* rin; float* H; bf16_t* hb; float* ssout; int mode;
    __device__ __forceinline__ void operator()(f32x4 (&acc)[2][2][4][2], const Unit& u, int wid, const bool zacc) const {
        EPI_LANE();
        const int cw = u.pn * 256 + wc * 32 + 8 * fq;
#pragma unroll
        for (int ai = 0; ai < 2; ++ai)
#pragma unroll
            for (int m = 0; m < 4; ++m) {
                const int row = u.pm * 256 + ai * 128 + wr * 64 + m * 16 + fr;
                float s = 0.f;
#pragma unroll
                for (int bj = 0; bj < 2; ++bj) {
                    const size_t o = (size_t)row * DM + bj * 128 + cw;
                    bf16_t* hp = hb + (size_t)row * XW + bj * 128 + cw;
                    f32x4 r0, r1;
                    if (mode & 1) { const u32x4 w = *(const u32x4*)hp; r0 = (f32x4){bflo(w.x), bfhi(w.x), bflo(w.y), bfhi(w.y)}; r1 = (f32x4){bflo(w.z), bfhi(w.z), bflo(w.w), bfhi(w.w)}; }
                    else { r0 = *(const f32x4*)(rin + o); r1 = *(const f32x4*)(rin + o + 4); }
                    const f32x4 v0 = acc[ai][bj][m][0] + r0, v1 = acc[ai][bj][m][1] + r1;
                    if (mode & 2) { *(f32x4*)(H + o) = v0; *(f32x4*)(H + o + 4) = v1; }
                    u32x4 w; w.x = pk2(v0[0], v0[1]); w.y = pk2(v0[2], v0[3]); w.z = pk2(v1[0], v1[1]); w.w = pk2(v1[2], v1[3]);
                    *(u32x4*)hp = w;
                    s += (v0[0] * v0[0] + v0[1] * v0[1]) + (v0[2] * v0[2] + v0[3] * v0[3]) + (v1[0] * v1[0] + v1[1] * v1[1]) + (v1[2] * v1[2] + v1[3] * v1[3]);
                    if (zacc) { acc[ai][bj][m][0] = (f32x4){0.f, 0.f, 0.f, 0.f}; acc[ai][bj][m][1] = (f32x4){0.f, 0.f, 0.f, 0.f}; }
                }
                s += __shfl_xor(s, 16); s += __shfl_xor(s, 32);
                if (fq == 0) ssout[(size_t)row * 16 + u.pn * 4 + wc] = s;
            }
    }
};

struct EpiGU {
    static constexpr bool HAS_HOOK = false;
    __device__ __forceinline__ bool dbl(const Unit&) const { return (DBL_EPI & 2) != 0; }
    const float* ss; bf16_t* ff;
    __device__ __forceinline__ void operator()(f32x4 (&acc)[2][2][4][2], const Unit& u, int wid, const bool zacc) const {
        EPI_LANE();
        const int cj = u.pn * 128 + wc * 16 + 4 * fq;
#pragma unroll
        for (int ai = 0; ai < 2; ++ai)
#pragma unroll
            for (int m = 0; m < 4; ++m) {
                const int row = u.pm * 256 + ai * 128 + wr * 64 + m * 16 + fr;
                const float rstd = row_rstd(ss, row);
#pragma unroll
                for (int bj = 0; bj < 2; ++bj) {
                    const f32x4 v0 = acc[ai][bj][m][0] * rstd, v1 = acc[ai][bj][m][1] * rstd;
                    u32x2 w; w.x = pk2(fsilu(v0[0]) * v0[1], fsilu(v0[2]) * v0[3]); w.y = pk2(fsilu(v1[0]) * v1[1], fsilu(v1[2]) * v1[3]);
                    NT_STORE((u32x2*)(ff + (size_t)row * DFF + bj * 64 + cj), w);
                    if (zacc) { acc[ai][bj][m][0] = (f32x4){0.f, 0.f, 0.f, 0.f}; acc[ai][bj][m][1] = (f32x4){0.f, 0.f, 0.f, 0.f}; }
                }
            }
    }
};

struct SchedPlain {
    const char* A; const char* B; int lda, ldb, nt, nM, nN, G, c, kind;
    __device__ __forceinline__ bool next(int i, Unit& u) const {
        const int L = i * G + c; if (L >= nM * nN) return false;
        tile_of(L, nM, nN, u.pm, u.pn);
        u.A = A + (size_t)u.pm * 256 * lda * 2; u.B = B + (size_t)u.pn * 256 * ldb * 2; u.nt = nt; u.kind = kind; u.aux = 0; return true;
    }
};
struct SchedC {
    const char* X; const char* Wg; const char* Wb; int G, c;
    __device__ __forceinline__ bool next(int i, Unit& u) const {
        const int j = i >> 2, sub = i & 3, L = j * G + c; if (L >= 64 * 4) return false;
        tile_of(L, 64, 4, u.pm, u.pn);
        const bool gate = sub < 3;
        u.A = X + (size_t)u.pm * 256 * XW * 2 + (gate ? 0 : 1024 * 2);
        u.B = gate ? Wg + (size_t)sub * (1024 * KC * 2) + (size_t)u.pn * 256 * KC * 2 : Wb + (size_t)u.pn * 256 * KC * 2;
        u.nt = gate ? 16 : 24; u.kind = gate ? K_GATE : K_BRANCH; u.aux = sub; return true;
    }
};
}
__device__ const double INV_A[8] = {0.15915494309189535, 0.03086376340470123, 0.005985185712713705, 0.001160663641240061, 0.00022507907903927653, 4.364795279280289e-05, 8.464330808241401e-06, 1.6414262627950345e-06};
__device__ const double INV_R[32] = {0.15915494309189535, 0.11934937021124886, 0.08949940160889101, 0.06711508300522726, 0.050329212104487035, 0.03774158471741977, 0.0283021958306234, 0.02122365276477766,
    0.015915494309189534, 0.011934937021124886, 0.008949940160889102, 0.006711508300522725, 0.005032921210448704, 0.003774158471741977, 0.00283021958306234, 0.0021223652764777662,
    0.0015915494309189536, 0.0011934937021124885, 0.0008949940160889102, 0.0006711508300522726, 0.0005032921210448703, 0.00037741584717419774, 0.00028302195830623395, 0.0002122365276477766,
    0.00015915494309189535, 0.00011934937021124886, 8.949940160889102e-05, 6.711508300522725e-05, 5.0329212104487035e-05, 3.774158471741978e-05, 2.8302195830623396e-05, 2.122365276477766e-05};
__device__ __forceinline__ float lg_gamma(int h) { return h == 0 ? -0.04580368961312479f : h == 1 ? -0.02272007650008353f : h == 2 ? -0.011315313227834146f : -0.005646563141142062f; }
__device__ __forceinline__ float ex2(float x) { return __builtin_amdgcn_exp2f(x); }
__device__ __forceinline__ float wave_sum(float v) {
#pragma unroll
    for (int o = 1; o < 64; o <<= 1) v += __shfl_xor(v, o);
    return v;
}
#define LDS_WAIT() asm volatile("s_waitcnt lgkmcnt(0)" ::: "memory")

__device__ __forceinline__ int dst_in(int s) {
    if (s < 640) { const int p = s & 63; return (p < 16) ? (s & ~63) + ((p < 8) ? 2 * p : 2 * (p - 8) + 1) : s; }
    if (s < 768) return s;
    if (s < 1280) { const int p = s & 63; return (s & ~63) + ((p < 32) ? 2 * p : 2 * (p - 32) + 1); }
    if (s < 2816) return s;
    return (s < 3328) ? 2816 + 2 * (s - 2816) : 2816 + 2 * (s - 3328) + 1;
}
__device__ __forceinline__ void cvt_item(const float* W, size_t ldw, int c0, const float* scale, bf16_t* dst, int ld, int k0, int mode, int rmul, int radd, LAS float* scr, int lane) {
    const int kr = lane >> 3, c4 = lane & 7;
    f32x4 v[8];
#pragma unroll
    for (int i = 0; i < 8; ++i) v[i] = *(const f32x4*)(W + (size_t)(k0 + 8 * i + kr) * ldw + c0 + 4 * c4);
#pragma unroll
    for (int i = 0; i < 8; ++i) { const float sc = scale ? scale[k0 + 8 * i + kr] : 1.f; LAS float* d = scr + (8 * i + kr) * 33 + 4 * c4; d[0] = v[i][0] * sc; d[1] = v[i][1] * sc; d[2] = v[i][2] * sc; d[3] = v[i][3] * sc; }
    LDS_WAIT(); asm volatile("" ::: "memory");
    const int c = lane & 7;
#pragma unroll
    for (int j = 0; j < 4; ++j) { const int n = (lane >> 3) + 8 * j; const LAS float* s = scr + (8 * c) * 33 + n;
        u32x4 o; o.x = pk2(s[0 * 33], s[1 * 33]); o.y = pk2(s[2 * 33], s[3 * 33]); o.z = pk2(s[4 * 33], s[5 * 33]); o.w = pk2(s[6 * 33], s[7 * 33]);
        const int row = (mode ? dst_in(c0 + n) : c0 + n) * rmul + radd;
        *(u32x4*)(dst + (size_t)row * ld + k0 + 8 * c) = o; }
    LDS_WAIT(); asm volatile("" ::: "memory");
}
constexpr int CV_J0 = 3456, CV_J2 = 768, CV_J3 = 512, CV_J4 = 2816, CV_J5 = 1408, CV_PER_LAYER = CV_J0 + CV_J2 + CV_J3 + CV_J4 + CV_J5;
__device__ __forceinline__ void phase_prologue(const Args& a, LAS unsigned char* lds, int G, const int tid) {
    const int lane = tid & 63, wave = tid >> 6;
    const int gw = blockIdx.x * 8 + wave, NGW = G * 8;
    LAS float* scr = (LAS float*)(lds + wave * 16384);
    for (int it = gw; it < DEPTH * CV_PER_LAYER; it += NGW) {
        const int l = it / CV_PER_LAYER; int r = it - l * CV_PER_LAYER;
        bf16_t* Wl = (bf16_t*)(a.ws + WS_W + (size_t)l * WL_SIZE);
        if (r < CV_J0) { const int kb = r / 216, cb = r % 216;
            if (cb < 120) cvt_item(a.w_in + (size_t)l * DM * DIN, DIN, cb * 32, a.norm_mix + l * DM, Wl + WL_IN / 2, DM, kb * 64, 1, 1, 0, scr, lane);
            else          cvt_item(a.w_in + (size_t)l * DM * DIN, DIN, cb * 32, a.norm_mix + l * DM, Wl + WL_C / 2, KC, kb * 64, 0, 1, -3840, scr, lane);
            continue; } r -= CV_J0;
        if (r < CV_J2) { const int i = r >> 8, kb = (r >> 5) & 7, cb = r & 31;
            cvt_item(a.w_branch + (size_t)(l * 3 + i) * 512 * DM, DM, cb * 32, nullptr, Wl + WL_B / 2 + i * 512, KC, kb * 64, 0, 1, 0, scr, lane); continue; } r -= CV_J2;
        if (r < CV_J3) { const int kb = r >> 5, cb = r & 31;
            cvt_item(a.w_out + (size_t)l * DM * DM, DM, cb * 32, nullptr, Wl + WL_OUT / 2, DM, kb * 64, 0, 1, 0, scr, lane); continue; } r -= CV_J3;
        if (r < CV_J4) { const int up = r / 1408, q = r % 1408, kb = q / 88, cb = q % 88;
            cvt_item((up ? a.w_u : a.w_g) + (size_t)l * DM * DFF, DFF, cb * 32, a.norm_ffn + l * DM, Wl + WL_GU / 2, DM, kb * 64, 0, 2, up, scr, lane); continue; } r -= CV_J4;
        { const int kb = r >> 5, cb = r & 31;
            cvt_item(a.w_d + (size_t)l * DFF * DM, DM, cb * 32, nullptr, Wl + WL_D / 2, DFF, kb * 64, 0, 1, 0, scr, lane); }
    }
    bf16_t* X = (bf16_t*)(a.ws + WS_X); float* ss = (float*)(a.ws + WS_SS);
    for (int row = gw; row < M; row += NGW) {
        const f32x4* xr = (const f32x4*)(a.x + (size_t)row * DM) + lane; float s = 0.f;
#pragma unroll
        for (int j = 0; j < 4; ++j) { const f32x4 v = xr[64 * j]; s += (v[0] * v[0] + v[1] * v[1]) + (v[2] * v[2] + v[3] * v[3]);
            u32x2 w; w.x = pk2(v[0], v[1]); w.y = pk2(v[2], v[3]); *(u32x2*)(X + (size_t)row * XW + (64 * j + lane) * 4) = w; }
        s = wave_sum(s); if (lane < 16) ss[(size_t)row * 16 + lane] = (lane == 0) ? s : 0.f;
    }
    const int gt = blockIdx.x * 512 + tid, NT = G * 512;
    f32x2* tabA = (f32x2*)(a.ws + WS_TABA); f32x2* tabR = (f32x2*)(a.ws + WS_TABR);
    for (int i = gt; i < SEQ * 8; i += NT) { double rev = (double)(i >> 3) * INV_A[i & 7]; rev -= __builtin_floor(rev); const float r = (float)rev; tabA[i] = (f32x2){__builtin_amdgcn_cosf(r), __builtin_amdgcn_sinf(r)}; }
    for (int i = gt; i < SEQ * 32; i += NT) { double rev = (double)(i >> 5) * INV_R[i & 31]; rev -= __builtin_floor(rev); const float r = (float)rev; tabR[i] = (f32x2){__builtin_amdgcn_cosf(r), __builtin_amdgcn_sinf(r)}; }
}

__device__ __forceinline__ void attn_naive(LAS unsigned char* lds, const bf16_t* P, bf16_t* X, const float* sinks, int unit, const int tid) {
    const int b = unit >> 5, n = (unit >> 1) & 15, g = unit & 1;
    LAS bf16_t* Ks = (LAS bf16_t*)lds; LAS bf16_t* Vs = Ks + 256 * 72;
    const long row0 = (long)b * SEQ + n * 128 - 128;
    for (int c = tid; c < 2048; c += 512) {
        const int key = c >> 3, ch = c & 7; u32x4 kv = {0u, 0u, 0u, 0u}, vv = {0u, 0u, 0u, 0u};
        if (n > 0 || key >= 128) { const bf16_t* src = P + (size_t)(row0 + key) * PW + g * 64 + ch * 8; kv = *(const u32x4*)(src + 512); vv = *(const u32x4*)(src + 640); }
        *(LAS u32x4*)(Ks + key * 72 + ch * 8) = kv; *(LAS u32x4*)(Vs + key * 72 + ch * 8) = vv;
    }
    __syncthreads();
    const int r = tid & 127, hq = g * 4 + (tid >> 7);
    const size_t qrow = (size_t)b * SEQ + n * 128 + r;
    float q[64], o[64];
    { const u32x4* qp = (const u32x4*)(P + qrow * PW + hq * 64);
#pragma unroll
      for (int c = 0; c < 8; ++c) { const u32x4 w = qp[c]; q[8 * c] = bflo(w.x); q[8 * c + 1] = bfhi(w.x); q[8 * c + 2] = bflo(w.y); q[8 * c + 3] = bfhi(w.y); q[8 * c + 4] = bflo(w.z); q[8 * c + 5] = bfhi(w.z); q[8 * c + 6] = bflo(w.w); q[8 * c + 7] = bfhi(w.w); } }
#pragma unroll
    for (int d = 0; d < 64; ++d) o[d] = 0.f;
    float mx = sinks[hq] * LOG2E, l = 1.f;
    for (int j = 0; j < 128; ++j) {
        const int kt = r + 1 + j; const bool valid = (n > 0) || (kt >= 128);
        const LAS u32x4* kp = (const LAS u32x4*)(Ks + kt * 72);
        float s = 0.f;
#pragma unroll
        for (int c = 0; c < 8; ++c) { const u32x4 w = kp[c];
            s += q[8 * c] * bflo(w.x) + q[8 * c + 1] * bfhi(w.x) + q[8 * c + 2] * bflo(w.y) + q[8 * c + 3] * bfhi(w.y) + q[8 * c + 4] * bflo(w.z) + q[8 * c + 5] * bfhi(w.z) + q[8 * c + 6] * bflo(w.w) + q[8 * c + 7] * bfhi(w.w); }
        s = valid ? s : -INFINITY;
        const float mn = fmaxf(mx, s), sc = ex2(mx - mn), p = ex2(s - mn);
        l = l * sc + p; mx = mn;
        const LAS u32x4* vp = (const LAS u32x4*)(Vs + kt * 72);
#pragma unroll
        for (int c = 0; c < 8; ++c) { const u32x4 w = vp[c];
            o[8 * c] = o[8 * c] * sc + p * bflo(w.x); o[8 * c + 1] = o[8 * c + 1] * sc + p * bfhi(w.x); o[8 * c + 2] = o[8 * c + 2] * sc + p * bflo(w.y); o[8 * c + 3] = o[8 * c + 3] * sc + p * bfhi(w.y);
            o[8 * c + 4] = o[8 * c + 4] * sc + p * bflo(w.z); o[8 * c + 5] = o[8 * c + 5] * sc + p * bfhi(w.z); o[8 * c + 6] = o[8 * c + 6] * sc + p * bflo(w.w); o[8 * c + 7] = o[8 * c + 7] * sc + p * bfhi(w.w); }
    }
    const float il = 1.f / l;
    u32x4* op = (u32x4*)(X + qrow * XW + 1024 + hq * 64);
#pragma unroll
    for (int c = 0; c < 8; ++c) { u32x4 w; w.x = pk2(o[8 * c] * il, o[8 * c + 1] * il); w.y = pk2(o[8 * c + 2] * il, o[8 * c + 3] * il); w.z = pk2(o[8 * c + 4] * il, o[8 * c + 5] * il); w.w = pk2(o[8 * c + 6] * il, o[8 * c + 7] * il); op[c] = w; }
    __syncthreads();
}

__device__ __forceinline__ void kv_naive(LAS unsigned char* lds, const bf16_t* P, float* kv, int unit, const int tid) {
    const int b = unit >> 6, h = (unit >> 4) & 3, n = unit & 15;
    LAS float* kz = (LAS float*)lds; LAS float* vs = kz + 128 * 64;
    const size_t rowc = (size_t)b * SEQ + n * 128; const float lg = lg_gamma(h);
    for (int i = tid; i < 128 * 8; i += 512) { const int tok = i >> 3, ch = i & 7; const u32x4 w = *(const u32x4*)(P + (rowc + tok) * PW + 1024 + h * 64 + ch * 8); const float z = ex2((float)(127 - tok) * lg);
        LAS float* d = kz + tok * 64 + ch * 8; d[0] = bflo(w.x) * z; d[1] = bfhi(w.x) * z; d[2] = bflo(w.y) * z; d[3] = bfhi(w.y) * z; d[4] = bflo(w.z) * z; d[5] = bfhi(w.z) * z; d[6] = bflo(w.w) * z; d[7] = bfhi(w.w) * z; }
    for (int i = tid; i < 128 * 16; i += 512) { const int tok = i >> 4, ch = i & 15; const u32x4 w = *(const u32x4*)(P + (rowc + tok) * PW + 1280 + h * 128 + ch * 8);
        LAS float* d = vs + tok * 128 + ch * 8; d[0] = bflo(w.x); d[1] = bfhi(w.x); d[2] = bflo(w.y); d[3] = bfhi(w.y); d[4] = bflo(w.z); d[5] = bfhi(w.z); d[6] = bflo(w.w); d[7] = bfhi(w.w); }
    __syncthreads();
    const int e = tid & 127, d0 = (tid >> 7) * 16;
    float acc[16];
#pragma unroll
    for (int dd = 0; dd < 16; ++dd) acc[dd] = 0.f;
    for (int tok = 0; tok < 128; ++tok) { const float vv = vs[tok * 128 + e];
#pragma unroll
        for (int dd = 0; dd < 16; ++dd) acc[dd] += kz[tok * 64 + d0 + dd] * vv; }
#pragma unroll
    for (int dd = 0; dd < 16; ++dd) kv[((size_t)unit * 64 + d0 + dd) * 128 + e] = acc[dd];
    __syncthreads();
}

__device__ __forceinline__ void ret_naive(LAS unsigned char* lds, const bf16_t* P, const float* kv, bf16_t* X, int unit, const int tid) {
    const int b = unit >> 6, h = (unit >> 4) & 3, n = unit & 15;
    LAS float* St = (LAS float*)lds;
    LAS bf16_t* qs = (LAS bf16_t*)(lds + 32768);
    LAS bf16_t* ks = (LAS bf16_t*)(lds + 49152);
    LAS bf16_t* vs = (LAS bf16_t*)(lds + 65536);
    const size_t rowc = (size_t)b * SEQ + n * 128; const float lg = lg_gamma(h);
    { const int e = tid & 127, d0 = (tid >> 7) * 16; float s[16];
#pragma unroll
      for (int dd = 0; dd < 16; ++dd) s[dd] = 0.f;
      for (int j = 0; j < n; ++j) { const float w = ex2((float)((n - 1 - j) * 128) * lg); const float* kj = kv + ((size_t)(unit - n + j) * 64 + d0) * 128 + e;
#pragma unroll
          for (int dd = 0; dd < 16; ++dd) s[dd] += w * kj[dd * 128]; }
#pragma unroll
      for (int dd = 0; dd < 16; ++dd) St[(d0 + dd) * 128 + e] = s[dd]; }
    for (int i = tid; i < 128 * 8; i += 512) { const int tok = i >> 3, ch = i & 7; const bf16_t* src = P + (rowc + tok) * PW + h * 64 + ch * 8;
        *(LAS u32x4*)(qs + tok * 64 + ch * 8) = *(const u32x4*)(src + 768); *(LAS u32x4*)(ks + tok * 64 + ch * 8) = *(const u32x4*)(src + 1024); }
    for (int i = tid; i < 128 * 16; i += 512) { const int tok = i >> 4, ch = i & 15; *(LAS u32x4*)(vs + tok * 128 + ch * 8) = *(const u32x4*)(P + (rowc + tok) * PW + 1280 + h * 128 + ch * 8); }
    __syncthreads();
    const int r = tid >> 2, e0 = (tid & 3) * 32;
    float q[64], y[32];
    { const LAS u32x4* qp = (const LAS u32x4*)(qs + r * 64);
#pragma unroll
      for (int c = 0; c < 8; ++c) { const u32x4 w = qp[c]; q[8 * c] = bflo(w.x); q[8 * c + 1] = bfhi(w.x); q[8 * c + 2] = bflo(w.y); q[8 * c + 3] = bfhi(w.y); q[8 * c + 4] = bflo(w.z); q[8 * c + 5] = bfhi(w.z); q[8 * c + 6] = bflo(w.w); q[8 * c + 7] = bfhi(w.w); } }
#pragma unroll
    for (int ee = 0; ee < 32; ++ee) y[ee] = 0.f;
#pragma unroll 2
    for (int d = 0; d < 64; ++d) { const float qd = bf2f(qs[r * 64 + d]); const LAS f32x4* sp = (const LAS f32x4*)(St + d * 128 + e0);
#pragma unroll
        for (int c = 0; c < 8; ++c) { const f32x4 sv = sp[c]; y[4 * c] += qd * sv[0]; y[4 * c + 1] += qd * sv[1]; y[4 * c + 2] += qd * sv[2]; y[4 * c + 3] += qd * sv[3]; } }
    { const float xi = ex2((float)(r + 1) * lg);
#pragma unroll
      for (int ee = 0; ee < 32; ++ee) y[ee] *= xi; }
    const int rmax = (tid | 63) >> 2;
    for (int kk = 0; kk <= rmax; ++kk) {
        const LAS u32x4* kp = (const LAS u32x4*)(ks + kk * 64);
        float s = 0.f;
#pragma unroll
        for (int c = 0; c < 8; ++c) { const u32x4 w = kp[c];
            s += q[8 * c] * bflo(w.x) + q[8 * c + 1] * bfhi(w.x) + q[8 * c + 2] * bflo(w.y) + q[8 * c + 3] * bfhi(w.y) + q[8 * c + 4] * bflo(w.z) + q[8 * c + 5] * bfhi(w.z) + q[8 * c + 6] * bflo(w.w) + q[8 * c + 7] * bfhi(w.w); }
        const float aw = (kk <= r) ? s * ex2((float)(r - kk) * lg) : 0.f;
        const LAS u32x4* vp = (const LAS u32x4*)(vs + kk * 128 + e0);
#pragma unroll
        for (int c = 0; c < 4; ++c) { const u32x4 w = vp[c];
            y[8 * c] += aw * bflo(w.x); y[8 * c + 1] += aw * bfhi(w.x); y[8 * c + 2] += aw * bflo(w.y); y[8 * c + 3] += aw * bfhi(w.y); y[8 * c + 4] += aw * bflo(w.z); y[8 * c + 5] += aw * bfhi(w.z); y[8 * c + 6] += aw * bflo(w.w); y[8 * c + 7] += aw * bfhi(w.w); }
    }
    float sq = 0.f;
#pragma unroll
    for (int ee = 0; ee < 32; ++ee) sq += y[ee] * y[ee];
    sq += __shfl_xor(sq, 1); sq += __shfl_xor(sq, 2);
    const float rs = rsqrtf(sq * (1.f / 128.f) + EPS);
    const u32x4* gp = (const u32x4*)(P + (rowc + r) * PW + 1792 + h * 128 + e0);
    u32x4* op = (u32x4*)(X + (rowc + r) * XW + 1536 + h * 128 + e0);
#pragma unroll
    for (int c = 0; c < 4; ++c) { const u32x4 gw = gp[c]; u32x4 w;
        w.x = pk2(y[8 * c] * rs * bflo(gw.x), y[8 * c + 1] * rs * bfhi(gw.x)); w.y = pk2(y[8 * c + 2] * rs * bflo(gw.y), y[8 * c + 3] * rs * bfhi(gw.y));
        w.z = pk2(y[8 * c + 4] * rs * bflo(gw.z), y[8 * c + 5] * rs * bfhi(gw.z)); w.w = pk2(y[8 * c + 6] * rs * bflo(gw.w), y[8 * c + 7] * rs * bfhi(gw.w)); op[c] = w; }
    __syncthreads();
}

__device__ __forceinline__ void conv_all(const bf16_t* P, const float* cw, bf16_t* X, int G, const int tid) {
    const int gt = blockIdx.x * 512 + tid, NT = G * 512;
    for (int i = gt; i < M * 64; i += NT) {
        const int row = i >> 6, ch = i & 63, t = row & (SEQ - 1);
        const bf16_t* p = P + (size_t)row * PW + ch * 8;
        const u32x4 cb = *(const u32x4*)(p + 2304), u0 = *(const u32x4*)(p + 2816);
        u32x4 u1 = {0u, 0u, 0u, 0u}, u2 = {0u, 0u, 0u, 0u};
        if (t >= 1) u1 = *(const u32x4*)(p + 2816 - PW);
        if (t >= 2) u2 = *(const u32x4*)(p + 2816 - 2 * PW);
        const f32x4 w0a = *(const f32x4*)(cw + ch * 8), w0b = *(const f32x4*)(cw + ch * 8 + 4), w1a = *(const f32x4*)(cw + 512 + ch * 8), w1b = *(const f32x4*)(cw + 512 + ch * 8 + 4),
                    w2a = *(const f32x4*)(cw + 1024 + ch * 8), w2b = *(const f32x4*)(cw + 1024 + ch * 8 + 4);
        u32x4 o;
        o.x = pk2(bflo(cb.x) * (w0a[0] * bflo(u2.x) + w1a[0] * bflo(u1.x) + w2a[0] * bflo(u0.x)), bfhi(cb.x) * (w0a[1] * bfhi(u2.x) + w1a[1] * bfhi(u1.x) + w2a[1] * bfhi(u0.x)));
        o.y = pk2(bflo(cb.y) * (w0a[2] * bflo(u2.y) + w1a[2] * bflo(u1.y) + w2a[2] * bflo(u0.y)), bfhi(cb.y) * (w0a[3] * bfhi(u2.y) + w1a[3] * bfhi(u1.y) + w2a[3] * bfhi(u0.y)));
        o.z = pk2(bflo(cb.z) * (w0b[0] * bflo(u2.z) + w1b[0] * bflo(u1.z) + w2b[0] * bflo(u0.z)), bfhi(cb.z) * (w0b[1] * bfhi(u2.z) + w1b[1] * bfhi(u1.z) + w2b[1] * bfhi(u0.z)));
        o.w = pk2(bflo(cb.w) * (w0b[2] * bflo(u2.w) + w1b[2] * bflo(u1.w) + w2b[2] * bflo(u0.w)), bfhi(cb.w) * (w0b[3] * bfhi(u2.w) + w1b[3] * bfhi(u1.w) + w2b[3] * bfhi(u0.w)));
        *(u32x4*)(X + (size_t)row * XW + 2048 + ch * 8) = o;
    }
}

__device__ __forceinline__ void final_norm(float* H, const float* ss, const float* g, int G, const int tid) {
    const int lane = tid & 63, gw = blockIdx.x * 8 + (tid >> 6), NGW = G * 8;
    for (int row = gw; row < M; row += NGW) {
        const float rstd = pg8::row_rstd(ss, row);
        f32x4* hr = (f32x4*)(H + (size_t)row * DM) + lane; const f32x4* gr = (const f32x4*)g + lane;
#pragma unroll
        for (int j = 0; j < 4; ++j) hr[64 * j] = hr[64 * j] * rstd * gr[64 * j];
    }
}
typedef float f32x16 __attribute__((ext_vector_type(16)));
#define MFMA32(a, b, c) __builtin_amdgcn_mfma_f32_32x32x16_bf16((a), (b), (c), 0, 0, 0)
__device__ __forceinline__ int crow(int i, int hh) { return (i & 3) + 8 * (i >> 2) + 4 * hh; }
__device__ __forceinline__ bf16x8 pack8(const f32x16& v, int s) {
    u32x4 t; t.x = pk2(v[8 * s], v[8 * s + 1]); t.y = pk2(v[8 * s + 2], v[8 * s + 3]); t.z = pk2(v[8 * s + 4], v[8 * s + 5]); t.w = pk2(v[8 * s + 6], v[8 * s + 7]);
    return __builtin_bit_cast(bf16x8, t);
}
__device__ __forceinline__ bf16x8 join8(u32x2 a, u32x2 b) { u32x4 t = {a.x, a.y, b.x, b.y}; return __builtin_bit_cast(bf16x8, t); }
__device__ __forceinline__ void tr_store8(LAS unsigned* T32, int pitch32, int c0, int p, u32x4 w0, u32x4 w1) {
    LAS unsigned* t = T32 + c0 * pitch32 + p;
    t[0 * pitch32] = (w0.x & 0xffffu) | (w1.x << 16); t[1 * pitch32] = (w0.x >> 16) | (w1.x & 0xffff0000u);
    t[2 * pitch32] = (w0.y & 0xffffu) | (w1.y << 16); t[3 * pitch32] = (w0.y >> 16) | (w1.y & 0xffff0000u);
    t[4 * pitch32] = (w0.z & 0xffffu) | (w1.z << 16); t[5 * pitch32] = (w0.z >> 16) | (w1.z & 0xffff0000u);
    t[6 * pitch32] = (w0.w & 0xffffu) | (w1.w << 16); t[7 * pitch32] = (w0.w >> 16) | (w1.w & 0xffff0000u);
}

__device__ __forceinline__ void attn_mfma(LAS unsigned char* lds, const bf16_t* P, bf16_t* X, const float* sinks, int unit, const int tid) {
    const int lane = tid & 63, wid = __builtin_amdgcn_readfirstlane(tid >> 6), r32 = lane & 31, hh = lane >> 5;
    const int b = unit >> 5, n = (unit >> 1) & 15, g = unit & 1;
    LAS bf16_t* Ks = (LAS bf16_t*)lds;
    LAS bf16_t* Vt = Ks + 256 * 72;
    const long row0 = (long)b * SEQ + n * 128 - 128;
    { u32x4 kv[4], w0[2], w1[2];
#pragma unroll
      for (int i = 0; i < 4; ++i) { const int c = tid + 512 * i, key = c >> 3, ch = c & 7; kv[i] = (u32x4){0u, 0u, 0u, 0u};
          if (n > 0 || key >= 128) kv[i] = *(const u32x4*)(P + (size_t)(row0 + key) * PW + 512 + g * 64 + ch * 8); }
#pragma unroll
      for (int i = 0; i < 2; ++i) { const int it = tid + 512 * i, kp = it & 127, ch = it >> 7; w0[i] = (u32x4){0u, 0u, 0u, 0u}; w1[i] = w0[i];
          if (n > 0 || kp >= 64) { const bf16_t* src = P + (size_t)(row0 + 2 * kp) * PW + 640 + g * 64 + ch * 8; w0[i] = *(const u32x4*)src; w1[i] = *(const u32x4*)(src + PW); } }
#pragma unroll
      for (int i = 0; i < 4; ++i) { const int c = tid + 512 * i, key = c >> 3, ch = c & 7; *(LAS u32x4*)(Ks + key * 72 + ch * 8) = kv[i]; }
#pragma unroll
      for (int i = 0; i < 2; ++i) { const int it = tid + 512 * i, kp = it & 127, ch = it >> 7; tr_store8((LAS unsigned*)Vt, 130, ch * 8, kp, w0[i], w1[i]); } }
    __syncthreads();
    const int hq = g * 4 + (wid >> 1);
    const float sink2 = sinks[hq] * LOG2E;
    for (int pass = 0; pass < 2; ++pass) {
        const int r0 = (wid & 1) * 64 + pass * 32;
        const size_t qrow = (size_t)b * SEQ + n * 128 + r0 + r32;
        bf16x8 qf[4];
        { const bf16_t* qp = P + qrow * PW + hq * 64 + 8 * hh;
#pragma unroll
          for (int s = 0; s < 4; ++s) qf[s] = *(const bf16x8*)(qp + 16 * s); }
        f32x16 S[5];
#pragma unroll
        for (int j = 0; j < 5; ++j) {
#pragma unroll
            for (int i = 0; i < 16; ++i) S[j][i] = 0.f;
            const LAS bf16_t* kp = Ks + (r0 + 32 * j + r32) * 72 + 8 * hh;
#pragma unroll
            for (int s = 0; s < 4; ++s) S[j] = MFMA32(*(const LAS bf16x8*)(kp + 16 * s), qf[s], S[j]);
        }
#pragma unroll
        for (int i = 0; i < 16; ++i) { const int c = crow(i, hh); if (c <= r32) S[0][i] = -INFINITY; if (c > r32) S[4][i] = -INFINITY; }
        if (n == 0) {
#pragma unroll
            for (int j = 0; j < 4; ++j) if (r0 + 32 * j < 128) {
#pragma unroll
                for (int i = 0; i < 16; ++i) S[j][i] = -INFINITY; }
        }
        float mx = sink2;
#pragma unroll
        for (int j = 0; j < 5; ++j)
#pragma unroll
            for (int i = 0; i < 16; ++i) mx = fmaxf(mx, S[j][i]);
        mx = fmaxf(mx, __shfl_xor(mx, 32));
        float l = 0.f;
#pragma unroll
        for (int j = 0; j < 5; ++j)
#pragma unroll
            for (int i = 0; i < 16; ++i) { const float p = ex2(S[j][i] - mx); S[j][i] = p; l += p; }
        l += __shfl_xor(l, 32);
        l += ex2(sink2 - mx);
        f32x16 o[2];
#pragma unroll
        for (int i = 0; i < 16; ++i) { o[0][i] = 0.f; o[1][i] = 0.f; }
#pragma unroll
        for (int j = 0; j < 5; ++j)
#pragma unroll
            for (int s = 0; s < 2; ++s) {
                const bf16x8 pf = pack8(S[j], s);
#pragma unroll
                for (int dt = 0; dt < 2; ++dt) {
                    const LAS bf16_t* vp = Vt + (32 * dt + r32) * 260 + r0 + 32 * j + 16 * s + 4 * hh;
                    o[dt] = MFMA32(join8(*(const LAS u32x2*)vp, *(const LAS u32x2*)(vp + 8)), pf, o[dt]);
                }
            }
        const float il = 1.f / l;
        bf16_t* op = X + qrow * XW + 1024 + hq * 64 + 4 * hh;
#pragma unroll
        for (int dt = 0; dt < 2; ++dt)
#pragma unroll
            for (int g4 = 0; g4 < 4; ++g4) { u32x2 w; w.x = pk2(o[dt][4 * g4] * il, o[dt][4 * g4 + 1] * il); w.y = pk2(o[dt][4 * g4 + 2] * il, o[dt][4 * g4 + 3] * il);
                *(u32x2*)(op + 32 * dt + 8 * g4) = w; }
    }
    __syncthreads();
}

__device__ __forceinline__ void kv_mfma(LAS unsigned char* lds, const bf16_t* P, float* kvT, int unit, const int tid) {
    const int lane = tid & 63, wid = __builtin_amdgcn_readfirstlane(tid >> 6), r32 = lane & 31, hh = lane >> 5;
    const int b = unit >> 6, h = (unit >> 4) & 3, n = unit & 15;
    LAS bf16_t* Kt = (LAS bf16_t*)lds;
    LAS bf16_t* Vt = Kt + 64 * 136;
    const size_t rowc = (size_t)b * SEQ + n * 128; const float lg = lg_gamma(h);
    { const int tp = tid & 63, ch = tid >> 6;
      const bf16_t* src = P + (rowc + 2 * tp) * PW + 1024 + h * 64 + ch * 8; const u32x4 w0 = *(const u32x4*)src, w1 = *(const u32x4*)(src + PW);
      const float z0 = ex2((float)(127 - 2 * tp) * lg), z1 = ex2((float)(126 - 2 * tp) * lg);
      LAS unsigned* t = (LAS unsigned*)Kt + (ch * 8) * 68 + tp;
      t[0 * 68] = pk2(bflo(w0.x) * z0, bflo(w1.x) * z1); t[1 * 68] = pk2(bfhi(w0.x) * z0, bfhi(w1.x) * z1); t[2 * 68] = pk2(bflo(w0.y) * z0, bflo(w1.y) * z1); t[3 * 68] = pk2(bfhi(w0.y) * z0, bfhi(w1.y) * z1);
      t[4 * 68] = pk2(bflo(w0.z) * z0, bflo(w1.z) * z1); t[5 * 68] = pk2(bfhi(w0.z) * z0, bfhi(w1.z) * z1); t[6 * 68] = pk2(bflo(w0.w) * z0, bflo(w1.w) * z1); t[7 * 68] = pk2(bfhi(w0.w) * z0, bfhi(w1.w) * z1); }
    for (int it = tid; it < 1024; it += 512) {
        const int tp = it & 63, ch = it >> 6; const bf16_t* src = P + (rowc + 2 * tp) * PW + 1280 + h * 128 + ch * 8;
        tr_store8((LAS unsigned*)Vt, 68, ch * 8, tp, *(const u32x4*)src, *(const u32x4*)(src + PW));
    }
    __syncthreads();
    const int et = wid >> 1, dt = wid & 1;
    f32x16 acc;
#pragma unroll
    for (int i = 0; i < 16; ++i) acc[i] = 0.f;
    const LAS bf16_t* ap = Vt + (32 * et + r32) * 136 + 8 * hh; const LAS bf16_t* bp = Kt + (32 * dt + r32) * 136 + 8 * hh;
#pragma unroll
    for (int s = 0; s < 8; ++s) acc = MFMA32(*(const LAS bf16x8*)(ap + 16 * s), *(const LAS bf16x8*)(bp + 16 * s), acc);
    float* o = kvT + ((size_t)unit * 128 + 32 * et) * 64 + 32 * dt + r32;
#pragma unroll
    for (int i = 0; i < 16; ++i) o[crow(i, hh) * 64] = acc[i];
    __syncthreads();
}

__device__ __forceinline__ void ret_mfma(LAS unsigned char* lds, const bf16_t* P, const float* kvT, bf16_t* X, int unit, const int tid) {
    const int lane = tid & 63, wid = __builtin_amdgcn_readfirstlane(tid >> 6), r32 = lane & 31, hh = lane >> 5;
    const int b = unit >> 6, h = (unit >> 4) & 3, n = unit & 15;
    LAS bf16_t* St = (LAS bf16_t*)lds;
    LAS bf16_t* Ks = St + 128 * 72;
    LAS bf16_t* Vt = Ks + 128 * 72;
    LAS float* ssq = (LAS float*)(Vt + 128 * 136);
    const size_t rowc = (size_t)b * SEQ + n * 128; const float lg = lg_gamma(h);
    const int rb = wid >> 1, eh = wid & 1;
    const size_t qrow = rowc + 32 * rb + r32;
    bf16x8 qf[4]; u32x2 gw[2][4];
    { const bf16_t* qp = P + qrow * PW + 768 + h * 64 + 8 * hh;
#pragma unroll
      for (int s = 0; s < 4; ++s) qf[s] = *(const bf16x8*)(qp + 16 * s);
      const bf16_t* gp = P + qrow * PW + 1792 + h * 128 + 64 * eh + 4 * hh;
#pragma unroll
      for (int et = 0; et < 2; ++et)
#pragma unroll
          for (int g4 = 0; g4 < 4; ++g4) gw[et][g4] = *(const u32x2*)(gp + 32 * et + 8 * g4); }
    { const int e = tid >> 2, d0 = (tid & 3) * 16; f32x4 s[4];
#pragma unroll
      for (int k = 0; k < 4; ++k) s[k] = (f32x4){0.f, 0.f, 0.f, 0.f};
      const f32x4* kb = (const f32x4*)(kvT + ((size_t)(unit - n) * 128 + e) * 64 + d0);
      int j = 0;
      for (; j + 4 <= n; j += 4) {
          f32x4 t[4][4];
#pragma unroll
          for (int q = 0; q < 4; ++q)
#pragma unroll
              for (int k = 0; k < 4; ++k) t[q][k] = kb[(size_t)(j + q) * 2048 + k];
#pragma unroll
          for (int q = 0; q < 4; ++q) { const float w = ex2((float)((n - 1 - j - q) * 128) * lg);
#pragma unroll
              for (int k = 0; k < 4; ++k) s[k] = s[k] + t[q][k] * w; }
      }
      for (; j < n; ++j) { const float w = ex2((float)((n - 1 - j) * 128) * lg);
#pragma unroll
          for (int k = 0; k < 4; ++k) s[k] = s[k] + kb[(size_t)j * 2048 + k] * w; }
      u32x4 w0, w1; w0.x = pk2(s[0][0], s[0][1]); w0.y = pk2(s[0][2], s[0][3]); w0.z = pk2(s[1][0], s[1][1]); w0.w = pk2(s[1][2], s[1][3]);
      w1.x = pk2(s[2][0], s[2][1]); w1.y = pk2(s[2][2], s[2][3]); w1.z = pk2(s[3][0], s[3][1]); w1.w = pk2(s[3][2], s[3][3]);
      *(LAS u32x4*)(St + e * 72 + d0) = w0; *(LAS u32x4*)(St + e * 72 + d0 + 8) = w1; }
    for (int c = tid; c < 1024; c += 512) { const int key = c >> 3, ch = c & 7; *(LAS u32x4*)(Ks + key * 72 + ch * 8) = *(const u32x4*)(P + (rowc + key) * PW + 1024 + h * 64 + ch * 8); }
    for (int it = tid; it < 1024; it += 512) {
        const int tp = it & 63, ch = it >> 6; const bf16_t* src = P + (rowc + 2 * tp) * PW + 1280 + h * 128 + ch * 8;
        tr_store8((LAS unsigned*)Vt, 68, ch * 8, tp, *(const u32x4*)src, *(const u32x4*)(src + PW));
    }
    __syncthreads();
    f32x16 o[2];
#pragma unroll
    for (int i = 0; i < 16; ++i) { o[0][i] = 0.f; o[1][i] = 0.f; }
#pragma unroll
    for (int et = 0; et < 2; ++et) { const LAS bf16_t* sp = St + (64 * eh + 32 * et + r32) * 72 + 8 * hh;
#pragma unroll
        for (int s = 0; s < 4; ++s) o[et] = MFMA32(*(const LAS bf16x8*)(sp + 16 * s), qf[s], o[et]); }
    { const float xi = ex2((float)(32 * rb + r32 + 1) * lg);
#pragma unroll
      for (int i = 0; i < 16; ++i) { o[0][i] *= xi; o[1][i] *= xi; } }
    for (int kt = 0; kt <= rb; ++kt) {
        f32x16 S;
#pragma unroll
        for (int i = 0; i < 16; ++i) S[i] = 0.f;
        const LAS bf16_t* kp = Ks + (32 * kt + r32) * 72 + 8 * hh;
#pragma unroll
        for (int s = 0; s < 4; ++s) S = MFMA32(*(const LAS bf16x8*)(kp + 16 * s), qf[s], S);
#pragma unroll
        for (int i = 0; i < 16; ++i) { const int diff = 32 * (rb - kt) + r32 - crow(i, hh); S[i] = diff >= 0 ? S[i] * ex2((float)diff * lg) : 0.f; }
#pragma unroll
        for (int s = 0; s < 2; ++s) {
            const bf16x8 pf = pack8(S, s);
#pragma unroll
            for (int et = 0; et < 2; ++et) {
                const LAS bf16_t* vp = Vt + (64 * eh + 32 * et + r32) * 136 + 32 * kt + 16 * s + 4 * hh;
                o[et] = MFMA32(join8(*(const LAS u32x2*)vp, *(const LAS u32x2*)(vp + 8)), pf, o[et]);
            }
        }
    }
    float sq = 0.f;
#pragma unroll
    for (int i = 0; i < 16; ++i) sq += o[0][i] * o[0][i] + o[1][i] * o[1][i];
    sq += __shfl_xor(sq, 32);
    if (hh == 0) ssq[eh * 128 + 32 * rb + r32] = sq;
    __syncthreads();
    const float rs = rsqrtf((ssq[32 * rb + r32] + ssq[128 + 32 * rb + r32]) * (1.f / 128.f) + EPS);
    bf16_t* op = X + qrow * XW + 1536 + h * 128 + 64 * eh + 4 * hh;
#pragma unroll
    for (int et = 0; et < 2; ++et)
#pragma unroll
        for (int g4 = 0; g4 < 4; ++g4) { const u32x2 g = gw[et][g4]; u32x2 w;
            w.x = pk2(o[et][4 * g4] * rs * bflo(g.x), o[et][4 * g4 + 1] * rs * bfhi(g.x)); w.y = pk2(o[et][4 * g4 + 2] * rs * bflo(g.y), o[et][4 * g4 + 3] * rs * bfhi(g.y));
            *(u32x2*)(op + 32 * et + 8 * g4) = w; }
    __syncthreads();
}
#define XB_TMO      128
#define XB_XCNT(j)  (256  + 64 * (j))
#define XB_XSUB(j)  (1280 + 64 * (j))
#define XB_XGEN(j)  (2304 + 64 * (j))
#define XB_TOP      3328
#define XB_TOPGEN   3392
#define XCD_BAR_WORDS 3456
#define XB_SPIN_CAP (1u << 18)
__device__ __forceinline__ unsigned xb_ld(unsigned* p)              { return __hip_atomic_load(p, __ATOMIC_RELAXED, __HIP_MEMORY_SCOPE_AGENT); }
__device__ __forceinline__ unsigned xb_add(unsigned* p, unsigned v) { return __hip_atomic_fetch_add(p, v, __ATOMIC_RELAXED, __HIP_MEMORY_SCOPE_AGENT); }
__device__ __forceinline__ unsigned xb_xcc_id() { return (unsigned)__builtin_amdgcn_s_getreg((3 << 11) | 20) & 0xFu; }
#define XB_SPIN(cond, bar) do { unsigned _sp = 0; while (cond) { __builtin_amdgcn_s_sleep(1); \
    if ((++_sp & 255u) == 0u) { if (xb_ld(&(bar)[XB_TMO])) break; if (_sp > XB_SPIN_CAP) { atomicAdd(&(bar)[XB_TMO], 1u); break; } } } } while (0)
struct XcdBarrier { unsigned* bar; unsigned x; volatile LAS unsigned* st; };
__device__ __forceinline__ XcdBarrier xcd_barrier_post(unsigned* bar, volatile LAS unsigned* st) {
    XcdBarrier b; b.bar = bar; b.x = xb_xcc_id(); b.st = st;
    if (threadIdx.x == 0) (void)xb_add(&bar[XB_XCNT(b.x)], 1u);
    return b;
}
__device__ __forceinline__ void xcd_barrier_complete(unsigned* bar, unsigned x, unsigned& nloc, unsigned& nx) {
    const unsigned G = gridDim.x * gridDim.y * gridDim.z;
    unsigned sum, cnt, mine, sp = 0u;
    for (;;) {
        sum = 0u; cnt = 0u; mine = 0u;
#pragma unroll
        for (unsigned j = 0; j < 16; ++j) { const unsigned c = xb_ld(&bar[XB_XCNT(j)]); sum += c; cnt += (c > 0u) ? 1u : 0u; mine = (j == x) ? c : mine; }
        if (sum == G) break;
        __builtin_amdgcn_s_sleep(1);
        if ((++sp & 255u) == 0u) { if (xb_ld(&bar[XB_TMO])) break; if (sp > XB_SPIN_CAP) { atomicAdd(&bar[XB_TMO], 1u); break; } }
    }
    nloc = mine > 0u ? mine : 1u; nx = cnt > 0u ? cnt : 1u;
}
__device__ __forceinline__ void xcd_barrier(const XcdBarrier& b) {
    asm volatile("s_waitcnt vmcnt(0)" ::: "memory");
    __syncthreads();
    if (threadIdx.x == 0) {
        unsigned* bar = b.bar;
        __builtin_amdgcn_s_waitcnt(0);
        unsigned nloc = b.st[0], nx = b.st[1];
        if (nloc == 0u) { xcd_barrier_complete(bar, b.x, nloc, nx); b.st[0] = nloc; b.st[1] = nx; }
        const unsigned old = xb_add(&bar[XB_XSUB(b.x)], 1u);
        const unsigned gen = old / nloc;
        if (old + 1u == (gen + 1u) * nloc) {
            __builtin_amdgcn_fence(__ATOMIC_RELEASE, "agent");
            asm volatile("s_waitcnt vmcnt(0)" ::: "memory");
            const unsigned og = xb_add(&bar[XB_TOP], 1u);
            const unsigned tg = og / nx;
            if (og + 1u == (tg + 1u) * nx) xb_add(&bar[XB_TOPGEN], 1u);
            else XB_SPIN(xb_ld(&bar[XB_TOPGEN]) == tg, bar);
            __builtin_amdgcn_fence(__ATOMIC_ACQUIRE, "agent");
            xb_add(&bar[XB_XGEN(b.x)], 1u);
            asm volatile("s_waitcnt vmcnt(0)" ::: "memory");
        } else {
            XB_SPIN(xb_ld(&bar[XB_XGEN(b.x)]) == gen, bar);
            __builtin_amdgcn_fence(__ATOMIC_ACQUIRE, "agent");
            asm volatile("s_waitcnt vmcnt(0)" ::: "memory");
        }
    }
    __syncthreads();
}

constexpr int NPH = 30;
#ifndef PHM
#define PHM 0x1ff
#endif
#ifndef MIX_NAIVE
#define MIX_NAIVE 0
#endif
#ifndef RES_BF16
#define RES_BF16 1
#endif
#ifndef DBL_BAR
#define DBL_BAR 0
#endif
#ifndef DBLM
#define DBLM 0
#endif
__global__ void __launch_bounds__(512, 2) mk_fwd(Args a) {
    extern __shared__ __attribute__((aligned(16))) unsigned char lds_raw[];
    LAS unsigned char* lds = (LAS unsigned char*)lds_raw;
    const int G = gridDim.x, c = blockIdx.x;
    volatile LAS unsigned* MISC = (volatile LAS unsigned*)(lds + MISC_OFF);
    if (threadIdx.x < 32) MISC[threadIdx.x] = 0u;
    __syncthreads();
    unsigned* ctl = (unsigned*)(a.ws + WS_CTL);
    XcdBarrier bar; bar.bar = ctl + 4096; bar.x = 0; bar.st = nullptr;
    const bool multi = (a.ph_hi - a.ph_lo) > 1;
    if (multi) bar = xcd_barrier_post(ctl + 4096, MISC + 8);

    bf16_t* X = (bf16_t*)(a.ws + WS_X); bf16_t* P = (bf16_t*)(a.ws + WS_P); float* ss = (float*)(a.ws + WS_SS);
    float* kvb = (float*)(a.ws + WS_KV);
    for (int ph = a.ph_lo; ph < a.ph_hi; ++ph) {
        const int kind_ = (ph == 0) ? 0 : (ph == NPH - 1) ? 1 : 2 + (ph - 1) % 7;
        for (int rep_ = 0; rep_ < (((DBLM >> kind_) & 1) ? 2 : 1); ++rep_) {
        if (rep_) __syncthreads();
        int tid = threadIdx.x; asm volatile("" : "+v"(tid));
        if (ph == 0) { if (PHM & 1) phase_prologue(a, lds, G, tid); }
        else if (ph == NPH - 1) { if (PHM & 2) final_norm(a.out, ss + (size_t)8 * M * 16, a.norm_final, G, tid); }
        else {
            const int l = (ph - 1) / 7, sub = (ph - 1) % 7;
            const char* Wl = (const char*)(a.ws + WS_W + (size_t)l * WL_SIZE);
            if (sub == 0 && (PHM & 4)) {
                pg8::SchedPlain S{(const char*)X, Wl + WL_IN, XW, DM, DM / 64, M / 256, NIN / 256, G, c, pg8::K_IN};
                pg8::EpiIn E{P, ss + (size_t)(2 * l) * M * 16, (const f32x4*)(a.ws + WS_TABA), (const f32x4*)(a.ws + WS_TABR)};
                pg8::gemm_phase(lds, XW, DM, S, E, tid);
            } else if (sub == 1 && (PHM & 8)) {
#if MIX_NAIVE & 1
                for (int u = c; u < 256; u += G) attn_naive(lds, P, X, a.sinks + l * 8, u, tid);
#else
                for (int u = c; u < 256; u += G) attn_mfma(lds, P, X, a.sinks + l * 8, u, tid);
#endif
#if MIX_NAIVE & 2
                for (int u = c; u < 512; u += G) kv_naive(lds, P, kvb, u, tid);
#else
                for (int u = c; u < 512; u += G) kv_mfma(lds, P, kvb, u, tid);
#endif
                conv_all(P, a.conv_w + l * 3 * 512, X, G, tid);
            } else if (sub == 2 && (PHM & 16)) {
#if MIX_NAIVE & 2
                for (int u = c; u < 512; u += G) ret_naive(lds, P, kvb, X, u, tid);
#else
                for (int u = c; u < 512; u += G) ret_mfma(lds, P, kvb, X, (u < 256) ? u : (u & ~15) | (15 - (u & 15)), tid);
#endif
            } else if (sub == 3 && (PHM & 32)) {
                pg8::SchedC S{(const char*)X, Wl + WL_C, Wl + WL_B, G, c};
                pg8::EpiC E{ss + (size_t)(2 * l) * M * 16, a.b_gate + l * 3 * DM, (u32x4*)(a.ws + WS_GS) + (size_t)c * 8192, (u32x4*)(a.ws + WS_MACC) + (size_t)c * 16384, (bf16_t*)(a.ws + WS_MB)};
                pg8::gemm_phase(lds, XW, KC, S, E, tid);
            } else if (sub == 4 && (PHM & 64)) {
                pg8::SchedPlain S{(const char*)(a.ws + WS_MB), Wl + WL_OUT, DM, DM, DM / 64, M / 256, DM / 256, G, c, pg8::K_RES};
                pg8::EpiRes E{l == 0 ? a.x : a.out, a.out, X, ss + (size_t)(2 * l + 1) * M * 16, RES_BF16 ? (l == 0 ? 0 : 1) : 2};
                pg8::gemm_phase(lds, DM, DM, S, E, tid);
            } else if (sub == 5 && (PHM & 128)) {
                pg8::SchedPlain S{(const char*)X, Wl + WL_GU, XW, DM, DM / 64, M / 256, NGU / 256, G, c, pg8::K_GU};
                pg8::EpiGU E{ss + (size_t)(2 * l + 1) * M * 16, (bf16_t*)(a.ws + WS_FF)};
                pg8::gemm_phase(lds, XW, DM, S, E, tid);
            } else if (sub == 6 && (PHM & 256)) {
                pg8::SchedPlain S{(const char*)(a.ws + WS_FF), Wl + WL_D, DFF, DFF, DFF / 64, M / 256, DM / 256, G, c, pg8::K_RES};
                pg8::EpiRes E{a.out, a.out, X, ss + (size_t)(2 * l + 2) * M * 16, RES_BF16 ? (l == DEPTH - 1 ? 3 : 1) : 2};
                pg8::gemm_phase(lds, DFF, DFF, S, E, tid);
            }
        }
        }
        if (ph + 1 < a.ph_hi) { xcd_barrier(bar);
#if DBL_BAR
            xcd_barrier(bar);
#endif
        }
    }
}

#ifndef MK_SINGLE
#define MK_SINGLE 0
#endif
extern "C" void kernel_launch(void* const* d_in, const int* in_sizes, int n_in, void* d_out, int out_size, void* d_ws, size_t ws_size, hipStream_t stream) {
    static int grid = 0;
    if (grid == 0) {
        if (n_in != 13 || out_size != M * DM || ws_size < WS_END) { fprintf(stderr, "kernel_launch: unexpected shapes (n_in %d, out %d, ws %zu)\n", n_in, out_size, ws_size); grid = -1; return; }
        int dev = 0, cus = 0, per_cu = 0;
        if (hipGetDevice(&dev) != hipSuccess || hipDeviceGetAttribute(&cus, hipDeviceAttributeMultiprocessorCount, dev) != hipSuccess) { grid = -1; return; }
        if (hipFuncSetAttribute((const void*)mk_fwd, hipFuncAttributeMaxDynamicSharedMemorySize, LDS_BYTES) != hipSuccess) { fprintf(stderr, "kernel_launch: hipFuncSetAttribute failed\n"); grid = -1; return; }
        if (hipOccupancyMaxActiveBlocksPerMultiprocessor(&per_cu, (const void*)mk_fwd, 512, LDS_BYTES) != hipSuccess || per_cu < 1) { fprintf(stderr, "kernel_launch: occupancy query says %d\n", per_cu); per_cu = 1; }
        (void)hipGetLastError();
        grid = cus;
        if (grid > 256) grid = 256;
    }
    if (grid < 0) return;
    (void)hipMemsetAsync((char*)d_ws + WS_CTL, 0, CTL_ZERO_BYTES, stream);
    Args a{};
    a.x = (const float*)d_in[0]; a.norm_mix = (const float*)d_in[1]; a.w_in = (const float*)d_in[2]; a.sinks = (const float*)d_in[3]; a.conv_w = (const float*)d_in[4];
    a.w_branch = (const float*)d_in[5]; a.b_gate = (const float*)d_in[6]; a.w_out = (const float*)d_in[7]; a.norm_ffn = (const float*)d_in[8];
    a.w_g = (const float*)d_in[9]; a.w_u = (const float*)d_in[10]; a.w_d = (const float*)d_in[11]; a.norm_final = (const float*)d_in[12];
    a.out = (float*)d_out; a.ws = (unsigned char*)d_ws;
#if MK_SINGLE
    a.ph_lo = 0; a.ph_hi = NPH;
    hipLaunchKernelGGL(mk_fwd, dim3(grid), dim3(512), LDS_BYTES, stream, a);
#else
    for (int ph = 0; ph < NPH; ++ph) { a.ph_lo = ph; a.ph_hi = ph + 1; hipLaunchKernelGGL(mk_fwd, dim3(grid), dim3(512), LDS_BYTES, stream, a); }
#endif
}
```

```cpp
#include <hip/hip_runtime.h>
#include <cstdio>
#include <cstdint>

#define LAS __attribute__((address_space(3)))
#define GAS __attribute__((address_space(1)))
typedef unsigned short bf16_t;
typedef short bf16x8 __attribute__((ext_vector_type(8)));
typedef float f32x4 __attribute__((ext_vector_type(4)));
typedef float f32x2 __attribute__((ext_vector_type(2)));
typedef unsigned u32x4 __attribute__((ext_vector_type(4)));
typedef unsigned u32x2 __attribute__((ext_vector_type(2)));
typedef __bf16 bf16x2_t __attribute__((ext_vector_type(2)));

constexpr int BATCH = 8, SEQ = 2048, DM = 1024, M = BATCH * SEQ, DEPTH = 4, DFF = 2816, DIN = 6912;
constexpr int PW = 3328;
constexpr int XW = 2560;
constexpr int NIN = 3840;
constexpr int NGU = 2 * DFF;
constexpr int KC = 1536;
constexpr float EPS = 1e-6f;
constexpr float LOG2E = 1.4426950408889634f;
constexpr float QSCALE = 0.18033688011112042f;

constexpr size_t MiB = 1u << 20;
constexpr size_t WS_CTL = 0, CTL_ZERO_BYTES = 262144;
constexpr size_t WS_SS = 388 * MiB;
constexpr size_t WS_TABA = 2 * MiB;
constexpr size_t WS_TABR = 2 * MiB + 131072;
constexpr size_t WS_W = 4 * MiB;
constexpr size_t WL_IN = 0, WL_C = 7864320, WL_B = 17301504, WL_OUT = 20447232, WL_GU = 22544384, WL_D = 34078720, WL_SIZE = 39845888;
constexpr size_t WS_X = 156 * MiB;
constexpr size_t WS_P = 236 * MiB;
constexpr size_t WS_MACC = WS_P, WS_MB = WS_P + 64 * MiB, WS_FF = WS_P;
constexpr size_t WS_GS = 340 * MiB;
constexpr size_t WS_KV = 372 * MiB;
constexpr size_t WS_END = 398 * MiB;
static_assert(WS_W + DEPTH * WL_SIZE <= WS_X, "weights");
static_assert((size_t)M * XW * 2 <= 80 * MiB && (size_t)M * PW * 2 <= 104 * MiB && (size_t)M * DFF * 2 <= 104 * MiB, "buffers");

constexpr int RING_BYTES = 131072, LDS_BYTES = 147456, MISC_OFF = RING_BYTES + 320;

__device__ __forceinline__ unsigned pk2(float lo, float hi) { f32x2 v = {lo, hi}; bf16x2_t b = __builtin_convertvector(v, bf16x2_t); return __builtin_bit_cast(unsigned, b); }
__device__ __forceinline__ float bflo(unsigned u) { return __uint_as_float(u << 16); }
__device__ __forceinline__ float bfhi(unsigned u) { return __uint_as_float(u & 0xffff0000u); }
__device__ __forceinline__ float bf2f(bf16_t b) { return __uint_as_float((unsigned)b << 16); }
__device__ __forceinline__ float fsilu(float x) { return x * __builtin_amdgcn_rcpf(1.f + __builtin_amdgcn_exp2f(-x * LOG2E)); }
__device__ __forceinline__ float fsigm(float x) { return __builtin_amdgcn_rcpf(1.f + __builtin_amdgcn_exp2f(-x * LOG2E)); }

struct Args {
    const float* x; const float* norm_mix; const float* w_in; const float* sinks; const float* conv_w; const float* w_branch; const float* b_gate; const float* w_out;
    const float* norm_ffn; const float* w_g; const float* w_u; const float* w_d; const float* norm_final;
    float* out; unsigned char* ws; int ph_lo, ph_hi;
};
#define MK_SINGLE 1
#ifndef DBL_EPI
#define DBL_EPI 0
#endif
namespace pg8 {
constexpr int BM = 256, BK = 64, HALF = 128, HTB = HALF * BK * 2  , STAGE_BYTES = 8 * HTB, NXCD = 8, WGM = 8;

__host__ __device__ __forceinline__ int lds_byte(int r, int c) { const int st = (r >> 4) * 2 + (c >> 5), rr = r & 15, cc = c & 31, ob = rr * 64 + cc * 2; return st * 1024 + (ob ^ (((ob >> 9) & 1) << 5)); }
__host__ __device__ __forceinline__ void stage_rc(int b, int& R, int& C) { const int st = b / 1024, sb = b % 1024, swz = sb ^ (((sb >> 9) & 1) << 5); R = (st >> 1) * 16 + swz / 64; C = (st & 1) * 32 + (swz % 64) / 2; }
__host__ __device__ __forceinline__ int perm32(int rho) { const int n = rho >> 4, i = rho & 15; return 8 * (i >> 2) + 4 * n + (i & 3); }

struct Unit { const char* A; const char* B; int nt, pm, pn, kind, aux; };

__device__ __forceinline__ void tile_of(int L, int nM, int nN, int& pm, int& pn) {
    const int nwg = nM * nN; int wgid = L;
    { const int q = nwg / NXCD, r = nwg % NXCD, xcd = wgid % NXCD, off = wgid / NXCD; wgid = (xcd < r ? xcd * (q + 1) : r * (q + 1) + (xcd - r) * q) + off; }
    const int nig = WGM * nN, gid = wgid / nig, fm = gid * WGM, gsz = (nM - fm) < WGM ? (nM - fm) : WGM;
    pm = fm + ((wgid % nig) % gsz); pn = (wgid % nig) / gsz;
}

template <class Epi, class Sched>
__device__ __forceinline__ void gemm_phase(LAS unsigned char* lds, const int lda, const int ldb, const Sched& S, const Epi& E, const int tid) {
    const int wid = __builtin_amdgcn_readfirstlane(tid >> 6), lane = tid & 63, wr = wid >> 2, wc = wid & 3, fr = lane & 15, fq = lane >> 4;
    unsigned voffA[2], voffB[2];
#pragma unroll
    for (int i = 0; i < 2; ++i) { int R, C; stage_rc(tid * 16 + i * 8192, R, C); const int Rb = (R & ~31) + perm32(R & 31);
        voffA[i] = (unsigned)(R * lda + C) * 2u; voffB[i] = (unsigned)(Rb * ldb + C) * 2u; }
    const size_t kstep = (size_t)(BK * 2);
    const size_t hstepA = (size_t)HALF * lda * 2, hstepB = (size_t)HALF * ldb * 2;
    const unsigned ldsw = (unsigned)wid * 1024u;
    const int aoff = lds_byte(wr * 64 + fr, fq * 8), boff = lds_byte(wc * 32 + fr, fq * 8);
#define PG8_SA(b, h) (((b) * 2 + (h)) * HTB)
#define PG8_SB(b, h) ((4 + (b) * 2 + (h)) * HTB)
#define PG8_STAGE(bufoff, gbase, voff) do { _Pragma("unroll") for (int _i = 0; _i < 2; ++_i) \
        __builtin_amdgcn_global_load_lds((const unsigned*)((const char*)(gbase) + (voff)[_i]), (LAS unsigned*)(lds + (bufoff) + ldsw + _i * 8192), 16, 0, 0); } while (0)
#define PG8_LDA(dst, b, h) do { _Pragma("unroll") for (int m = 0; m < 4; ++m) _Pragma("unroll") for (int k = 0; k < 2; ++k) dst[m][k] = *(const LAS bf16x8*)(lds + PG8_SA(b, h) + aoff + m * 2048 + k * 1024); } while (0)
#define PG8_LDB(dst, b, h) do { _Pragma("unroll") for (int n = 0; n < 2; ++n) _Pragma("unroll") for (int k = 0; k < 2; ++k) dst[n][k] = *(const LAS bf16x8*)(lds + PG8_SB(b, h) + boff + n * 2048 + k * 1024); } while (0)
#define PG8_MMA(ai, bj, At, Bt) do { __builtin_amdgcn_s_setprio(1); _Pragma("unroll") for (int m = 0; m < 4; ++m) _Pragma("unroll") for (int n = 0; n < 2; ++n) _Pragma("unroll") for (int k = 0; k < 2; ++k) \
        acc[ai][bj][m][n] = __builtin_amdgcn_mfma_f32_16x16x32_bf16(Bt[n][k], At[m][k], acc[ai][bj][m][n], 0, 0, 0); __builtin_amdgcn_s_setprio(0); } while (0)
#define PG8_WAIT_V(n) asm volatile("s_waitcnt vmcnt(" #n ")" ::: "memory")
#define PG8_WAIT_L(n) asm volatile("s_waitcnt lgkmcnt(" #n ")" ::: "memory")
#define PG8_BAR __builtin_amdgcn_s_barrier()
#define PG8_SCHED __builtin_amdgcn_sched_barrier(0)
    Unit cur, nxt; int ui = 0;
    if (!S.next(0, cur)) return;
    f32x4 acc[2][2][4][2];
#pragma unroll
    for (int a = 0; a < 2; ++a)
#pragma unroll
        for (int b = 0; b < 2; ++b)
#pragma unroll
            for (int m = 0; m < 4; ++m)
#pragma unroll
                for (int n = 0; n < 2; ++n) acc[a][b][m][n] = (f32x4){0.f, 0.f, 0.f, 0.f};
    bf16x8 At[4][2], B0[2][2], B1[2][2];
    const char* cA = cur.A; const char* cB = cur.B;
    PG8_STAGE(PG8_SB(0, 0), cB, voffB); PG8_STAGE(PG8_SB(0, 1), cB + hstepB, voffB); PG8_STAGE(PG8_SA(0, 0), cA, voffA); PG8_STAGE(PG8_SA(0, 1), cA + hstepA, voffA);
    if (wr == 1) PG8_BAR;
    PG8_WAIT_V(2); PG8_BAR;
    PG8_STAGE(PG8_SB(1, 0), cB + kstep, voffB); PG8_STAGE(PG8_SA(1, 0), cA + kstep, voffA); PG8_STAGE(PG8_SB(1, 1), cB + hstepB + kstep, voffB);
    PG8_WAIT_V(6); PG8_BAR;
    for (;;) {
        const bool has_next = S.next(ui + 1, nxt);
        const char* nA = has_next ? nxt.A : cA; const char* nB = has_next ? nxt.B : cB;
        const int nt = cur.nt;
        for (int t = 0; t < nt; t += 2) {
            const bool last = (t == nt - 2);
            if constexpr (Epi::HAS_HOOK) E.hook(acc, cur, t, wid);
            const char* a1 = cA + (size_t)(t + 1) * kstep;
            const char* a2 = last ? nA : cA + (size_t)(t + 2) * kstep; const char* b2 = last ? nB : cB + (size_t)(t + 2) * kstep;
            const char* a3 = a2 + kstep; const char* b3 = b2 + kstep;
            PG8_LDB(B0, 0, 0); PG8_LDB(B1, 0, 1); PG8_SCHED; PG8_LDA(At, 0, 0); PG8_STAGE(PG8_SA(1, 1), a1 + hstepA, voffA);
            PG8_WAIT_V(8); PG8_WAIT_L(0); PG8_BAR; PG8_MMA(0, 0, At, B0); PG8_MMA(0, 1, At, B1); PG8_BAR; PG8_SCHED;
            PG8_LDA(At, 0, 1); PG8_STAGE(PG8_SB(0, 0), b2, voffB); PG8_STAGE(PG8_SB(0, 1), b2 + hstepB, voffB); PG8_STAGE(PG8_SA(0, 0), a2, voffA);
            PG8_WAIT_V(8); PG8_WAIT_L(0); PG8_BAR; PG8_MMA(1, 0, At, B0); PG8_MMA(1, 1, At, B1); PG8_BAR; PG8_SCHED;
            PG8_LDB(B0, 1, 0); PG8_LDB(B1, 1, 1); PG8_SCHED; PG8_LDA(At, 1, 0); PG8_STAGE(PG8_SA(0, 1), a2 + hstepA, voffA);
            PG8_WAIT_V(8); PG8_WAIT_L(0); PG8_BAR; PG8_MMA(0, 0, At, B0); PG8_MMA(0, 1, At, B1); PG8_BAR; PG8_SCHED;
            PG8_LDA(At, 1, 1); PG8_STAGE(PG8_SB(1, 0), b3, voffB); PG8_STAGE(PG8_SB(1, 1), b3 + hstepB, voffB); PG8_STAGE(PG8_SA(1, 0), a3, voffA);
            PG8_WAIT_V(8); PG8_WAIT_L(0); PG8_BAR; PG8_MMA(1, 0, At, B0); PG8_MMA(1, 1, At, B1); PG8_BAR; PG8_SCHED;
        }
        if (wr == 0) PG8_BAR;
#if DBL_EPI
        if (E.dbl(cur)) { E(acc, cur, wid, false); asm volatile("" ::: "memory"); }
#endif
        E(acc, cur, wid, true);
        if (!has_next) break;
        cur = nxt; cA = nA; cB = nB; ++ui;
        if (wr == 1) PG8_BAR;
    }
    PG8_WAIT_V(0);
    PG8_BAR;
#undef PG8_SA
#undef PG8_SB
#undef PG8_STAGE
#undef PG8_LDA
#undef PG8_LDB
#undef PG8_MMA
#undef PG8_WAIT_V
#undef PG8_WAIT_L
#undef PG8_BAR
#undef PG8_SCHED
}
}
namespace pg8 {
#ifndef EPIC_TEST
#define EPIC_TEST(x) (x)
#endif
__device__ __forceinline__ float row_rstd(const float* ss, int row) {
    const f32x4* p = (const f32x4*)(ss + (size_t)row * 16); const f32x4 a = p[0], b = p[1], c = p[2], d = p[3];
    const float s = ((a[0] + a[1]) + (a[2] + a[3])) + ((b[0] + b[1]) + (b[2] + b[3])) + (((c[0] + c[1]) + (c[2] + c[3])) + ((d[0] + d[1]) + (d[2] + d[3])));
    return rsqrtf(s * (1.f / DM) + EPS);
}
#ifndef USE_NT
#define USE_NT 0
#endif
#if USE_NT
#define NT_STORE(p, v) __builtin_nontemporal_store((v), (p))
#else
#define NT_STORE(p, v) (*(p) = (v))
#endif
#define EPI_LANE() const int lane_ = (int)__builtin_amdgcn_mbcnt_hi(~0u, __builtin_amdgcn_mbcnt_lo(~0u, 0u)); const int wr = wid >> 2, wc = wid & 3, fr = lane_ & 15, fq = lane_ >> 4, tid = wid * 64 + lane_; (void)wr; (void)wc; (void)fr; (void)fq; (void)tid
__device__ __forceinline__ void row_rstd8(const float* ss, int rbase, int lane, int fr, float (&rs)[8]) {
    const float a = row_rstd(ss, rbase + lane), b = row_rstd(ss, rbase + 128 + lane);
#pragma unroll
    for (int m = 0; m < 4; ++m) { rs[m] = __shfl(a, m * 16 + fr); rs[4 + m] = __shfl(b, m * 16 + fr); }
}
enum { K_IN = 0, K_GATE = 1, K_BRANCH = 2, K_RES = 3, K_GU = 4 };

__device__ __forceinline__ void rot1(float& a, float& b, float rev) {
    const float fr_ = rev - floorf(rev), c = __builtin_amdgcn_cosf(fr_), s = __builtin_amdgcn_sinf(fr_);
    const float na = a * c - b * s, nb = b * c + a * s; a = na; b = nb;
}
__device__ __forceinline__ f32x4 rot4(f32x4 v, f32x4 t) { return (f32x4){v[0] * t[0] - v[1] * t[1], v[1] * t[0] + v[0] * t[1], v[2] * t[2] - v[3] * t[3], v[3] * t[2] + v[2] * t[3]}; }

struct EpiIn {
    static constexpr bool HAS_HOOK = false;
    __device__ __forceinline__ bool dbl(const Unit&) const { return (DBL_EPI & 1) != 0; }
    bf16_t* P; const float* ss;
    __device__ __forceinline__ void operator()(f32x4 (&acc)[2][2][4][2], const Unit& u, int wid, const bool zacc) const {
        EPI_LANE();
        const int pn = u.pn;
        const int cw = wc * 32 + 8 * fq;
        const int p0 = (wc & 1) * 32 + 8 * fq;
        float ivA[4], ivR[4];
#pragma unroll
        for (int j = 0; j < 4; ++j) { ivA[j] = __builtin_amdgcn_exp2f(-(float)(4 * (fq & 1) + j) * (18.931568569324174f / 8.f)) * 0.15915494309189535f;
                                      ivR[j] = __builtin_amdgcn_exp2f(-(float)((wc & 1) * 16 + 4 * fq + j) * (13.287712379549449f / 32.f)) * 0.15915494309189535f; }
        float rs8[8];
        row_rstd8(ss, u.pm * 256 + wr * 64, lane_, fr, rs8);
#pragma unroll
        for (int ai = 0; ai < 2; ++ai)
#pragma unroll
            for (int m = 0; m < 4; ++m) {
                const int row = u.pm * 256 + ai * 128 + wr * 64 + m * 16 + fr;
                const float rstd = rs8[ai * 4 + m];
                const float fpos = (float)(row & (SEQ - 1));
#pragma unroll
                for (int bj = 0; bj < 2; ++bj) {
                    f32x4 v0 = acc[ai][bj][m][0] * rstd, v1 = acc[ai][bj][m][1] * rstd;
                    const int gc = pn * 256 + bj * 128 + cw;
                    if (pn >= 11) {
                        u32x2 w; w.x = pk2(v0[0] * v0[1], v0[2] * v0[3]); w.y = pk2(v1[0] * v1[1], v1[2] * v1[3]);
                        NT_STORE((u32x2*)(P + (size_t)row * PW + 2816 + ((gc - 2816) >> 1)), w);
                    } else {
                        if (pn < 2 || (pn == 2 && bj == 0)) {
                            if (p0 < 16) {
                                float x[8] = {v0[0], v0[1], v0[2], v0[3], v1[0], v1[1], v1[2], v1[3]};
#pragma unroll
                                for (int j = 0; j < 4; ++j) rot1(x[2 * j], x[2 * j + 1], fpos * ivA[j]);
                                v0 = (f32x4){x[0], x[1], x[2], x[3]}; v1 = (f32x4){x[4], x[5], x[6], x[7]};
                            }
                            if (pn < 2) { v0 = v0 * QSCALE; v1 = v1 * QSCALE; }
                        } else if (pn == 3 || pn == 4) {
                            float x[8] = {v0[0], v0[1], v0[2], v0[3], v1[0], v1[1], v1[2], v1[3]};
#pragma unroll
                            for (int j = 0; j < 4; ++j) rot1(x[2 * j], x[2 * j + 1], fpos * ivR[j]);
                            v0 = (f32x4){x[0], x[1], x[2], x[3]}; v1 = (f32x4){x[4], x[5], x[6], x[7]};
                            if (pn == 4) { v0 = v0 * 0.125f; v1 = v1 * 0.125f; }
                        } else if (pn == 7 || pn == 8) {
#pragma unroll
                            for (int j = 0; j < 4; ++j) { v0[j] = fsilu(v0[j]); v1[j] = fsilu(v1[j]); }
                        }
                        u32x4 w; w.x = pk2(v0[0], v0[1]); w.y = pk2(v0[2], v0[3]); w.z = pk2(v1[0], v1[1]); w.w = pk2(v1[2], v1[3]);
                        NT_STORE((u32x4*)(P + (size_t)row * PW + gc), w);
                    }
                    if (zacc) { acc[ai][bj][m][0] = (f32x4){0.f, 0.f, 0.f, 0.f}; acc[ai][bj][m][1] = (f32x4){0.f, 0.f, 0.f, 0.f}; }
                }
                asm volatile("" ::: "memory");
            }
    }
};

struct EpiC {
    static constexpr bool HAS_HOOK = true;
    __device__ __forceinline__ bool dbl(const Unit&) const { return false; }
    const float* ss; const float* bg; u32x4* G0; u32x4* G12; bf16_t* mb;
    __device__ __forceinline__ u32x4* gbuf(int br) const { return br == 0 ? G0 : G12 + (size_t)(br - 1) * 8192; }
    __device__ __forceinline__ void hook(f32x4 (&acc)[2][2][4][2], const Unit& u, int t, int wid) const {
        if (u.kind != K_BRANCH || (t != 8 && t != 16)) return;
        EPI_LANE();
        const int br = (t >> 3) - 1;
        const u32x4* Ga = gbuf(br); const u32x4* Gb = gbuf(br + 1);
#pragma unroll
        for (int ai = 0; ai < 2; ++ai)
#pragma unroll
            for (int m = 0; m < 4; ++m) {
#pragma unroll
                for (int bj = 0; bj < 2; ++bj) {
                    const int idx = (ai * 4 + m) * 2 + bj;
                    const u32x4 ga = Ga[(unsigned)(idx * 512 + tid)], gb = Gb[(unsigned)(idx * 512 + tid)];
                    f32x4 d0 = (f32x4){bflo(gb.x), bfhi(gb.x), bflo(gb.y), bfhi(gb.y)}, d1 = (f32x4){bflo(gb.z), bfhi(gb.z), bflo(gb.w), bfhi(gb.w)};
#pragma unroll
                    for (int j = 0; j < 4; ++j) { d0[j] = __builtin_amdgcn_rcpf(fmaxf(d0[j], 1e-30f)); d1[j] = __builtin_amdgcn_rcpf(fmaxf(d1[j], 1e-30f)); }
                    acc[ai][bj][m][0] = acc[ai][bj][m][0] * ((f32x4){bflo(ga.x), bfhi(ga.x), bflo(ga.y), bfhi(ga.y)} * d0);
                    acc[ai][bj][m][1] = acc[ai][bj][m][1] * ((f32x4){bflo(ga.z), bfhi(ga.z), bflo(ga.w), bfhi(ga.w)} * d1);
                }
                asm volatile("" ::: "memory");
            }
    }
    __device__ __forceinline__ void operator()(f32x4 (&acc)[2][2][4][2], const Unit& u, int wid, const bool zacc) const {
        EPI_LANE();
        const int cw = u.pn * 256 + wc * 32 + 8 * fq;
        if (EPIC_TEST(u.kind == K_GATE)) {
            const int br = u.aux;
            const float* b = bg + br * DM + cw; u32x4* Gw = gbuf(br);
            float rs8[8];
            row_rstd8(ss, u.pm * 256 + wr * 64, lane_, fr, rs8);
            const f32x4 bv00 = *(const f32x4*)(b), bv01 = *(const f32x4*)(b + 4), bv10 = *(const f32x4*)(b + 128), bv11 = *(const f32x4*)(b + 132);
            asm volatile("" ::: "memory");
#pragma unroll
            for (int ai = 0; ai < 2; ++ai)
#pragma unroll
                for (int m = 0; m < 4; ++m) {
                    const float rstd = rs8[ai * 4 + m];
#pragma unroll
                    for (int bj = 0; bj < 2; ++bj) {
                        f32x4 v0 = acc[ai][bj][m][0] * rstd + (bj ? bv10 : bv00), v1 = acc[ai][bj][m][1] * rstd + (bj ? bv11 : bv01);
#pragma unroll
                        for (int j = 0; j < 4; ++j) { v0[j] = fsigm(v0[j]); v1[j] = fsigm(v1[j]); }
                        u32x4 w; w.x = pk2(v0[0], v0[1]); w.y = pk2(v0[2], v0[3]); w.z = pk2(v1[0], v1[1]); w.w = pk2(v1[2], v1[3]);
                        Gw[(unsigned)(((ai * 4 + m) * 2 + bj) * 512 + tid)] = w;
                        if (zacc) { acc[ai][bj][m][0] = (f32x4){0.f, 0.f, 0.f, 0.f}; acc[ai][bj][m][1] = (f32x4){0.f, 0.f, 0.f, 0.f}; }
                    }
                    asm volatile("" ::: "memory");
                }
        } else {
            const u32x4* Ga = gbuf(2);
#pragma unroll
            for (int ai = 0; ai < 2; ++ai) {
                u32x4 gg[8];
#pragma unroll
                for (int q = 0; q < 8; ++q) gg[q] = Ga[(unsigned)((ai * 8 + q) * 512 + tid)];
                asm volatile("" ::: "memory");
#pragma unroll
                for (int m = 0; m < 4; ++m) {
                    const int row = u.pm * 256 + ai * 128 + wr * 64 + m * 16 + fr;
#pragma unroll
                    for (int bj = 0; bj < 2; ++bj) {
                        const u32x4 g = gg[m * 2 + bj];
                        const f32x4 v0 = acc[ai][bj][m][0] * (f32x4){bflo(g.x), bfhi(g.x), bflo(g.y), bfhi(g.y)};
                        const f32x4 v1 = acc[ai][bj][m][1] * (f32x4){bflo(g.z), bfhi(g.z), bflo(g.w), bfhi(g.w)};
                        u32x4 w; w.x = pk2(v0[0], v0[1]); w.y = pk2(v0[2], v0[3]); w.z = pk2(v1[0], v1[1]); w.w = pk2(v1[2], v1[3]);
                        *(u32x4*)(mb + (size_t)row * DM + bj * 128 + cw) = w;
                        if (zacc) { acc[ai][bj][m][0] = (f32x4){0.f, 0.f, 0.f, 0.f}; acc[ai][bj][m][1] = (f32x4){0.f, 0.f, 0.f, 0.f}; }
                    }
                }
                asm volatile("" ::: "memory");
            }
        }
    }
};

struct EpiRes {
    static constexpr bool HAS_HOOK = false;
    __device__ __forceinline__ bool dbl(const Unit&) const { return (DBL_EPI & 4) != 0 && rin != H; }
    const float* rin; float* H; bf16_t* hb; float* ssout; int mode; bf16_t* hbd;
    __device__ __forceinline__ void operator()(f32x4 (&acc)[2][2][4][2], const Unit& u, int wid, const bool zacc) const {
        EPI_LANE();
        const int cw = u.pn * 256 + wc * 32 + 8 * fq;
        if (mode & 1) {
            u32x4 rr[8][2];
#pragma unroll
            for (int q = 0; q < 8; ++q)
#pragma unroll
                for (int bj = 0; bj < 2; ++bj) rr[q][bj] = *(const u32x4*)(hb + (size_t)(u.pm * 256 + (q >> 2) * 128 + wr * 64 + (q & 3) * 16 + fr) * XW + bj * 128 + cw);
            asm volatile("" ::: "memory");
#pragma unroll
            for (int ai = 0; ai < 2; ++ai)
#pragma unroll
                for (int m = 0; m < 4; ++m) {
                    const int row = u.pm * 256 + ai * 128 + wr * 64 + m * 16 + fr;
                    float s = 0.f;
#pragma unroll
                    for (int bj = 0; bj < 2; ++bj) {
                        const size_t o = (size_t)row * DM + bj * 128 + cw;
                        const u32x4 w = rr[ai * 4 + m][bj];
                        const f32x4 v0 = acc[ai][bj][m][0] + (f32x4){bflo(w.x), bfhi(w.x), bflo(w.y), bfhi(w.y)}, v1 = acc[ai][bj][m][1] + (f32x4){bflo(w.z), bfhi(w.z), bflo(w.w), bfhi(w.w)};
                        if (mode & 2) { *(f32x4*)(H + o) = v0; *(f32x4*)(H + o + 4) = v1; }
                        u32x4 wo; wo.x = pk2(v0[0], v0[1]); wo.y = pk2(v0[2], v0[3]); wo.z = pk2(v1[0], v1[1]); wo.w = pk2(v1[2], v1[3]);
                        *(u32x4*)(hb + (size_t)row * XW + bj * 128 + cw) = wo;
                        if (hbd) *(u32x4*)(hbd + (size_t)row * DM + bj * 128 + cw) = wo;
                        s += (v0[0] * v0[0] + v0[1] * v0[1]) + (v0[2] * v0[2] + v0[3] * v0[3]) + (v1[0] * v1[0] + v1[1] * v1[1]) + (v1[2] * v1[2] + v1[3] * v1[3]);
                        if (zacc) { acc[ai][bj][m][0] = (f32x4){0.f, 0.f, 0.f, 0.f}; acc[ai][bj][m][1] = (f32x4){0.f, 0.f, 0.f, 0.f}; }
                    }
                    s += __shfl_xor(s, 16); s += __shfl_xor(s, 32);
                    if (fq == 0) ssout[(size_t)row * 16 + u.pn * 4 + wc] = s;
                }
            return;
        }
#pragma unroll
        for (int ai = 0; ai < 2; ++ai)
#pragma unroll
            for (int m = 0; m < 4; ++m) {
                const int row = u.pm * 256 + ai * 128 + wr * 64 + m * 16 + fr;
                float s = 0.f;
#pragma unroll
                for (int bj = 0; bj < 2; ++bj) {
                    const size_t o = (size_t)row * DM + bj * 128 + cw;
                    const f32x4 v0 = acc[ai][bj][m][0] + *(const f32x4*)(rin + o), v1 = acc[ai][bj][m][1] + *(const f32x4*)(rin + o + 4);
                    if (mode & 2) { *(f32x4*)(H + o) = v0; *(f32x4*)(H + o + 4) = v1; }
                    u32x4 w; w.x = pk2(v0[0], v0[1]); w.y = pk2(v0[2], v0[3]); w.z = pk2(v1[0], v1[1]); w.w = pk2(v1[2], v1[3]);
                    *(u32x4*)(hb + (size_t)row * XW + bj * 128 + cw) = w;
                    if (hbd) *(u32x4*)(hbd + (size_t)row * DM + bj * 128 + cw) = w;
                    s += (v0[0] * v0[0] + v0[1] * v0[1]) + (v0[2] * v0[2] + v0[3] * v0[3]) + (v1[0] * v1[0] + v1[1] * v1[1]) + (v1[2] * v1[2] + v1[3] * v1[3]);
                    if (zacc) { acc[ai][bj][m][0] = (f32x4){0.f, 0.f, 0.f, 0.f}; acc[ai][bj][m][1] = (f32x4){0.f, 0.f, 0.f, 0.f}; }
                }
                s += __shfl_xor(s, 16); s += __shfl_xor(s, 32);
                if (fq == 0) ssout[(size_t)row * 16 + u.pn * 4 + wc] = s;
            }
    }
};

struct EpiGU {
    static constexpr bool HAS_HOOK = false;
    __device__ __forceinline__ bool dbl(const Unit&) const { return (DBL_EPI & 2) != 0; }
    const float* ss; bf16_t* ff;
    __device__ __forceinline__ void operator()(f32x4 (&acc)[2][2][4][2], const Unit& u, int wid, const bool zacc) const {
        EPI_LANE();
        const int cj = u.pn * 128 + wc * 16 + 4 * fq;
        float rs8[8];
        row_rstd8(ss, u.pm * 256 + wr * 64, lane_, fr, rs8);
#pragma unroll
        for (int ai = 0; ai < 2; ++ai)
#pragma unroll
            for (int m = 0; m < 4; ++m) {
                const int row = u.pm * 256 + ai * 128 + wr * 64 + m * 16 + fr;
                const float rstd = rs8[ai * 4 + m];
#pragma unroll
                for (int bj = 0; bj < 2; ++bj) {
                    const f32x4 v0 = acc[ai][bj][m][0] * rstd, v1 = acc[ai][bj][m][1] * rstd;
                    u32x2 w; w.x = pk2(fsilu(v0[0]) * v0[1], fsilu(v0[2]) * v0[3]); w.y = pk2(fsilu(v1[0]) * v1[1], fsilu(v1[2]) * v1[3]);
                    NT_STORE((u32x2*)(ff + (size_t)row * DFF + bj * 64 + cj), w);
                    if (zacc) { acc[ai][bj][m][0] = (f32x4){0.f, 0.f, 0.f, 0.f}; acc[ai][bj][m][1] = (f32x4){0.f, 0.f, 0.f, 0.f}; }
                }
            }
    }
};

struct SchedPlain {
    const char* A; const char* B; int lda, ldb, nt, nM, nN, G, c, kind, pm0;
    __device__ __forceinline__ bool next(int i, Unit& u) const {
        const int L = i * G + c; if (L >= nM * nN) return false;
        tile_of(L, nM, nN, u.pm, u.pn); u.pm += pm0;
        u.A = A + (size_t)u.pm * 256 * lda * 2; u.B = B + (size_t)u.pn * 256 * ldb * 2; u.nt = nt; u.kind = kind; u.aux = 0; return true;
    }
};
struct SchedC {
    const char* X; const char* Wg; const char* Wb; int nM, G, c, pm0;
    __device__ __forceinline__ bool next(int i, Unit& u) const {
        const int j = i >> 2, sub = i & 3, L = j * G + c; if (L >= nM * 4) return false;
        tile_of(L, nM, 4, u.pm, u.pn); u.pm += pm0;
        const bool gate = sub < 3;
        u.A = X + (size_t)u.pm * 256 * XW * 2 + (gate ? 0 : 1024 * 2);
        u.B = gate ? Wg + (size_t)sub * (1024 * KC * 2) + (size_t)u.pn * 256 * KC * 2 : Wb + (size_t)u.pn * 256 * KC * 2;
        u.nt = gate ? 16 : 24; u.kind = gate ? K_GATE : K_BRANCH; u.aux = sub; return true;
    }
};
}
__device__ const double INV_A[8] = {0.15915494309189535, 0.03086376340470123, 0.005985185712713705, 0.001160663641240061, 0.00022507907903927653, 4.364795279280289e-05, 8.464330808241401e-06, 1.6414262627950345e-06};
__device__ const double INV_R[32] = {0.15915494309189535, 0.11934937021124886, 0.08949940160889101, 0.06711508300522726, 0.050329212104487035, 0.03774158471741977, 0.0283021958306234, 0.02122365276477766,
    0.015915494309189534, 0.011934937021124886, 0.008949940160889102, 0.006711508300522725, 0.005032921210448704, 0.003774158471741977, 0.00283021958306234, 0.0021223652764777662,
    0.0015915494309189536, 0.0011934937021124885, 0.0008949940160889102, 0.0006711508300522726, 0.0005032921210448703, 0.00037741584717419774, 0.00028302195830623395, 0.0002122365276477766,
    0.00015915494309189535, 0.00011934937021124886, 8.949940160889102e-05, 6.711508300522725e-05, 5.0329212104487035e-05, 3.774158471741978e-05, 2.8302195830623396e-05, 2.122365276477766e-05};
__device__ __forceinline__ float lg_gamma(int h) { return h == 0 ? -0.04580368961312479f : h == 1 ? -0.02272007650008353f : h == 2 ? -0.011315313227834146f : -0.005646563141142062f; }
__device__ __forceinline__ float ex2(float x) { return __builtin_amdgcn_exp2f(x); }
__device__ __forceinline__ float wave_sum(float v) {
#pragma unroll
    for (int o = 1; o < 64; o <<= 1) v += __shfl_xor(v, o);
    return v;
}
#define LDS_WAIT() asm volatile("s_waitcnt lgkmcnt(0)" ::: "memory")

__device__ __forceinline__ int dst_in(int s) {
    if (s < 640) { const int p = s & 63; return (p < 16) ? (s & ~63) + ((p < 8) ? 2 * p : 2 * (p - 8) + 1) : s; }
    if (s < 768) return s;
    if (s < 1280) { const int p = s & 63; return (s & ~63) + ((p < 32) ? 2 * p : 2 * (p - 32) + 1); }
    if (s < 2816) return s;
    return (s < 3328) ? 2816 + 2 * (s - 2816) : 2816 + 2 * (s - 3328) + 1;
}
__device__ __forceinline__ void cvt_item(const float* W, size_t ldw, int c0, const float* scale, bf16_t* dst, int ld, int k0, int mode, int rmul, int radd, LAS float* scr, int lane) {
    const int kr = lane >> 3, c4 = lane & 7;
    f32x4 v[8];
#pragma unroll
    for (int i = 0; i < 8; ++i) v[i] = *(const f32x4*)(W + (size_t)(k0 + 8 * i + kr) * ldw + c0 + 4 * c4);
#pragma unroll
    for (int i = 0; i < 8; ++i) { const float sc = scale ? scale[k0 + 8 * i + kr] : 1.f; LAS float* d = scr + (8 * i + kr) * 33 + 4 * c4; d[0] = v[i][0] * sc; d[1] = v[i][1] * sc; d[2] = v[i][2] * sc; d[3] = v[i][3] * sc; }
    LDS_WAIT(); asm volatile("" ::: "memory");
    const int c = lane & 7;
#pragma unroll
    for (int j = 0; j < 4; ++j) { const int n = (lane >> 3) + 8 * j; const LAS float* s = scr + (8 * c) * 33 + n;
        u32x4 o; o.x = pk2(s[0 * 33], s[1 * 33]); o.y = pk2(s[2 * 33], s[3 * 33]); o.z = pk2(s[4 * 33], s[5 * 33]); o.w = pk2(s[6 * 33], s[7 * 33]);
        const int row = (mode ? dst_in(c0 + n) : c0 + n) * rmul + radd;
        *(u32x4*)(dst + (size_t)row * ld + k0 + 8 * c) = o; }
    LDS_WAIT(); asm volatile("" ::: "memory");
}
constexpr int CV_J0 = 3456, CV_J2 = 768, CV_J3 = 512, CV_J4 = 2816, CV_J5 = 1408, CV_PER_LAYER = CV_J0 + CV_J2 + CV_J3 + CV_J4 + CV_J5;
__device__ __forceinline__ void phase_prologue(const Args& a, LAS unsigned char* lds, int G, const int tid) {
    const int lane = tid & 63, wave = tid >> 6;
    const int gw = blockIdx.x * 8 + wave, NGW = G * 8;
    LAS float* scr = (LAS float*)(lds + wave * 16384);
    for (int it = gw; it < DEPTH * CV_PER_LAYER; it += NGW) {
        const int l = it / CV_PER_LAYER; int r = it - l * CV_PER_LAYER;
        bf16_t* Wl = (bf16_t*)(a.ws + WS_W + (size_t)l * WL_SIZE);
        if (r < CV_J0) { const int kb = r / 216, cb = r % 216;
            if (cb < 120) cvt_item(a.w_in + (size_t)l * DM * DIN, DIN, cb * 32, a.norm_mix + l * DM, Wl + WL_IN / 2, DM, kb * 64, 1, 1, 0, scr, lane);
            else          cvt_item(a.w_in + (size_t)l * DM * DIN, DIN, cb * 32, a.norm_mix + l * DM, Wl + WL_C / 2, KC, kb * 64, 0, 1, -3840, scr, lane);
            continue; } r -= CV_J0;
        if (r < CV_J2) { const int i = r >> 8, kb = (r >> 5) & 7, cb = r & 31;
            cvt_item(a.w_branch + (size_t)(l * 3 + i) * 512 * DM, DM, cb * 32, nullptr, Wl + WL_B / 2 + i * 512, KC, kb * 64, 0, 1, 0, scr, lane); continue; } r -= CV_J2;
        if (r < CV_J3) { const int kb = r >> 5, cb = r & 31;
            cvt_item(a.w_out + (size_t)l * DM * DM, DM, cb * 32, nullptr, Wl + WL_OUT / 2, DM, kb * 64, 0, 1, 0, scr, lane); continue; } r -= CV_J3;
        if (r < CV_J4) { const int up = r / 1408, q = r % 1408, kb = q / 88, cb = q % 88;
            cvt_item((up ? a.w_u : a.w_g) + (size_t)l * DM * DFF, DFF, cb * 32, a.norm_ffn + l * DM, Wl + WL_GU / 2, DM, kb * 64, 0, 2, up, scr, lane); continue; } r -= CV_J4;
        { const int kb = r >> 5, cb = r & 31;
            cvt_item(a.w_d + (size_t)l * DFF * DM, DM, cb * 32, nullptr, Wl + WL_D / 2, DFF, kb * 64, 0, 1, 0, scr, lane); }
    }
    bf16_t* X = (bf16_t*)(a.ws + WS_X); float* ss = (float*)(a.ws + WS_SS);
    for (int row = gw; row < M; row += NGW) {
        const f32x4* xr = (const f32x4*)(a.x + (size_t)row * DM) + lane; float s = 0.f;
#pragma unroll
        for (int j = 0; j < 4; ++j) { const f32x4 v = xr[64 * j]; s += (v[0] * v[0] + v[1] * v[1]) + (v[2] * v[2] + v[3] * v[3]);
            u32x2 w; w.x = pk2(v[0], v[1]); w.y = pk2(v[2], v[3]); *(u32x2*)(X + (size_t)row * XW + (64 * j + lane) * 4) = w; }
        s = wave_sum(s); if (lane < 16) ss[(size_t)row * 16 + lane] = (lane == 0) ? s : 0.f;
    }
}

__device__ __forceinline__ void attn_naive(LAS unsigned char* lds, const bf16_t* P, bf16_t* X, const float* sinks, int unit, const int tid) {
    const int b = unit >> 5, n = (unit >> 1) & 15, g = unit & 1;
    LAS bf16_t* Ks = (LAS bf16_t*)lds; LAS bf16_t* Vs = Ks + 256 * 72;
    const long row0 = (long)b * SEQ + n * 128 - 128;
    for (int c = tid; c < 2048; c += 512) {
        const int key = c >> 3, ch = c & 7; u32x4 kv = {0u, 0u, 0u, 0u}, vv = {0u, 0u, 0u, 0u};
        if (n > 0 || key >= 128) { const bf16_t* src = P + (size_t)(row0 + key) * PW + g * 64 + ch * 8; kv = *(const u32x4*)(src + 512); vv = *(const u32x4*)(src + 640); }
        *(LAS u32x4*)(Ks + key * 72 + ch * 8) = kv; *(LAS u32x4*)(Vs + key * 72 + ch * 8) = vv;
    }
    __syncthreads();
    const int r = tid & 127, hq = g * 4 + (tid >> 7);
    const size_t qrow = (size_t)b * SEQ + n * 128 + r;
    float q[64], o[64];
    { const u32x4* qp = (const u32x4*)(P + qrow * PW + hq * 64);
#pragma unroll
      for (int c = 0; c < 8; ++c) { const u32x4 w = qp[c]; q[8 * c] = bflo(w.x); q[8 * c + 1] = bfhi(w.x); q[8 * c + 2] = bflo(w.y); q[8 * c + 3] = bfhi(w.y); q[8 * c + 4] = bflo(w.z); q[8 * c + 5] = bfhi(w.z); q[8 * c + 6] = bflo(w.w); q[8 * c + 7] = bfhi(w.w); } }
#pragma unroll
    for (int d = 0; d < 64; ++d) o[d] = 0.f;
    float mx = sinks[hq] * LOG2E, l = 1.f;
    for (int j = 0; j < 128; ++j) {
        const int kt = r + 1 + j; const bool valid = (n > 0) || (kt >= 128);
        const LAS u32x4* kp = (const LAS u32x4*)(Ks + kt * 72);
        float s = 0.f;
#pragma unroll
        for (int c = 0; c < 8; ++c) { const u32x4 w = kp[c];
            s += q[8 * c] * bflo(w.x) + q[8 * c + 1] * bfhi(w.x) + q[8 * c + 2] * bflo(w.y) + q[8 * c + 3] * bfhi(w.y) + q[8 * c + 4] * bflo(w.z) + q[8 * c + 5] * bfhi(w.z) + q[8 * c + 6] * bflo(w.w) + q[8 * c + 7] * bfhi(w.w); }
        s = valid ? s : -INFINITY;
        const float mn = fmaxf(mx, s), sc = ex2(mx - mn), p = ex2(s - mn);
        l = l * sc + p; mx = mn;
        const LAS u32x4* vp = (const LAS u32x4*)(Vs + kt * 72);
#pragma unroll
        for (int c = 0; c < 8; ++c) { const u32x4 w = vp[c];
            o[8 * c] = o[8 * c] * sc + p * bflo(w.x); o[8 * c + 1] = o[8 * c + 1] * sc + p * bfhi(w.x); o[8 * c + 2] = o[8 * c + 2] * sc + p * bflo(w.y); o[8 * c + 3] = o[8 * c + 3] * sc + p * bfhi(w.y);
            o[8 * c + 4] = o[8 * c + 4] * sc + p * bflo(w.z); o[8 * c + 5] = o[8 * c + 5] * sc + p * bfhi(w.z); o[8 * c + 6] = o[8 * c + 6] * sc + p * bflo(w.w); o[8 * c + 7] = o[8 * c + 7] * sc + p * bfhi(w.w); }
    }
    const float il = 1.f / l;
    u32x4* op = (u32x4*)(X + qrow * XW + 1024 + hq * 64);
#pragma unroll
    for (int c = 0; c < 8; ++c) { u32x4 w; w.x = pk2(o[8 * c] * il, o[8 * c + 1] * il); w.y = pk2(o[8 * c + 2] * il, o[8 * c + 3] * il); w.z = pk2(o[8 * c + 4] * il, o[8 * c + 5] * il); w.w = pk2(o[8 * c + 6] * il, o[8 * c + 7] * il); op[c] = w; }
    __syncthreads();
}

__device__ __forceinline__ void kv_naive(LAS unsigned char* lds, const bf16_t* P, float* kv, int unit, const int tid) {
    const int b = unit >> 6, h = (unit >> 4) & 3, n = unit & 15;
    LAS float* kz = (LAS float*)lds; LAS float* vs = kz + 128 * 64;
    const size_t rowc = (size_t)b * SEQ + n * 128; const float lg = lg_gamma(h);
    for (int i = tid; i < 128 * 8; i += 512) { const int tok = i >> 3, ch = i & 7; const u32x4 w = *(const u32x4*)(P + (rowc + tok) * PW + 1024 + h * 64 + ch * 8); const float z = ex2((float)(127 - tok) * lg);
        LAS float* d = kz + tok * 64 + ch * 8; d[0] = bflo(w.x) * z; d[1] = bfhi(w.x) * z; d[2] = bflo(w.y) * z; d[3] = bfhi(w.y) * z; d[4] = bflo(w.z) * z; d[5] = bfhi(w.z) * z; d[6] = bflo(w.w) * z; d[7] = bfhi(w.w) * z; }
    for (int i = tid; i < 128 * 16; i += 512) { const int tok = i >> 4, ch = i & 15; const u32x4 w = *(const u32x4*)(P + (rowc + tok) * PW + 1280 + h * 128 + ch * 8);
        LAS float* d = vs + tok * 128 + ch * 8; d[0] = bflo(w.x); d[1] = bfhi(w.x); d[2] = bflo(w.y); d[3] = bfhi(w.y); d[4] = bflo(w.z); d[5] = bfhi(w.z); d[6] = bflo(w.w); d[7] = bfhi(w.w); }
    __syncthreads();
    const int e = tid & 127, d0 = (tid >> 7) * 16;
    float acc[16];
#pragma unroll
    for (int dd = 0; dd < 16; ++dd) acc[dd] = 0.f;
    for (int tok = 0; tok < 128; ++tok) { const float vv = vs[tok * 128 + e];
#pragma unroll
        for (int dd = 0; dd < 16; ++dd) acc[dd] += kz[tok * 64 + d0 + dd] * vv; }
#pragma unroll
    for (int dd = 0; dd < 16; ++dd) kv[((size_t)unit * 64 + d0 + dd) * 128 + e] = acc[dd];
    __syncthreads();
}

__device__ __forceinline__ void ret_naive(LAS unsigned char* lds, const bf16_t* P, const float* kv, bf16_t* X, int unit, const int tid) {
    const int b = unit >> 6, h = (unit >> 4) & 3, n = unit & 15;
    LAS float* St = (LAS float*)lds;
    LAS bf16_t* qs = (LAS bf16_t*)(lds + 32768);
    LAS bf16_t* ks = (LAS bf16_t*)(lds + 49152);
    LAS bf16_t* vs = (LAS bf16_t*)(lds + 65536);
    const size_t rowc = (size_t)b * SEQ + n * 128; const float lg = lg_gamma(h);
    { const int e = tid & 127, d0 = (tid >> 7) * 16; float s[16];
#pragma unroll
      for (int dd = 0; dd < 16; ++dd) s[dd] = 0.f;
      for (int j = 0; j < n; ++j) { const float w = ex2((float)((n - 1 - j) * 128) * lg); const float* kj = kv + ((size_t)(unit - n + j) * 64 + d0) * 128 + e;
#pragma unroll
          for (int dd = 0; dd < 16; ++dd) s[dd] += w * kj[dd * 128]; }
#pragma unroll
      for (int dd = 0; dd < 16; ++dd) St[(d0 + dd) * 128 + e] = s[dd]; }
    for (int i = tid; i < 128 * 8; i += 512) { const int tok = i >> 3, ch = i & 7; const bf16_t* src = P + (rowc + tok) * PW + h * 64 + ch * 8;
        *(LAS u32x4*)(qs + tok * 64 + ch * 8) = *(const u32x4*)(src + 768); *(LAS u32x4*)(ks + tok * 64 + ch * 8) = *(const u32x4*)(src + 1024); }
    for (int i = tid; i < 128 * 16; i += 512) { const int tok = i >> 4, ch = i & 15; *(LAS u32x4*)(vs + tok * 128 + ch * 8) = *(const u32x4*)(P + (rowc + tok) * PW + 1280 + h * 128 + ch * 8); }
    __syncthreads();
    const int r = tid >> 2, e0 = (tid & 3) * 32;
    float q[64], y[32];
    { const LAS u32x4* qp = (const LAS u32x4*)(qs + r * 64);
#pragma unroll
      for (int c = 0; c < 8; ++c) { const u32x4 w = qp[c]; q[8 * c] = bflo(w.x); q[8 * c + 1] = bfhi(w.x); q[8 * c + 2] = bflo(w.y); q[8 * c + 3] = bfhi(w.y); q[8 * c + 4] = bflo(w.z); q[8 * c + 5] = bfhi(w.z); q[8 * c + 6] = bflo(w.w); q[8 * c + 7] = bfhi(w.w); } }
#pragma unroll
    for (int ee = 0; ee < 32; ++ee) y[ee] = 0.f;
#pragma unroll 2
    for (int d = 0; d < 64; ++d) { const float qd = bf2f(qs[r * 64 + d]); const LAS f32x4* sp = (const LAS f32x4*)(St + d * 128 + e0);
#pragma unroll
        for (int c = 0; c < 8; ++c) { const f32x4 sv = sp[c]; y[4 * c] += qd * sv[0]; y[4 * c + 1] += qd * sv[1]; y[4 * c + 2] += qd * sv[2]; y[4 * c + 3] += qd * sv[3]; } }
    { const float xi = ex2((float)(r + 1) * lg);
#pragma unroll
      for (int ee = 0; ee < 32; ++ee) y[ee] *= xi; }
    const int rmax = (tid | 63) >> 2;
    for (int kk = 0; kk <= rmax; ++kk) {
        const LAS u32x4* kp = (const LAS u32x4*)(ks + kk * 64);
        float s = 0.f;
#pragma unroll
        for (int c = 0; c < 8; ++c) { const u32x4 w = kp[c];
            s += q[8 * c] * bflo(w.x) + q[8 * c + 1] * bfhi(w.x) + q[8 * c + 2] * bflo(w.y) + q[8 * c + 3] * bfhi(w.y) + q[8 * c + 4] * bflo(w.z) + q[8 * c + 5] * bfhi(w.z) + q[8 * c + 6] * bflo(w.w) + q[8 * c + 7] * bfhi(w.w); }
        const float aw = (kk <= r) ? s * ex2((float)(r - kk) * lg) : 0.f;
        const LAS u32x4* vp = (const LAS u32x4*)(vs + kk * 128 + e0);
#pragma unroll
        for (int c = 0; c < 4; ++c) { const u32x4 w = vp[c];
            y[8 * c] += aw * bflo(w.x); y[8 * c + 1] += aw * bfhi(w.x); y[8 * c + 2] += aw * bflo(w.y); y[8 * c + 3] += aw * bfhi(w.y); y[8 * c + 4] += aw * bflo(w.z); y[8 * c + 5] += aw * bfhi(w.z); y[8 * c + 6] += aw * bflo(w.w); y[8 * c + 7] += aw * bfhi(w.w); }
    }
    float sq = 0.f;
#pragma unroll
    for (int ee = 0; ee < 32; ++ee) sq += y[ee] * y[ee];
    sq += __shfl_xor(sq, 1); sq += __shfl_xor(sq, 2);
    const float rs = rsqrtf(sq * (1.f / 128.f) + EPS);
    const u32x4* gp = (const u32x4*)(P + (rowc + r) * PW + 1792 + h * 128 + e0);
    u32x4* op = (u32x4*)(X + (rowc + r) * XW + 1536 + h * 128 + e0);
#pragma unroll
    for (int c = 0; c < 4; ++c) { const u32x4 gw = gp[c]; u32x4 w;
        w.x = pk2(y[8 * c] * rs * bflo(gw.x), y[8 * c + 1] * rs * bfhi(gw.x)); w.y = pk2(y[8 * c + 2] * rs * bflo(gw.y), y[8 * c + 3] * rs * bfhi(gw.y));
        w.z = pk2(y[8 * c + 4] * rs * bflo(gw.z), y[8 * c + 5] * rs * bfhi(gw.z)); w.w = pk2(y[8 * c + 6] * rs * bflo(gw.w), y[8 * c + 7] * rs * bfhi(gw.w)); op[c] = w; }
    __syncthreads();
}

__device__ __forceinline__ void conv_all(const bf16_t* P, const float* cw, bf16_t* X, int G, int c, int row0, int nrows, const int tid) {
    const int gt = c * 512 + tid, NT = G * 512;
    for (int i = gt; i < nrows * 64; i += NT) {
        const int row = row0 + (i >> 6), ch = i & 63, t = row & (SEQ - 1);
        const bf16_t* p = P + (size_t)row * PW + ch * 8;
        const u32x4 cb = *(const u32x4*)(p + 2304), u0 = *(const u32x4*)(p + 2816);
        u32x4 u1 = {0u, 0u, 0u, 0u}, u2 = {0u, 0u, 0u, 0u};
        if (t >= 1) u1 = *(const u32x4*)(p + 2816 - PW);
        if (t >= 2) u2 = *(const u32x4*)(p + 2816 - 2 * PW);
        const f32x4 w0a = *(const f32x4*)(cw + ch * 8), w0b = *(const f32x4*)(cw + ch * 8 + 4), w1a = *(const f32x4*)(cw + 512 + ch * 8), w1b = *(const f32x4*)(cw + 512 + ch * 8 + 4),
                    w2a = *(const f32x4*)(cw + 1024 + ch * 8), w2b = *(const f32x4*)(cw + 1024 + ch * 8 + 4);
        u32x4 o;
        o.x = pk2(bflo(cb.x) * (w0a[0] * bflo(u2.x) + w1a[0] * bflo(u1.x) + w2a[0] * bflo(u0.x)), bfhi(cb.x) * (w0a[1] * bfhi(u2.x) + w1a[1] * bfhi(u1.x) + w2a[1] * bfhi(u0.x)));
        o.y = pk2(bflo(cb.y) * (w0a[2] * bflo(u2.y) + w1a[2] * bflo(u1.y) + w2a[2] * bflo(u0.y)), bfhi(cb.y) * (w0a[3] * bfhi(u2.y) + w1a[3] * bfhi(u1.y) + w2a[3] * bfhi(u0.y)));
        o.z = pk2(bflo(cb.z) * (w0b[0] * bflo(u2.z) + w1b[0] * bflo(u1.z) + w2b[0] * bflo(u0.z)), bfhi(cb.z) * (w0b[1] * bfhi(u2.z) + w1b[1] * bfhi(u1.z) + w2b[1] * bfhi(u0.z)));
        o.w = pk2(bflo(cb.w) * (w0b[2] * bflo(u2.w) + w1b[2] * bflo(u1.w) + w2b[2] * bflo(u0.w)), bfhi(cb.w) * (w0b[3] * bfhi(u2.w) + w1b[3] * bfhi(u1.w) + w2b[3] * bfhi(u0.w)));
        *(u32x4*)(X + (size_t)row * XW + 2048 + ch * 8) = o;
    }
}

__device__ __forceinline__ void final_norm(float* H, const float* ss, const float* g, int G, int c, int row0, int nrows, const int tid) {
    const int lane = tid & 63, gw = c * 8 + (tid >> 6), NGW = G * 8;
    for (int row = row0 + gw; row < row0 + nrows; row += NGW) {
        const float rstd = pg8::row_rstd(ss, row);
        f32x4* hr = (f32x4*)(H + (size_t)row * DM) + lane; const f32x4* gr = (const f32x4*)g + lane;
#pragma unroll
        for (int j = 0; j < 4; ++j) hr[64 * j] = hr[64 * j] * rstd * gr[64 * j];
    }
}
#ifndef RET_PROBE
#define RET_PROBE 0
#endif
typedef float f32x16 __attribute__((ext_vector_type(16)));
#define MFMA32(a, b, c) __builtin_amdgcn_mfma_f32_32x32x16_bf16((a), (b), (c), 0, 0, 0)
__device__ __forceinline__ int crow(int i, int hh) { return (i & 3) + 8 * (i >> 2) + 4 * hh; }
__device__ __forceinline__ bf16x8 pack8(const f32x16& v, int s) {
    u32x4 t; t.x = pk2(v[8 * s], v[8 * s + 1]); t.y = pk2(v[8 * s + 2], v[8 * s + 3]); t.z = pk2(v[8 * s + 4], v[8 * s + 5]); t.w = pk2(v[8 * s + 6], v[8 * s + 7]);
    return __builtin_bit_cast(bf16x8, t);
}
__device__ __forceinline__ bf16x8 join8(u32x2 a, u32x2 b) { u32x4 t = {a.x, a.y, b.x, b.y}; return __builtin_bit_cast(bf16x8, t); }
__device__ __forceinline__ void tr_store8(LAS unsigned* T32, int pitch32, int ch, int p, u32x4 w0, u32x4 w1) {
    LAS unsigned* t = T32 + (ch * 8) * pitch32 + (p ^ ((ch & 7) << 2));
    t[0 * pitch32] = (w0.x & 0xffffu) | (w1.x << 16); t[1 * pitch32] = (w0.x >> 16) | (w1.x & 0xffff0000u);
    t[2 * pitch32] = (w0.y & 0xffffu) | (w1.y << 16); t[3 * pitch32] = (w0.y >> 16) | (w1.y & 0xffff0000u);
    t[4 * pitch32] = (w0.z & 0xffffu) | (w1.z << 16); t[5 * pitch32] = (w0.z >> 16) | (w1.z & 0xffff0000u);
    t[6 * pitch32] = (w0.w & 0xffffu) | (w1.w << 16); t[7 * pitch32] = (w0.w >> 16) | (w1.w & 0xffff0000u);
}
__device__ __forceinline__ int tr_off(int c, int pitch32, int d) { return 2 * (c * pitch32 + (d ^ (((c >> 3) & 7) << 2))); }

__device__ __forceinline__ void attn_mfma(LAS unsigned char* lds, const bf16_t* P, bf16_t* X, const float* sinks, int unit, const int tid) {
    const int lane = tid & 63, wid = __builtin_amdgcn_readfirstlane(tid >> 6), r32 = lane & 31, hh = lane >> 5;
    const int b = unit >> 5, n = (unit >> 1) & 15, g = unit & 1;
    LAS bf16_t* Ks = (LAS bf16_t*)lds;
    LAS bf16_t* Vt = Ks + 256 * 72;
    const long row0 = (long)b * SEQ + n * 128 - 128;
    { u32x4 kv[4], w0[2], w1[2];
#pragma unroll
      for (int i = 0; i < 4; ++i) { const int c = tid + 512 * i, key = c >> 3, ch = c & 7; kv[i] = (u32x4){0u, 0u, 0u, 0u};
          if (n > 0 || key >= 128) kv[i] = *(const u32x4*)(P + (size_t)(row0 + key) * PW + 512 + g * 64 + ch * 8); }
#pragma unroll
      for (int i = 0; i < 2; ++i) { const int it = tid + 512 * i, kp = it >> 3, ch = it & 7; w0[i] = (u32x4){0u, 0u, 0u, 0u}; w1[i] = w0[i];
          if (n > 0 || kp >= 64) { const bf16_t* src = P + (size_t)(row0 + 2 * kp) * PW + 640 + g * 64 + ch * 8; w0[i] = *(const u32x4*)src; w1[i] = *(const u32x4*)(src + PW); } }
#pragma unroll
      for (int i = 0; i < 4; ++i) { const int c = tid + 512 * i, key = c >> 3, ch = c & 7; *(LAS u32x4*)(Ks + key * 72 + ch * 8) = kv[i]; }
#pragma unroll
      for (int i = 0; i < 2; ++i) { const int it = tid + 512 * i, kp = it >> 3, ch = it & 7; tr_store8((LAS unsigned*)Vt, 132, ch, kp, w0[i], w1[i]); } }
    __syncthreads();
    const int hq = g * 4 + (wid >> 1);
    const float sink2 = sinks[hq] * LOG2E;
    for (int pass = 0; pass < 2; ++pass) {
        const int r0 = (wid & 1) * 64 + pass * 32;
        const size_t qrow = (size_t)b * SEQ + n * 128 + r0 + r32;
        bf16x8 qf[4];
        { const bf16_t* qp = P + qrow * PW + hq * 64 + 8 * hh;
#pragma unroll
          for (int s = 0; s < 4; ++s) qf[s] = *(const bf16x8*)(qp + 16 * s); }
        f32x16 S[5];
#pragma unroll
        for (int j = 0; j < 5; ++j) {
#pragma unroll
            for (int i = 0; i < 16; ++i) S[j][i] = 0.f;
            const LAS bf16_t* kp = Ks + (r0 + 32 * j + r32) * 72 + 8 * hh;
#pragma unroll
            for (int s = 0; s < 4; ++s) S[j] = MFMA32(*(const LAS bf16x8*)(kp + 16 * s), qf[s], S[j]);
        }
#pragma unroll
        for (int i = 0; i < 16; ++i) { const int c = crow(i, hh); if (c <= r32) S[0][i] = -INFINITY; if (c > r32) S[4][i] = -INFINITY; }
        if (n == 0) {
#pragma unroll
            for (int j = 0; j < 4; ++j) if (r0 + 32 * j < 128) {
#pragma unroll
                for (int i = 0; i < 16; ++i) S[j][i] = -INFINITY; }
        }
        float mx = sink2;
#pragma unroll
        for (int j = 0; j < 5; ++j)
#pragma unroll
            for (int i = 0; i < 16; ++i) mx = fmaxf(mx, S[j][i]);
        mx = fmaxf(mx, __shfl_xor(mx, 32));
        float l = 0.f;
#pragma unroll
        for (int j = 0; j < 5; ++j)
#pragma unroll
            for (int i = 0; i < 16; ++i) { const float p = ex2(S[j][i] - mx); S[j][i] = p; l += p; }
        l += __shfl_xor(l, 32);
        l += ex2(sink2 - mx);
        f32x16 o[2];
#pragma unroll
        for (int i = 0; i < 16; ++i) { o[0][i] = 0.f; o[1][i] = 0.f; }
#pragma unroll
        for (int j = 0; j < 5; ++j)
#pragma unroll
            for (int s = 0; s < 2; ++s) {
                const bf16x8 pf = pack8(S[j], s);
#pragma unroll
                for (int dt = 0; dt < 2; ++dt) {
                    const int dd = (r0 + 32 * j + 16 * s + 4 * hh) >> 1;
                    o[dt] = MFMA32(join8(*(const LAS u32x2*)(Vt + tr_off(32 * dt + r32, 132, dd)), *(const LAS u32x2*)(Vt + tr_off(32 * dt + r32, 132, dd + 4))), pf, o[dt]);
                }
            }
        const float il = 1.f / l;
        bf16_t* op = X + qrow * XW + 1024 + hq * 64 + 4 * hh;
#pragma unroll
        for (int dt = 0; dt < 2; ++dt)
#pragma unroll
            for (int g4 = 0; g4 < 4; ++g4) { u32x2 w; w.x = pk2(o[dt][4 * g4] * il, o[dt][4 * g4 + 1] * il); w.y = pk2(o[dt][4 * g4 + 2] * il, o[dt][4 * g4 + 3] * il);
                *(u32x2*)(op + 32 * dt + 8 * g4) = w; }
    }
    __syncthreads();
}

__device__ __forceinline__ void kv_mfma(LAS unsigned char* lds, const bf16_t* P, bf16_t* kvT, int unit, const int tid) {
    const int lane = tid & 63, wid = __builtin_amdgcn_readfirstlane(tid >> 6), r32 = lane & 31, hh = lane >> 5;
    const int b = unit >> 6, h = (unit >> 4) & 3, n = unit & 15;
    LAS bf16_t* Kt = (LAS bf16_t*)lds;
    LAS bf16_t* Vt = Kt + 64 * 136;
    const size_t rowc = (size_t)b * SEQ + n * 128; const float lg = lg_gamma(h);
    { const int tp = tid >> 3, ch = tid & 7;
      const bf16_t* src = P + (rowc + 2 * tp) * PW + 1024 + h * 64 + ch * 8; const u32x4 w0 = *(const u32x4*)src, w1 = *(const u32x4*)(src + PW);
      const int tv = tid >> 3, cv = 2 * (tid & 7);
      const bf16_t* sv = P + (rowc + 2 * tv) * PW + 1280 + h * 128 + cv * 8;
      const u32x4 va0 = *(const u32x4*)sv, va1 = *(const u32x4*)(sv + PW), vb0 = *(const u32x4*)(sv + 8), vb1 = *(const u32x4*)(sv + 8 + PW);
      const float z0 = ex2((float)(127 - 2 * tp) * lg), z1 = ex2((float)(126 - 2 * tp) * lg);
      LAS unsigned* t = (LAS unsigned*)Kt + (ch * 8) * 68 + (tp ^ ((ch & 7) << 2));
      t[0 * 68] = pk2(bflo(w0.x) * z0, bflo(w1.x) * z1); t[1 * 68] = pk2(bfhi(w0.x) * z0, bfhi(w1.x) * z1); t[2 * 68] = pk2(bflo(w0.y) * z0, bflo(w1.y) * z1); t[3 * 68] = pk2(bfhi(w0.y) * z0, bfhi(w1.y) * z1);
      t[4 * 68] = pk2(bflo(w0.z) * z0, bflo(w1.z) * z1); t[5 * 68] = pk2(bfhi(w0.z) * z0, bfhi(w1.z) * z1); t[6 * 68] = pk2(bflo(w0.w) * z0, bflo(w1.w) * z1); t[7 * 68] = pk2(bfhi(w0.w) * z0, bfhi(w1.w) * z1);
      tr_store8((LAS unsigned*)Vt, 68, cv, tv, va0, va1); tr_store8((LAS unsigned*)Vt, 68, cv + 1, tv, vb0, vb1); }
    __syncthreads();
    const int et = wid >> 1, dt = wid & 1;
    f32x16 acc;
#pragma unroll
    for (int i = 0; i < 16; ++i) acc[i] = 0.f;
#pragma unroll
    for (int s = 0; s < 8; ++s) acc = MFMA32(*(const LAS bf16x8*)(Kt + tr_off(32 * dt + r32, 68, 8 * s + 4 * hh)), *(const LAS bf16x8*)(Vt + tr_off(32 * et + r32, 68, 8 * s + 4 * hh)), acc);
    bf16_t* o = kvT + ((size_t)unit * 128 + 32 * et + r32) * 64 + 32 * dt + 4 * hh;
#pragma unroll
    for (int g4 = 0; g4 < 4; ++g4) { u32x2 w; w.x = pk2(acc[4 * g4], acc[4 * g4 + 1]); w.y = pk2(acc[4 * g4 + 2], acc[4 * g4 + 3]); *(u32x2*)(o + 8 * g4) = w; }
    __syncthreads();
}

__device__ __forceinline__ void ret_mfma(LAS unsigned char* lds, const bf16_t* P, const bf16_t* kvT, bf16_t* X, int unit, const int tid) {
    const int lane = tid & 63, wid = __builtin_amdgcn_readfirstlane(tid >> 6), r32 = lane & 31, hh = lane >> 5;
    const int b = unit >> 6, h = (unit >> 4) & 3, n = unit & 15;
    LAS bf16_t* St = (LAS bf16_t*)lds;
    LAS bf16_t* Ks = St + 128 * 72;
    LAS bf16_t* Vt = Ks + 128 * 72;
    LAS float* ssq = (LAS float*)(Vt + 128 * 136);
    const size_t rowc = (size_t)b * SEQ + n * 128; const float lg = lg_gamma(h);
    const int rb = wid >> 1, eh = wid & 1;
    const size_t qrow = rowc + 32 * rb + r32;
    bf16x8 qf[4];
    { const bf16_t* qp = P + qrow * PW + 768 + h * 64 + 8 * hh;
#pragma unroll
      for (int s = 0; s < 4; ++s) qf[s] = *(const bf16x8*)(qp + 16 * s);
    }
    {
    u32x4 kst[2], vst0[2], vst1[2];
#pragma unroll
    for (int i = 0; i < 2; ++i) { const int c = tid + 512 * i; kst[i] = *(const u32x4*)(P + (rowc + (c >> 3)) * PW + 1024 + h * 64 + (c & 7) * 8);
        const int it = tid + 512 * i; const bf16_t* src = P + (rowc + 2 * (it >> 4)) * PW + 1280 + h * 128 + (it & 15) * 8; vst0[i] = *(const u32x4*)src; vst1[i] = *(const u32x4*)(src + PW); }
    { const int e = tid >> 2, d0 = (tid & 3) * 16; float s[16];
#pragma unroll
      for (int k = 0; k < 16; ++k) s[k] = 0.f;
      if (n > 0) {
          const u32x4* kb = (const u32x4*)(kvT + ((size_t)(unit - n) * 128 + e) * 64 + d0);
#pragma unroll
          for (int g = 0; g < 2; ++g) {
              const int j0 = 12 * g, nj = g ? 3 : 12;
              if (g && n <= 12) break;
              u32x4 t[12][2];
#pragma unroll
              for (int j = 0; j < 12; ++j) if (j < nj) { const int jj = (j0 + j) < n ? (j0 + j) : n - 1; t[j][0] = kb[(size_t)jj * 1024]; t[j][1] = kb[(size_t)jj * 1024 + 1]; }
#pragma unroll
              for (int j = 0; j < 12; ++j) if (j < nj) { const float w = (j0 + j) < n ? ex2((float)((n - 1 - j0 - j) * 128) * lg) : 0.f;
#pragma unroll
                  for (int q = 0; q < 2; ++q) { const u32x4 v = t[j][q];
                      s[8 * q] += w * bflo(v.x); s[8 * q + 1] += w * bfhi(v.x); s[8 * q + 2] += w * bflo(v.y); s[8 * q + 3] += w * bfhi(v.y);
                      s[8 * q + 4] += w * bflo(v.z); s[8 * q + 5] += w * bfhi(v.z); s[8 * q + 6] += w * bflo(v.w); s[8 * q + 7] += w * bfhi(v.w); } }
          }
      }
      u32x4 w0, w1; w0.x = pk2(s[0], s[1]); w0.y = pk2(s[2], s[3]); w0.z = pk2(s[4], s[5]); w0.w = pk2(s[6], s[7]);
      w1.x = pk2(s[8], s[9]); w1.y = pk2(s[10], s[11]); w1.z = pk2(s[12], s[13]); w1.w = pk2(s[14], s[15]);
      *(LAS u32x4*)(St + e * 72 + d0) = w0; *(LAS u32x4*)(St + e * 72 + d0 + 8) = w1; }
#pragma unroll
    for (int i = 0; i < 2; ++i) { const int c = tid + 512 * i; *(LAS u32x4*)(Ks + (c >> 3) * 72 + (c & 7) * 8) = kst[i]; }
#pragma unroll
    for (int i = 0; i < 2; ++i) { const int it = tid + 512 * i; tr_store8((LAS unsigned*)Vt, 68, it & 15, it >> 4, vst0[i], vst1[i]); }
    __syncthreads();
    }
    {
    u32x2 gw[2][4];
    { const bf16_t* gp = P + qrow * PW + 1792 + h * 128 + 64 * eh + 4 * hh;
#pragma unroll
      for (int et = 0; et < 2; ++et)
#pragma unroll
          for (int g4 = 0; g4 < 4; ++g4) gw[et][g4] = *(const u32x2*)(gp + 32 * et + 8 * g4); }
    f32x16 o[2];
#pragma unroll
    for (int i = 0; i < 16; ++i) { o[0][i] = 0.f; o[1][i] = 0.f; }
#pragma unroll
    for (int et = 0; et < 2; ++et) { const LAS bf16_t* sp = St + (64 * eh + 32 * et + r32) * 72 + 8 * hh;
#pragma unroll
        for (int s = 0; s < 4; ++s) o[et] = MFMA32(*(const LAS bf16x8*)(sp + 16 * s), qf[s], o[et]); }
    { const float xi = ex2((float)(32 * rb + r32 + 1) * lg);
#pragma unroll
      for (int i = 0; i < 16; ++i) { o[0][i] *= xi; o[1][i] *= xi; } }
    for (int kt = 0; kt <= rb; ++kt) {
        f32x16 S;
#pragma unroll
        for (int i = 0; i < 16; ++i) S[i] = 0.f;
        const LAS bf16_t* kp = Ks + (32 * kt + r32) * 72 + 8 * hh;
#pragma unroll
        for (int s = 0; s < 4; ++s) S = MFMA32(*(const LAS bf16x8*)(kp + 16 * s), qf[s], S);
#pragma unroll
        for (int i = 0; i < 16; ++i) { const int diff = 32 * (rb - kt) + r32 - crow(i, hh); S[i] = diff >= 0 ? S[i] * ex2((float)diff * lg) : 0.f; }
#pragma unroll
        for (int s = 0; s < 2; ++s) {
            const bf16x8 pf = pack8(S, s);
#pragma unroll
            for (int et = 0; et < 2; ++et) {
                const int er = 64 * eh + 32 * et + r32, dd = 16 * kt + 8 * s + 2 * hh;
                o[et] = MFMA32(join8(*(const LAS u32x2*)(Vt + tr_off(er, 68, dd)), *(const LAS u32x2*)(Vt + tr_off(er, 68, dd + 4))), pf, o[et]);
            }
        }
    }
    float sq = 0.f;
#pragma unroll
    for (int i = 0; i < 16; ++i) sq += o[0][i] * o[0][i] + o[1][i] * o[1][i];
    sq += __shfl_xor(sq, 32);
    if (hh == 0) ssq[eh * 128 + 32 * rb + r32] = sq;
    __syncthreads();
    const float rs = rsqrtf((ssq[32 * rb + r32] + ssq[128 + 32 * rb + r32]) * (1.f / 128.f) + EPS);
    bf16_t* op = X + qrow * XW + 1536 + h * 128 + 64 * eh + 4 * hh;
#pragma unroll
    for (int et = 0; et < 2; ++et)
#pragma unroll
        for (int g4 = 0; g4 < 4; ++g4) { const u32x2 g = gw[et][g4]; u32x2 w;
            w.x = pk2(o[et][4 * g4] * rs * bflo(g.x), o[et][4 * g4 + 1] * rs * bfhi(g.x)); w.y = pk2(o[et][4 * g4 + 2] * rs * bflo(g.y), o[et][4 * g4 + 3] * rs * bfhi(g.y));
            *(u32x2*)(op + 32 * et + 8 * g4) = w; }
    }
    __syncthreads();
}
#define XB_TMO      128
#define XB_XCNT(j)  (256  + 64 * (j))
#define XB_XSUB(j)  (1280 + 64 * (j))
#define XB_XGEN(j)  (2304 + 64 * (j))
#define XB_TOP      3328
#define XB_TOPGEN   3392
#define XCD_BAR_WORDS 3456
#define XB_SPIN_CAP (1u << 18)
__device__ __forceinline__ unsigned xb_ld(unsigned* p)              { return __hip_atomic_load(p, __ATOMIC_RELAXED, __HIP_MEMORY_SCOPE_AGENT); }
__device__ __forceinline__ unsigned xb_add(unsigned* p, unsigned v) { return __hip_atomic_fetch_add(p, v, __ATOMIC_RELAXED, __HIP_MEMORY_SCOPE_AGENT); }
__device__ __forceinline__ unsigned xb_xcc_id() { return (unsigned)__builtin_amdgcn_s_getreg((3 << 11) | 20) & 0xFu; }
#define XB_SPIN(cond, bar) do { unsigned _sp = 0; while (cond) { __builtin_amdgcn_s_sleep(1); \
    if ((++_sp & 255u) == 0u) { if (xb_ld(&(bar)[XB_TMO])) break; if (_sp > XB_SPIN_CAP) { atomicAdd(&(bar)[XB_TMO], 1u); break; } } } } while (0)
struct XcdBarrier { unsigned* bar; unsigned x; volatile LAS unsigned* st; unsigned nexp; };
__device__ __forceinline__ XcdBarrier xcd_barrier_post(unsigned* bar, volatile LAS unsigned* st, unsigned nexp) {
    XcdBarrier b; b.bar = bar; b.x = xb_xcc_id(); b.st = st; b.nexp = nexp;
    if (threadIdx.x == 0) (void)xb_add(&bar[XB_XCNT(b.x)], 1u);
    return b;
}
__device__ __forceinline__ void xcd_barrier_complete(unsigned* bar, unsigned x, unsigned G, unsigned& nloc, unsigned& nx) {
    unsigned sum, cnt, mine, sp = 0u;
    for (;;) {
        sum = 0u; cnt = 0u; mine = 0u;
#pragma unroll
        for (unsigned j = 0; j < 16; ++j) { const unsigned c = xb_ld(&bar[XB_XCNT(j)]); sum += c; cnt += (c > 0u) ? 1u : 0u; mine = (j == x) ? c : mine; }
        if (sum == G) break;
        __builtin_amdgcn_s_sleep(1);
        if ((++sp & 255u) == 0u) { if (xb_ld(&bar[XB_TMO])) break; if (sp > XB_SPIN_CAP) { atomicAdd(&bar[XB_TMO], 1u); break; } }
    }
    nloc = mine > 0u ? mine : 1u; nx = cnt > 0u ? cnt : 1u;
}
__device__ __forceinline__ void xcd_barrier(const XcdBarrier& b) {
    asm volatile("s_waitcnt vmcnt(0)" ::: "memory");
    __syncthreads();
    if (threadIdx.x == 0) {
        unsigned* bar = b.bar;
        __builtin_amdgcn_s_waitcnt(0);
        unsigned nloc = b.st[0], nx = b.st[1];
        if (nloc == 0u) { xcd_barrier_complete(bar, b.x, b.nexp, nloc, nx); b.st[0] = nloc; b.st[1] = nx; }
        const unsigned old = xb_add(&bar[XB_XSUB(b.x)], 1u);
        const unsigned gen = old / nloc;
        if (old + 1u == (gen + 1u) * nloc) {
            __builtin_amdgcn_fence(__ATOMIC_RELEASE, "agent");
            asm volatile("s_waitcnt vmcnt(0)" ::: "memory");
            const unsigned og = xb_add(&bar[XB_TOP], 1u);
            const unsigned tg = og / nx;
            if (og + 1u == (tg + 1u) * nx) xb_add(&bar[XB_TOPGEN], 1u);
            else XB_SPIN(xb_ld(&bar[XB_TOPGEN]) == tg, bar);
            __builtin_amdgcn_fence(__ATOMIC_ACQUIRE, "agent");
            xb_add(&bar[XB_XGEN(b.x)], 1u);
            asm volatile("s_waitcnt vmcnt(0)" ::: "memory");
        } else {
            XB_SPIN(xb_ld(&bar[XB_XGEN(b.x)]) == gen, bar);
            __builtin_amdgcn_fence(__ATOMIC_ACQUIRE, "agent");
            asm volatile("s_waitcnt vmcnt(0)" ::: "memory");
        }
    }
    __syncthreads();
}

constexpr int NPH = 30;
#ifndef PHM
#define PHM 0x1ff
#endif
#ifndef MIX_NAIVE
#define MIX_NAIVE 0
#endif
#ifndef RES_BF16
#define RES_BF16 1
#endif
#ifndef HBD_EXP
#define HBD_EXP 0
#endif
#ifndef DBL_BAR
#define DBL_BAR 0
#endif
#ifndef DBLM
#define DBLM 0
#endif
#ifndef MK_NG
#define MK_NG 1
#endif
#ifndef MK_STAGGER
#define MK_STAGGER 1500
#endif
__global__ void __launch_bounds__(512, 2) mk_fwd(Args a) {
    extern __shared__ __attribute__((aligned(16))) unsigned char lds_raw[];
    LAS unsigned char* lds = (LAS unsigned char*)lds_raw;
    const int Gall = gridDim.x, call = blockIdx.x;
    constexpr int NG = MK_NG, MG = M / NG;
    const int grp = (call >> 3) % NG, c = ((call >> 3) / NG) * 8 + (call & 7), G = Gall / NG;
    const int row0 = grp * MG, pm0 = grp * (MG / 256);
    volatile LAS unsigned* MISC = (volatile LAS unsigned*)(lds + MISC_OFF);
    if (threadIdx.x < 32) MISC[threadIdx.x] = 0u;
    __syncthreads();
    unsigned* ctl = (unsigned*)(a.ws + WS_CTL);
    const bool multi = (a.ph_hi - a.ph_lo) > 1;
    XcdBarrier barAll, bar; barAll.bar = ctl + 4096; barAll.x = 0; barAll.st = nullptr; barAll.nexp = 0; bar = barAll;
    if (multi) { barAll = xcd_barrier_post(ctl + 4096, MISC + 8, (unsigned)Gall);
                 bar = (NG == 1) ? barAll : xcd_barrier_post(ctl + 4096 + (1 + grp) * XCD_BAR_WORDS, MISC + 10, (unsigned)G); }

    bf16_t* X = (bf16_t*)(a.ws + WS_X); bf16_t* P = (bf16_t*)(a.ws + WS_P); float* ss = (float*)(a.ws + WS_SS);
#if MIX_NAIVE & 2
    float* kvb = (float*)(a.ws + WS_KV);
#else
    bf16_t* kvb = (bf16_t*)(a.ws + WS_KV);
#endif
    for (int ph = a.ph_lo; ph < a.ph_hi; ++ph) {
        const int kind_ = (ph == 0) ? 0 : (ph == NPH - 1) ? 1 : 2 + (ph - 1) % 7;
        for (int rep_ = 0; rep_ < (((DBLM >> kind_) & 1) ? 2 : 1); ++rep_) {
        if (rep_) __syncthreads();
        int tid = threadIdx.x; asm volatile("" : "+v"(tid));
        if (ph == 0) { if (PHM & 1) phase_prologue(a, lds, Gall, tid); }
        else if (ph == NPH - 1) { if (PHM & 2) final_norm(a.out, ss + (size_t)8 * M * 16, a.norm_final, G, c, row0, MG, tid); }
        else {
            const int l = (ph - 1) / 7, sub = (ph - 1) % 7;
            const char* Wl = (const char*)(a.ws + WS_W + (size_t)l * WL_SIZE);
            if (sub == 0 && (PHM & 4)) {
                pg8::SchedPlain S{(const char*)X, Wl + WL_IN, XW, DM, DM / 64, MG / 256, NIN / 256, G, c, pg8::K_IN, pm0};
                pg8::EpiIn E{P, ss + (size_t)(2 * l) * M * 16};
                pg8::gemm_phase(lds, XW, DM, S, E, tid);
            } else if (sub == 1 && (PHM & 8)) {
#if MIX_NAIVE & 1
                for (int u = c; u < 256 / NG; u += G) attn_naive(lds, P, X, a.sinks + l * 8, grp * (256 / NG) + u, tid);
#else
                for (int u = c; u < 256 / NG; u += G) attn_mfma(lds, P, X, a.sinks + l * 8, grp * (256 / NG) + u, tid);
#endif
#if MIX_NAIVE & 2
                for (int u = c; u < 512 / NG; u += G) kv_naive(lds, P, kvb, grp * (512 / NG) + u, tid);
#else
                for (int u = c; u < 512 / NG; u += G) kv_mfma(lds, P, kvb, grp * (512 / NG) + u, tid);
#endif
                conv_all(P, a.conv_w + l * 3 * 512, X, G, c, row0, MG, tid);
            } else if (sub == 2 && (PHM & 16)) {
#if MIX_NAIVE & 2
                for (int u = c; u < 512 / NG; u += G) ret_naive(lds, P, kvb, X, grp * (512 / NG) + u, tid);
#else
                for (int u = c; u < 512 / NG; u += G) ret_mfma(lds, P, kvb, X, grp * (512 / NG) + ((u < 256 / NG) ? u : (u & ~15) | (15 - (u & 15))), tid);
#endif
            } else if (sub == 3 && (PHM & 32)) {
                pg8::SchedC S{(const char*)X, Wl + WL_C, Wl + WL_B, MG / 256, G, c, pm0};
                pg8::EpiC E{ss + (size_t)(2 * l) * M * 16, a.b_gate + l * 3 * DM, (u32x4*)(a.ws + WS_GS) + (size_t)call * 8192, (u32x4*)(a.ws + WS_MACC) + (size_t)call * 16384, (bf16_t*)(a.ws + WS_MB)};
                pg8::gemm_phase(lds, XW, KC, S, E, tid);
            } else if (sub == 4 && (PHM & 64)) {
                pg8::SchedPlain S{(const char*)(a.ws + WS_MB), Wl + WL_OUT, DM, DM, DM / 64, MG / 256, DM / 256, G, c, pg8::K_RES, pm0};
                pg8::EpiRes E{l == 0 ? a.x : a.out, a.out, X, ss + (size_t)(2 * l + 1) * M * 16, RES_BF16 ? (l == 0 ? 0 : 1) : 2, HBD_EXP ? (bf16_t*)(a.ws + 398 * MiB) : nullptr};
                pg8::gemm_phase(lds, DM, DM, S, E, tid);
            } else if (sub == 5 && (PHM & 128)) {
                const int ldE = HBD_EXP ? DM : XW;
                pg8::SchedPlain S{HBD_EXP ? (const char*)(a.ws + 398 * MiB) : (const char*)X, Wl + WL_GU, ldE, DM, DM / 64, MG / 256, NGU / 256, G, c, pg8::K_GU, pm0};
                pg8::EpiGU E{ss + (size_t)(2 * l + 1) * M * 16, (bf16_t*)(a.ws + WS_FF)};
                pg8::gemm_phase(lds, ldE, DM, S, E, tid);
            } else if (sub == 6 && (PHM & 256)) {
                pg8::SchedPlain S{(const char*)(a.ws + WS_FF), Wl + WL_D, DFF, DFF, DFF / 64, MG / 256, DM / 256, G, c, pg8::K_RES, pm0};
                pg8::EpiRes E{a.out, a.out, X, ss + (size_t)(2 * l + 2) * M * 16, RES_BF16 ? (l == DEPTH - 1 ? 3 : 1) : 2, nullptr};
                pg8::gemm_phase(lds, DFF, DFF, S, E, tid);
            }
        }
        }
        if (ph + 1 < a.ph_hi) {
            if (ph == 0) { xcd_barrier(barAll);
                if (NG > 1 && grp > 0) { const unsigned long long t0 = __builtin_amdgcn_s_memrealtime(); while (__builtin_amdgcn_s_memrealtime() - t0 < (unsigned long long)(grp * MK_STAGGER)) __builtin_amdgcn_s_sleep(8); } }
            else xcd_barrier(bar);
#if DBL_BAR
            xcd_barrier(bar);
#endif
        }
    }
}

#ifndef MK_SINGLE
#define MK_SINGLE 0
#endif
extern "C" void kernel_launch(void* const* d_in, const int* in_sizes, int n_in, void* d_out, int out_size, void* d_ws, size_t ws_size, hipStream_t stream) {
    static int grid = 0;
    if (grid == 0) {
        if (n_in != 13 || out_size != M * DM || ws_size < WS_END) { fprintf(stderr, "kernel_launch: unexpected shapes (n_in %d, out %d, ws %zu)\n", n_in, out_size, ws_size); grid = -1; return; }
        int dev = 0, cus = 0, per_cu = 0;
        if (hipGetDevice(&dev) != hipSuccess || hipDeviceGetAttribute(&cus, hipDeviceAttributeMultiprocessorCount, dev) != hipSuccess) { grid = -1; return; }
        if (hipFuncSetAttribute((const void*)mk_fwd, hipFuncAttributeMaxDynamicSharedMemorySize, LDS_BYTES) != hipSuccess) { fprintf(stderr, "kernel_launch: hipFuncSetAttribute failed\n"); grid = -1; return; }
        if (hipOccupancyMaxActiveBlocksPerMultiprocessor(&per_cu, (const void*)mk_fwd, 512, LDS_BYTES) != hipSuccess || per_cu < 1) { fprintf(stderr, "kernel_launch: occupancy query says %d\n", per_cu); per_cu = 1; }
        (void)hipGetLastError();
        grid = cus;
        if (grid > 256) grid = 256;
    }
    if (grid < 0) return;
    (void)hipMemsetAsync((char*)d_ws + WS_CTL, 0, CTL_ZERO_BYTES, stream);
    Args a{};
    a.x = (const float*)d_in[0]; a.norm_mix = (const float*)d_in[1]; a.w_in = (const float*)d_in[2]; a.sinks = (const float*)d_in[3]; a.conv_w = (const float*)d_in[4];
    a.w_branch = (const float*)d_in[5]; a.b_gate = (const float*)d_in[6]; a.w_out = (const float*)d_in[7]; a.norm_ffn = (const float*)d_in[8];
    a.w_g = (const float*)d_in[9]; a.w_u = (const float*)d_in[10]; a.w_d = (const float*)d_in[11]; a.norm_final = (const float*)d_in[12];
    a.out = (float*)d_out; a.ws = (unsigned char*)d_ws;
#if MK_SINGLE
    a.ph_lo = 0; a.ph_hi = NPH;
    hipLaunchKernelGGL(mk_fwd, dim3(grid), dim3(512), LDS_BYTES, stream, a);
#else
    for (int ph = 0; ph < NPH; ++ph) { a.ph_lo = ph; a.ph_hi = ph + 1; hipLaunchKernelGGL(mk_fwd, dim3(grid), dim3(512), LDS_BYTES, stream, a); }
#endif
}
```

```cpp
#include <hip/hip_runtime.h>
#include <cstdio>
#include <cstdint>

#define LAS __attribute__((address_space(3)))
#define GAS __attribute__((address_space(1)))
typedef unsigned short bf16_t;
typedef short bf16x8 __attribute__((ext_vector_type(8)));
typedef float f32x4 __attribute__((ext_vector_type(4)));
typedef float f32x2 __attribute__((ext_vector_type(2)));
typedef unsigned u32x4 __attribute__((ext_vector_type(4)));
typedef unsigned u32x2 __attribute__((ext_vector_type(2)));
typedef __bf16 bf16x2_t __attribute__((ext_vector_type(2)));

constexpr int BATCH = 8, SEQ = 2048, DM = 1024, M = BATCH * SEQ, DEPTH = 4, DFF = 2816, DIN = 6912;
constexpr int PW = 3328;
constexpr int XW = 2560;
constexpr int NIN = 3840;
constexpr int NGU = 2 * DFF;
constexpr int KC = 1536;
constexpr float EPS = 1e-6f;
constexpr float LOG2E = 1.4426950408889634f;
constexpr float QSCALE = 0.18033688011112042f;

constexpr size_t MiB = 1u << 20;
constexpr size_t WS_CTL = 0, CTL_ZERO_BYTES = 262144;
constexpr size_t WS_SS = 388 * MiB;
constexpr size_t WS_TABA = 2 * MiB;
constexpr size_t WS_TABR = 2 * MiB + 131072;
constexpr size_t WS_W = 4 * MiB;
constexpr size_t WL_IN = 0, WL_C = 7864320, WL_B = 17301504, WL_OUT = 20447232, WL_GU = 22544384, WL_D = 34078720, WL_SIZE = 39845888;
constexpr size_t WS_X = 156 * MiB;
constexpr size_t WS_P = 236 * MiB;
constexpr size_t WS_MACC = WS_P, WS_MB = WS_P + 64 * MiB, WS_FF = WS_P;
constexpr size_t WS_GS = 340 * MiB;
constexpr size_t WS_KV = 372 * MiB;
constexpr size_t WS_END = 398 * MiB;
static_assert(WS_W + DEPTH * WL_SIZE <= WS_X, "weights");
static_assert((size_t)M * XW * 2 <= 80 * MiB && (size_t)M * PW * 2 <= 104 * MiB && (size_t)M * DFF * 2 <= 104 * MiB, "buffers");

constexpr int RING_BYTES = 131072, LDS_BYTES = 147456, MISC_OFF = RING_BYTES + 320;

__device__ __forceinline__ unsigned pk2(float lo, float hi) { f32x2 v = {lo, hi}; bf16x2_t b = __builtin_convertvector(v, bf16x2_t); return __builtin_bit_cast(unsigned, b); }
__device__ __forceinline__ float bflo(unsigned u) { return __uint_as_float(u << 16); }
__device__ __forceinline__ float bfhi(unsigned u) { return __uint_as_float(u & 0xffff0000u); }
__device__ __forceinline__ float bf2f(bf16_t b) { return __uint_as_float((unsigned)b << 16); }
__device__ __forceinline__ float fsilu(float x) { return x * __builtin_amdgcn_rcpf(1.f + __builtin_amdgcn_exp2f(-x * LOG2E)); }
__device__ __forceinline__ float fsigm(float x) { return __builtin_amdgcn_rcpf(1.f + __builtin_amdgcn_exp2f(-x * LOG2E)); }

struct Args {
    const float* x; const float* norm_mix; const float* w_in; const float* sinks; const float* conv_w; const float* w_branch; const float* b_gate; const float* w_out;
    const float* norm_ffn; const float* w_g; const float* w_u; const float* w_d; const float* norm_final;
    float* out; unsigned char* ws; int ph_lo, ph_hi;
};
#define MK_SINGLE 1
#ifndef DBL_EPI
#define DBL_EPI 0
#endif
namespace pg8 {
constexpr int BM = 256, BK = 64, HALF = 128, HTB = HALF * BK * 2  , STAGE_BYTES = 8 * HTB, NXCD = 8, WGM = 8;

__host__ __device__ __forceinline__ int lds_byte(int r, int c) { const int st = (r >> 4) * 2 + (c >> 5), rr = r & 15, cc = c & 31, ob = rr * 64 + cc * 2; return st * 1024 + (ob ^ (((ob >> 9) & 1) << 5)); }
__host__ __device__ __forceinline__ void stage_rc(int b, int& R, int& C) { const int st = b / 1024, sb = b % 1024, swz = sb ^ (((sb >> 9) & 1) << 5); R = (st >> 1) * 16 + swz / 64; C = (st & 1) * 32 + (swz % 64) / 2; }
__host__ __device__ __forceinline__ int perm32(int rho) { const int n = rho >> 4, i = rho & 15; return 8 * (i >> 2) + 4 * n + (i & 3); }

struct Unit { const char* A; const char* B; int nt, pm, pn, kind, aux; };

__device__ __forceinline__ void tile_of(int L, int nM, int nN, int& pm, int& pn) {
    const int nwg = nM * nN; int wgid = L;
    { const int q = nwg / NXCD, r = nwg % NXCD, xcd = wgid % NXCD, off = wgid / NXCD; wgid = (xcd < r ? xcd * (q + 1) : r * (q + 1) + (xcd - r) * q) + off; }
    const int nig = WGM * nN, gid = wgid / nig, fm = gid * WGM, gsz = (nM - fm) < WGM ? (nM - fm) : WGM;
    pm = fm + ((wgid % nig) % gsz); pn = (wgid % nig) / gsz;
}

template <class Epi, class Sched>
__device__ __forceinline__ void gemm_phase(LAS unsigned char* lds, const int lda, const int ldb, const Sched& S, const Epi& E, const int tid) {
    const int wid = __builtin_amdgcn_readfirstlane(tid >> 6), lane = tid & 63, wr = wid >> 2, wc = wid & 3, fr = lane & 15, fq = lane >> 4;
    unsigned voffA[2], voffB[2];
#pragma unroll
    for (int i = 0; i < 2; ++i) { int R, C; stage_rc(tid * 16 + i * 8192, R, C); const int Rb = 2 * (R & ~31) + perm32(R & 31);
        voffA[i] = (unsigned)(R * lda + C) * 2u; voffB[i] = (unsigned)(Rb * ldb + C) * 2u; }
    const size_t kstep = (size_t)(BK * 2);
    const size_t hstepA = (size_t)HALF * lda * 2, hstepB = (size_t)32 * ldb * 2;
    const unsigned ldsw = (unsigned)wid * 1024u;
    const int aoff = lds_byte(wr * 64 + fr, fq * 8), boff = lds_byte(wc * 32 + fr, fq * 8);
#define PG8_SA(b, h) (((b) * 2 + (h)) * HTB)
#define PG8_SB(b, h) ((4 + (b) * 2 + (h)) * HTB)
#define PG8_STAGE(bufoff, gbase, voff) do { _Pragma("unroll") for (int _i = 0; _i < 2; ++_i) \
        __builtin_amdgcn_global_load_lds((const unsigned*)((const char*)(gbase) + (voff)[_i]), (LAS unsigned*)(lds + (bufoff) + ldsw + _i * 8192), 16, 0, 0); } while (0)
#define PG8_LDA(dst, b, h) do { _Pragma("unroll") for (int m = 0; m < 4; ++m) _Pragma("unroll") for (int k = 0; k < 2; ++k) dst[m][k] = *(const LAS bf16x8*)(lds + PG8_SA(b, h) + aoff + m * 2048 + k * 1024); } while (0)
#define PG8_LDB(dst, b, h) do { _Pragma("unroll") for (int n = 0; n < 2; ++n) _Pragma("unroll") for (int k = 0; k < 2; ++k) dst[n][k] = *(const LAS bf16x8*)(lds + PG8_SB(b, h) + boff + n * 2048 + k * 1024); } while (0)
#define PG8_MMA(ai, bj, At, Bt) do { __builtin_amdgcn_s_setprio(1); _Pragma("unroll") for (int m = 0; m < 4; ++m) _Pragma("unroll") for (int n = 0; n < 2; ++n) _Pragma("unroll") for (int k = 0; k < 2; ++k) \
        acc[ai][bj][m][n] = __builtin_amdgcn_mfma_f32_16x16x32_bf16(Bt[n][k], At[m][k], acc[ai][bj][m][n], 0, 0, 0); __builtin_amdgcn_s_setprio(0); } while (0)
#define PG8_WAIT_V(n) asm volatile("s_waitcnt vmcnt(" #n ")" ::: "memory")
#define PG8_WAIT_L(n) asm volatile("s_waitcnt lgkmcnt(" #n ")" ::: "memory")
#define PG8_BAR __builtin_amdgcn_s_barrier()
#define PG8_SCHED __builtin_amdgcn_sched_barrier(0)
    Unit cur, nxt; int ui = 0;
    if (!S.next(0, cur)) return;
    f32x4 acc[2][2][4][2];
#pragma unroll
    for (int a = 0; a < 2; ++a)
#pragma unroll
        for (int b = 0; b < 2; ++b)
#pragma unroll
            for (int m = 0; m < 4; ++m)
#pragma unroll
                for (int n = 0; n < 2; ++n) acc[a][b][m][n] = (f32x4){0.f, 0.f, 0.f, 0.f};
    bf16x8 At[4][2], B0[2][2], B1[2][2];
    const char* cA = cur.A; const char* cB = cur.B;
    PG8_STAGE(PG8_SB(0, 0), cB, voffB); PG8_STAGE(PG8_SB(0, 1), cB + hstepB, voffB); PG8_STAGE(PG8_SA(0, 0), cA, voffA); PG8_STAGE(PG8_SA(0, 1), cA + hstepA, voffA);
    if (wr == 1) PG8_BAR;
    PG8_WAIT_V(2); PG8_BAR;
    PG8_STAGE(PG8_SB(1, 0), cB + kstep, voffB); PG8_STAGE(PG8_SA(1, 0), cA + kstep, voffA); PG8_STAGE(PG8_SB(1, 1), cB + hstepB + kstep, voffB);
    PG8_WAIT_V(6); PG8_BAR;
    for (;;) {
        const bool has_next = S.next(ui + 1, nxt);
        const char* nA = has_next ? nxt.A : cA; const char* nB = has_next ? nxt.B : cB;
        const int nt = cur.nt;
        for (int t = 0; t < nt; t += 2) {
            const bool last = (t == nt - 2);
            if constexpr (Epi::HAS_HOOK) E.hook(acc, cur, t, wid);
            const char* a1 = cA + (size_t)(t + 1) * kstep;
            const char* a2 = last ? nA : cA + (size_t)(t + 2) * kstep; const char* b2 = last ? nB : cB + (size_t)(t + 2) * kstep;
            const char* a3 = a2 + kstep; const char* b3 = b2 + kstep;
            PG8_LDB(B0, 0, 0); PG8_LDB(B1, 0, 1); PG8_SCHED; PG8_LDA(At, 0, 0); PG8_STAGE(PG8_SA(1, 1), a1 + hstepA, voffA);
            PG8_WAIT_V(8); PG8_WAIT_L(0); PG8_BAR; PG8_MMA(0, 0, At, B0); PG8_MMA(0, 1, At, B1); PG8_BAR; PG8_SCHED;
            PG8_LDA(At, 0, 1); PG8_STAGE(PG8_SB(0, 0), b2, voffB); PG8_STAGE(PG8_SB(0, 1), b2 + hstepB, voffB); PG8_STAGE(PG8_SA(0, 0), a2, voffA);
            PG8_WAIT_V(8); PG8_WAIT_L(0); PG8_BAR; PG8_MMA(1, 0, At, B0); PG8_MMA(1, 1, At, B1); PG8_BAR; PG8_SCHED;
            PG8_LDB(B0, 1, 0); PG8_LDB(B1, 1, 1); PG8_SCHED; PG8_LDA(At, 1, 0); PG8_STAGE(PG8_SA(0, 1), a2 + hstepA, voffA);
            PG8_WAIT_V(8); PG8_WAIT_L(0); PG8_BAR; PG8_MMA(0, 0, At, B0); PG8_MMA(0, 1, At, B1); PG8_BAR; PG8_SCHED;
            PG8_LDA(At, 1, 1); PG8_STAGE(PG8_SB(1, 0), b3, voffB); PG8_STAGE(PG8_SB(1, 1), b3 + hstepB, voffB); PG8_STAGE(PG8_SA(1, 0), a3, voffA);
            PG8_WAIT_V(8); PG8_WAIT_L(0); PG8_BAR; PG8_MMA(1, 0, At, B0); PG8_MMA(1, 1, At, B1); PG8_BAR; PG8_SCHED;
        }
        if (wr == 0) PG8_BAR;
#if DBL_EPI
        if (E.dbl(cur)) { E(acc, cur, wid, false); asm volatile("" ::: "memory"); }
#endif
        E(acc, cur, wid, true);
        if (!has_next) break;
        cur = nxt; cA = nA; cB = nB; ++ui;
        if (wr == 1) PG8_BAR;
    }
    PG8_WAIT_V(0);
    PG8_BAR;
#undef PG8_SA
#undef PG8_SB
#undef PG8_STAGE
#undef PG8_LDA
#undef PG8_LDB
#undef PG8_MMA
#undef PG8_WAIT_V
#undef PG8_WAIT_L
#undef PG8_BAR
#undef PG8_SCHED
}
}
namespace pg8 {
#ifndef EPIC_TEST
#define EPIC_TEST(x) (x)
#endif
__device__ __forceinline__ float row_rstd(const float* ss, int row) {
    const f32x4* p = (const f32x4*)(ss + (size_t)row * 16); const f32x4 a = p[0], b = p[1], c = p[2], d = p[3];
    const float s = ((a[0] + a[1]) + (a[2] + a[3])) + ((b[0] + b[1]) + (b[2] + b[3])) + (((c[0] + c[1]) + (c[2] + c[3])) + ((d[0] + d[1]) + (d[2] + d[3])));
    return rsqrtf(s * (1.f / DM) + EPS);
}
#ifndef USE_NT
#define USE_NT 0
#endif
#if USE_NT
#define NT_STORE(p, v) __builtin_nontemporal_store((v), (p))
#else
#define NT_STORE(p, v) (*(p) = (v))
#endif
#define EPI_LANE() const int lane_ = (int)__builtin_amdgcn_mbcnt_hi(~0u, __builtin_amdgcn_mbcnt_lo(~0u, 0u)); const int wr = wid >> 2, wc = wid & 3, fr = lane_ & 15, fq = lane_ >> 4, tid = wid * 64 + lane_; (void)wr; (void)wc; (void)fr; (void)fq; (void)tid
__device__ __forceinline__ void row_rstd8(const float* ss, int rbase, int lane, int fr, float (&rs)[8]) {
    const float a = row_rstd(ss, rbase + lane), b = row_rstd(ss, rbase + 128 + lane);
#pragma unroll
    for (int m = 0; m < 4; ++m) { rs[m] = __shfl(a, m * 16 + fr); rs[4 + m] = __shfl(b, m * 16 + fr); }
}
enum { K_IN = 0, K_GATE = 1, K_BRANCH = 2, K_RES = 3, K_GU = 4 };

__device__ __forceinline__ void rot1(float& a, float& b, float rev) {
    const float fr_ = rev - floorf(rev), c = __builtin_amdgcn_cosf(fr_), s = __builtin_amdgcn_sinf(fr_);
    const float na = a * c - b * s, nb = b * c + a * s; a = na; b = nb;
}
__device__ __forceinline__ f32x4 rot4(f32x4 v, f32x4 t) { return (f32x4){v[0] * t[0] - v[1] * t[1], v[1] * t[0] + v[0] * t[1], v[2] * t[2] - v[3] * t[3], v[3] * t[2] + v[2] * t[3]}; }

struct EpiIn {
    static constexpr bool HAS_HOOK = false;
    __device__ __forceinline__ bool dbl(const Unit&) const { return (DBL_EPI & 1) != 0; }
    bf16_t* P; const float* ss;
    __device__ __forceinline__ void operator()(f32x4 (&acc)[2][2][4][2], const Unit& u, int wid, const bool zacc) const {
        EPI_LANE();
        const int pn = u.pn;
        const int cw = wc * 64 + 8 * fq;
        float ivA[4], ivR[4];
#pragma unroll
        for (int j = 0; j < 4; ++j) { ivA[j] = __builtin_amdgcn_exp2f(-(float)(4 * (fq & 1) + j) * (18.931568569324174f / 8.f)) * 0.15915494309189535f;
                                      ivR[j] = __builtin_amdgcn_exp2f(-(float)(4 * fq + j) * (13.287712379549449f / 32.f)) * 0.15915494309189535f; }
        float rs8[8];
        row_rstd8(ss, u.pm * 256 + wr * 64, lane_, fr, rs8);
#pragma unroll
        for (int ai = 0; ai < 2; ++ai)
#pragma unroll
            for (int m = 0; m < 4; ++m) {
                const int row = u.pm * 256 + ai * 128 + wr * 64 + m * 16 + fr;
                const float rstd = rs8[ai * 4 + m];
                const float fpos = (float)(row & (SEQ - 1));
#pragma unroll
                for (int bj = 0; bj < 2; ++bj) {
                    f32x4 v0 = acc[ai][bj][m][0] * rstd, v1 = acc[ai][bj][m][1] * rstd;
                    const int gc = pn * 256 + bj * 32 + cw;
                    if (pn >= 11) {
                        if (bj == 0) { const f32x4 x0 = acc[ai][1][m][0] * rstd, x1 = acc[ai][1][m][1] * rstd;
                            u32x4 w; w.x = pk2(v0[0] * x0[0], v0[1] * x0[1]); w.y = pk2(v0[2] * x0[2], v0[3] * x0[3]); w.z = pk2(v1[0] * x1[0], v1[1] * x1[1]); w.w = pk2(v1[2] * x1[2], v1[3] * x1[3]);
                            NT_STORE((u32x4*)(P + (size_t)row * PW + 2816 + (pn - 11) * 128 + wc * 32 + 8 * fq), w); }
                    } else {
                        if (pn < 2 || (pn == 2 && wc < 2)) {
                            if (bj == 0 && fq < 2) {
                                float x[8] = {v0[0], v0[1], v0[2], v0[3], v1[0], v1[1], v1[2], v1[3]};
#pragma unroll
                                for (int j = 0; j < 4; ++j) rot1(x[2 * j], x[2 * j + 1], fpos * ivA[j]);
                                v0 = (f32x4){x[0], x[1], x[2], x[3]}; v1 = (f32x4){x[4], x[5], x[6], x[7]};
                            }
                            if (pn < 2) { v0 = v0 * QSCALE; v1 = v1 * QSCALE; }
                        } else if (pn == 3 || pn == 4) {
                            float x[8] = {v0[0], v0[1], v0[2], v0[3], v1[0], v1[1], v1[2], v1[3]};
#pragma unroll
                            for (int j = 0; j < 4; ++j) rot1(x[2 * j], x[2 * j + 1], fpos * (bj ? ivR[j] * 0.01f : ivR[j]));
                            v0 = (f32x4){x[0], x[1], x[2], x[3]}; v1 = (f32x4){x[4], x[5], x[6], x[7]};
                            if (pn == 4) { v0 = v0 * 0.125f; v1 = v1 * 0.125f; }
                        } else if (pn == 7 || pn == 8) {
#pragma unroll
                            for (int j = 0; j < 4; ++j) { v0[j] = fsilu(v0[j]); v1[j] = fsilu(v1[j]); }
                        }
                        u32x4 w; w.x = pk2(v0[0], v0[1]); w.y = pk2(v0[2], v0[3]); w.z = pk2(v1[0], v1[1]); w.w = pk2(v1[2], v1[3]);
                        NT_STORE((u32x4*)(P + (size_t)row * PW + gc), w);
                    }
                    if (zacc) { acc[ai][bj][m][0] = (f32x4){0.f, 0.f, 0.f, 0.f}; acc[ai][bj][m][1] = (f32x4){0.f, 0.f, 0.f, 0.f}; }
                }
                asm volatile("" ::: "memory");
            }
    }
};

struct EpiC {
    static constexpr bool HAS_HOOK = true;
    __device__ __forceinline__ bool dbl(const Unit&) const { return false; }
    const float* ss; const float* bg; u32x4* G0; u32x4* G12; bf16_t* mb;
    __device__ __forceinline__ u32x4* gbuf(int br) const { return br == 0 ? G0 : G12 + (size_t)(br - 1) * 8192; }
    __device__ __forceinline__ void hook(f32x4 (&acc)[2][2][4][2], const Unit& u, int t, int wid) const {
        if (u.kind != K_BRANCH || (t != 8 && t != 16)) return;
        EPI_LANE();
        const int br = (t >> 3) - 1;
        const u32x4* Ga = gbuf(br); const u32x4* Gb = gbuf(br + 1);
#pragma unroll
        for (int ai = 0; ai < 2; ++ai)
#pragma unroll
            for (int m = 0; m < 4; ++m) {
#pragma unroll
                for (int bj = 0; bj < 2; ++bj) {
                    const int idx = (ai * 4 + m) * 2 + bj;
                    const u32x4 ga = Ga[(unsigned)(idx * 512 + tid)], gb = Gb[(unsigned)(idx * 512 + tid)];
                    f32x4 d0 = (f32x4){bflo(gb.x), bfhi(gb.x), bflo(gb.y), bfhi(gb.y)}, d1 = (f32x4){bflo(gb.z), bfhi(gb.z), bflo(gb.w), bfhi(gb.w)};
#pragma unroll
                    for (int j = 0; j < 4; ++j) { d0[j] = __builtin_amdgcn_rcpf(fmaxf(d0[j], 1e-30f)); d1[j] = __builtin_amdgcn_rcpf(fmaxf(d1[j], 1e-30f)); }
                    acc[ai][bj][m][0] = acc[ai][bj][m][0] * ((f32x4){bflo(ga.x), bfhi(ga.x), bflo(ga.y), bfhi(ga.y)} * d0);
                    acc[ai][bj][m][1] = acc[ai][bj][m][1] * ((f32x4){bflo(ga.z), bfhi(ga.z), bflo(ga.w), bfhi(ga.w)} * d1);
                }
                asm volatile("" ::: "memory");
            }
    }
    __device__ __forceinline__ void operator()(f32x4 (&acc)[2][2][4][2], const Unit& u, int wid, const bool zacc) const {
        EPI_LANE();
        const int cw = u.pn * 256 + wc * 64 + 8 * fq;
        if (EPIC_TEST(u.kind == K_GATE)) {
            const int br = u.aux;
            const float* b = bg + br * DM + cw; u32x4* Gw = gbuf(br);
            float rs8[8];
            row_rstd8(ss, u.pm * 256 + wr * 64, lane_, fr, rs8);
            const f32x4 bv00 = *(const f32x4*)(b), bv01 = *(const f32x4*)(b + 4), bv10 = *(const f32x4*)(b + 32), bv11 = *(const f32x4*)(b + 36);
            asm volatile("" ::: "memory");
#pragma unroll
            for (int ai = 0; ai < 2; ++ai)
#pragma unroll
                for (int m = 0; m < 4; ++m) {
                    const float rstd = rs8[ai * 4 + m];
#pragma unroll
                    for (int bj = 0; bj < 2; ++bj) {
                        f32x4 v0 = acc[ai][bj][m][0] * rstd + (bj ? bv10 : bv00), v1 = acc[ai][bj][m][1] * rstd + (bj ? bv11 : bv01);
#pragma unroll
                        for (int j = 0; j < 4; ++j) { v0[j] = fsigm(v0[j]); v1[j] = fsigm(v1[j]); }
                        u32x4 w; w.x = pk2(v0[0], v0[1]); w.y = pk2(v0[2], v0[3]); w.z = pk2(v1[0], v1[1]); w.w = pk2(v1[2], v1[3]);
                        Gw[(unsigned)(((ai * 4 + m) * 2 + bj) * 512 + tid)] = w;
                        if (zacc) { acc[ai][bj][m][0] = (f32x4){0.f, 0.f, 0.f, 0.f}; acc[ai][bj][m][1] = (f32x4){0.f, 0.f, 0.f, 0.f}; }
                    }
                    asm volatile("" ::: "memory");
                }
        } else {
            const u32x4* Ga = gbuf(2);
#pragma unroll
            for (int ai = 0; ai < 2; ++ai) {
                u32x4 gg[8];
#pragma unroll
                for (int q = 0; q < 8; ++q) gg[q] = Ga[(unsigned)((ai * 8 + q) * 512 + tid)];
                asm volatile("" ::: "memory");
#pragma unroll
                for (int m = 0; m < 4; ++m) {
                    const int row = u.pm * 256 + ai * 128 + wr * 64 + m * 16 + fr;
#pragma unroll
                    for (int bj = 0; bj < 2; ++bj) {
                        const u32x4 g = gg[m * 2 + bj];
                        const f32x4 v0 = acc[ai][bj][m][0] * (f32x4){bflo(g.x), bfhi(g.x), bflo(g.y), bfhi(g.y)};
                        const f32x4 v1 = acc[ai][bj][m][1] * (f32x4){bflo(g.z), bfhi(g.z), bflo(g.w), bfhi(g.w)};
                        u32x4 w; w.x = pk2(v0[0], v0[1]); w.y = pk2(v0[2], v0[3]); w.z = pk2(v1[0], v1[1]); w.w = pk2(v1[2], v1[3]);
                        *(u32x4*)(mb + (size_t)row * DM + bj * 32 + cw) = w;
                        if (zacc) { acc[ai][bj][m][0] = (f32x4){0.f, 0.f, 0.f, 0.f}; acc[ai][bj][m][1] = (f32x4){0.f, 0.f, 0.f, 0.f}; }
                    }
                }
                asm volatile("" ::: "memory");
            }
        }
    }
};

struct EpiRes {
    static constexpr bool HAS_HOOK = false;
    __device__ __forceinline__ bool dbl(const Unit&) const { return (DBL_EPI & 4) != 0 && rin != H; }
    const float* rin; float* H; bf16_t* hb; float* ssout; int mode; bf16_t* hbd;
    __device__ __forceinline__ void operator()(f32x4 (&acc)[2][2][4][2], const Unit& u, int wid, const bool zacc) const {
        EPI_LANE();
        const int cw = u.pn * 256 + wc * 64 + 8 * fq;
        if (mode & 1) {
            u32x4 rr[8][2];
#pragma unroll
            for (int q = 0; q < 8; ++q)
#pragma unroll
                for (int bj = 0; bj < 2; ++bj) rr[q][bj] = *(const u32x4*)(hb + (size_t)(u.pm * 256 + (q >> 2) * 128 + wr * 64 + (q & 3) * 16 + fr) * XW + bj * 32 + cw);
            asm volatile("" ::: "memory");
#pragma unroll
            for (int ai = 0; ai < 2; ++ai)
#pragma unroll
                for (int m = 0; m < 4; ++m) {
                    const int row = u.pm * 256 + ai * 128 + wr * 64 + m * 16 + fr;
                    float s = 0.f;
#pragma unroll
                    for (int bj = 0; bj < 2; ++bj) {
                        const size_t o = (size_t)row * DM + bj * 32 + cw;
                        const u32x4 w = rr[ai * 4 + m][bj];
                        const f32x4 v0 = acc[ai][bj][m][0] + (f32x4){bflo(w.x), bfhi(w.x), bflo(w.y), bfhi(w.y)}, v1 = acc[ai][bj][m][1] + (f32x4){bflo(w.z), bfhi(w.z), bflo(w.w), bfhi(w.w)};
                        if (mode & 2) { *(f32x4*)(H + o) = v0; *(f32x4*)(H + o + 4) = v1; }
                        u32x4 wo; wo.x = pk2(v0[0], v0[1]); wo.y = pk2(v0[2], v0[3]); wo.z = pk2(v1[0], v1[1]); wo.w = pk2(v1[2], v1[3]);
                        *(u32x4*)(hb + (size_t)row * XW + bj * 32 + cw) = wo;
                        if (hbd) *(u32x4*)(hbd + (size_t)row * DM + bj * 32 + cw) = wo;
                        s += (v0[0] * v0[0] + v0[1] * v0[1]) + (v0[2] * v0[2] + v0[3] * v0[3]) + (v1[0] * v1[0] + v1[1] * v1[1]) + (v1[2] * v1[2] + v1[3] * v1[3]);
                        if (zacc) { acc[ai][bj][m][0] = (f32x4){0.f, 0.f, 0.f, 0.f}; acc[ai][bj][m][1] = (f32x4){0.f, 0.f, 0.f, 0.f}; }
                    }
                    s += __shfl_xor(s, 16); s += __shfl_xor(s, 32);
                    if (fq == 0) ssout[(size_t)row * 16 + u.pn * 4 + wc] = s;
                }
            return;
        }
#pragma unroll
        for (int ai = 0; ai < 2; ++ai)
#pragma unroll
            for (int m = 0; m < 4; ++m) {
                const int row = u.pm * 256 + ai * 128 + wr * 64 + m * 16 + fr;
                float s = 0.f;
#pragma unroll
                for (int bj = 0; bj < 2; ++bj) {
                    const size_t o = (size_t)row * DM + bj * 32 + cw;
                    const f32x4 v0 = acc[ai][bj][m][0] + *(const f32x4*)(rin + o), v1 = acc[ai][bj][m][1] + *(const f32x4*)(rin + o + 4);
                    if (mode & 2) { *(f32x4*)(H + o) = v0; *(f32x4*)(H + o + 4) = v1; }
                    u32x4 w; w.x = pk2(v0[0], v0[1]); w.y = pk2(v0[2], v0[3]); w.z = pk2(v1[0], v1[1]); w.w = pk2(v1[2], v1[3]);
                    *(u32x4*)(hb + (size_t)row * XW + bj * 32 + cw) = w;
                    if (hbd) *(u32x4*)(hbd + (size_t)row * DM + bj * 32 + cw) = w;
                    s += (v0[0] * v0[0] + v0[1] * v0[1]) + (v0[2] * v0[2] + v0[3] * v0[3]) + (v1[0] * v1[0] + v1[1] * v1[1]) + (v1[2] * v1[2] + v1[3] * v1[3]);
                    if (zacc) { acc[ai][bj][m][0] = (f32x4){0.f, 0.f, 0.f, 0.f}; acc[ai][bj][m][1] = (f32x4){0.f, 0.f, 0.f, 0.f}; }
                }
                s += __shfl_xor(s, 16); s += __shfl_xor(s, 32);
                if (fq == 0) ssout[(size_t)row * 16 + u.pn * 4 + wc] = s;
            }
    }
};

struct EpiGU {
    static constexpr bool HAS_HOOK = false;
    __device__ __forceinline__ bool dbl(const Unit&) const { return (DBL_EPI & 2) != 0; }
    const float* ss; bf16_t* ff;
    __device__ __forceinline__ void operator()(f32x4 (&acc)[2][2][4][2], const Unit& u, int wid, const bool zacc) const {
        EPI_LANE();
        const int cj = u.pn * 128 + wc * 32 + 8 * fq;
        float rs8[8];
        row_rstd8(ss, u.pm * 256 + wr * 64, lane_, fr, rs8);
        asm volatile("" ::: "memory");
#pragma unroll
        for (int ai = 0; ai < 2; ++ai)
#pragma unroll
            for (int m = 0; m < 4; ++m) {
                const int row = u.pm * 256 + ai * 128 + wr * 64 + m * 16 + fr;
                const float rstd = rs8[ai * 4 + m];
                const f32x4 g0 = acc[ai][0][m][0] * rstd, g1 = acc[ai][0][m][1] * rstd, u0 = acc[ai][1][m][0] * rstd, u1 = acc[ai][1][m][1] * rstd;
                u32x4 w; w.x = pk2(fsilu(g0[0]) * u0[0], fsilu(g0[1]) * u0[1]); w.y = pk2(fsilu(g0[2]) * u0[2], fsilu(g0[3]) * u0[3]);
                w.z = pk2(fsilu(g1[0]) * u1[0], fsilu(g1[1]) * u1[1]); w.w = pk2(fsilu(g1[2]) * u1[2], fsilu(g1[3]) * u1[3]);
                NT_STORE((u32x4*)(ff + (size_t)row * DFF + cj), w);
                if (zacc) {
#pragma unroll
                    for (int bj = 0; bj < 2; ++bj) { acc[ai][bj][m][0] = (f32x4){0.f, 0.f, 0.f, 0.f}; acc[ai][bj][m][1] = (f32x4){0.f, 0.f, 0.f, 0.f}; } }
            }
    }
};

struct SchedPlain {
    const char* A; const char* B; int lda, ldb, nt, nM, nN, G, c, kind, pm0;
    __device__ __forceinline__ bool next(int i, Unit& u) const {
        const int L = i * G + c; if (L >= nM * nN) return false;
        tile_of(L, nM, nN, u.pm, u.pn); u.pm += pm0;
        u.A = A + (size_t)u.pm * 256 * lda * 2; u.B = B + (size_t)u.pn * 256 * ldb * 2; u.nt = nt; u.kind = kind; u.aux = 0; return true;
    }
};
struct SchedC {
    const char* X; const char* Wg; const char* Wb; int nM, G, c, pm0;
    __device__ __forceinline__ bool next(int i, Unit& u) const {
        const int j = i >> 2, sub = i & 3, L = j * G + c; if (L >= nM * 4) return false;
        tile_of(L, nM, 4, u.pm, u.pn); u.pm += pm0;
        const bool gate = sub < 3;
        u.A = X + (size_t)u.pm * 256 * XW * 2 + (gate ? 0 : 1024 * 2);
        u.B = gate ? Wg + (size_t)sub * (1024 * KC * 2) + (size_t)u.pn * 256 * KC * 2 : Wb + (size_t)u.pn * 256 * KC * 2;
        u.nt = gate ? 16 : 24; u.kind = gate ? K_GATE : K_BRANCH; u.aux = sub; return true;
    }
};
}
__device__ const double INV_A[8] = {0.15915494309189535, 0.03086376340470123, 0.005985185712713705, 0.001160663641240061, 0.00022507907903927653, 4.364795279280289e-05, 8.464330808241401e-06, 1.6414262627950345e-06};
__device__ const double INV_R[32] = {0.15915494309189535, 0.11934937021124886, 0.08949940160889101, 0.06711508300522726, 0.050329212104487035, 0.03774158471741977, 0.0283021958306234, 0.02122365276477766,
    0.015915494309189534, 0.011934937021124886, 0.008949940160889102, 0.006711508300522725, 0.005032921210448704, 0.003774158471741977, 0.00283021958306234, 0.0021223652764777662,
    0.0015915494309189536, 0.0011934937021124885, 0.0008949940160889102, 0.0006711508300522726, 0.0005032921210448703, 0.00037741584717419774, 0.00028302195830623395, 0.0002122365276477766,
    0.00015915494309189535, 0.00011934937021124886, 8.949940160889102e-05, 6.711508300522725e-05, 5.0329212104487035e-05, 3.774158471741978e-05, 2.8302195830623396e-05, 2.122365276477766e-05};
__device__ __forceinline__ float lg_gamma(int h) { return h == 0 ? -0.04580368961312479f : h == 1 ? -0.02272007650008353f : h == 2 ? -0.011315313227834146f : -0.005646563141142062f; }
__device__ __forceinline__ float ex2(float x) { return __builtin_amdgcn_exp2f(x); }
__device__ __forceinline__ float wave_sum(float v) {
#pragma unroll
    for (int o = 1; o < 64; o <<= 1) v += __shfl_xor(v, o);
    return v;
}
#define LDS_WAIT() asm volatile("s_waitcnt lgkmcnt(0)" ::: "memory")

__device__ __forceinline__ int dst_in(int s) {
    if (s < 640) { const int p = s & 63; return (p < 16) ? (s & ~63) + ((p < 8) ? 2 * p : 2 * (p - 8) + 1) : s; }
    if (s < 768) return s;
    if (s < 1280) { const int p = s & 63; return (s & ~63) + ((p < 32) ? 2 * p : 2 * (p - 32) + 1); }
    if (s < 2816) return s;
    { const int j = (s < 3328) ? s - 2816 : s - 3328; return 2816 + (j >> 5) * 64 + ((s < 3328) ? 0 : 32) + (j & 31); }
}
__device__ __forceinline__ void cvt_item(const float* W, size_t ldw, int c0, const float* scale, bf16_t* dst, int ld, int k0, int mode, int rmul, int radd, LAS float* scr, int lane) {
    const int kr = lane >> 3, c4 = lane & 7;
    f32x4 v[8];
#pragma unroll
    for (int i = 0; i < 8; ++i) v[i] = *(const f32x4*)(W + (size_t)(k0 + 8 * i + kr) * ldw + c0 + 4 * c4);
#pragma unroll
    for (int i = 0; i < 8; ++i) { const float sc = scale ? scale[k0 + 8 * i + kr] : 1.f; LAS float* d = scr + (8 * i + kr) * 33 + 4 * c4; d[0] = v[i][0] * sc; d[1] = v[i][1] * sc; d[2] = v[i][2] * sc; d[3] = v[i][3] * sc; }
    LDS_WAIT(); asm volatile("" ::: "memory");
    const int c = lane & 7;
#pragma unroll
    for (int j = 0; j < 4; ++j) { const int n = (lane >> 3) + 8 * j; const LAS float* s = scr + (8 * c) * 33 + n;
        u32x4 o; o.x = pk2(s[0 * 33], s[1 * 33]); o.y = pk2(s[2 * 33], s[3 * 33]); o.z = pk2(s[4 * 33], s[5 * 33]); o.w = pk2(s[6 * 33], s[7 * 33]);
        const int cc = c0 + n, row = (mode == 2) ? ((cc >> 5) * 64 + radd + (cc & 31)) : (mode ? dst_in(cc) : cc) * rmul + radd;
        *(u32x4*)(dst + (size_t)row * ld + k0 + 8 * c) = o; }
    LDS_WAIT(); asm volatile("" ::: "memory");
}
constexpr int CV_J0 = 3456, CV_J2 = 768, CV_J3 = 512, CV_J4 = 2816, CV_J5 = 1408, CV_PER_LAYER = CV_J0 + CV_J2 + CV_J3 + CV_J4 + CV_J5;
__device__ __forceinline__ void phase_prologue(const Args& a, LAS unsigned char* lds, int G, const int tid) {
    const int lane = tid & 63, wave = tid >> 6;
    const int gw = blockIdx.x * 8 + wave, NGW = G * 8;
    LAS float* scr = (LAS float*)(lds + wave * 16384);
    for (int it = gw; it < DEPTH * CV_PER_LAYER; it += NGW) {
        const int l = it / CV_PER_LAYER; int r = it - l * CV_PER_LAYER;
        bf16_t* Wl = (bf16_t*)(a.ws + WS_W + (size_t)l * WL_SIZE);
        if (r < CV_J0) { const int kb = r / 216, cb = r % 216;
            if (cb < 120) cvt_item(a.w_in + (size_t)l * DM * DIN, DIN, cb * 32, a.norm_mix + l * DM, Wl + WL_IN / 2, DM, kb * 64, 1, 1, 0, scr, lane);
            else          cvt_item(a.w_in + (size_t)l * DM * DIN, DIN, cb * 32, a.norm_mix + l * DM, Wl + WL_C / 2, KC, kb * 64, 0, 1, -3840, scr, lane);
            continue; } r -= CV_J0;
        if (r < CV_J2) { const int i = r >> 8, kb = (r >> 5) & 7, cb = r & 31;
            cvt_item(a.w_branch + (size_t)(l * 3 + i) * 512 * DM, DM, cb * 32, nullptr, Wl + WL_B / 2 + i * 512, KC, kb * 64, 0, 1, 0, scr, lane); continue; } r -= CV_J2;
        if (r < CV_J3) { const int kb = r >> 5, cb = r & 31;
            cvt_item(a.w_out + (size_t)l * DM * DM, DM, cb * 32, nullptr, Wl + WL_OUT / 2, DM, kb * 64, 0, 1, 0, scr, lane); continue; } r -= CV_J3;
        if (r < CV_J4) { const int up = r / 1408, q = r % 1408, kb = q / 88, cb = q % 88;
            cvt_item((up ? a.w_u : a.w_g) + (size_t)l * DM * DFF, DFF, cb * 32, a.norm_ffn + l * DM, Wl + WL_GU / 2, DM, kb * 64, 2, 1, up * 32, scr, lane); continue; } r -= CV_J4;
        { const int kb = r >> 5, cb = r & 31;
            cvt_item(a.w_d + (size_t)l * DFF * DM, DM, cb * 32, nullptr, Wl + WL_D / 2, DFF, kb * 64, 0, 1, 0, scr, lane); }
    }
    bf16_t* X = (bf16_t*)(a.ws + WS_X); float* ss = (float*)(a.ws + WS_SS);
    for (int row = gw; row < M; row += NGW) {
        const f32x4* xr = (const f32x4*)(a.x + (size_t)row * DM) + lane; float s = 0.f;
#pragma unroll
        for (int j = 0; j < 4; ++j) { const f32x4 v = xr[64 * j]; s += (v[0] * v[0] + v[1] * v[1]) + (v[2] * v[2] + v[3] * v[3]);
            u32x2 w; w.x = pk2(v[0], v[1]); w.y = pk2(v[2], v[3]); *(u32x2*)(X + (size_t)row * XW + (64 * j + lane) * 4) = w; }
        s = wave_sum(s); if (lane < 16) ss[(size_t)row * 16 + lane] = (lane == 0) ? s : 0.f;
    }
}

__device__ __forceinline__ void attn_naive(LAS unsigned char* lds, const bf16_t* P, bf16_t* X, const float* sinks, int unit, const int tid) {
    const int b = unit >> 5, n = (unit >> 1) & 15, g = unit & 1;
    LAS bf16_t* Ks = (LAS bf16_t*)lds; LAS bf16_t* Vs = Ks + 256 * 72;
    const long row0 = (long)b * SEQ + n * 128 - 128;
    for (int c = tid; c < 2048; c += 512) {
        const int key = c >> 3, ch = c & 7; u32x4 kv = {0u, 0u, 0u, 0u}, vv = {0u, 0u, 0u, 0u};
        if (n > 0 || key >= 128) { const bf16_t* src = P + (size_t)(row0 + key) * PW + g * 64 + ch * 8; kv = *(const u32x4*)(src + 512); vv = *(const u32x4*)(src + 640); }
        *(LAS u32x4*)(Ks + key * 72 + ch * 8) = kv; *(LAS u32x4*)(Vs + key * 72 + ch * 8) = vv;
    }
    __syncthreads();
    const int r = tid & 127, hq = g * 4 + (tid >> 7);
    const size_t qrow = (size_t)b * SEQ + n * 128 + r;
    float q[64], o[64];
    { const u32x4* qp = (const u32x4*)(P + qrow * PW + hq * 64);
#pragma unroll
      for (int c = 0; c < 8; ++c) { const u32x4 w = qp[c]; q[8 * c] = bflo(w.x); q[8 * c + 1] = bfhi(w.x); q[8 * c + 2] = bflo(w.y); q[8 * c + 3] = bfhi(w.y); q[8 * c + 4] = bflo(w.z); q[8 * c + 5] = bfhi(w.z); q[8 * c + 6] = bflo(w.w); q[8 * c + 7] = bfhi(w.w); } }
#pragma unroll
    for (int d = 0; d < 64; ++d) o[d] = 0.f;
    float mx = sinks[hq] * LOG2E, l = 1.f;
    for (int j = 0; j < 128; ++j) {
        const int kt = r + 1 + j; const bool valid = (n > 0) || (kt >= 128);
        const LAS u32x4* kp = (const LAS u32x4*)(Ks + kt * 72);
        float s = 0.f;
#pragma unroll
        for (int c = 0; c < 8; ++c) { const u32x4 w = kp[c];
            s += q[8 * c] * bflo(w.x) + q[8 * c + 1] * bfhi(w.x) + q[8 * c + 2] * bflo(w.y) + q[8 * c + 3] * bfhi(w.y) + q[8 * c + 4] * bflo(w.z) + q[8 * c + 5] * bfhi(w.z) + q[8 * c + 6] * bflo(w.w) + q[8 * c + 7] * bfhi(w.w); }
        s = valid ? s : -INFINITY;
        const float mn = fmaxf(mx, s), sc = ex2(mx - mn), p = ex2(s - mn);
        l = l * sc + p; mx = mn;
        const LAS u32x4* vp = (const LAS u32x4*)(Vs + kt * 72);
#pragma unroll
        for (int c = 0; c < 8; ++c) { const u32x4 w = vp[c];
            o[8 * c] = o[8 * c] * sc + p * bflo(w.x); o[8 * c + 1] = o[8 * c + 1] * sc + p * bfhi(w.x); o[8 * c + 2] = o[8 * c + 2] * sc + p * bflo(w.y); o[8 * c + 3] = o[8 * c + 3] * sc + p * bfhi(w.y);
            o[8 * c + 4] = o[8 * c + 4] * sc + p * bflo(w.z); o[8 * c + 5] = o[8 * c + 5] * sc + p * bfhi(w.z); o[8 * c + 6] = o[8 * c + 6] * sc + p * bflo(w.w); o[8 * c + 7] = o[8 * c + 7] * sc + p * bfhi(w.w); }
    }
    const float il = 1.f / l;
    u32x4* op = (u32x4*)(X + qrow * XW + 1024 + hq * 64);
#pragma unroll
    for (int c = 0; c < 8; ++c) { u32x4 w; w.x = pk2(o[8 * c] * il, o[8 * c + 1] * il); w.y = pk2(o[8 * c + 2] * il, o[8 * c + 3] * il); w.z = pk2(o[8 * c + 4] * il, o[8 * c + 5] * il); w.w = pk2(o[8 * c + 6] * il, o[8 * c + 7] * il); op[c] = w; }
    __syncthreads();
}

__device__ __forceinline__ void kv_naive(LAS unsigned char* lds, const bf16_t* P, float* kv, int unit, const int tid) {
    const int b = unit >> 6, h = (unit >> 4) & 3, n = unit & 15;
    LAS float* kz = (LAS float*)lds; LAS float* vs = kz + 128 * 64;
    const size_t rowc = (size_t)b * SEQ + n * 128; const float lg = lg_gamma(h);
    for (int i = tid; i < 128 * 8; i += 512) { const int tok = i >> 3, ch = i & 7; const u32x4 w = *(const u32x4*)(P + (rowc + tok) * PW + 1024 + h * 64 + ch * 8); const float z = ex2((float)(127 - tok) * lg);
        LAS float* d = kz + tok * 64 + ch * 8; d[0] = bflo(w.x) * z; d[1] = bfhi(w.x) * z; d[2] = bflo(w.y) * z; d[3] = bfhi(w.y) * z; d[4] = bflo(w.z) * z; d[5] = bfhi(w.z) * z; d[6] = bflo(w.w) * z; d[7] = bfhi(w.w) * z; }
    for (int i = tid; i < 128 * 16; i += 512) { const int tok = i >> 4, ch = i & 15; const u32x4 w = *(const u32x4*)(P + (rowc + tok) * PW + 1280 + h * 128 + ch * 8);
        LAS float* d = vs + tok * 128 + ch * 8; d[0] = bflo(w.x); d[1] = bfhi(w.x); d[2] = bflo(w.y); d[3] = bfhi(w.y); d[4] = bflo(w.z); d[5] = bfhi(w.z); d[6] = bflo(w.w); d[7] = bfhi(w.w); }
    __syncthreads();
    const int e = tid & 127, d0 = (tid >> 7) * 16;
    float acc[16];
#pragma unroll
    for (int dd = 0; dd < 16; ++dd) acc[dd] = 0.f;
    for (int tok = 0; tok < 128; ++tok) { const float vv = vs[tok * 128 + e];
#pragma unroll
        for (int dd = 0; dd < 16; ++dd) acc[dd] += kz[tok * 64 + d0 + dd] * vv; }
#pragma unroll
    for (int dd = 0; dd < 16; ++dd) kv[((size_t)unit * 64 + d0 + dd) * 128 + e] = acc[dd];
    __syncthreads();
}

__device__ __forceinline__ void ret_naive(LAS unsigned char* lds, const bf16_t* P, const float* kv, bf16_t* X, int unit, const int tid) {
    const int b = unit >> 6, h = (unit >> 4) & 3, n = unit & 15;
    LAS float* St = (LAS float*)lds;
    LAS bf16_t* qs = (LAS bf16_t*)(lds + 32768);
    LAS bf16_t* ks = (LAS bf16_t*)(lds + 49152);
    LAS bf16_t* vs = (LAS bf16_t*)(lds + 65536);
    const size_t rowc = (size_t)b * SEQ + n * 128; const float lg = lg_gamma(h);
    { const int e = tid & 127, d0 = (tid >> 7) * 16; float s[16];
#pragma unroll
      for (int dd = 0; dd < 16; ++dd) s[dd] = 0.f;
      for (int j = 0; j < n; ++j) { const float w = ex2((float)((n - 1 - j) * 128) * lg); const float* kj = kv + ((size_t)(unit - n + j) * 64 + d0) * 128 + e;
#pragma unroll
          for (int dd = 0; dd < 16; ++dd) s[dd] += w * kj[dd * 128]; }
#pragma unroll
      for (int dd = 0; dd < 16; ++dd) St[(d0 + dd) * 128 + e] = s[dd]; }
    for (int i = tid; i < 128 * 8; i += 512) { const int tok = i >> 3, ch = i & 7; const bf16_t* src = P + (rowc + tok) * PW + h * 64 + ch * 8;
        *(LAS u32x4*)(qs + tok * 64 + ch * 8) = *(const u32x4*)(src + 768); *(LAS u32x4*)(ks + tok * 64 + ch * 8) = *(const u32x4*)(src + 1024); }
    for (int i = tid; i < 128 * 16; i += 512) { const int tok = i >> 4, ch = i & 15; *(LAS u32x4*)(vs + tok * 128 + ch * 8) = *(const u32x4*)(P + (rowc + tok) * PW + 1280 + h * 128 + ch * 8); }
    __syncthreads();
    const int r = tid >> 2, e0 = (tid & 3) * 32;
    float q[64], y[32];
    { const LAS u32x4* qp = (const LAS u32x4*)(qs + r * 64);
#pragma unroll
      for (int c = 0; c < 8; ++c) { const u32x4 w = qp[c]; q[8 * c] = bflo(w.x); q[8 * c + 1] = bfhi(w.x); q[8 * c + 2] = bflo(w.y); q[8 * c + 3] = bfhi(w.y); q[8 * c + 4] = bflo(w.z); q[8 * c + 5] = bfhi(w.z); q[8 * c + 6] = bflo(w.w); q[8 * c + 7] = bfhi(w.w); } }
#pragma unroll
    for (int ee = 0; ee < 32; ++ee) y[ee] = 0.f;
#pragma unroll 2
    for (int d = 0; d < 64; ++d) { const float qd = bf2f(qs[r * 64 + d]); const LAS f32x4* sp = (const LAS f32x4*)(St + d * 128 + e0);
#pragma unroll
        for (int c = 0; c < 8; ++c) { const f32x4 sv = sp[c]; y[4 * c] += qd * sv[0]; y[4 * c + 1] += qd * sv[1]; y[4 * c + 2] += qd * sv[2]; y[4 * c + 3] += qd * sv[3]; } }
    { const float xi = ex2((float)(r + 1) * lg);
#pragma unroll
      for (int ee = 0; ee < 32; ++ee) y[ee] *= xi; }
    const int rmax = (tid | 63) >> 2;
    for (int kk = 0; kk <= rmax; ++kk) {
        const LAS u32x4* kp = (const LAS u32x4*)(ks + kk * 64);
        float s = 0.f;
#pragma unroll
        for (int c = 0; c < 8; ++c) { const u32x4 w = kp[c];
            s += q[8 * c] * bflo(w.x) + q[8 * c + 1] * bfhi(w.x) + q[8 * c + 2] * bflo(w.y) + q[8 * c + 3] * bfhi(w.y) + q[8 * c + 4] * bflo(w.z) + q[8 * c + 5] * bfhi(w.z) + q[8 * c + 6] * bflo(w.w) + q[8 * c + 7] * bfhi(w.w); }
        const float aw = (kk <= r) ? s * ex2((float)(r - kk) * lg) : 0.f;
        const LAS u32x4* vp = (const LAS u32x4*)(vs + kk * 128 + e0);
#pragma unroll
        for (int c = 0; c < 4; ++c) { const u32x4 w = vp[c];
            y[8 * c] += aw * bflo(w.x); y[8 * c + 1] += aw * bfhi(w.x); y[8 * c + 2] += aw * bflo(w.y); y[8 * c + 3] += aw * bfhi(w.y); y[8 * c + 4] += aw * bflo(w.z); y[8 * c + 5] += aw * bfhi(w.z); y[8 * c + 6] += aw * bflo(w.w); y[8 * c + 7] += aw * bfhi(w.w); }
    }
    float sq = 0.f;
#pragma unroll
    for (int ee = 0; ee < 32; ++ee) sq += y[ee] * y[ee];
    sq += __shfl_xor(sq, 1); sq += __shfl_xor(sq, 2);
    const float rs = rsqrtf(sq * (1.f / 128.f) + EPS);
    const u32x4* gp = (const u32x4*)(P + (rowc + r) * PW + 1792 + h * 128 + e0);
    u32x4* op = (u32x4*)(X + (rowc + r) * XW + 1536 + h * 128 + e0);
#pragma unroll
    for (int c = 0; c < 4; ++c) { const u32x4 gw = gp[c]; u32x4 w;
        w.x = pk2(y[8 * c] * rs * bflo(gw.x), y[8 * c + 1] * rs * bfhi(gw.x)); w.y = pk2(y[8 * c + 2] * rs * bflo(gw.y), y[8 * c + 3] * rs * bfhi(gw.y));
        w.z = pk2(y[8 * c + 4] * rs * bflo(gw.z), y[8 * c + 5] * rs * bfhi(gw.z)); w.w = pk2(y[8 * c + 6] * rs * bflo(gw.w), y[8 * c + 7] * rs * bfhi(gw.w)); op[c] = w; }
    __syncthreads();
}

__device__ __forceinline__ void conv_all(const bf16_t* P, const float* cw, bf16_t* X, int G, int c, int row0, int nrows, const int tid) {
    const int gt = c * 512 + tid, NT = G * 512;
    for (int i = gt; i < nrows * 64; i += NT) {
        const int row = row0 + (i >> 6), ch = i & 63, t = row & (SEQ - 1);
        const bf16_t* p = P + (size_t)row * PW + ch * 8;
        const u32x4 cb = *(const u32x4*)(p + 2304), u0 = *(const u32x4*)(p + 2816);
        u32x4 u1 = {0u, 0u, 0u, 0u}, u2 = {0u, 0u, 0u, 0u};
        if (t >= 1) u1 = *(const u32x4*)(p + 2816 - PW);
        if (t >= 2) u2 = *(const u32x4*)(p + 2816 - 2 * PW);
        const f32x4 w0a = *(const f32x4*)(cw + ch * 8), w0b = *(const f32x4*)(cw + ch * 8 + 4), w1a = *(const f32x4*)(cw + 512 + ch * 8), w1b = *(const f32x4*)(cw + 512 + ch * 8 + 4),
                    w2a = *(const f32x4*)(cw + 1024 + ch * 8), w2b = *(const f32x4*)(cw + 1024 + ch * 8 + 4);
        u32x4 o;
        o.x = pk2(bflo(cb.x) * (w0a[0] * bflo(u2.x) + w1a[0] * bflo(u1.x) + w2a[0] * bflo(u0.x)), bfhi(cb.x) * (w0a[1] * bfhi(u2.x) + w1a[1] * bfhi(u1.x) + w2a[1] * bfhi(u0.x)));
        o.y = pk2(bflo(cb.y) * (w0a[2] * bflo(u2.y) + w1a[2] * bflo(u1.y) + w2a[2] * bflo(u0.y)), bfhi(cb.y) * (w0a[3] * bfhi(u2.y) + w1a[3] * bfhi(u1.y) + w2a[3] * bfhi(u0.y)));
        o.z = pk2(bflo(cb.z) * (w0b[0] * bflo(u2.z) + w1b[0] * bflo(u1.z) + w2b[0] * bflo(u0.z)), bfhi(cb.z) * (w0b[1] * bfhi(u2.z) + w1b[1] * bfhi(u1.z) + w2b[1] * bfhi(u0.z)));
        o.w = pk2(bflo(cb.w) * (w0b[2] * bflo(u2.w) + w1b[2] * bflo(u1.w) + w2b[2] * bflo(u0.w)), bfhi(cb.w) * (w0b[3] * bfhi(u2.w) + w1b[3] * bfhi(u1.w) + w2b[3] * bfhi(u0.w)));
        *(u32x4*)(X + (size_t)row * XW + 2048 + ch * 8) = o;
    }
}

__device__ __forceinline__ void final_norm(float* H, const float* ss, const float* g, int G, int c, int row0, int nrows, const int tid) {
    const int lane = tid & 63, gw = c * 8 + (tid >> 6), NGW = G * 8;
    for (int row = row0 + gw; row < row0 + nrows; row += NGW) {
        const float rstd = pg8::row_rstd(ss, row);
        f32x4* hr = (f32x4*)(H + (size_t)row * DM) + lane; const f32x4* gr = (const f32x4*)g + lane;
#pragma unroll
        for (int j = 0; j < 4; ++j) hr[64 * j] = hr[64 * j] * rstd * gr[64 * j];
    }
}
#ifndef RET_PROBE
#define RET_PROBE 0
#endif
typedef float f32x16 __attribute__((ext_vector_type(16)));
#define MFMA32(a, b, c) __builtin_amdgcn_mfma_f32_32x32x16_bf16((a), (b), (c), 0, 0, 0)
__device__ __forceinline__ int crow(int i, int hh) { return (i & 3) + 8 * (i >> 2) + 4 * hh; }
__device__ __forceinline__ bf16x8 pack8(const f32x16& v, int s) {
    u32x4 t; t.x = pk2(v[8 * s], v[8 * s + 1]); t.y = pk2(v[8 * s + 2], v[8 * s + 3]); t.z = pk2(v[8 * s + 4], v[8 * s + 5]); t.w = pk2(v[8 * s + 6], v[8 * s + 7]);
    return __builtin_bit_cast(bf16x8, t);
}
__device__ __forceinline__ bf16x8 join8(u32x2 a, u32x2 b) { u32x4 t = {a.x, a.y, b.x, b.y}; return __builtin_bit_cast(bf16x8, t); }
__device__ __forceinline__ void tr_store8(LAS unsigned* T32, int pitch32, int ch, int p, u32x4 w0, u32x4 w1) {
    LAS unsigned* t = T32 + (ch * 8) * pitch32 + (p ^ ((ch & 7) << 2));
    t[0 * pitch32] = (w0.x & 0xffffu) | (w1.x << 16); t[1 * pitch32] = (w0.x >> 16) | (w1.x & 0xffff0000u);
    t[2 * pitch32] = (w0.y & 0xffffu) | (w1.y << 16); t[3 * pitch32] = (w0.y >> 16) | (w1.y & 0xffff0000u);
    t[4 * pitch32] = (w0.z & 0xffffu) | (w1.z << 16); t[5 * pitch32] = (w0.z >> 16) | (w1.z & 0xffff0000u);
    t[6 * pitch32] = (w0.w & 0xffffu) | (w1.w << 16); t[7 * pitch32] = (w0.w >> 16) | (w1.w & 0xffff0000u);
}
__device__ __forceinline__ int tr_off(int c, int pitch32, int d) { return 2 * (c * pitch32 + (d ^ (((c >> 3) & 7) << 2))); }

__device__ __forceinline__ void attn_mfma(LAS unsigned char* lds, const bf16_t* P, bf16_t* X, const float* sinks, int unit, const int tid) {
    const int lane = tid & 63, wid = __builtin_amdgcn_readfirstlane(tid >> 6), r32 = lane & 31, hh = lane >> 5;
    const int b = unit >> 5, n = (unit >> 1) & 15, g = unit & 1;
    LAS bf16_t* Ks = (LAS bf16_t*)lds;
    LAS bf16_t* Vt = Ks + 256 * 72;
    const long row0 = (long)b * SEQ + n * 128 - 128;
    { u32x4 kv[4], w0[2], w1[2];
#pragma unroll
      for (int i = 0; i < 4; ++i) { const int c = tid + 512 * i, key = c >> 3, ch = c & 7; kv[i] = (u32x4){0u, 0u, 0u, 0u};
          if (n > 0 || key >= 128) kv[i] = *(const u32x4*)(P + (size_t)(row0 + key) * PW + 512 + g * 64 + ch * 8); }
#pragma unroll
      for (int i = 0; i < 2; ++i) { const int it = tid + 512 * i, kp = it >> 3, ch = it & 7; w0[i] = (u32x4){0u, 0u, 0u, 0u}; w1[i] = w0[i];
          if (n > 0 || kp >= 64) { const bf16_t* src = P + (size_t)(row0 + 2 * kp) * PW + 640 + g * 64 + ch * 8; w0[i] = *(const u32x4*)src; w1[i] = *(const u32x4*)(src + PW); } }
#pragma unroll
      for (int i = 0; i < 4; ++i) { const int c = tid + 512 * i, key = c >> 3, ch = c & 7; *(LAS u32x4*)(Ks + key * 72 + ch * 8) = kv[i]; }
#pragma unroll
      for (int i = 0; i < 2; ++i) { const int it = tid + 512 * i, kp = it >> 3, ch = it & 7; tr_store8((LAS unsigned*)Vt, 132, ch, kp, w0[i], w1[i]); } }
    __syncthreads();
    const int hq = g * 4 + (wid >> 1);
    const float sink2 = sinks[hq] * LOG2E;
    for (int pass = 0; pass < 2; ++pass) {
        const int r0 = (wid & 1) * 64 + pass * 32;
        const size_t qrow = (size_t)b * SEQ + n * 128 + r0 + r32;
        bf16x8 qf[4];
        { const bf16_t* qp = P + qrow * PW + hq * 64 + 8 * hh;
#pragma unroll
          for (int s = 0; s < 4; ++s) qf[s] = *(const bf16x8*)(qp + 16 * s); }
        f32x16 S[5];
#pragma unroll
        for (int j = 0; j < 5; ++j) {
#pragma unroll
            for (int i = 0; i < 16; ++i) S[j][i] = 0.f;
            const LAS bf16_t* kp = Ks + (r0 + 32 * j + r32) * 72 + 8 * hh;
#pragma unroll
            for (int s = 0; s < 4; ++s) S[j] = MFMA32(*(const LAS bf16x8*)(kp + 16 * s), qf[s], S[j]);
        }
#pragma unroll
        for (int i = 0; i < 16; ++i) { const int c = crow(i, hh); if (c <= r32) S[0][i] = -INFINITY; if (c > r32) S[4][i] = -INFINITY; }
        if (n == 0) {
#pragma unroll
            for (int j = 0; j < 4; ++j) if (r0 + 32 * j < 128) {
#pragma unroll
                for (int i = 0; i < 16; ++i) S[j][i] = -INFINITY; }
        }
        float mx = sink2;
#pragma unroll
        for (int j = 0; j < 5; ++j)
#pragma unroll
            for (int i = 0; i < 16; ++i) mx = fmaxf(mx, S[j][i]);
        mx = fmaxf(mx, __shfl_xor(mx, 32));
        float l = 0.f;
#pragma unroll
        for (int j = 0; j < 5; ++j)
#pragma unroll
            for (int i = 0; i < 16; ++i) { const float p = ex2(S[j][i] - mx); S[j][i] = p; l += p; }
        l += __shfl_xor(l, 32);
        l += ex2(sink2 - mx);
        f32x16 o[2];
#pragma unroll
        for (int i = 0; i < 16; ++i) { o[0][i] = 0.f; o[1][i] = 0.f; }
#pragma unroll
        for (int j = 0; j < 5; ++j)
#pragma unroll
            for (int s = 0; s < 2; ++s) {
                const bf16x8 pf = pack8(S[j], s);
#pragma unroll
                for (int dt = 0; dt < 2; ++dt) {
                    const int dd = (r0 + 32 * j + 16 * s + 4 * hh) >> 1;
                    o[dt] = MFMA32(join8(*(const LAS u32x2*)(Vt + tr_off(32 * dt + r32, 132, dd)), *(const LAS u32x2*)(Vt + tr_off(32 * dt + r32, 132, dd + 4))), pf, o[dt]);
                }
            }
        const float il = 1.f / l;
        bf16_t* op = X + qrow * XW + 1024 + hq * 64 + 4 * hh;
#pragma unroll
        for (int dt = 0; dt < 2; ++dt)
#pragma unroll
            for (int g4 = 0; g4 < 4; ++g4) { u32x2 w; w.x = pk2(o[dt][4 * g4] * il, o[dt][4 * g4 + 1] * il); w.y = pk2(o[dt][4 * g4 + 2] * il, o[dt][4 * g4 + 3] * il);
                *(u32x2*)(op + 32 * dt + 8 * g4) = w; }
    }
    __syncthreads();
}

__device__ __forceinline__ void kv_mfma(LAS unsigned char* lds, const bf16_t* P, bf16_t* kvT, int unit, const int tid) {
    const int lane = tid & 63, wid = __builtin_amdgcn_readfirstlane(tid >> 6), r32 = lane & 31, hh = lane >> 5;
    const int b = unit >> 6, h = (unit >> 4) & 3, n = unit & 15;
    LAS bf16_t* Kt = (LAS bf16_t*)lds;
    LAS bf16_t* Vt = Kt + 64 * 136;
    const size_t rowc = (size_t)b * SEQ + n * 128; const float lg = lg_gamma(h);
    { const int tp = tid >> 3, ch = tid & 7;
      const bf16_t* src = P + (rowc + 2 * tp) * PW + 1024 + h * 64 + ch * 8; const u32x4 w0 = *(const u32x4*)src, w1 = *(const u32x4*)(src + PW);
      const int tv = tid >> 3, cv = 2 * (tid & 7);
      const bf16_t* sv = P + (rowc + 2 * tv) * PW + 1280 + h * 128 + cv * 8;
      const u32x4 va0 = *(const u32x4*)sv, va1 = *(const u32x4*)(sv + PW), vb0 = *(const u32x4*)(sv + 8), vb1 = *(const u32x4*)(sv + 8 + PW);
      const float z0 = ex2((float)(127 - 2 * tp) * lg), z1 = ex2((float)(126 - 2 * tp) * lg);
      LAS unsigned* t = (LAS unsigned*)Kt + (ch * 8) * 68 + (tp ^ ((ch & 7) << 2));
      t[0 * 68] = pk2(bflo(w0.x) * z0, bflo(w1.x) * z1); t[1 * 68] = pk2(bfhi(w0.x) * z0, bfhi(w1.x) * z1); t[2 * 68] = pk2(bflo(w0.y) * z0, bflo(w1.y) * z1); t[3 * 68] = pk2(bfhi(w0.y) * z0, bfhi(w1.y) * z1);
      t[4 * 68] = pk2(bflo(w0.z) * z0, bflo(w1.z) * z1); t[5 * 68] = pk2(bfhi(w0.z) * z0, bfhi(w1.z) * z1); t[6 * 68] = pk2(bflo(w0.w) * z0, bflo(w1.w) * z1); t[7 * 68] = pk2(bfhi(w0.w) * z0, bfhi(w1.w) * z1);
      tr_store8((LAS unsigned*)Vt, 68, cv, tv, va0, va1); tr_store8((LAS unsigned*)Vt, 68, cv + 1, tv, vb0, vb1); }
    __syncthreads();
    const int et = wid >> 1, dt = wid & 1;
    f32x16 acc;
#pragma unroll
    for (int i = 0; i < 16; ++i) acc[i] = 0.f;
#pragma unroll
    for (int s = 0; s < 8; ++s) acc = MFMA32(*(const LAS bf16x8*)(Kt + tr_off(32 * dt + r32, 68, 8 * s + 4 * hh)), *(const LAS bf16x8*)(Vt + tr_off(32 * et + r32, 68, 8 * s + 4 * hh)), acc);
    bf16_t* o = kvT + ((size_t)unit * 128 + 32 * et + r32) * 64 + 32 * dt + 4 * hh;
#pragma unroll
    for (int g4 = 0; g4 < 4; ++g4) { u32x2 w; w.x = pk2(acc[4 * g4], acc[4 * g4 + 1]); w.y = pk2(acc[4 * g4 + 2], acc[4 * g4 + 3]); *(u32x2*)(o + 8 * g4) = w; }
    __syncthreads();
}

__device__ __forceinline__ void ret_mfma(LAS unsigned char* lds, const bf16_t* P, const bf16_t* kvT, bf16_t* X, int unit, const int tid) {
    const int lane = tid & 63, wid = __builtin_amdgcn_readfirstlane(tid >> 6), r32 = lane & 31, hh = lane >> 5;
    const int b = unit >> 6, h = (unit >> 4) & 3, n = unit & 15;
    LAS bf16_t* St = (LAS bf16_t*)lds;
    LAS bf16_t* Ks = St + 128 * 72;
    LAS bf16_t* Vt = Ks + 128 * 72;
    LAS float* ssq = (LAS float*)(Vt + 128 * 136);
    const size_t rowc = (size_t)b * SEQ + n * 128; const float lg = lg_gamma(h);
    const int rb = wid >> 1, eh = wid & 1;
    const size_t qrow = rowc + 32 * rb + r32;
    bf16x8 qf[4];
    { const bf16_t* qp = P + qrow * PW + 768 + h * 64 + 8 * hh;
#pragma unroll
      for (int s = 0; s < 4; ++s) qf[s] = *(const bf16x8*)(qp + 16 * s);
    }
    {
    u32x4 kst[2], vst0[2], vst1[2];
#pragma unroll
    for (int i = 0; i < 2; ++i) { const int c = tid + 512 * i; kst[i] = *(const u32x4*)(P + (rowc + (c >> 3)) * PW + 1024 + h * 64 + (c & 7) * 8);
        const int it = tid + 512 * i; const bf16_t* src = P + (rowc + 2 * (it >> 4)) * PW + 1280 + h * 128 + (it & 15) * 8; vst0[i] = *(const u32x4*)src; vst1[i] = *(const u32x4*)(src + PW); }
    { const int e = tid >> 2, d0 = (tid & 3) * 16; float s[16];
#pragma unroll
      for (int k = 0; k < 16; ++k) s[k] = 0.f;
      if (n > 0) {
          const u32x4* kb = (const u32x4*)(kvT + ((size_t)(unit - n) * 128 + e) * 64 + d0);
#pragma unroll
          for (int g = 0; g < 2; ++g) {
              const int j0 = 12 * g, nj = g ? 3 : 12;
              if (g && n <= 12) break;
              u32x4 t[12][2];
#pragma unroll
              for (int j = 0; j < 12; ++j) if (j < nj) { const int jj = (j0 + j) < n ? (j0 + j) : n - 1; t[j][0] = kb[(size_t)jj * 1024]; t[j][1] = kb[(size_t)jj * 1024 + 1]; }
#pragma unroll
              for (int j = 0; j < 12; ++j) if (j < nj) { const float w = (j0 + j) < n ? ex2((float)((n - 1 - j0 - j) * 128) * lg) : 0.f;
#pragma unroll
                  for (int q = 0; q < 2; ++q) { const u32x4 v = t[j][q];
                      s[8 * q] += w * bflo(v.x); s[8 * q + 1] += w * bfhi(v.x); s[8 * q + 2] += w * bflo(v.y); s[8 * q + 3] += w * bfhi(v.y);
                      s[8 * q + 4] += w * bflo(v.z); s[8 * q + 5] += w * bfhi(v.z); s[8 * q + 6] += w * bflo(v.w); s[8 * q + 7] += w * bfhi(v.w); } }
          }
      }
      u32x4 w0, w1; w0.x = pk2(s[0], s[1]); w0.y = pk2(s[2], s[3]); w0.z = pk2(s[4], s[5]); w0.w = pk2(s[6], s[7]);
      w1.x = pk2(s[8], s[9]); w1.y = pk2(s[10], s[11]); w1.z = pk2(s[12], s[13]); w1.w = pk2(s[14], s[15]);
      *(LAS u32x4*)(St + e * 72 + d0) = w0; *(LAS u32x4*)(St + e * 72 + d0 + 8) = w1; }
#pragma unroll
    for (int i = 0; i < 2; ++i) { const int c = tid + 512 * i; *(LAS u32x4*)(Ks + (c >> 3) * 72 + (c & 7) * 8) = kst[i]; }
#pragma unroll
    for (int i = 0; i < 2; ++i) { const int it = tid + 512 * i; tr_store8((LAS unsigned*)Vt, 68, it & 15, it >> 4, vst0[i], vst1[i]); }
    __syncthreads();
    }
    {
    u32x2 gw[2][4];
    { const bf16_t* gp = P + qrow * PW + 1792 + h * 128 + 64 * eh + 4 * hh;
#pragma unroll
      for (int et = 0; et < 2; ++et)
#pragma unroll
          for (int g4 = 0; g4 < 4; ++g4) gw[et][g4] = *(const u32x2*)(gp + 32 * et + 8 * g4); }
    f32x16 o[2];
#pragma unroll
    for (int i = 0; i < 16; ++i) { o[0][i] = 0.f; o[1][i] = 0.f; }
#pragma unroll
    for (int et = 0; et < 2; ++et) { const LAS bf16_t* sp = St + (64 * eh + 32 * et + r32) * 72 + 8 * hh;
#pragma unroll
        for (int s = 0; s < 4; ++s) o[et] = MFMA32(*(const LAS bf16x8*)(sp + 16 * s), qf[s], o[et]); }
    { const float xi = ex2((float)(32 * rb + r32 + 1) * lg);
#pragma unroll
      for (int i = 0; i < 16; ++i) { o[0][i] *= xi; o[1][i] *= xi; } }
    for (int kt = 0; kt <= rb; ++kt) {
        f32x16 S;
#pragma unroll
        for (int i = 0; i < 16; ++i) S[i] = 0.f;
        const LAS bf16_t* kp = Ks + (32 * kt + r32) * 72 + 8 * hh;
#pragma unroll
        for (int s = 0; s < 4; ++s) S = MFMA32(*(const LAS bf16x8*)(kp + 16 * s), qf[s], S);
#pragma unroll
        for (int i = 0; i < 16; ++i) { const int diff = 32 * (rb - kt) + r32 - crow(i, hh); S[i] = diff >= 0 ? S[i] * ex2((float)diff * lg) : 0.f; }
#pragma unroll
        for (int s = 0; s < 2; ++s) {
            const bf16x8 pf = pack8(S, s);
#pragma unroll
            for (int et = 0; et < 2; ++et) {
                const int er = 64 * eh + 32 * et + r32, dd = 16 * kt + 8 * s + 2 * hh;
                o[et] = MFMA32(join8(*(const LAS u32x2*)(Vt + tr_off(er, 68, dd)), *(const LAS u32x2*)(Vt + tr_off(er, 68, dd + 4))), pf, o[et]);
            }
        }
    }
    float sq = 0.f;
#pragma unroll
    for (int i = 0; i < 16; ++i) sq += o[0][i] * o[0][i] + o[1][i] * o[1][i];
    sq += __shfl_xor(sq, 32);
    if (hh == 0) ssq[eh * 128 + 32 * rb + r32] = sq;
    __syncthreads();
    const float rs = rsqrtf((ssq[32 * rb + r32] + ssq[128 + 32 * rb + r32]) * (1.f / 128.f) + EPS);
    bf16_t* op = X + qrow * XW + 1536 + h * 128 + 64 * eh + 4 * hh;
#pragma unroll
    for (int et = 0; et < 2; ++et)
#pragma unroll
        for (int g4 = 0; g4 < 4; ++g4) { const u32x2 g = gw[et][g4]; u32x2 w;
            w.x = pk2(o[et][4 * g4] * rs * bflo(g.x), o[et][4 * g4 + 1] * rs * bfhi(g.x)); w.y = pk2(o[et][4 * g4 + 2] * rs * bflo(g.y), o[et][4 * g4 + 3] * rs * bfhi(g.y));
            *(u32x2*)(op + 32 * et + 8 * g4) = w; }
    }
    __syncthreads();
}
#define XB_TMO      128
#define XB_XCNT(j)  (256  + 64 * (j))
#define XB_XSUB(j)  (1280 + 64 * (j))
#define XB_XGEN(j)  (2304 + 64 * (j))
#define XB_TOP      3328
#define XB_TOPGEN   3392
#define XCD_BAR_WORDS 3456
#define XB_SPIN_CAP (1u << 18)
__device__ __forceinline__ unsigned xb_ld(unsigned* p)              { return __hip_atomic_load(p, __ATOMIC_RELAXED, __HIP_MEMORY_SCOPE_AGENT); }
__device__ __forceinline__ unsigned xb_add(unsigned* p, unsigned v) { return __hip_atomic_fetch_add(p, v, __ATOMIC_RELAXED, __HIP_MEMORY_SCOPE_AGENT); }
__device__ __forceinline__ unsigned xb_xcc_id() { return (unsigned)__builtin_amdgcn_s_getreg((3 << 11) | 20) & 0xFu; }
#define XB_SPIN(cond, bar) do { unsigned _sp = 0; while (cond) { __builtin_amdgcn_s_sleep(1); \
    if ((++_sp & 255u) == 0u) { if (xb_ld(&(bar)[XB_TMO])) break; if (_sp > XB_SPIN_CAP) { atomicAdd(&(bar)[XB_TMO], 1u); break; } } } } while (0)
struct XcdBarrier { unsigned* bar; unsigned x; volatile LAS unsigned* st; unsigned nexp; };
__device__ __forceinline__ XcdBarrier xcd_barrier_post(unsigned* bar, volatile LAS unsigned* st, unsigned nexp) {
    XcdBarrier b; b.bar = bar; b.x = xb_xcc_id(); b.st = st; b.nexp = nexp;
    if (threadIdx.x == 0) (void)xb_add(&bar[XB_XCNT(b.x)], 1u);
    return b;
}
__device__ __forceinline__ void xcd_barrier_complete(unsigned* bar, unsigned x, unsigned G, unsigned& nloc, unsigned& nx) {
    unsigned sum, cnt, mine, sp = 0u;
    for (;;) {
        sum = 0u; cnt = 0u; mine = 0u;
#pragma unroll
        for (unsigned j = 0; j < 16; ++j) { const unsigned c = xb_ld(&bar[XB_XCNT(j)]); sum += c; cnt += (c > 0u) ? 1u : 0u; mine = (j == x) ? c : mine; }
        if (sum == G) break;
        __builtin_amdgcn_s_sleep(1);
        if ((++sp & 255u) == 0u) { if (xb_ld(&bar[XB_TMO])) break; if (sp > XB_SPIN_CAP) { atomicAdd(&bar[XB_TMO], 1u); break; } }
    }
    nloc = mine > 0u ? mine : 1u; nx = cnt > 0u ? cnt : 1u;
}
__device__ __forceinline__ void xcd_barrier(const XcdBarrier& b) {
    asm volatile("s_waitcnt vmcnt(0)" ::: "memory");
    __syncthreads();
    if (threadIdx.x == 0) {
        unsigned* bar = b.bar;
        __builtin_amdgcn_s_waitcnt(0);
        unsigned nloc = b.st[0], nx = b.st[1];
        if (nloc == 0u) { xcd_barrier_complete(bar, b.x, b.nexp, nloc, nx); b.st[0] = nloc; b.st[1] = nx; }
        const unsigned old = xb_add(&bar[XB_XSUB(b.x)], 1u);
        const unsigned gen = old / nloc;
        if (old + 1u == (gen + 1u) * nloc) {
            __builtin_amdgcn_fence(__ATOMIC_RELEASE, "agent");
            asm volatile("s_waitcnt vmcnt(0)" ::: "memory");
            const unsigned og = xb_add(&bar[XB_TOP], 1u);
            const unsigned tg = og / nx;
            if (og + 1u == (tg + 1u) * nx) xb_add(&bar[XB_TOPGEN], 1u);
            else XB_SPIN(xb_ld(&bar[XB_TOPGEN]) == tg, bar);
            __builtin_amdgcn_fence(__ATOMIC_ACQUIRE, "agent");
            xb_add(&bar[XB_XGEN(b.x)], 1u);
            asm volatile("s_waitcnt vmcnt(0)" ::: "memory");
        } else {
            XB_SPIN(xb_ld(&bar[XB_XGEN(b.x)]) == gen, bar);
            __builtin_amdgcn_fence(__ATOMIC_ACQUIRE, "agent");
            asm volatile("s_waitcnt vmcnt(0)" ::: "memory");
        }
    }
    __syncthreads();
}

constexpr int NPH = 30;
#ifndef PHM
#define PHM 0x1ff
#endif
#ifndef MIX_NAIVE
#define MIX_NAIVE 0
#endif
#ifndef RES_BF16
#define RES_BF16 1
#endif
#ifndef HBD_EXP
#define HBD_EXP 0
#endif
#ifndef B1_PROBE
#define B1_PROBE 0
#endif
#ifndef DBL_BAR
#define DBL_BAR 0
#endif
#ifndef DBLM
#define DBLM 0
#endif
#ifndef MK_NG
#define MK_NG 1
#endif
#ifndef MK_STAGGER
#define MK_STAGGER 1500
#endif
__global__ void __launch_bounds__(512, 2) mk_fwd(Args a) {
    extern __shared__ __attribute__((aligned(16))) unsigned char lds_raw[];
    LAS unsigned char* lds = (LAS unsigned char*)lds_raw;
    const int Gall = gridDim.x, call = blockIdx.x;
    constexpr int NG = MK_NG, MG = M / NG;
    const int grp = (call >> 3) % NG, c = ((call >> 3) / NG) * 8 + (call & 7), G = Gall / NG;
    const int row0 = grp * MG, pm0 = grp * (MG / 256);
    volatile LAS unsigned* MISC = (volatile LAS unsigned*)(lds + MISC_OFF);
    if (threadIdx.x < 32) MISC[threadIdx.x] = 0u;
    __syncthreads();
    unsigned* ctl = (unsigned*)(a.ws + WS_CTL);
    const bool multi = (a.ph_hi - a.ph_lo) > 1;
    XcdBarrier barAll, bar; barAll.bar = ctl + 4096; barAll.x = 0; barAll.st = nullptr; barAll.nexp = 0; bar = barAll;
    if (multi) { barAll = xcd_barrier_post(ctl + 4096, MISC + 8, (unsigned)Gall);
                 bar = (NG == 1) ? barAll : xcd_barrier_post(ctl + 4096 + (1 + grp) * XCD_BAR_WORDS, MISC + 10, (unsigned)G); }

    bf16_t* X = (bf16_t*)(a.ws + WS_X); bf16_t* P = (bf16_t*)(a.ws + WS_P); float* ss = (float*)(a.ws + WS_SS);
#if MIX_NAIVE & 2
    float* kvb = (float*)(a.ws + WS_KV);
#else
    bf16_t* kvb = (bf16_t*)(a.ws + WS_KV);
#endif
    for (int ph = a.ph_lo; ph < a.ph_hi; ++ph) {
        const int kind_ = (ph == 0) ? 0 : (ph == NPH - 1) ? 1 : 2 + (ph - 1) % 7;
        for (int rep_ = 0; rep_ < (((DBLM >> kind_) & 1) ? 2 : 1); ++rep_) {
        if (rep_) __syncthreads();
        int tid = threadIdx.x; asm volatile("" : "+v"(tid));
        if (ph == 0) { if (PHM & 1) phase_prologue(a, lds, Gall, tid); }
        else if (ph == NPH - 1) { if (PHM & 2) final_norm(a.out, ss + (size_t)8 * M * 16, a.norm_final, G, c, row0, MG, tid); }
        else {
            const int l = (ph - 1) / 7, sub = (ph - 1) % 7;
            const char* Wl = (const char*)(a.ws + WS_W + (size_t)l * WL_SIZE);
            if (sub == 0 && (PHM & 4)) {
                pg8::SchedPlain S{(const char*)X, Wl + WL_IN, XW, DM, DM / 64, MG / 256, NIN / 256, G, c, pg8::K_IN, pm0};
                pg8::EpiIn E{P, ss + (size_t)(2 * l) * M * 16};
                pg8::gemm_phase(lds, XW, DM, S, E, tid);
            } else if (sub == 1 && (PHM & 8)) {
#if MIX_NAIVE & 1
                for (int u = c; u < 256 / NG; u += G) attn_naive(lds, P, X, a.sinks + l * 8, grp * (256 / NG) + u, tid);
#else
                for (int rr_ = 0; rr_ < ((B1_PROBE & 1) ? 2 : 1); ++rr_)
                for (int u = c; u < 256 / NG; u += G) attn_mfma(lds, P, X, a.sinks + l * 8, grp * (256 / NG) + u, tid);
#endif
#if MIX_NAIVE & 2
                for (int u = c; u < 512 / NG; u += G) kv_naive(lds, P, kvb, grp * (512 / NG) + u, tid);
#else
                for (int rr_ = 0; rr_ < ((B1_PROBE & 2) ? 2 : 1); ++rr_)
                for (int u = c; u < 512 / NG; u += G) kv_mfma(lds, P, kvb, grp * (512 / NG) + u, tid);
#endif
                for (int rr_ = 0; rr_ < ((B1_PROBE & 4) ? 2 : 1); ++rr_)
                conv_all(P, a.conv_w + l * 3 * 512, X, G, c, row0, MG, tid);
            } else if (sub == 2 && (PHM & 16)) {
#if MIX_NAIVE & 2
                for (int u = c; u < 512 / NG; u += G) ret_naive(lds, P, kvb, X, grp * (512 / NG) + u, tid);
#else
                for (int u = c; u < 512 / NG; u += G) ret_mfma(lds, P, kvb, X, grp * (512 / NG) + ((u < 256 / NG) ? u : (u & ~15) | (15 - (u & 15))), tid);
#endif
            } else if (sub == 3 && (PHM & 32)) {
                pg8::SchedC S{(const char*)X, Wl + WL_C, Wl + WL_B, MG / 256, G, c, pm0};
                pg8::EpiC E{ss + (size_t)(2 * l) * M * 16, a.b_gate + l * 3 * DM, (u32x4*)(a.ws + WS_GS) + (size_t)call * 8192, (u32x4*)(a.ws + WS_MACC) + (size_t)call * 16384, (bf16_t*)(a.ws + WS_MB)};
                pg8::gemm_phase(lds, XW, KC, S, E, tid);
            } else if (sub == 4 && (PHM & 64)) {
                pg8::SchedPlain S{(const char*)(a.ws + WS_MB), Wl + WL_OUT, DM, DM, DM / 64, MG / 256, DM / 256, G, c, pg8::K_RES, pm0};
                pg8::EpiRes E{l == 0 ? a.x : a.out, a.out, X, ss + (size_t)(2 * l + 1) * M * 16, RES_BF16 ? (l == 0 ? 0 : 1) : 2, HBD_EXP ? (bf16_t*)(a.ws + 398 * MiB) : nullptr};
                pg8::gemm_phase(lds, DM, DM, S, E, tid);
            } else if (sub == 5 && (PHM & 128)) {
                const int ldE = HBD_EXP ? DM : XW;
                pg8::SchedPlain S{HBD_EXP ? (const char*)(a.ws + 398 * MiB) : (const char*)X, Wl + WL_GU, ldE, DM, DM / 64, MG / 256, NGU / 256, G, c, pg8::K_GU, pm0};
                pg8::EpiGU E{ss + (size_t)(2 * l + 1) * M * 16, (bf16_t*)(a.ws + WS_FF)};
                pg8::gemm_phase(lds, ldE, DM, S, E, tid);
            } else if (sub == 6 && (PHM & 256)) {
                pg8::SchedPlain S{(const char*)(a.ws + WS_FF), Wl + WL_D, DFF, DFF, DFF / 64, MG / 256, DM / 256, G, c, pg8::K_RES, pm0};
                pg8::EpiRes E{a.out, a.out, X, ss + (size_t)(2 * l + 2) * M * 16, RES_BF16 ? (l == DEPTH - 1 ? 3 : 1) : 2, nullptr};
                pg8::gemm_phase(lds, DFF, DFF, S, E, tid);
            }
        }
        }
        if (ph + 1 < a.ph_hi) {
            if (ph == 0) { xcd_barrier(barAll);
                if (NG > 1 && grp > 0) { const unsigned long long t0 = __builtin_amdgcn_s_memrealtime(); while (__builtin_amdgcn_s_memrealtime() - t0 < (unsigned long long)(grp * MK_STAGGER)) __builtin_amdgcn_s_sleep(8); } }
            else xcd_barrier(bar);
#if DBL_BAR
            xcd_barrier(bar);
#endif
        }
    }
}

#ifndef MK_SINGLE
#define MK_SINGLE 0
#endif
extern "C" void kernel_launch(void* const* d_in, const int* in_sizes, int n_in, void* d_out, int out_size, void* d_ws, size_t ws_size, hipStream_t stream) {
    static int grid = 0;
    if (grid == 0) {
        if (n_in != 13 || out_size != M * DM || ws_size < WS_END) { fprintf(stderr, "kernel_launch: unexpected shapes (n_in %d, out %d, ws %zu)\n", n_in, out_size, ws_size); grid = -1; return; }
        int dev = 0, cus = 0, per_cu = 0;
        if (hipGetDevice(&dev) != hipSuccess || hipDeviceGetAttribute(&cus, hipDeviceAttributeMultiprocessorCount, dev) != hipSuccess) { grid = -1; return; }
        if (hipFuncSetAttribute((const void*)mk_fwd, hipFuncAttributeMaxDynamicSharedMemorySize, LDS_BYTES) != hipSuccess) { fprintf(stderr, "kernel_launch: hipFuncSetAttribute failed\n"); grid = -1; return; }
        if (hipOccupancyMaxActiveBlocksPerMultiprocessor(&per_cu, (const void*)mk_fwd, 512, LDS_BYTES) != hipSuccess || per_cu < 1) { fprintf(stderr, "kernel_launch: occupancy query says %d\n", per_cu); per_cu = 1; }
        (void)hipGetLastError();
        grid = cus;
        if (grid > 256) grid = 256;
    }
    if (grid < 0) return;
    (void)hipMemsetAsync((char*)d_ws + WS_CTL, 0, CTL_ZERO_BYTES, stream);
    Args a{};
    a.x = (const float*)d_in[0]; a.norm_mix = (const float*)d_in[1]; a.w_in = (const float*)d_in[2]; a.sinks = (const float*)d_in[3]; a.conv_w = (const float*)d_in[4];
    a.w_branch = (const float*)d_in[5]; a.b_gate = (const float*)d_in[6]; a.w_out = (const float*)d_in[7]; a.norm_ffn = (const float*)d_in[8];
    a.w_g = (const float*)d_in[9]; a.w_u = (const float*)d_in[10]; a.w_d = (const float*)d_in[11]; a.norm_final = (const float*)d_in[12];
    a.out = (float*)d_out; a.ws = (unsigned char*)d_ws;
#if MK_SINGLE
    a.ph_lo = 0; a.ph_hi = NPH;
    hipLaunchKernelGGL(mk_fwd, dim3(grid), dim3(512), LDS_BYTES, stream, a);
#else
    for (int ph = 0; ph < NPH; ++ph) { a.ph_lo = ph; a.ph_hi = ph + 1; hipLaunchKernelGGL(mk_fwd, dim3(grid), dim3(512), LDS_BYTES, stream, a); }
#endif
}
```

```cpp
#include <hip/hip_runtime.h>
#include <cstdio>
#include <cstdint>

#define LAS __attribute__((address_space(3)))
#define GAS __attribute__((address_space(1)))
typedef unsigned short bf16_t;
typedef short bf16x8 __attribute__((ext_vector_type(8)));
typedef float f32x4 __attribute__((ext_vector_type(4)));
typedef float f32x2 __attribute__((ext_vector_type(2)));
typedef unsigned u32x4 __attribute__((ext_vector_type(4)));
typedef unsigned u32x2 __attribute__((ext_vector_type(2)));
typedef __bf16 bf16x2_t __attribute__((ext_vector_type(2)));

constexpr int BATCH = 8, SEQ = 2048, DM = 1024, M = BATCH * SEQ, DEPTH = 4, DFF = 2816, DIN = 6912;
constexpr int PW = 3328;
constexpr int XW = 2560;
constexpr int NIN = 3840;
constexpr int NGU = 2 * DFF;
constexpr int KC = 1536;
constexpr float EPS = 1e-6f;
constexpr float LOG2E = 1.4426950408889634f;
constexpr float QSCALE = 0.18033688011112042f;

constexpr size_t MiB = 1u << 20;
constexpr size_t WS_CTL = 0, CTL_ZERO_BYTES = 262144;
constexpr size_t WS_SS = 388 * MiB;
constexpr size_t WS_TABA = 2 * MiB;
constexpr size_t WS_TABR = 2 * MiB + 131072;
constexpr size_t WS_W = 4 * MiB;
constexpr size_t WL_IN = 0, WL_C = 7864320, WL_B = 17301504, WL_OUT = 20447232, WL_GU = 22544384, WL_D = 34078720, WL_SIZE = 39845888;
constexpr size_t WS_X = 156 * MiB;
constexpr size_t WS_P = 236 * MiB;
constexpr size_t WS_MACC = WS_P, WS_MB = WS_P + 64 * MiB, WS_FF = WS_P;
constexpr size_t WS_GS = 340 * MiB;
constexpr size_t WS_KV = 372 * MiB;
constexpr size_t WS_END = 398 * MiB;
static_assert(WS_W + DEPTH * WL_SIZE <= WS_X, "weights");
static_assert((size_t)M * XW * 2 <= 80 * MiB && (size_t)M * PW * 2 <= 104 * MiB && (size_t)M * DFF * 2 <= 104 * MiB, "buffers");

constexpr int RING_BYTES = 131072, LDS_BYTES = 147456, MISC_OFF = RING_BYTES + 320;

__device__ __forceinline__ unsigned pk2(float lo, float hi) { f32x2 v = {lo, hi}; bf16x2_t b = __builtin_convertvector(v, bf16x2_t); return __builtin_bit_cast(unsigned, b); }
__device__ __forceinline__ float bflo(unsigned u) { return __uint_as_float(u << 16); }
__device__ __forceinline__ float bfhi(unsigned u) { return __uint_as_float(u & 0xffff0000u); }
__device__ __forceinline__ float bf2f(bf16_t b) { return __uint_as_float((unsigned)b << 16); }
__device__ __forceinline__ float fsilu(float x) { return x * __builtin_amdgcn_rcpf(1.f + __builtin_amdgcn_exp2f(-x * LOG2E)); }
__device__ __forceinline__ float fsigm(float x) { return __builtin_amdgcn_rcpf(1.f + __builtin_amdgcn_exp2f(-x * LOG2E)); }

struct Args {
    const float* x; const float* norm_mix; const float* w_in; const float* sinks; const float* conv_w; const float* w_branch; const float* b_gate; const float* w_out;
    const float* norm_ffn; const float* w_g; const float* w_u; const float* w_d; const float* norm_final;
    float* out; unsigned char* ws; int ph_lo, ph_hi;
};
#define MK_SINGLE 1
#ifndef DBL_EPI
#define DBL_EPI 0
#endif
namespace pg8 {
constexpr int BM = 256, BK = 64, HALF = 128, HTB = HALF * BK * 2  , STAGE_BYTES = 8 * HTB, NXCD = 8, WGM = 8;

__host__ __device__ __forceinline__ int lds_byte(int r, int c) { const int st = (r >> 4) * 2 + (c >> 5), rr = r & 15, cc = c & 31, ob = rr * 64 + cc * 2; return st * 1024 + (ob ^ (((ob >> 9) & 1) << 5)); }
__host__ __device__ __forceinline__ void stage_rc(int b, int& R, int& C) { const int st = b / 1024, sb = b % 1024, swz = sb ^ (((sb >> 9) & 1) << 5); R = (st >> 1) * 16 + swz / 64; C = (st & 1) * 32 + (swz % 64) / 2; }
__host__ __device__ __forceinline__ int perm32(int rho) { const int n = rho >> 4, i = rho & 15; return 8 * (i >> 2) + 4 * n + (i & 3); }

struct Unit { const char* A; const char* B; int nt, pm, pn, kind, aux; };

__device__ __forceinline__ void tile_of(int L, int nM, int nN, int& pm, int& pn) {
    const int nwg = nM * nN; int wgid = L;
    { const int q = nwg / NXCD, r = nwg % NXCD, xcd = wgid % NXCD, off = wgid / NXCD; wgid = (xcd < r ? xcd * (q + 1) : r * (q + 1) + (xcd - r) * q) + off; }
    const int nig = WGM * nN, gid = wgid / nig, fm = gid * WGM, gsz = (nM - fm) < WGM ? (nM - fm) : WGM;
    pm = fm + ((wgid % nig) % gsz); pn = (wgid % nig) / gsz;
}

template <class Epi, class Sched>
__device__ __forceinline__ void gemm_phase(LAS unsigned char* lds, const int lda, const int ldb, const Sched& S, const Epi& E, const int tid) {
    const int wid = __builtin_amdgcn_readfirstlane(tid >> 6), lane = tid & 63, wr = wid >> 2, wc = wid & 3, fr = lane & 15, fq = lane >> 4;
    unsigned voffA[2], voffB[2];
#pragma unroll
    for (int i = 0; i < 2; ++i) { int R, C; stage_rc(tid * 16 + i * 8192, R, C); const int Rb = 2 * (R & ~31) + perm32(R & 31);
        voffA[i] = (unsigned)(R * lda + C) * 2u; voffB[i] = (unsigned)(Rb * ldb + C) * 2u; }
    const size_t kstep = (size_t)(BK * 2);
    const size_t hstepA = (size_t)HALF * lda * 2, hstepB = (size_t)32 * ldb * 2;
    const unsigned ldsw = (unsigned)wid * 1024u;
    const int aoff = lds_byte(wr * 64 + fr, fq * 8), boff = lds_byte(wc * 32 + fr, fq * 8);
#define PG8_SA(b, h) (((b) * 2 + (h)) * HTB)
#define PG8_SB(b, h) ((4 + (b) * 2 + (h)) * HTB)
#define PG8_STAGE(bufoff, gbase, voff) do { _Pragma("unroll") for (int _i = 0; _i < 2; ++_i) \
        __builtin_amdgcn_global_load_lds((const unsigned*)((const char*)(gbase) + (voff)[_i]), (LAS unsigned*)(lds + (bufoff) + ldsw + _i * 8192), 16, 0, 0); } while (0)
#define PG8_LDA(dst, b, h) do { _Pragma("unroll") for (int m = 0; m < 4; ++m) _Pragma("unroll") for (int k = 0; k < 2; ++k) dst[m][k] = *(const LAS bf16x8*)(lds + PG8_SA(b, h) + aoff + m * 2048 + k * 1024); } while (0)
#define PG8_LDB(dst, b, h) do { _Pragma("unroll") for (int n = 0; n < 2; ++n) _Pragma("unroll") for (int k = 0; k < 2; ++k) dst[n][k] = *(const LAS bf16x8*)(lds + PG8_SB(b, h) + boff + n * 2048 + k * 1024); } while (0)
#define PG8_MMA(ai, bj, At, Bt) do { __builtin_amdgcn_s_setprio(1); _Pragma("unroll") for (int m = 0; m < 4; ++m) _Pragma("unroll") for (int n = 0; n < 2; ++n) _Pragma("unroll") for (int k = 0; k < 2; ++k) \
        acc[ai][bj][m][n] = __builtin_amdgcn_mfma_f32_16x16x32_bf16(Bt[n][k], At[m][k], acc[ai][bj][m][n], 0, 0, 0); __builtin_amdgcn_s_setprio(0); } while (0)
#define PG8_WAIT_V(n) asm volatile("s_waitcnt vmcnt(" #n ")" ::: "memory")
#define PG8_WAIT_L(n) asm volatile("s_waitcnt lgkmcnt(" #n ")" ::: "memory")
#define PG8_BAR __builtin_amdgcn_s_barrier()
#define PG8_SCHED __builtin_amdgcn_sched_barrier(0)
    Unit cur, nxt; int ui = 0;
    if (!S.next(0, cur)) return;
    f32x4 acc[2][2][4][2];
#pragma unroll
    for (int a = 0; a < 2; ++a)
#pragma unroll
        for (int b = 0; b < 2; ++b)
#pragma unroll
            for (int m = 0; m < 4; ++m)
#pragma unroll
                for (int n = 0; n < 2; ++n) acc[a][b][m][n] = (f32x4){0.f, 0.f, 0.f, 0.f};
    bf16x8 At[4][2], B0[2][2], B1[2][2];
    const char* cA = cur.A; const char* cB = cur.B;
    PG8_STAGE(PG8_SB(0, 0), cB, voffB); PG8_STAGE(PG8_SB(0, 1), cB + hstepB, voffB); PG8_STAGE(PG8_SA(0, 0), cA, voffA); PG8_STAGE(PG8_SA(0, 1), cA + hstepA, voffA);
    if (wr == 1) PG8_BAR;
    PG8_WAIT_V(2); PG8_BAR;
    PG8_STAGE(PG8_SB(1, 0), cB + kstep, voffB); PG8_STAGE(PG8_SA(1, 0), cA + kstep, voffA); PG8_STAGE(PG8_SB(1, 1), cB + hstepB + kstep, voffB);
    PG8_WAIT_V(6); PG8_BAR;
    for (;;) {
        const bool has_next = S.next(ui + 1, nxt);
        const char* nA = has_next ? nxt.A : cA; const char* nB = has_next ? nxt.B : cB;
        const int nt = cur.nt;
        for (int t = 0; t < nt; t += 2) {
            const bool last = (t == nt - 2);
            if constexpr (Epi::HAS_HOOK) E.hook(acc, cur, t, wid);
            const char* a1 = cA + (size_t)(t + 1) * kstep;
            const char* a2 = last ? nA : cA + (size_t)(t + 2) * kstep; const char* b2 = last ? nB : cB + (size_t)(t + 2) * kstep;
            const char* a3 = a2 + kstep; const char* b3 = b2 + kstep;
            PG8_LDB(B0, 0, 0); PG8_LDB(B1, 0, 1); PG8_SCHED; PG8_LDA(At, 0, 0); PG8_STAGE(PG8_SA(1, 1), a1 + hstepA, voffA);
            PG8_WAIT_V(8); PG8_WAIT_L(0); PG8_BAR; PG8_MMA(0, 0, At, B0); PG8_MMA(0, 1, At, B1); PG8_BAR; PG8_SCHED;
            PG8_LDA(At, 0, 1); PG8_STAGE(PG8_SB(0, 0), b2, voffB); PG8_STAGE(PG8_SB(0, 1), b2 + hstepB, voffB); PG8_STAGE(PG8_SA(0, 0), a2, voffA);
            PG8_WAIT_V(8); PG8_WAIT_L(0); PG8_BAR; PG8_MMA(1, 0, At, B0); PG8_MMA(1, 1, At, B1); PG8_BAR; PG8_SCHED;
            PG8_LDB(B0, 1, 0); PG8_LDB(B1, 1, 1); PG8_SCHED; PG8_LDA(At, 1, 0); PG8_STAGE(PG8_SA(0, 1), a2 + hstepA, voffA);
            PG8_WAIT_V(8); PG8_WAIT_L(0); PG8_BAR; PG8_MMA(0, 0, At, B0); PG8_MMA(0, 1, At, B1); PG8_BAR; PG8_SCHED;
            PG8_LDA(At, 1, 1); PG8_STAGE(PG8_SB(1, 0), b3, voffB); PG8_STAGE(PG8_SB(1, 1), b3 + hstepB, voffB); PG8_STAGE(PG8_SA(1, 0), a3, voffA);
            PG8_WAIT_V(8); PG8_WAIT_L(0); PG8_BAR; PG8_MMA(1, 0, At, B0); PG8_MMA(1, 1, At, B1); PG8_BAR; PG8_SCHED;
        }
        if (wr == 0) PG8_BAR;
#if DBL_EPI
        if (E.dbl(cur)) { E(acc, cur, wid, false); asm volatile("" ::: "memory"); }
#endif
        E(acc, cur, wid, true);
        if (!has_next) break;
        cur = nxt; cA = nA; cB = nB; ++ui;
        if (wr == 1) PG8_BAR;
    }
    PG8_WAIT_V(0);
    PG8_BAR;
#undef PG8_SA
#undef PG8_SB
#undef PG8_STAGE
#undef PG8_LDA
#undef PG8_LDB
#undef PG8_MMA
#undef PG8_WAIT_V
#undef PG8_WAIT_L
#undef PG8_BAR
#undef PG8_SCHED
}
}
namespace pg8 {
#ifndef EPIC_TEST
#define EPIC_TEST(x) (x)
#endif
__device__ __forceinline__ float row_rstd(const float* ss, int row) {
    const f32x4* p = (const f32x4*)(ss + (size_t)row * 16); const f32x4 a = p[0], b = p[1], c = p[2], d = p[3];
    const float s = ((a[0] + a[1]) + (a[2] + a[3])) + ((b[0] + b[1]) + (b[2] + b[3])) + (((c[0] + c[1]) + (c[2] + c[3])) + ((d[0] + d[1]) + (d[2] + d[3])));
    return rsqrtf(s * (1.f / DM) + EPS);
}
#ifndef USE_NT
#define USE_NT 0
#endif
#if USE_NT
#define NT_STORE(p, v) __builtin_nontemporal_store((v), (p))
#else
#define NT_STORE(p, v) (*(p) = (v))
#endif
#ifndef WT_STORES
#define WT_STORES 0
#endif
#if WT_STORES
#define RSRC(ptr, bytes) __builtin_amdgcn_make_buffer_rsrc((void*)(ptr), (short)0, (int)(bytes), 0x00020000)
#define ST16(rs, base, elt_off, v) __builtin_amdgcn_raw_buffer_store_b128((v), (rs), (unsigned)((elt_off) * sizeof(*(base))), 0, 16)
#else
#define RSRC(ptr, bytes) 0
#define ST16(rs, base, elt_off, v) (*(u32x4*)((base) + (elt_off)) = (v))
#endif
#define EPI_LANE() const int lane_ = (int)__builtin_amdgcn_mbcnt_hi(~0u, __builtin_amdgcn_mbcnt_lo(~0u, 0u)); const int wr = wid >> 2, wc = wid & 3, fr = lane_ & 15, fq = lane_ >> 4, tid = wid * 64 + lane_; (void)wr; (void)wc; (void)fr; (void)fq; (void)tid
__device__ __forceinline__ void row_rstd8(const float* ss, int rbase, int lane, int fr, float (&rs)[8]) {
    const float a = row_rstd(ss, rbase + lane), b = row_rstd(ss, rbase + 128 + lane);
#pragma unroll
    for (int m = 0; m < 4; ++m) { rs[m] = __shfl(a, m * 16 + fr); rs[4 + m] = __shfl(b, m * 16 + fr); }
}
enum { K_IN = 0, K_GATE = 1, K_BRANCH = 2, K_RES = 3, K_GU = 4 };

__device__ __forceinline__ void rot1(float& a, float& b, float rev) {
    const float fr_ = rev - floorf(rev), c = __builtin_amdgcn_cosf(fr_), s = __builtin_amdgcn_sinf(fr_);
    const float na = a * c - b * s, nb = b * c + a * s; a = na; b = nb;
}
__device__ __forceinline__ f32x4 rot4(f32x4 v, f32x4 t) { return (f32x4){v[0] * t[0] - v[1] * t[1], v[1] * t[0] + v[0] * t[1], v[2] * t[2] - v[3] * t[3], v[3] * t[2] + v[2] * t[3]}; }

struct EpiIn {
    static constexpr bool HAS_HOOK = false;
    __device__ __forceinline__ bool dbl(const Unit&) const { return (DBL_EPI & 1) != 0; }
    bf16_t* P; const float* ss;
    __device__ __forceinline__ void operator()(f32x4 (&acc)[2][2][4][2], const Unit& u, int wid, const bool zacc) const {
        EPI_LANE();
        const int pn = u.pn;
        const auto rsP = RSRC(P, (size_t)M * PW * 2); (void)rsP;
        const int cw = wc * 64 + 8 * fq;
        float ivA[4], ivR[4];
#pragma unroll
        for (int j = 0; j < 4; ++j) { ivA[j] = __builtin_amdgcn_exp2f(-(float)(4 * (fq & 1) + j) * (18.931568569324174f / 8.f)) * 0.15915494309189535f;
                                      ivR[j] = __builtin_amdgcn_exp2f(-(float)(4 * fq + j) * (13.287712379549449f / 32.f)) * 0.15915494309189535f; }
        float rs8[8];
        row_rstd8(ss, u.pm * 256 + wr * 64, lane_, fr, rs8);
#pragma unroll
        for (int ai = 0; ai < 2; ++ai)
#pragma unroll
            for (int m = 0; m < 4; ++m) {
                const int row = u.pm * 256 + ai * 128 + wr * 64 + m * 16 + fr;
                const float rstd = rs8[ai * 4 + m];
                const float fpos = (float)(row & (SEQ - 1));
#pragma unroll
                for (int bj = 0; bj < 2; ++bj) {
                    f32x4 v0 = acc[ai][bj][m][0] * rstd, v1 = acc[ai][bj][m][1] * rstd;
                    const int gc = pn * 256 + bj * 32 + cw;
                    if (pn >= 11) {
                        if (bj == 0) { const f32x4 x0 = acc[ai][1][m][0] * rstd, x1 = acc[ai][1][m][1] * rstd;
                            u32x4 w; w.x = pk2(v0[0] * x0[0], v0[1] * x0[1]); w.y = pk2(v0[2] * x0[2], v0[3] * x0[3]); w.z = pk2(v1[0] * x1[0], v1[1] * x1[1]); w.w = pk2(v1[2] * x1[2], v1[3] * x1[3]);
                            ST16(rsP, P, (size_t)row * PW + 2816 + (pn - 11) * 128 + wc * 32 + 8 * fq, w); }
                    } else {
                        if (pn < 2 || (pn == 2 && wc < 2)) {
                            if (bj == 0 && fq < 2) {
                                float x[8] = {v0[0], v0[1], v0[2], v0[3], v1[0], v1[1], v1[2], v1[3]};
#pragma unroll
                                for (int j = 0; j < 4; ++j) rot1(x[2 * j], x[2 * j + 1], fpos * ivA[j]);
                                v0 = (f32x4){x[0], x[1], x[2], x[3]}; v1 = (f32x4){x[4], x[5], x[6], x[7]};
                            }
                            if (pn < 2) { v0 = v0 * QSCALE; v1 = v1 * QSCALE; }
                        } else if (pn == 3 || pn == 4) {
                            float x[8] = {v0[0], v0[1], v0[2], v0[3], v1[0], v1[1], v1[2], v1[3]};
#pragma unroll
                            for (int j = 0; j < 4; ++j) rot1(x[2 * j], x[2 * j + 1], fpos * (bj ? ivR[j] * 0.01f : ivR[j]));
                            v0 = (f32x4){x[0], x[1], x[2], x[3]}; v1 = (f32x4){x[4], x[5], x[6], x[7]};
                            if (pn == 4) { v0 = v0 * 0.125f; v1 = v1 * 0.125f; }
                        } else if (pn == 7 || pn == 8) {
#pragma unroll
                            for (int j = 0; j < 4; ++j) { v0[j] = fsilu(v0[j]); v1[j] = fsilu(v1[j]); }
                        }
                        u32x4 w; w.x = pk2(v0[0], v0[1]); w.y = pk2(v0[2], v0[3]); w.z = pk2(v1[0], v1[1]); w.w = pk2(v1[2], v1[3]);
                        ST16(rsP, P, (size_t)row * PW + gc, w);
                    }
                    if (zacc) { acc[ai][bj][m][0] = (f32x4){0.f, 0.f, 0.f, 0.f}; acc[ai][bj][m][1] = (f32x4){0.f, 0.f, 0.f, 0.f}; }
                }
                asm volatile("" ::: "memory");
            }
    }
};

struct EpiC {
    static constexpr bool HAS_HOOK = true;
    __device__ __forceinline__ bool dbl(const Unit&) const { return false; }
    const float* ss; const float* bg; u32x4* G0; u32x4* G12; bf16_t* mb;
    __device__ __forceinline__ u32x4* gbuf(int br) const { return br == 0 ? G0 : G12 + (size_t)(br - 1) * 8192; }
    __device__ __forceinline__ void hook(f32x4 (&acc)[2][2][4][2], const Unit& u, int t, int wid) const {
        if (u.kind != K_BRANCH || (t != 8 && t != 16)) return;
        EPI_LANE();
        const int br = (t >> 3) - 1;
        const u32x4* Ga = gbuf(br); const u32x4* Gb = gbuf(br + 1);
#pragma unroll
        for (int ai = 0; ai < 2; ++ai) {
            u32x4 ga[8], gb[8];
#pragma unroll
            for (int q = 0; q < 8; ++q) { ga[q] = Ga[(unsigned)((ai * 8 + q) * 512 + tid)]; gb[q] = Gb[(unsigned)((ai * 8 + q) * 512 + tid)]; }
            asm volatile("" ::: "memory");
#pragma unroll
            for (int m = 0; m < 4; ++m)
#pragma unroll
                for (int bj = 0; bj < 2; ++bj) {
                    const u32x4 a_ = ga[m * 2 + bj], b_ = gb[m * 2 + bj];
                    f32x4 d0 = (f32x4){bflo(b_.x), bfhi(b_.x), bflo(b_.y), bfhi(b_.y)}, d1 = (f32x4){bflo(b_.z), bfhi(b_.z), bflo(b_.w), bfhi(b_.w)};
#pragma unroll
                    for (int j = 0; j < 4; ++j) { d0[j] = __builtin_amdgcn_rcpf(fmaxf(d0[j], 1e-30f)); d1[j] = __builtin_amdgcn_rcpf(fmaxf(d1[j], 1e-30f)); }
                    acc[ai][bj][m][0] = acc[ai][bj][m][0] * ((f32x4){bflo(a_.x), bfhi(a_.x), bflo(a_.y), bfhi(a_.y)} * d0);
                    acc[ai][bj][m][1] = acc[ai][bj][m][1] * ((f32x4){bflo(a_.z), bfhi(a_.z), bflo(a_.w), bfhi(a_.w)} * d1);
                }
            asm volatile("" ::: "memory");
        }
    }
    __device__ __forceinline__ void operator()(f32x4 (&acc)[2][2][4][2], const Unit& u, int wid, const bool zacc) const {
        EPI_LANE();
        const int cw = u.pn * 256 + wc * 64 + 8 * fq;
        if (EPIC_TEST(u.kind == K_GATE)) {
            const int br = u.aux;
            const float* b = bg + br * DM + cw; u32x4* Gw = gbuf(br);
            float rs8[8];
            row_rstd8(ss, u.pm * 256 + wr * 64, lane_, fr, rs8);
            const f32x4 bv00 = *(const f32x4*)(b), bv01 = *(const f32x4*)(b + 4), bv10 = *(const f32x4*)(b + 32), bv11 = *(const f32x4*)(b + 36);
            asm volatile("" ::: "memory");
#pragma unroll
            for (int ai = 0; ai < 2; ++ai)
#pragma unroll
                for (int m = 0; m < 4; ++m) {
                    const float rstd = rs8[ai * 4 + m];
#pragma unroll
                    for (int bj = 0; bj < 2; ++bj) {
                        f32x4 v0 = acc[ai][bj][m][0] * rstd + (bj ? bv10 : bv00), v1 = acc[ai][bj][m][1] * rstd + (bj ? bv11 : bv01);
#pragma unroll
                        for (int j = 0; j < 4; ++j) { v0[j] = fsigm(v0[j]); v1[j] = fsigm(v1[j]); }
                        u32x4 w; w.x = pk2(v0[0], v0[1]); w.y = pk2(v0[2], v0[3]); w.z = pk2(v1[0], v1[1]); w.w = pk2(v1[2], v1[3]);
                        Gw[(unsigned)(((ai * 4 + m) * 2 + bj) * 512 + tid)] = w;
                        if (zacc) { acc[ai][bj][m][0] = (f32x4){0.f, 0.f, 0.f, 0.f}; acc[ai][bj][m][1] = (f32x4){0.f, 0.f, 0.f, 0.f}; }
                    }
                    asm volatile("" ::: "memory");
                }
        } else {
            const u32x4* Ga = gbuf(2);
            const auto rsM = RSRC(mb, (size_t)M * DM * 2); (void)rsM;
#pragma unroll
            for (int ai = 0; ai < 2; ++ai) {
                u32x4 gg[8];
#pragma unroll
                for (int q = 0; q < 8; ++q) gg[q] = Ga[(unsigned)((ai * 8 + q) * 512 + tid)];
                asm volatile("" ::: "memory");
#pragma unroll
                for (int m = 0; m < 4; ++m) {
                    const int row = u.pm * 256 + ai * 128 + wr * 64 + m * 16 + fr;
#pragma unroll
                    for (int bj = 0; bj < 2; ++bj) {
                        const u32x4 g = gg[m * 2 + bj];
                        const f32x4 v0 = acc[ai][bj][m][0] * (f32x4){bflo(g.x), bfhi(g.x), bflo(g.y), bfhi(g.y)};
                        const f32x4 v1 = acc[ai][bj][m][1] * (f32x4){bflo(g.z), bfhi(g.z), bflo(g.w), bfhi(g.w)};
                        u32x4 w; w.x = pk2(v0[0], v0[1]); w.y = pk2(v0[2], v0[3]); w.z = pk2(v1[0], v1[1]); w.w = pk2(v1[2], v1[3]);
                        ST16(rsM, mb, (size_t)row * DM + bj * 32 + cw, w);
                        if (zacc) { acc[ai][bj][m][0] = (f32x4){0.f, 0.f, 0.f, 0.f}; acc[ai][bj][m][1] = (f32x4){0.f, 0.f, 0.f, 0.f}; }
                    }
                }
                asm volatile("" ::: "memory");
            }
        }
    }
};

struct EpiRes {
    static constexpr bool HAS_HOOK = false;
    __device__ __forceinline__ bool dbl(const Unit&) const { return (DBL_EPI & 4) != 0 && rin != H; }
    const float* rin; float* H; bf16_t* hb; float* ssout; int mode; bf16_t* hbd;
    __device__ __forceinline__ void operator()(f32x4 (&acc)[2][2][4][2], const Unit& u, int wid, const bool zacc) const {
        EPI_LANE();
        const int cw = u.pn * 256 + wc * 64 + 8 * fq;
        const auto rsH = RSRC(hb, (size_t)M * XW * 2); (void)rsH;
        if (mode & 1) {
            u32x4 rr[8][2];
#pragma unroll
            for (int q = 0; q < 8; ++q)
#pragma unroll
                for (int bj = 0; bj < 2; ++bj) rr[q][bj] = *(const u32x4*)(hb + (size_t)(u.pm * 256 + (q >> 2) * 128 + wr * 64 + (q & 3) * 16 + fr) * XW + bj * 32 + cw);
            asm volatile("" ::: "memory");
#pragma unroll
            for (int ai = 0; ai < 2; ++ai)
#pragma unroll
                for (int m = 0; m < 4; ++m) {
                    const int row = u.pm * 256 + ai * 128 + wr * 64 + m * 16 + fr;
                    float s = 0.f;
#pragma unroll
                    for (int bj = 0; bj < 2; ++bj) {
                        const size_t o = (size_t)row * DM + bj * 32 + cw;
                        const u32x4 w = rr[ai * 4 + m][bj];
                        const f32x4 v0 = acc[ai][bj][m][0] + (f32x4){bflo(w.x), bfhi(w.x), bflo(w.y), bfhi(w.y)}, v1 = acc[ai][bj][m][1] + (f32x4){bflo(w.z), bfhi(w.z), bflo(w.w), bfhi(w.w)};
                        if (mode & 2) { *(f32x4*)(H + o) = v0; *(f32x4*)(H + o + 4) = v1; }
                        u32x4 wo; wo.x = pk2(v0[0], v0[1]); wo.y = pk2(v0[2], v0[3]); wo.z = pk2(v1[0], v1[1]); wo.w = pk2(v1[2], v1[3]);
                        ST16(rsH, hb, (size_t)row * XW + bj * 32 + cw, wo);
                        if (hbd) *(u32x4*)(hbd + (size_t)row * DM + bj * 32 + cw) = wo;
                        s += (v0[0] * v0[0] + v0[1] * v0[1]) + (v0[2] * v0[2] + v0[3] * v0[3]) + (v1[0] * v1[0] + v1[1] * v1[1]) + (v1[2] * v1[2] + v1[3] * v1[3]);
                        if (zacc) { acc[ai][bj][m][0] = (f32x4){0.f, 0.f, 0.f, 0.f}; acc[ai][bj][m][1] = (f32x4){0.f, 0.f, 0.f, 0.f}; }
                    }
                    s += __shfl_xor(s, 16); s += __shfl_xor(s, 32);
                    if (fq == 0) ssout[(size_t)row * 16 + u.pn * 4 + wc] = s;
                }
            return;
        }
#pragma unroll
        for (int ai = 0; ai < 2; ++ai) {
            f32x4 rr[4][2][2];
#pragma unroll
            for (int m = 0; m < 4; ++m)
#pragma unroll
                for (int bj = 0; bj < 2; ++bj) { const float* rp = rin + (size_t)(u.pm * 256 + ai * 128 + wr * 64 + m * 16 + fr) * DM + bj * 32 + cw; rr[m][bj][0] = *(const f32x4*)rp; rr[m][bj][1] = *(const f32x4*)(rp + 4); }
            asm volatile("" ::: "memory");
#pragma unroll
            for (int m = 0; m < 4; ++m) {
                const int row = u.pm * 256 + ai * 128 + wr * 64 + m * 16 + fr;
                float s = 0.f;
#pragma unroll
                for (int bj = 0; bj < 2; ++bj) {
                    const size_t o = (size_t)row * DM + bj * 32 + cw;
                    const f32x4 v0 = acc[ai][bj][m][0] + rr[m][bj][0], v1 = acc[ai][bj][m][1] + rr[m][bj][1];
                    if (mode & 2) { *(f32x4*)(H + o) = v0; *(f32x4*)(H + o + 4) = v1; }
                    u32x4 w; w.x = pk2(v0[0], v0[1]); w.y = pk2(v0[2], v0[3]); w.z = pk2(v1[0], v1[1]); w.w = pk2(v1[2], v1[3]);
                    ST16(rsH, hb, (size_t)row * XW + bj * 32 + cw, w);
                    if (hbd) *(u32x4*)(hbd + (size_t)row * DM + bj * 32 + cw) = w;
                    s += (v0[0] * v0[0] + v0[1] * v0[1]) + (v0[2] * v0[2] + v0[3] * v0[3]) + (v1[0] * v1[0] + v1[1] * v1[1]) + (v1[2] * v1[2] + v1[3] * v1[3]);
                    if (zacc) { acc[ai][bj][m][0] = (f32x4){0.f, 0.f, 0.f, 0.f}; acc[ai][bj][m][1] = (f32x4){0.f, 0.f, 0.f, 0.f}; }
                }
                s += __shfl_xor(s, 16); s += __shfl_xor(s, 32);
                if (fq == 0) ssout[(size_t)row * 16 + u.pn * 4 + wc] = s;
            }
            asm volatile("" ::: "memory");
        }
    }
};

struct EpiGU {
    static constexpr bool HAS_HOOK = false;
    __device__ __forceinline__ bool dbl(const Unit&) const { return (DBL_EPI & 2) != 0; }
    const float* ss; bf16_t* ff;
    __device__ __forceinline__ void operator()(f32x4 (&acc)[2][2][4][2], const Unit& u, int wid, const bool zacc) const {
        EPI_LANE();
        const int cj = u.pn * 128 + wc * 32 + 8 * fq;
        const auto rsF = RSRC(ff, (size_t)M * DFF * 2); (void)rsF;
        float rs8[8];
        row_rstd8(ss, u.pm * 256 + wr * 64, lane_, fr, rs8);
        asm volatile("" ::: "memory");
#pragma unroll
        for (int ai = 0; ai < 2; ++ai)
#pragma unroll
            for (int m = 0; m < 4; ++m) {
                const int row = u.pm * 256 + ai * 128 + wr * 64 + m * 16 + fr;
                const float rstd = rs8[ai * 4 + m];
                const f32x4 g0 = acc[ai][0][m][0] * rstd, g1 = acc[ai][0][m][1] * rstd, u0 = acc[ai][1][m][0] * rstd, u1 = acc[ai][1][m][1] * rstd;
                u32x4 w; w.x = pk2(fsilu(g0[0]) * u0[0], fsilu(g0[1]) * u0[1]); w.y = pk2(fsilu(g0[2]) * u0[2], fsilu(g0[3]) * u0[3]);
                w.z = pk2(fsilu(g1[0]) * u1[0], fsilu(g1[1]) * u1[1]); w.w = pk2(fsilu(g1[2]) * u1[2], fsilu(g1[3]) * u1[3]);
                ST16(rsF, ff, (size_t)row * DFF + cj, w);
                if (zacc) {
#pragma unroll
                    for (int bj = 0; bj < 2; ++bj) { acc[ai][bj][m][0] = (f32x4){0.f, 0.f, 0.f, 0.f}; acc[ai][bj][m][1] = (f32x4){0.f, 0.f, 0.f, 0.f}; } }
            }
    }
};

struct SchedPlain {
    const char* A; const char* B; int lda, ldb, nt, nM, nN, G, c, kind, pm0;
    __device__ __forceinline__ bool next(int i, Unit& u) const {
        const int L = i * G + c; if (L >= nM * nN) return false;
        tile_of(L, nM, nN, u.pm, u.pn); u.pm += pm0;
        u.A = A + (size_t)u.pm * 256 * lda * 2; u.B = B + (size_t)u.pn * 256 * ldb * 2; u.nt = nt; u.kind = kind; u.aux = 0; return true;
    }
};
struct SchedC {
    const char* X; const char* Wg; const char* Wb; int nM, G, c, pm0;
    __device__ __forceinline__ bool next(int i, Unit& u) const {
        const int j = i >> 2, sub = i & 3, L = j * G + c; if (L >= nM * 4) return false;
        tile_of(L, nM, 4, u.pm, u.pn); u.pm += pm0;
        const bool gate = sub < 3;
        u.A = X + (size_t)u.pm * 256 * XW * 2 + (gate ? 0 : 1024 * 2);
        u.B = gate ? Wg + (size_t)sub * (1024 * KC * 2) + (size_t)u.pn * 256 * KC * 2 : Wb + (size_t)u.pn * 256 * KC * 2;
        u.nt = gate ? 16 : 24; u.kind = gate ? K_GATE : K_BRANCH; u.aux = sub; return true;
    }
};
}
__device__ const double INV_A[8] = {0.15915494309189535, 0.03086376340470123, 0.005985185712713705, 0.001160663641240061, 0.00022507907903927653, 4.364795279280289e-05, 8.464330808241401e-06, 1.6414262627950345e-06};
__device__ const double INV_R[32] = {0.15915494309189535, 0.11934937021124886, 0.08949940160889101, 0.06711508300522726, 0.050329212104487035, 0.03774158471741977, 0.0283021958306234, 0.02122365276477766,
    0.015915494309189534, 0.011934937021124886, 0.008949940160889102, 0.006711508300522725, 0.005032921210448704, 0.003774158471741977, 0.00283021958306234, 0.0021223652764777662,
    0.0015915494309189536, 0.0011934937021124885, 0.0008949940160889102, 0.0006711508300522726, 0.0005032921210448703, 0.00037741584717419774, 0.00028302195830623395, 0.0002122365276477766,
    0.00015915494309189535, 0.00011934937021124886, 8.949940160889102e-05, 6.711508300522725e-05, 5.0329212104487035e-05, 3.774158471741978e-05, 2.8302195830623396e-05, 2.122365276477766e-05};
__device__ __forceinline__ float lg_gamma(int h) { return h == 0 ? -0.04580368961312479f : h == 1 ? -0.02272007650008353f : h == 2 ? -0.011315313227834146f : -0.005646563141142062f; }
__device__ __forceinline__ float ex2(float x) { return __builtin_amdgcn_exp2f(x); }
__device__ __forceinline__ float wave_sum(float v) {
#pragma unroll
    for (int o = 1; o < 64; o <<= 1) v += __shfl_xor(v, o);
    return v;
}
#define LDS_WAIT() asm volatile("s_waitcnt lgkmcnt(0)" ::: "memory")

__device__ __forceinline__ int dst_in(int s) {
    if (s < 640) { const int p = s & 63; return (p < 16) ? (s & ~63) + ((p < 8) ? 2 * p : 2 * (p - 8) + 1) : s; }
    if (s < 768) return s;
    if (s < 1280) { const int p = s & 63; return (s & ~63) + ((p < 32) ? 2 * p : 2 * (p - 32) + 1); }
    if (s < 2816) return s;
    { const int j = (s < 3328) ? s - 2816 : s - 3328; return 2816 + (j >> 5) * 64 + ((s < 3328) ? 0 : 32) + (j & 31); }
}
struct CvDesc { const float* W; size_t ldw; const float* scale; bf16_t* dst; int c0, ld, k0, mode, rmul, radd; };
constexpr int CV_J0 = 3456, CV_J2 = 768, CV_J3 = 512, CV_J4 = 2816, CV_J5 = 1408, CV_PER_LAYER = CV_J0 + CV_J2 + CV_J3 + CV_J4 + CV_J5;
__device__ __forceinline__ CvDesc cv_desc(const Args& a, int it) {
    const int l = it / CV_PER_LAYER; int r = it - l * CV_PER_LAYER;
    bf16_t* Wl = (bf16_t*)(a.ws + WS_W + (size_t)l * WL_SIZE);
    if (r < CV_J0) { const int kb = r / 216, cb = r % 216;
        if (cb < 120) return CvDesc{a.w_in + (size_t)l * DM * DIN, DIN, a.norm_mix + l * DM, Wl + WL_IN / 2, cb * 32, DM, kb * 64, 1, 1, 0};
        return CvDesc{a.w_in + (size_t)l * DM * DIN, DIN, a.norm_mix + l * DM, Wl + WL_C / 2, cb * 32, KC, kb * 64, 0, 1, -3840}; }
    r -= CV_J0;
    if (r < CV_J2) { const int i = r >> 8, kb = (r >> 5) & 7, cb = r & 31;
        return CvDesc{a.w_branch + (size_t)(l * 3 + i) * 512 * DM, DM, nullptr, Wl + WL_B / 2 + i * 512, cb * 32, KC, kb * 64, 0, 1, 0}; }
    r -= CV_J2;
    if (r < CV_J3) { const int kb = r >> 5, cb = r & 31; return CvDesc{a.w_out + (size_t)l * DM * DM, DM, nullptr, Wl + WL_OUT / 2, cb * 32, DM, kb * 64, 0, 1, 0}; }
    r -= CV_J3;
    if (r < CV_J4) { const int up = r / 1408, q = r % 1408, kb = q / 88, cb = q % 88;
        return CvDesc{(up ? a.w_u : a.w_g) + (size_t)l * DM * DFF, DFF, a.norm_ffn + l * DM, Wl + WL_GU / 2, cb * 32, DM, kb * 64, 2, 1, up * 32}; }
    r -= CV_J4;
    { const int kb = r >> 5, cb = r & 31; return CvDesc{a.w_d + (size_t)l * DFF * DM, DM, nullptr, Wl + WL_D / 2, cb * 32, DFF, kb * 64, 0, 1, 0}; }
}
__device__ __forceinline__ void cv_load(const CvDesc& d, int lane, f32x4 (&v)[8], float (&sc)[8]) {
    const int kr = lane >> 3, c4 = lane & 7;
#pragma unroll
    for (int i = 0; i < 8; ++i) { v[i] = *(const f32x4*)(d.W + (size_t)(d.k0 + 8 * i + kr) * d.ldw + d.c0 + 4 * c4); sc[i] = d.scale ? d.scale[d.k0 + 8 * i + kr] : 1.f; }
}
__device__ __forceinline__ void cv_finish(const CvDesc& d, int lane, const f32x4 (&v)[8], const float (&sc)[8], LAS float* scr) {
    const int kr = lane >> 3, c4 = lane & 7;
#pragma unroll
    for (int i = 0; i < 8; ++i) { LAS float* p = scr + (8 * i + kr) * 33 + 4 * c4; p[0] = v[i][0] * sc[i]; p[1] = v[i][1] * sc[i]; p[2] = v[i][2] * sc[i]; p[3] = v[i][3] * sc[i]; }
    LDS_WAIT(); asm volatile("" ::: "memory");
    const int c = lane & 7;
#pragma unroll
    for (int j = 0; j < 4; ++j) { const int n = (lane >> 3) + 8 * j; const LAS float* s = scr + (8 * c) * 33 + n;
        u32x4 o; o.x = pk2(s[0 * 33], s[1 * 33]); o.y = pk2(s[2 * 33], s[3 * 33]); o.z = pk2(s[4 * 33], s[5 * 33]); o.w = pk2(s[6 * 33], s[7 * 33]);
        const int cc = d.c0 + n, row = (d.mode == 2) ? ((cc >> 5) * 64 + d.radd + (cc & 31)) : (d.mode ? dst_in(cc) : cc) * d.rmul + d.radd;
        *(u32x4*)(d.dst + (size_t)row * d.ld + d.k0 + 8 * c) = o; }
    LDS_WAIT(); asm volatile("" ::: "memory");
}
__device__ __forceinline__ void phase_prologue(const Args& a, LAS unsigned char* lds, int G, const int tid) {
    const int lane = tid & 63, wave = tid >> 6;
    const int gw = blockIdx.x * 8 + wave, NGW = G * 8;
    LAS float* scr = (LAS float*)(lds + wave * 16384);
    constexpr int NIT = DEPTH * CV_PER_LAYER;
    if (gw < NIT) {
        CvDesc cur = cv_desc(a, gw); f32x4 v[8]; float sc[8];
        cv_load(cur, lane, v, sc);
        for (int it = gw; it < NIT; it += NGW) {
            const bool more = it + NGW < NIT;
            CvDesc nxt = cv_desc(a, more ? it + NGW : it); f32x4 vn[8]; float scn[8];
            if (more) cv_load(nxt, lane, vn, scn);
            cv_finish(cur, lane, v, sc, scr);
            if (more) { cur = nxt;
#pragma unroll
                for (int i = 0; i < 8; ++i) { v[i] = vn[i]; sc[i] = scn[i]; } }
        }
    }
    bf16_t* X = (bf16_t*)(a.ws + WS_X); float* ss = (float*)(a.ws + WS_SS);
    for (int row = gw; row < M; row += NGW) {
        const f32x4* xr = (const f32x4*)(a.x + (size_t)row * DM) + lane; float s = 0.f;
#pragma unroll
        for (int j = 0; j < 4; ++j) { const f32x4 v = xr[64 * j]; s += (v[0] * v[0] + v[1] * v[1]) + (v[2] * v[2] + v[3] * v[3]);
            u32x2 w; w.x = pk2(v[0], v[1]); w.y = pk2(v[2], v[3]); *(u32x2*)(X + (size_t)row * XW + (64 * j + lane) * 4) = w; }
        s = wave_sum(s); if (lane < 16) ss[(size_t)row * 16 + lane] = (lane == 0) ? s : 0.f;
    }
}

__device__ __forceinline__ void attn_naive(LAS unsigned char* lds, const bf16_t* P, bf16_t* X, const float* sinks, int unit, const int tid) {
    const int b = unit >> 5, n = (unit >> 1) & 15, g = unit & 1;
    LAS bf16_t* Ks = (LAS bf16_t*)lds; LAS bf16_t* Vs = Ks + 256 * 72;
    const long row0 = (long)b * SEQ + n * 128 - 128;
    for (int c = tid; c < 2048; c += 512) {
        const int key = c >> 3, ch = c & 7; u32x4 kv = {0u, 0u, 0u, 0u}, vv = {0u, 0u, 0u, 0u};
        if (n > 0 || key >= 128) { const bf16_t* src = P + (size_t)(row0 + key) * PW + g * 64 + ch * 8; kv = *(const u32x4*)(src + 512); vv = *(const u32x4*)(src + 640); }
        *(LAS u32x4*)(Ks + key * 72 + ch * 8) = kv; *(LAS u32x4*)(Vs + key * 72 + ch * 8) = vv;
    }
    __syncthreads();
    const int r = tid & 127, hq = g * 4 + (tid >> 7);
    const size_t qrow = (size_t)b * SEQ + n * 128 + r;
    float q[64], o[64];
    { const u32x4* qp = (const u32x4*)(P + qrow * PW + hq * 64);
#pragma unroll
      for (int c = 0; c < 8; ++c) { const u32x4 w = qp[c]; q[8 * c] = bflo(w.x); q[8 * c + 1] = bfhi(w.x); q[8 * c + 2] = bflo(w.y); q[8 * c + 3] = bfhi(w.y); q[8 * c + 4] = bflo(w.z); q[8 * c + 5] = bfhi(w.z); q[8 * c + 6] = bflo(w.w); q[8 * c + 7] = bfhi(w.w); } }
#pragma unroll
    for (int d = 0; d < 64; ++d) o[d] = 0.f;
    float mx = sinks[hq] * LOG2E, l = 1.f;
    for (int j = 0; j < 128; ++j) {
        const int kt = r + 1 + j; const bool valid = (n > 0) || (kt >= 128);
        const LAS u32x4* kp = (const LAS u32x4*)(Ks + kt * 72);
        float s = 0.f;
#pragma unroll
        for (int c = 0; c < 8; ++c) { const u32x4 w = kp[c];
            s += q[8 * c] * bflo(w.x) + q[8 * c + 1] * bfhi(w.x) + q[8 * c + 2] * bflo(w.y) + q[8 * c + 3] * bfhi(w.y) + q[8 * c + 4] * bflo(w.z) + q[8 * c + 5] * bfhi(w.z) + q[8 * c + 6] * bflo(w.w) + q[8 * c + 7] * bfhi(w.w); }
        s = valid ? s : -INFINITY;
        const float mn = fmaxf(mx, s), sc = ex2(mx - mn), p = ex2(s - mn);
        l = l * sc + p; mx = mn;
        const LAS u32x4* vp = (const LAS u32x4*)(Vs + kt * 72);
#pragma unroll
        for (int c = 0; c < 8; ++c) { const u32x4 w = vp[c];
            o[8 * c] = o[8 * c] * sc + p * bflo(w.x); o[8 * c + 1] = o[8 * c + 1] * sc + p * bfhi(w.x); o[8 * c + 2] = o[8 * c + 2] * sc + p * bflo(w.y); o[8 * c + 3] = o[8 * c + 3] * sc + p * bfhi(w.y);
            o[8 * c + 4] = o[8 * c + 4] * sc + p * bflo(w.z); o[8 * c + 5] = o[8 * c + 5] * sc + p * bfhi(w.z); o[8 * c + 6] = o[8 * c + 6] * sc + p * bflo(w.w); o[8 * c + 7] = o[8 * c + 7] * sc + p * bfhi(w.w); }
    }
    const float il = 1.f / l;
    u32x4* op = (u32x4*)(X + qrow * XW + 1024 + hq * 64);
#pragma unroll
    for (int c = 0; c < 8; ++c) { u32x4 w; w.x = pk2(o[8 * c] * il, o[8 * c + 1] * il); w.y = pk2(o[8 * c + 2] * il, o[8 * c + 3] * il); w.z = pk2(o[8 * c + 4] * il, o[8 * c + 5] * il); w.w = pk2(o[8 * c + 6] * il, o[8 * c + 7] * il); op[c] = w; }
    __syncthreads();
}

__device__ __forceinline__ void kv_naive(LAS unsigned char* lds, const bf16_t* P, float* kv, int unit, const int tid) {
    const int b = unit >> 6, h = (unit >> 4) & 3, n = unit & 15;
    LAS float* kz = (LAS float*)lds; LAS float* vs = kz + 128 * 64;
    const size_t rowc = (size_t)b * SEQ + n * 128; const float lg = lg_gamma(h);
    for (int i = tid; i < 128 * 8; i += 512) { const int tok = i >> 3, ch = i & 7; const u32x4 w = *(const u32x4*)(P + (rowc + tok) * PW + 1024 + h * 64 + ch * 8); const float z = ex2((float)(127 - tok) * lg);
        LAS float* d = kz + tok * 64 + ch * 8; d[0] = bflo(w.x) * z; d[1] = bfhi(w.x) * z; d[2] = bflo(w.y) * z; d[3] = bfhi(w.y) * z; d[4] = bflo(w.z) * z; d[5] = bfhi(w.z) * z; d[6] = bflo(w.w) * z; d[7] = bfhi(w.w) * z; }
    for (int i = tid; i < 128 * 16; i += 512) { const int tok = i >> 4, ch = i & 15; const u32x4 w = *(const u32x4*)(P + (rowc + tok) * PW + 1280 + h * 128 + ch * 8);
        LAS float* d = vs + tok * 128 + ch * 8; d[0] = bflo(w.x); d[1] = bfhi(w.x); d[2] = bflo(w.y); d[3] = bfhi(w.y); d[4] = bflo(w.z); d[5] = bfhi(w.z); d[6] = bflo(w.w); d[7] = bfhi(w.w); }
    __syncthreads();
    const int e = tid & 127, d0 = (tid >> 7) * 16;
    float acc[16];
#pragma unroll
    for (int dd = 0; dd < 16; ++dd) acc[dd] = 0.f;
    for (int tok = 0; tok < 128; ++tok) { const float vv = vs[tok * 128 + e];
#pragma unroll
        for (int dd = 0; dd < 16; ++dd) acc[dd] += kz[tok * 64 + d0 + dd] * vv; }
#pragma unroll
    for (int dd = 0; dd < 16; ++dd) kv[((size_t)unit * 64 + d0 + dd) * 128 + e] = acc[dd];
    __syncthreads();
}

__device__ __forceinline__ void ret_naive(LAS unsigned char* lds, const bf16_t* P, const float* kv, bf16_t* X, int unit, const int tid) {
    const int b = unit >> 6, h = (unit >> 4) & 3, n = unit & 15;
    LAS float* St = (LAS float*)lds;
    LAS bf16_t* qs = (LAS bf16_t*)(lds + 32768);
    LAS bf16_t* ks = (LAS bf16_t*)(lds + 49152);
    LAS bf16_t* vs = (LAS bf16_t*)(lds + 65536);
    const size_t rowc = (size_t)b * SEQ + n * 128; const float lg = lg_gamma(h);
    { const int e = tid & 127, d0 = (tid >> 7) * 16; float s[16];
#pragma unroll
      for (int dd = 0; dd < 16; ++dd) s[dd] = 0.f;
      for (int j = 0; j < n; ++j) { const float w = ex2((float)((n - 1 - j) * 128) * lg); const float* kj = kv + ((size_t)(unit - n + j) * 64 + d0) * 128 + e;
#pragma unroll
          for (int dd = 0; dd < 16; ++dd) s[dd] += w * kj[dd * 128]; }
#pragma unroll
      for (int dd = 0; dd < 16; ++dd) St[(d0 + dd) * 128 + e] = s[dd]; }
    for (int i = tid; i < 128 * 8; i += 512) { const int tok = i >> 3, ch = i & 7; const bf16_t* src = P + (rowc + tok) * PW + h * 64 + ch * 8;
        *(LAS u32x4*)(qs + tok * 64 + ch * 8) = *(const u32x4*)(src + 768); *(LAS u32x4*)(ks + tok * 64 + ch * 8) = *(const u32x4*)(src + 1024); }
    for (int i = tid; i < 128 * 16; i += 512) { const int tok = i >> 4, ch = i & 15; *(LAS u32x4*)(vs + tok * 128 + ch * 8) = *(const u32x4*)(P + (rowc + tok) * PW + 1280 + h * 128 + ch * 8); }
    __syncthreads();
    const int r = tid >> 2, e0 = (tid & 3) * 32;
    float q[64], y[32];
    { const LAS u32x4* qp = (const LAS u32x4*)(qs + r * 64);
#pragma unroll
      for (int c = 0; c < 8; ++c) { const u32x4 w = qp[c]; q[8 * c] = bflo(w.x); q[8 * c + 1] = bfhi(w.x); q[8 * c + 2] = bflo(w.y); q[8 * c + 3] = bfhi(w.y); q[8 * c + 4] = bflo(w.z); q[8 * c + 5] = bfhi(w.z); q[8 * c + 6] = bflo(w.w); q[8 * c + 7] = bfhi(w.w); } }
#pragma unroll
    for (int ee = 0; ee < 32; ++ee) y[ee] = 0.f;
#pragma unroll 2
    for (int d = 0; d < 64; ++d) { const float qd = bf2f(qs[r * 64 + d]); const LAS f32x4* sp = (const LAS f32x4*)(St + d * 128 + e0);
#pragma unroll
        for (int c = 0; c < 8; ++c) { const f32x4 sv = sp[c]; y[4 * c] += qd * sv[0]; y[4 * c + 1] += qd * sv[1]; y[4 * c + 2] += qd * sv[2]; y[4 * c + 3] += qd * sv[3]; } }
    { const float xi = ex2((float)(r + 1) * lg);
#pragma unroll
      for (int ee = 0; ee < 32; ++ee) y[ee] *= xi; }
    const int rmax = (tid | 63) >> 2;
    for (int kk = 0; kk <= rmax; ++kk) {
        const LAS u32x4* kp = (const LAS u32x4*)(ks + kk * 64);
        float s = 0.f;
#pragma unroll
        for (int c = 0; c < 8; ++c) { const u32x4 w = kp[c];
            s += q[8 * c] * bflo(w.x) + q[8 * c + 1] * bfhi(w.x) + q[8 * c + 2] * bflo(w.y) + q[8 * c + 3] * bfhi(w.y) + q[8 * c + 4] * bflo(w.z) + q[8 * c + 5] * bfhi(w.z) + q[8 * c + 6] * bflo(w.w) + q[8 * c + 7] * bfhi(w.w); }
        const float aw = (kk <= r) ? s * ex2((float)(r - kk) * lg) : 0.f;
        const LAS u32x4* vp = (const LAS u32x4*)(vs + kk * 128 + e0);
#pragma unroll
        for (int c = 0; c < 4; ++c) { const u32x4 w = vp[c];
            y[8 * c] += aw * bflo(w.x); y[8 * c + 1] += aw * bfhi(w.x); y[8 * c + 2] += aw * bflo(w.y); y[8 * c + 3] += aw * bfhi(w.y); y[8 * c + 4] += aw * bflo(w.z); y[8 * c + 5] += aw * bfhi(w.z); y[8 * c + 6] += aw * bflo(w.w); y[8 * c + 7] += aw * bfhi(w.w); }
    }
    float sq = 0.f;
#pragma unroll
    for (int ee = 0; ee < 32; ++ee) sq += y[ee] * y[ee];
    sq += __shfl_xor(sq, 1); sq += __shfl_xor(sq, 2);
    const float rs = rsqrtf(sq * (1.f / 128.f) + EPS);
    const u32x4* gp = (const u32x4*)(P + (rowc + r) * PW + 1792 + h * 128 + e0);
    u32x4* op = (u32x4*)(X + (rowc + r) * XW + 1536 + h * 128 + e0);
#pragma unroll
    for (int c = 0; c < 4; ++c) { const u32x4 gw = gp[c]; u32x4 w;
        w.x = pk2(y[8 * c] * rs * bflo(gw.x), y[8 * c + 1] * rs * bfhi(gw.x)); w.y = pk2(y[8 * c + 2] * rs * bflo(gw.y), y[8 * c + 3] * rs * bfhi(gw.y));
        w.z = pk2(y[8 * c + 4] * rs * bflo(gw.z), y[8 * c + 5] * rs * bfhi(gw.z)); w.w = pk2(y[8 * c + 6] * rs * bflo(gw.w), y[8 * c + 7] * rs * bfhi(gw.w)); op[c] = w; }
    __syncthreads();
}

__device__ __forceinline__ void conv_all(const bf16_t* P, const float* cw, bf16_t* X, int G, int c, int row0, int nrows, const int tid) {
    const int gt = c * 512 + tid, NT = G * 512;
    for (int i = gt; i < nrows * 64; i += NT) {
        const int row = row0 + (i >> 6), ch = i & 63, t = row & (SEQ - 1);
        const bf16_t* p = P + (size_t)row * PW + ch * 8;
        const u32x4 cb = *(const u32x4*)(p + 2304), u0 = *(const u32x4*)(p + 2816);
        u32x4 u1 = {0u, 0u, 0u, 0u}, u2 = {0u, 0u, 0u, 0u};
        if (t >= 1) u1 = *(const u32x4*)(p + 2816 - PW);
        if (t >= 2) u2 = *(const u32x4*)(p + 2816 - 2 * PW);
        const f32x4 w0a = *(const f32x4*)(cw + ch * 8), w0b = *(const f32x4*)(cw + ch * 8 + 4), w1a = *(const f32x4*)(cw + 512 + ch * 8), w1b = *(const f32x4*)(cw + 512 + ch * 8 + 4),
                    w2a = *(const f32x4*)(cw + 1024 + ch * 8), w2b = *(const f32x4*)(cw + 1024 + ch * 8 + 4);
        u32x4 o;
        o.x = pk2(bflo(cb.x) * (w0a[0] * bflo(u2.x) + w1a[0] * bflo(u1.x) + w2a[0] * bflo(u0.x)), bfhi(cb.x) * (w0a[1] * bfhi(u2.x) + w1a[1] * bfhi(u1.x) + w2a[1] * bfhi(u0.x)));
        o.y = pk2(bflo(cb.y) * (w0a[2] * bflo(u2.y) + w1a[2] * bflo(u1.y) + w2a[2] * bflo(u0.y)), bfhi(cb.y) * (w0a[3] * bfhi(u2.y) + w1a[3] * bfhi(u1.y) + w2a[3] * bfhi(u0.y)));
        o.z = pk2(bflo(cb.z) * (w0b[0] * bflo(u2.z) + w1b[0] * bflo(u1.z) + w2b[0] * bflo(u0.z)), bfhi(cb.z) * (w0b[1] * bfhi(u2.z) + w1b[1] * bfhi(u1.z) + w2b[1] * bfhi(u0.z)));
        o.w = pk2(bflo(cb.w) * (w0b[2] * bflo(u2.w) + w1b[2] * bflo(u1.w) + w2b[2] * bflo(u0.w)), bfhi(cb.w) * (w0b[3] * bfhi(u2.w) + w1b[3] * bfhi(u1.w) + w2b[3] * bfhi(u0.w)));
        *(u32x4*)(X + (size_t)row * XW + 2048 + ch * 8) = o;
    }
}

__device__ __forceinline__ void final_norm(float* H, const float* ss, const float* g, int G, int c, int row0, int nrows, const int tid) {
    const int lane = tid & 63, gw = c * 8 + (tid >> 6), NGW = G * 8;
    const f32x4* gr = (const f32x4*)g + lane;
    f32x4 gv[4];
#pragma unroll
    for (int j = 0; j < 4; ++j) gv[j] = gr[64 * j];
    for (int row = row0 + gw; row < row0 + nrows; row += 2 * NGW) {
        f32x4* h0 = (f32x4*)(H + (size_t)row * DM) + lane; f32x4* h1 = (f32x4*)(H + (size_t)(row + NGW) * DM) + lane;
        f32x4 a0[4], a1[4];
#pragma unroll
        for (int j = 0; j < 4; ++j) { a0[j] = h0[64 * j]; a1[j] = h1[64 * j]; }
        const float r0 = pg8::row_rstd(ss, row), r1 = pg8::row_rstd(ss, row + NGW);
#pragma unroll
        for (int j = 0; j < 4; ++j) { h0[64 * j] = a0[j] * r0 * gv[j]; h1[64 * j] = a1[j] * r1 * gv[j]; }
    }
}
#ifndef RET_PROBE
#define RET_PROBE 0
#endif
typedef float f32x16 __attribute__((ext_vector_type(16)));
#define MFMA32(a, b, c) __builtin_amdgcn_mfma_f32_32x32x16_bf16((a), (b), (c), 0, 0, 0)
__device__ __forceinline__ int crow(int i, int hh) { return (i & 3) + 8 * (i >> 2) + 4 * hh; }
__device__ __forceinline__ bf16x8 pack8(const f32x16& v, int s) {
    u32x4 t; t.x = pk2(v[8 * s], v[8 * s + 1]); t.y = pk2(v[8 * s + 2], v[8 * s + 3]); t.z = pk2(v[8 * s + 4], v[8 * s + 5]); t.w = pk2(v[8 * s + 6], v[8 * s + 7]);
    return __builtin_bit_cast(bf16x8, t);
}
__device__ __forceinline__ bf16x8 join8(u32x2 a, u32x2 b) { u32x4 t = {a.x, a.y, b.x, b.y}; return __builtin_bit_cast(bf16x8, t); }
__device__ __forceinline__ void tr_store8(LAS unsigned* T32, int pitch32, int ch, int p, u32x4 w0, u32x4 w1) {
    LAS unsigned* t = T32 + (ch * 8) * pitch32 + (p ^ ((ch & 7) << 2));
    t[0 * pitch32] = (w0.x & 0xffffu) | (w1.x << 16); t[1 * pitch32] = (w0.x >> 16) | (w1.x & 0xffff0000u);
    t[2 * pitch32] = (w0.y & 0xffffu) | (w1.y << 16); t[3 * pitch32] = (w0.y >> 16) | (w1.y & 0xffff0000u);
    t[4 * pitch32] = (w0.z & 0xffffu) | (w1.z << 16); t[5 * pitch32] = (w0.z >> 16) | (w1.z & 0xffff0000u);
    t[6 * pitch32] = (w0.w & 0xffffu) | (w1.w << 16); t[7 * pitch32] = (w0.w >> 16) | (w1.w & 0xffff0000u);
}
__device__ __forceinline__ int tr_off(int c, int pitch32, int d) { return 2 * (c * pitch32 + (d ^ (((c >> 3) & 7) << 2))); }

__device__ __forceinline__ void attn_mfma(LAS unsigned char* lds, const bf16_t* P, bf16_t* X, const float* sinks, int unit, const int tid) {
    const int lane = tid & 63, wid = __builtin_amdgcn_readfirstlane(tid >> 6), r32 = lane & 31, hh = lane >> 5;
    const int b = unit >> 5, n = (unit >> 1) & 15, g = unit & 1;
    LAS bf16_t* Ks = (LAS bf16_t*)lds;
    LAS bf16_t* Vt = Ks + 256 * 72;
    const long row0 = (long)b * SEQ + n * 128 - 128;
    { u32x4 kv[4], w0[2], w1[2];
#pragma unroll
      for (int i = 0; i < 4; ++i) { const int c = tid + 512 * i, key = c >> 3, ch = c & 7; kv[i] = (u32x4){0u, 0u, 0u, 0u};
          if (n > 0 || key >= 128) kv[i] = *(const u32x4*)(P + (size_t)(row0 + key) * PW + 512 + g * 64 + ch * 8); }
#pragma unroll
      for (int i = 0; i < 2; ++i) { const int it = tid + 512 * i, kp = it >> 3, ch = it & 7; w0[i] = (u32x4){0u, 0u, 0u, 0u}; w1[i] = w0[i];
          if (n > 0 || kp >= 64) { const bf16_t* src = P + (size_t)(row0 + 2 * kp) * PW + 640 + g * 64 + ch * 8; w0[i] = *(const u32x4*)src; w1[i] = *(const u32x4*)(src + PW); } }
#pragma unroll
      for (int i = 0; i < 4; ++i) { const int c = tid + 512 * i, key = c >> 3, ch = c & 7; *(LAS u32x4*)(Ks + key * 72 + ch * 8) = kv[i]; }
#pragma unroll
      for (int i = 0; i < 2; ++i) { const int it = tid + 512 * i, kp = it >> 3, ch = it & 7; tr_store8((LAS unsigned*)Vt, 132, ch, kp, w0[i], w1[i]); } }
    const int hq = g * 4 + (wid >> 1);
    const float sink2 = sinks[hq] * LOG2E;
    bf16x8 qfa[2][4];
#pragma unroll
    for (int pass = 0; pass < 2; ++pass) { const bf16_t* qp = P + ((size_t)b * SEQ + n * 128 + (wid & 1) * 64 + pass * 32 + r32) * PW + hq * 64 + 8 * hh;
#pragma unroll
        for (int s = 0; s < 4; ++s) qfa[pass][s] = *(const bf16x8*)(qp + 16 * s); }
    __syncthreads();
#pragma unroll
    for (int pass = 0; pass < 2; ++pass) {
        const int r0 = (wid & 1) * 64 + pass * 32;
        const size_t qrow = (size_t)b * SEQ + n * 128 + r0 + r32;
        const bf16x8 (&qf)[4] = qfa[pass];
        f32x16 S[5];
#pragma unroll
        for (int j = 0; j < 5; ++j) {
#pragma unroll
            for (int i = 0; i < 16; ++i) S[j][i] = 0.f;
            const LAS bf16_t* kp = Ks + (r0 + 32 * j + r32) * 72 + 8 * hh;
#pragma unroll
            for (int s = 0; s < 4; ++s) S[j] = MFMA32(*(const LAS bf16x8*)(kp + 16 * s), qf[s], S[j]);
        }
#pragma unroll
        for (int i = 0; i < 16; ++i) { const int c = crow(i, hh); if (c <= r32) S[0][i] = -INFINITY; if (c > r32) S[4][i] = -INFINITY; }
        if (n == 0) {
#pragma unroll
            for (int j = 0; j < 4; ++j) if (r0 + 32 * j < 128) {
#pragma unroll
                for (int i = 0; i < 16; ++i) S[j][i] = -INFINITY; }
        }
        float mx = sink2;
#pragma unroll
        for (int j = 0; j < 5; ++j)
#pragma unroll
            for (int i = 0; i < 16; ++i) mx = fmaxf(mx, S[j][i]);
        mx = fmaxf(mx, __shfl_xor(mx, 32));
        float l = 0.f;
#pragma unroll
        for (int j = 0; j < 5; ++j)
#pragma unroll
            for (int i = 0; i < 16; ++i) { const float p = ex2(S[j][i] - mx); S[j][i] = p; l += p; }
        l += __shfl_xor(l, 32);
        l += ex2(sink2 - mx);
        f32x16 o[2];
#pragma unroll
        for (int i = 0; i < 16; ++i) { o[0][i] = 0.f; o[1][i] = 0.f; }
#pragma unroll
        for (int j = 0; j < 5; ++j)
#pragma unroll
            for (int s = 0; s < 2; ++s) {
                const bf16x8 pf = pack8(S[j], s);
#pragma unroll
                for (int dt = 0; dt < 2; ++dt) {
                    const int dd = (r0 + 32 * j + 16 * s + 4 * hh) >> 1;
                    o[dt] = MFMA32(join8(*(const LAS u32x2*)(Vt + tr_off(32 * dt + r32, 132, dd)), *(const LAS u32x2*)(Vt + tr_off(32 * dt + r32, 132, dd + 4))), pf, o[dt]);
                }
            }
        const float il = 1.f / l;
        bf16_t* op = X + qrow * XW + 1024 + hq * 64 + 4 * hh;
#pragma unroll
        for (int dt = 0; dt < 2; ++dt)
#pragma unroll
            for (int g4 = 0; g4 < 4; ++g4) { u32x2 w; w.x = pk2(o[dt][4 * g4] * il, o[dt][4 * g4 + 1] * il); w.y = pk2(o[dt][4 * g4 + 2] * il, o[dt][4 * g4 + 3] * il);
                *(u32x2*)(op + 32 * dt + 8 * g4) = w; }
    }
    __syncthreads();
}

__device__ __forceinline__ void kv_mfma(LAS unsigned char* lds, const bf16_t* P, bf16_t* kvT, int unit, const int tid) {
    const int lane = tid & 63, wid = __builtin_amdgcn_readfirstlane(tid >> 6), r32 = lane & 31, hh = lane >> 5;
    const int b = unit >> 6, h = (unit >> 4) & 3, n = unit & 15;
    LAS bf16_t* Kt = (LAS bf16_t*)lds;
    LAS bf16_t* Vt = Kt + 64 * 136;
    const size_t rowc = (size_t)b * SEQ + n * 128; const float lg = lg_gamma(h);
    { const int tp = tid >> 3, ch = tid & 7;
      const bf16_t* src = P + (rowc + 2 * tp) * PW + 1024 + h * 64 + ch * 8; const u32x4 w0 = *(const u32x4*)src, w1 = *(const u32x4*)(src + PW);
      const int tv = tid >> 3, cv = 2 * (tid & 7);
      const bf16_t* sv = P + (rowc + 2 * tv) * PW + 1280 + h * 128 + cv * 8;
      const u32x4 va0 = *(const u32x4*)sv, va1 = *(const u32x4*)(sv + PW), vb0 = *(const u32x4*)(sv + 8), vb1 = *(const u32x4*)(sv + 8 + PW);
      const float z0 = ex2((float)(127 - 2 * tp) * lg), z1 = ex2((float)(126 - 2 * tp) * lg);
      LAS unsigned* t = (LAS unsigned*)Kt + (ch * 8) * 68 + (tp ^ ((ch & 7) << 2));
      t[0 * 68] = pk2(bflo(w0.x) * z0, bflo(w1.x) * z1); t[1 * 68] = pk2(bfhi(w0.x) * z0, bfhi(w1.x) * z1); t[2 * 68] = pk2(bflo(w0.y) * z0, bflo(w1.y) * z1); t[3 * 68] = pk2(bfhi(w0.y) * z0, bfhi(w1.y) * z1);
      t[4 * 68] = pk2(bflo(w0.z) * z0, bflo(w1.z) * z1); t[5 * 68] = pk2(bfhi(w0.z) * z0, bfhi(w1.z) * z1); t[6 * 68] = pk2(bflo(w0.w) * z0, bflo(w1.w) * z1); t[7 * 68] = pk2(bfhi(w0.w) * z0, bfhi(w1.w) * z1);
      tr_store8((LAS unsigned*)Vt, 68, cv, tv, va0, va1); tr_store8((LAS unsigned*)Vt, 68, cv + 1, tv, vb0, vb1); }
    __syncthreads();
    const int et = wid >> 1, dt = wid & 1;
    f32x16 acc;
#pragma unroll
    for (int i = 0; i < 16; ++i) acc[i] = 0.f;
#pragma unroll
    for (int s = 0; s < 8; ++s) acc = MFMA32(*(const LAS bf16x8*)(Kt + tr_off(32 * dt + r32, 68, 8 * s + 4 * hh)), *(const LAS bf16x8*)(Vt + tr_off(32 * et + r32, 68, 8 * s + 4 * hh)), acc);
    bf16_t* o = kvT + ((size_t)unit * 128 + 32 * et + r32) * 64 + 32 * dt + 4 * hh;
#pragma unroll
    for (int g4 = 0; g4 < 4; ++g4) { u32x2 w; w.x = pk2(acc[4 * g4], acc[4 * g4 + 1]); w.y = pk2(acc[4 * g4 + 2], acc[4 * g4 + 3]); *(u32x2*)(o + 8 * g4) = w; }
    __syncthreads();
}

__device__ __forceinline__ void ret_mfma(LAS unsigned char* lds, const bf16_t* P, const bf16_t* kvT, bf16_t* X, int unit, const int tid) {
    const int lane = tid & 63, wid = __builtin_amdgcn_readfirstlane(tid >> 6), r32 = lane & 31, hh = lane >> 5;
    const int b = unit >> 6, h = (unit >> 4) & 3, n = unit & 15;
    LAS bf16_t* St = (LAS bf16_t*)lds;
    LAS bf16_t* Ks = St + 128 * 72;
    LAS bf16_t* Vt = Ks + 128 * 72;
    LAS float* ssq = (LAS float*)(Vt + 128 * 136);
    const size_t rowc = (size_t)b * SEQ + n * 128; const float lg = lg_gamma(h);
    const int rb = wid >> 1, eh = wid & 1;
    const size_t qrow = rowc + 32 * rb + r32;
    bf16x8 qf[4];
    { const bf16_t* qp = P + qrow * PW + 768 + h * 64 + 8 * hh;
#pragma unroll
      for (int s = 0; s < 4; ++s) qf[s] = *(const bf16x8*)(qp + 16 * s);
    }
    {
    u32x4 kst[2], vst0[2], vst1[2];
#pragma unroll
    for (int i = 0; i < 2; ++i) { const int c = tid + 512 * i; kst[i] = *(const u32x4*)(P + (rowc + (c >> 3)) * PW + 1024 + h * 64 + (c & 7) * 8);
        const int it = tid + 512 * i; const bf16_t* src = P + (rowc + 2 * (it >> 4)) * PW + 1280 + h * 128 + (it & 15) * 8; vst0[i] = *(const u32x4*)src; vst1[i] = *(const u32x4*)(src + PW); }
    { const int e = tid >> 2, d0 = (tid & 3) * 16; float s[16];
#pragma unroll
      for (int k = 0; k < 16; ++k) s[k] = 0.f;
      if (n > 0) {
          const u32x4* kb = (const u32x4*)(kvT + ((size_t)(unit - n) * 128 + e) * 64 + d0);
#pragma unroll
          for (int g = 0; g < 2; ++g) {
              const int j0 = 12 * g, nj = g ? 3 : 12;
              if (g && n <= 12) break;
              u32x4 t[12][2];
#pragma unroll
              for (int j = 0; j < 12; ++j) if (j < nj) { const int jj = (j0 + j) < n ? (j0 + j) : n - 1; t[j][0] = kb[(size_t)jj * 1024]; t[j][1] = kb[(size_t)jj * 1024 + 1]; }
#pragma unroll
              for (int j = 0; j < 12; ++j) if (j < nj) { const float w = (j0 + j) < n ? ex2((float)((n - 1 - j0 - j) * 128) * lg) : 0.f;
#pragma unroll
                  for (int q = 0; q < 2; ++q) { const u32x4 v = t[j][q];
                      s[8 * q] += w * bflo(v.x); s[8 * q + 1] += w * bfhi(v.x); s[8 * q + 2] += w * bflo(v.y); s[8 * q + 3] += w * bfhi(v.y);
                      s[8 * q + 4] += w * bflo(v.z); s[8 * q + 5] += w * bfhi(v.z); s[8 * q + 6] += w * bflo(v.w); s[8 * q + 7] += w * bfhi(v.w); } }
          }
      }
      u32x4 w0, w1; w0.x = pk2(s[0], s[1]); w0.y = pk2(s[2], s[3]); w0.z = pk2(s[4], s[5]); w0.w = pk2(s[6], s[7]);
      w1.x = pk2(s[8], s[9]); w1.y = pk2(s[10], s[11]); w1.z = pk2(s[12], s[13]); w1.w = pk2(s[14], s[15]);
      *(LAS u32x4*)(St + e * 72 + d0) = w0; *(LAS u32x4*)(St + e * 72 + d0 + 8) = w1; }
#pragma unroll
    for (int i = 0; i < 2; ++i) { const int c = tid + 512 * i; *(LAS u32x4*)(Ks + (c >> 3) * 72 + (c & 7) * 8) = kst[i]; }
#pragma unroll
    for (int i = 0; i < 2; ++i) { const int it = tid + 512 * i; tr_store8((LAS unsigned*)Vt, 68, it & 15, it >> 4, vst0[i], vst1[i]); }
    __syncthreads();
    }
    {
    u32x2 gw[2][4];
    { const bf16_t* gp = P + qrow * PW + 1792 + h * 128 + 64 * eh + 4 * hh;
#pragma unroll
      for (int et = 0; et < 2; ++et)
#pragma unroll
          for (int g4 = 0; g4 < 4; ++g4) gw[et][g4] = *(const u32x2*)(gp + 32 * et + 8 * g4); }
    f32x16 o[2];
#pragma unroll
    for (int i = 0; i < 16; ++i) { o[0][i] = 0.f; o[1][i] = 0.f; }
#pragma unroll
    for (int et = 0; et < 2; ++et) { const LAS bf16_t* sp = St + (64 * eh + 32 * et + r32) * 72 + 8 * hh;
#pragma unroll
        for (int s = 0; s < 4; ++s) o[et] = MFMA32(*(const LAS bf16x8*)(sp + 16 * s), qf[s], o[et]); }
    { const float xi = ex2((float)(32 * rb + r32 + 1) * lg);
#pragma unroll
      for (int i = 0; i < 16; ++i) { o[0][i] *= xi; o[1][i] *= xi; } }
    for (int kt = 0; kt <= rb; ++kt) {
        f32x16 S;
#pragma unroll
        for (int i = 0; i < 16; ++i) S[i] = 0.f;
        const LAS bf16_t* kp = Ks + (32 * kt + r32) * 72 + 8 * hh;
#pragma unroll
        for (int s = 0; s < 4; ++s) S = MFMA32(*(const LAS bf16x8*)(kp + 16 * s), qf[s], S);
#pragma unroll
        for (int i = 0; i < 16; ++i) { const int diff = 32 * (rb - kt) + r32 - crow(i, hh); S[i] = diff >= 0 ? S[i] * ex2((float)diff * lg) : 0.f; }
#pragma unroll
        for (int s = 0; s < 2; ++s) {
            const bf16x8 pf = pack8(S, s);
#pragma unroll
            for (int et = 0; et < 2; ++et) {
                const int er = 64 * eh + 32 * et + r32, dd = 16 * kt + 8 * s + 2 * hh;
                o[et] = MFMA32(join8(*(const LAS u32x2*)(Vt + tr_off(er, 68, dd)), *(const LAS u32x2*)(Vt + tr_off(er, 68, dd + 4))), pf, o[et]);
            }
        }
    }
    float sq = 0.f;
#pragma unroll
    for (int i = 0; i < 16; ++i) sq += o[0][i] * o[0][i] + o[1][i] * o[1][i];
    sq += __shfl_xor(sq, 32);
    if (hh == 0) ssq[eh * 128 + 32 * rb + r32] = sq;
    __syncthreads();
    const float rs = rsqrtf((ssq[32 * rb + r32] + ssq[128 + 32 * rb + r32]) * (1.f / 128.f) + EPS);
    bf16_t* op = X + qrow * XW + 1536 + h * 128 + 64 * eh + 4 * hh;
#pragma unroll
    for (int et = 0; et < 2; ++et)
#pragma unroll
        for (int g4 = 0; g4 < 4; ++g4) { const u32x2 g = gw[et][g4]; u32x2 w;
            w.x = pk2(o[et][4 * g4] * rs * bflo(g.x), o[et][4 * g4 + 1] * rs * bfhi(g.x)); w.y = pk2(o[et][4 * g4 + 2] * rs * bflo(g.y), o[et][4 * g4 + 3] * rs * bfhi(g.y));
            *(u32x2*)(op + 32 * et + 8 * g4) = w; }
    }
    __syncthreads();
}
#define XB_TMO      128
#define XB_XCNT(j)  (256  + 64 * (j))
#define XB_XSUB(j)  (1280 + 64 * (j))
#define XB_XGEN(j)  (2304 + 64 * (j))
#define XB_TOP      3328
#define XB_TOPGEN   3392
#define XCD_BAR_WORDS 3456
#define XB_SPIN_CAP (1u << 18)
__device__ __forceinline__ unsigned xb_ld(unsigned* p)              { return __hip_atomic_load(p, __ATOMIC_RELAXED, __HIP_MEMORY_SCOPE_AGENT); }
__device__ __forceinline__ unsigned xb_add(unsigned* p, unsigned v) { return __hip_atomic_fetch_add(p, v, __ATOMIC_RELAXED, __HIP_MEMORY_SCOPE_AGENT); }
__device__ __forceinline__ unsigned xb_xcc_id() { return (unsigned)__builtin_amdgcn_s_getreg((3 << 11) | 20) & 0xFu; }
#define XB_SPIN(cond, bar) do { unsigned _sp = 0; while (cond) { __builtin_amdgcn_s_sleep(1); \
    if ((++_sp & 255u) == 0u) { if (xb_ld(&(bar)[XB_TMO])) break; if (_sp > XB_SPIN_CAP) { atomicAdd(&(bar)[XB_TMO], 1u); break; } } } } while (0)
struct XcdBarrier { unsigned* bar; unsigned x; volatile LAS unsigned* st; unsigned nexp; };
__device__ __forceinline__ XcdBarrier xcd_barrier_post(unsigned* bar, volatile LAS unsigned* st, unsigned nexp) {
    XcdBarrier b; b.bar = bar; b.x = xb_xcc_id(); b.st = st; b.nexp = nexp;
    if (threadIdx.x == 0) (void)xb_add(&bar[XB_XCNT(b.x)], 1u);
    return b;
}
__device__ __forceinline__ void xcd_barrier_complete(unsigned* bar, unsigned x, unsigned G, unsigned& nloc, unsigned& nx) {
    unsigned sum, cnt, mine, sp = 0u;
    for (;;) {
        sum = 0u; cnt = 0u; mine = 0u;
#pragma unroll
        for (unsigned j = 0; j < 16; ++j) { const unsigned c = xb_ld(&bar[XB_XCNT(j)]); sum += c; cnt += (c > 0u) ? 1u : 0u; mine = (j == x) ? c : mine; }
        if (sum == G) break;
        __builtin_amdgcn_s_sleep(1);
        if ((++sp & 255u) == 0u) { if (xb_ld(&bar[XB_TMO])) break; if (sp > XB_SPIN_CAP) { atomicAdd(&bar[XB_TMO], 1u); break; } }
    }
    nloc = mine > 0u ? mine : 1u; nx = cnt > 0u ? cnt : 1u;
}
__device__ __forceinline__ void xcd_barrier(const XcdBarrier& b) {
    asm volatile("s_waitcnt vmcnt(0)" ::: "memory");
    __syncthreads();
    if (threadIdx.x == 0) {
        unsigned* bar = b.bar;
        __builtin_amdgcn_s_waitcnt(0);
        unsigned nloc = b.st[0], nx = b.st[1];
        if (nloc == 0u) { xcd_barrier_complete(bar, b.x, b.nexp, nloc, nx); b.st[0] = nloc; b.st[1] = nx; }
        const unsigned old = xb_add(&bar[XB_XSUB(b.x)], 1u);
        const unsigned gen = old / nloc;
        if (old + 1u == (gen + 1u) * nloc) {
            __builtin_amdgcn_fence(__ATOMIC_RELEASE, "agent");
            asm volatile("s_waitcnt vmcnt(0)" ::: "memory");
            const unsigned og = xb_add(&bar[XB_TOP], 1u);
            const unsigned tg = og / nx;
            if (og + 1u == (tg + 1u) * nx) xb_add(&bar[XB_TOPGEN], 1u);
            else XB_SPIN(xb_ld(&bar[XB_TOPGEN]) == tg, bar);
            __builtin_amdgcn_fence(__ATOMIC_ACQUIRE, "agent");
            xb_add(&bar[XB_XGEN(b.x)], 1u);
            asm volatile("s_waitcnt vmcnt(0)" ::: "memory");
        } else {
            XB_SPIN(xb_ld(&bar[XB_XGEN(b.x)]) == gen, bar);
            __builtin_amdgcn_fence(__ATOMIC_ACQUIRE, "agent");
            asm volatile("s_waitcnt vmcnt(0)" ::: "memory");
        }
    }
    __syncthreads();
}

constexpr int NPH = 30;
#ifndef PHM
#define PHM 0x1ff
#endif
#ifndef MIX_NAIVE
#define MIX_NAIVE 0
#endif
#ifndef RES_BF16
#define RES_BF16 1
#endif
#ifndef HBD_EXP
#define HBD_EXP 0
#endif
#ifndef B1_PROBE
#define B1_PROBE 0
#endif
#ifndef DBL_BAR
#define DBL_BAR 0
#endif
#ifndef DBLM
#define DBLM 0
#endif
#ifndef MK_NG
#define MK_NG 1
#endif
#ifndef MK_STAGGER
#define MK_STAGGER 1500
#endif
__global__ void __launch_bounds__(512, 2) mk_fwd(Args a) {
    extern __shared__ __attribute__((aligned(16))) unsigned char lds_raw[];
    LAS unsigned char* lds = (LAS unsigned char*)lds_raw;
    const int Gall = gridDim.x, call = blockIdx.x;
    constexpr int NG = MK_NG, MG = M / NG;
    const int grp = (call >> 3) % NG, c = ((call >> 3) / NG) * 8 + (call & 7), G = Gall / NG;
    const int row0 = grp * MG, pm0 = grp * (MG / 256);
    volatile LAS unsigned* MISC = (volatile LAS unsigned*)(lds + MISC_OFF);
    if (threadIdx.x < 32) MISC[threadIdx.x] = 0u;
    __syncthreads();
    unsigned* ctl = (unsigned*)(a.ws + WS_CTL);
    const bool multi = (a.ph_hi - a.ph_lo) > 1;
    XcdBarrier barAll, bar; barAll.bar = ctl + 4096; barAll.x = 0; barAll.st = nullptr; barAll.nexp = 0; bar = barAll;
    if (multi) { barAll = xcd_barrier_post(ctl + 4096, MISC + 8, (unsigned)Gall);
                 bar = (NG == 1) ? barAll : xcd_barrier_post(ctl + 4096 + (1 + grp) * XCD_BAR_WORDS, MISC + 10, (unsigned)G); }

    bf16_t* X = (bf16_t*)(a.ws + WS_X); bf16_t* P = (bf16_t*)(a.ws + WS_P); float* ss = (float*)(a.ws + WS_SS);
#if MIX_NAIVE & 2
    float* kvb = (float*)(a.ws + WS_KV);
#else
    bf16_t* kvb = (bf16_t*)(a.ws + WS_KV);
#endif
    for (int ph = a.ph_lo; ph < a.ph_hi; ++ph) {
        const int kind_ = (ph == 0) ? 0 : (ph == NPH - 1) ? 1 : 2 + (ph - 1) % 7;
        for (int rep_ = 0; rep_ < (((DBLM >> kind_) & 1) ? 2 : 1); ++rep_) {
        if (rep_) __syncthreads();
        int tid = threadIdx.x; asm volatile("" : "+v"(tid));
        if (ph == 0) { if (PHM & 1) phase_prologue(a, lds, Gall, tid); }
        else if (ph == NPH - 1) { if (PHM & 2) final_norm(a.out, ss + (size_t)8 * M * 16, a.norm_final, G, c, row0, MG, tid); }
        else {
            const int l = (ph - 1) / 7, sub = (ph - 1) % 7;
            const char* Wl = (const char*)(a.ws + WS_W + (size_t)l * WL_SIZE);
            if (sub == 0 && (PHM & 4)) {
                pg8::SchedPlain S{(const char*)X, Wl + WL_IN, XW, DM, DM / 64, MG / 256, NIN / 256, G, c, pg8::K_IN, pm0};
                pg8::EpiIn E{P, ss + (size_t)(2 * l) * M * 16};
                pg8::gemm_phase(lds, XW, DM, S, E, tid);
            } else if (sub == 1 && (PHM & 8)) {
#if MIX_NAIVE & 1
                for (int u = c; u < 256 / NG; u += G) attn_naive(lds, P, X, a.sinks + l * 8, grp * (256 / NG) + u, tid);
#else
                for (int rr_ = 0; rr_ < ((B1_PROBE & 1) ? 2 : 1); ++rr_)
                for (int u = c; u < 256 / NG; u += G) attn_mfma(lds, P, X, a.sinks + l * 8, grp * (256 / NG) + u, tid);
#endif
#if MIX_NAIVE & 2
                for (int u = c; u < 512 / NG; u += G) kv_naive(lds, P, kvb, grp * (512 / NG) + u, tid);
#else
                for (int rr_ = 0; rr_ < ((B1_PROBE & 2) ? 2 : 1); ++rr_)
                for (int u = c; u < 512 / NG; u += G) kv_mfma(lds, P, kvb, grp * (512 / NG) + u, tid);
#endif
                for (int rr_ = 0; rr_ < ((B1_PROBE & 4) ? 2 : 1); ++rr_)
                conv_all(P, a.conv_w + l * 3 * 512, X, G, c, row0, MG, tid);
            } else if (sub == 2 && (PHM & 16)) {
#if MIX_NAIVE & 2
                for (int u = c; u < 512 / NG; u += G) ret_naive(lds, P, kvb, X, grp * (512 / NG) + u, tid);
#else
                for (int u = c; u < 512 / NG; u += G) ret_mfma(lds, P, kvb, X, grp * (512 / NG) + ((u < 256 / NG) ? u : (u & ~15) | (15 - (u & 15))), tid);
#endif
            } else if (sub == 3 && (PHM & 32)) {
                pg8::SchedC S{(const char*)X, Wl + WL_C, Wl + WL_B, MG / 256, G, c, pm0};
                pg8::EpiC E{ss + (size_t)(2 * l) * M * 16, a.b_gate + l * 3 * DM, (u32x4*)(a.ws + WS_GS) + (size_t)call * 8192, (u32x4*)(a.ws + WS_MACC) + (size_t)call * 16384, (bf16_t*)(a.ws + WS_MB)};
                pg8::gemm_phase(lds, XW, KC, S, E, tid);
            } else if (sub == 4 && (PHM & 64)) {
                pg8::SchedPlain S{(const char*)(a.ws + WS_MB), Wl + WL_OUT, DM, DM, DM / 64, MG / 256, DM / 256, G, c, pg8::K_RES, pm0};
                pg8::EpiRes E{l == 0 ? a.x : a.out, a.out, X, ss + (size_t)(2 * l + 1) * M * 16, RES_BF16 ? (l == 0 ? 0 : 1) : 2, HBD_EXP ? (bf16_t*)(a.ws + 398 * MiB) : nullptr};
                pg8::gemm_phase(lds, DM, DM, S, E, tid);
            } else if (sub == 5 && (PHM & 128)) {
                const int ldE = HBD_EXP ? DM : XW;
                pg8::SchedPlain S{HBD_EXP ? (const char*)(a.ws + 398 * MiB) : (const char*)X, Wl + WL_GU, ldE, DM, DM / 64, MG / 256, NGU / 256, G, c, pg8::K_GU, pm0};
                pg8::EpiGU E{ss + (size_t)(2 * l + 1) * M * 16, (bf16_t*)(a.ws + WS_FF)};
                pg8::gemm_phase(lds, ldE, DM, S, E, tid);
            } else if (sub == 6 && (PHM & 256)) {
                pg8::SchedPlain S{(const char*)(a.ws + WS_FF), Wl + WL_D, DFF, DFF, DFF / 64, MG / 256, DM / 256, G, c, pg8::K_RES, pm0};
                pg8::EpiRes E{a.out, a.out, X, ss + (size_t)(2 * l + 2) * M * 16, RES_BF16 ? (l == DEPTH - 1 ? 3 : 1) : 2, nullptr};
                pg8::gemm_phase(lds, DFF, DFF, S, E, tid);
            }
        }
        }
        if (ph + 1 < a.ph_hi) {
            if (ph == 0) { xcd_barrier(barAll);
                if (NG > 1 && grp > 0) { const unsigned long long t0 = __builtin_amdgcn_s_memrealtime(); while (__builtin_amdgcn_s_memrealtime() - t0 < (unsigned long long)(grp * MK_STAGGER)) __builtin_amdgcn_s_sleep(8); } }
            else xcd_barrier(bar);
#if DBL_BAR
            xcd_barrier(bar);
#endif
        }
    }
}

#ifndef MK_SINGLE
#define MK_SINGLE 0
#endif
extern "C" void kernel_launch(void* const* d_in, const int* in_sizes, int n_in, void* d_out, int out_size, void* d_ws, size_t ws_size, hipStream_t stream) {
    static int grid = 0;
    if (grid == 0) {
        if (n_in != 13 || out_size != M * DM || ws_size < WS_END) { fprintf(stderr, "kernel_launch: unexpected shapes (n_in %d, out %d, ws %zu)\n", n_in, out_size, ws_size); grid = -1; return; }
        int dev = 0, cus = 0, per_cu = 0;
        if (hipGetDevice(&dev) != hipSuccess || hipDeviceGetAttribute(&cus, hipDeviceAttributeMultiprocessorCount, dev) != hipSuccess) { grid = -1; return; }
        if (hipFuncSetAttribute((const void*)mk_fwd, hipFuncAttributeMaxDynamicSharedMemorySize, LDS_BYTES) != hipSuccess) { fprintf(stderr, "kernel_launch: hipFuncSetAttribute failed\n"); grid = -1; return; }
        if (hipOccupancyMaxActiveBlocksPerMultiprocessor(&per_cu, (const void*)mk_fwd, 512, LDS_BYTES) != hipSuccess || per_cu < 1) { fprintf(stderr, "kernel_launch: occupancy query says %d\n", per_cu); per_cu = 1; }
        (void)hipGetLastError();
        grid = cus;
        if (grid > 256) grid = 256;
    }
    if (grid < 0) return;
    (void)hipMemsetAsync((char*)d_ws + WS_CTL, 0, CTL_ZERO_BYTES, stream);
    Args a{};
    a.x = (const float*)d_in[0]; a.norm_mix = (const float*)d_in[1]; a.w_in = (const float*)d_in[2]; a.sinks = (const float*)d_in[3]; a.conv_w = (const float*)d_in[4];
    a.w_branch = (const float*)d_in[5]; a.b_gate = (const float*)d_in[6]; a.w_out = (const float*)d_in[7]; a.norm_ffn = (const float*)d_in[8];
    a.w_g = (const float*)d_in[9]; a.w_u = (const float*)d_in[10]; a.w_d = (const float*)d_in[11]; a.norm_final = (const float*)d_in[12];
    a.out = (float*)d_out; a.ws = (unsigned char*)d_ws;
#if MK_SINGLE
    a.ph_lo = 0; a.ph_hi = NPH;
    hipLaunchKernelGGL(mk_fwd, dim3(grid), dim3(512), LDS_BYTES, stream, a);
#else
    for (int ph = 0; ph < NPH; ++ph) { a.ph_lo = ph; a.ph_hi = ph + 1; hipLaunchKernelGGL(mk_fwd, dim3(grid), dim3(512), LDS_BYTES, stream, a); }
#endif
}
```

```cpp
#include <hip/hip_runtime.h>
#include <cstdio>
#include <cstdint>

#define LAS __attribute__((address_space(3)))
#define GAS __attribute__((address_space(1)))
typedef unsigned short bf16_t;
typedef short bf16x8 __attribute__((ext_vector_type(8)));
typedef float f32x4 __attribute__((ext_vector_type(4)));
typedef float f32x2 __attribute__((ext_vector_type(2)));
typedef unsigned u32x4 __attribute__((ext_vector_type(4)));
typedef unsigned u32x2 __attribute__((ext_vector_type(2)));
typedef __bf16 bf16x2_t __attribute__((ext_vector_type(2)));

constexpr int BATCH = 8, SEQ = 2048, DM = 1024, M = BATCH * SEQ, DEPTH = 4, DFF = 2816, DIN = 6912;
constexpr int PW = 3328;
constexpr int XW = 2560;
constexpr int NIN = 3840;
constexpr int NGU = 2 * DFF;
constexpr int KC = 1536;
constexpr float EPS = 1e-6f;
constexpr float LOG2E = 1.4426950408889634f;
constexpr float QSCALE = 0.18033688011112042f;

constexpr size_t MiB = 1u << 20;
constexpr size_t WS_CTL = 0, CTL_ZERO_BYTES = 262144;
constexpr size_t WS_SS = 388 * MiB;
constexpr size_t WS_TABA = 2 * MiB;
constexpr size_t WS_TABR = 2 * MiB + 131072;
constexpr size_t WS_W = 4 * MiB;
constexpr size_t WL_IN = 0, WL_C = 7864320, WL_B = 17301504, WL_OUT = 20447232, WL_GU = 22544384, WL_D = 34078720, WL_SIZE = 39845888;
constexpr size_t WS_X = 156 * MiB;
constexpr size_t WS_P = 236 * MiB;
constexpr size_t WS_MACC = WS_P, WS_MB = WS_P + 64 * MiB, WS_FF = WS_P;
constexpr size_t WS_GS = 340 * MiB;
constexpr size_t WS_KV = 372 * MiB;
constexpr size_t WS_END = 398 * MiB;
static_assert(WS_W + DEPTH * WL_SIZE <= WS_X, "weights");
static_assert((size_t)M * XW * 2 <= 80 * MiB && (size_t)M * PW * 2 <= 104 * MiB && (size_t)M * DFF * 2 <= 104 * MiB, "buffers");

constexpr int RING_BYTES = 131072, LDS_BYTES = 147456, MISC_OFF = RING_BYTES + 320;

__device__ __forceinline__ unsigned pk2(float lo, float hi) { f32x2 v = {lo, hi}; bf16x2_t b = __builtin_convertvector(v, bf16x2_t); return __builtin_bit_cast(unsigned, b); }
__device__ __forceinline__ float bflo(unsigned u) { return __uint_as_float(u << 16); }
__device__ __forceinline__ float bfhi(unsigned u) { return __uint_as_float(u & 0xffff0000u); }
__device__ __forceinline__ float bf2f(bf16_t b) { return __uint_as_float((unsigned)b << 16); }
__device__ __forceinline__ float fsilu(float x) { return x * __builtin_amdgcn_rcpf(1.f + __builtin_amdgcn_exp2f(-x * LOG2E)); }
__device__ __forceinline__ float fsigm(float x) { return __builtin_amdgcn_rcpf(1.f + __builtin_amdgcn_exp2f(-x * LOG2E)); }

struct Args {
    const float* x; const float* norm_mix; const float* w_in; const float* sinks; const float* conv_w; const float* w_branch; const float* b_gate; const float* w_out;
    const float* norm_ffn; const float* w_g; const float* w_u; const float* w_d; const float* norm_final;
    float* out; unsigned char* ws; int ph_lo, ph_hi;
};
#define MK_SINGLE 1
#ifndef DBL_EPI
#define DBL_EPI 0
#endif
namespace pg8 {
constexpr int BM = 256, BK = 64, HALF = 128, HTB = HALF * BK * 2  , STAGE_BYTES = 8 * HTB, NXCD = 8, WGM = 8;

__host__ __device__ __forceinline__ int lds_byte(int r, int c) { const int st = (r >> 4) * 2 + (c >> 5), rr = r & 15, cc = c & 31, ob = rr * 64 + cc * 2; return st * 1024 + (ob ^ (((ob >> 9) & 1) << 5)); }
__host__ __device__ __forceinline__ void stage_rc(int b, int& R, int& C) { const int st = b / 1024, sb = b % 1024, swz = sb ^ (((sb >> 9) & 1) << 5); R = (st >> 1) * 16 + swz / 64; C = (st & 1) * 32 + (swz % 64) / 2; }
__host__ __device__ __forceinline__ int perm32(int rho) { const int n = rho >> 4, i = rho & 15; return 8 * (i >> 2) + 4 * n + (i & 3); }

struct Unit { const char* A; const char* B; int nt, pm, pn, kind, aux; };

__device__ __forceinline__ void tile_of(int L, int nM, int nN, int& pm, int& pn) {
    const int nwg = nM * nN; int wgid = L;
    { const int q = nwg / NXCD, r = nwg % NXCD, xcd = wgid % NXCD, off = wgid / NXCD; wgid = (xcd < r ? xcd * (q + 1) : r * (q + 1) + (xcd - r) * q) + off; }
    const int nig = WGM * nN, gid = wgid / nig, fm = gid * WGM, gsz = (nM - fm) < WGM ? (nM - fm) : WGM;
    pm = fm + ((wgid % nig) % gsz); pn = (wgid % nig) / gsz;
}

template <class Epi, class Sched>
__device__ __forceinline__ void gemm_phase(LAS unsigned char* lds, const int lda, const int ldb, const Sched& S, const Epi& E, const int tid) {
    const int wid = __builtin_amdgcn_readfirstlane(tid >> 6), lane = tid & 63, wr = wid >> 2, wc = wid & 3, fr = lane & 15, fq = lane >> 4;
    unsigned voffA[2], voffB[2];
#pragma unroll
    for (int i = 0; i < 2; ++i) { int R, C; stage_rc(tid * 16 + i * 8192, R, C); const int Rb = 2 * (R & ~31) + perm32(R & 31);
        voffA[i] = (unsigned)(R * lda + C) * 2u; voffB[i] = (unsigned)(Rb * ldb + C) * 2u; }
    const size_t kstep = (size_t)(BK * 2);
    const size_t hstepA = (size_t)HALF * lda * 2, hstepB = (size_t)32 * ldb * 2;
    const unsigned ldsw = (unsigned)wid * 1024u;
    const int aoff = lds_byte(wr * 64 + fr, fq * 8), boff = lds_byte(wc * 32 + fr, fq * 8);
#define PG8_SA(b, h) (((b) * 2 + (h)) * HTB)
#define PG8_SB(b, h) ((4 + (b) * 2 + (h)) * HTB)
#define PG8_STAGE(bufoff, gbase, voff) do { _Pragma("unroll") for (int _i = 0; _i < 2; ++_i) \
        __builtin_amdgcn_global_load_lds((const unsigned*)((const char*)(gbase) + (voff)[_i]), (LAS unsigned*)(lds + (bufoff) + ldsw + _i * 8192), 16, 0, 0); } while (0)
#define PG8_LDA(dst, b, h) do { _Pragma("unroll") for (int m = 0; m < 4; ++m) _Pragma("unroll") for (int k = 0; k < 2; ++k) dst[m][k] = *(const LAS bf16x8*)(lds + PG8_SA(b, h) + aoff + m * 2048 + k * 1024); } while (0)
#define PG8_LDB(dst, b, h) do { _Pragma("unroll") for (int n = 0; n < 2; ++n) _Pragma("unroll") for (int k = 0; k < 2; ++k) dst[n][k] = *(const LAS bf16x8*)(lds + PG8_SB(b, h) + boff + n * 2048 + k * 1024); } while (0)
#define PG8_MMA(ai, bj, At, Bt) do { __builtin_amdgcn_s_setprio(1); _Pragma("unroll") for (int m = 0; m < 4; ++m) _Pragma("unroll") for (int n = 0; n < 2; ++n) _Pragma("unroll") for (int k = 0; k < 2; ++k) \
        acc[ai][bj][m][n] = __builtin_amdgcn_mfma_f32_16x16x32_bf16(Bt[n][k], At[m][k], acc[ai][bj][m][n], 0, 0, 0); __builtin_amdgcn_s_setprio(0); } while (0)
#define PG8_WAIT_V(n) asm volatile("s_waitcnt vmcnt(" #n ")" ::: "memory")
#define PG8_WAIT_L(n) asm volatile("s_waitcnt lgkmcnt(" #n ")" ::: "memory")
#define PG8_BAR __builtin_amdgcn_s_barrier()
#define PG8_SCHED __builtin_amdgcn_sched_barrier(0)
    Unit cur, nxt; int ui = 0;
    if (!S.next(0, cur)) return;
    f32x4 acc[2][2][4][2];
#pragma unroll
    for (int a = 0; a < 2; ++a)
#pragma unroll
        for (int b = 0; b < 2; ++b)
#pragma unroll
            for (int m = 0; m < 4; ++m)
#pragma unroll
                for (int n = 0; n < 2; ++n) acc[a][b][m][n] = (f32x4){0.f, 0.f, 0.f, 0.f};
    bf16x8 At[4][2], B0[2][2], B1[2][2];
    const char* cA = cur.A; const char* cB = cur.B;
    PG8_STAGE(PG8_SB(0, 0), cB, voffB); PG8_STAGE(PG8_SB(0, 1), cB + hstepB, voffB); PG8_STAGE(PG8_SA(0, 0), cA, voffA); PG8_STAGE(PG8_SA(0, 1), cA + hstepA, voffA);
    if (wr == 1) PG8_BAR;
    PG8_WAIT_V(2); PG8_BAR;
    PG8_STAGE(PG8_SB(1, 0), cB + kstep, voffB); PG8_STAGE(PG8_SA(1, 0), cA + kstep, voffA); PG8_STAGE(PG8_SB(1, 1), cB + hstepB + kstep, voffB);
    PG8_WAIT_V(6); PG8_BAR;
    for (;;) {
        const bool has_next = S.next(ui + 1, nxt);
        const char* nA = has_next ? nxt.A : cA; const char* nB = has_next ? nxt.B : cB;
        const int nt = cur.nt;
        for (int t = 0; t < nt; t += 2) {
            const bool last = (t == nt - 2);
            if constexpr (Epi::HAS_HOOK) E.hook(acc, cur, t, wid);
            const char* a1 = cA + (size_t)(t + 1) * kstep;
            const char* a2 = last ? nA : cA + (size_t)(t + 2) * kstep; const char* b2 = last ? nB : cB + (size_t)(t + 2) * kstep;
            const char* a3 = a2 + kstep; const char* b3 = b2 + kstep;
            PG8_LDB(B0, 0, 0); PG8_LDB(B1, 0, 1); PG8_SCHED; PG8_LDA(At, 0, 0); PG8_STAGE(PG8_SA(1, 1), a1 + hstepA, voffA);
            PG8_WAIT_V(8); PG8_WAIT_L(0); PG8_BAR; PG8_MMA(0, 0, At, B0); PG8_MMA(0, 1, At, B1); PG8_BAR; PG8_SCHED;
            PG8_LDA(At, 0, 1); PG8_STAGE(PG8_SB(0, 0), b2, voffB); PG8_STAGE(PG8_SB(0, 1), b2 + hstepB, voffB); PG8_STAGE(PG8_SA(0, 0), a2, voffA);
            PG8_WAIT_V(8); PG8_WAIT_L(0); PG8_BAR; PG8_MMA(1, 0, At, B0); PG8_MMA(1, 1, At, B1); PG8_BAR; PG8_SCHED;
            PG8_LDB(B0, 1, 0); PG8_LDB(B1, 1, 1); PG8_SCHED; PG8_LDA(At, 1, 0); PG8_STAGE(PG8_SA(0, 1), a2 + hstepA, voffA);
            PG8_WAIT_V(8); PG8_WAIT_L(0); PG8_BAR; PG8_MMA(0, 0, At, B0); PG8_MMA(0, 1, At, B1); PG8_BAR; PG8_SCHED;
            PG8_LDA(At, 1, 1); PG8_STAGE(PG8_SB(1, 0), b3, voffB); PG8_STAGE(PG8_SB(1, 1), b3 + hstepB, voffB); PG8_STAGE(PG8_SA(1, 0), a3, voffA);
            PG8_WAIT_V(8); PG8_WAIT_L(0); PG8_BAR; PG8_MMA(1, 0, At, B0); PG8_MMA(1, 1, At, B1); PG8_BAR; PG8_SCHED;
        }
        if (wr == 0) PG8_BAR;
#if DBL_EPI
        if (E.dbl(cur)) { E(acc, cur, wid, false); asm volatile("" ::: "memory"); }
#endif
        E(acc, cur, wid, true);
        if (!has_next) break;
        cur = nxt; cA = nA; cB = nB; ++ui;
        if (wr == 1) PG8_BAR;
    }
    PG8_WAIT_V(0);
    PG8_BAR;
#undef PG8_SA
#undef PG8_SB
#undef PG8_STAGE
#undef PG8_LDA
#undef PG8_LDB
#undef PG8_MMA
#undef PG8_WAIT_V
#undef PG8_WAIT_L
#undef PG8_BAR
#undef PG8_SCHED
}
}
namespace pg8 {
#ifndef EPIC_TEST
#define EPIC_TEST(x) (x)
#endif
__device__ __forceinline__ float row_rstd(const float* ss, int row) {
    const f32x4* p = (const f32x4*)(ss + (size_t)row * 16); const f32x4 a = p[0], b = p[1], c = p[2], d = p[3];
    const float s = ((a[0] + a[1]) + (a[2] + a[3])) + ((b[0] + b[1]) + (b[2] + b[3])) + (((c[0] + c[1]) + (c[2] + c[3])) + ((d[0] + d[1]) + (d[2] + d[3])));
    return rsqrtf(s * (1.f / DM) + EPS);
}
#ifndef USE_NT
#define USE_NT 0
#endif
#if USE_NT
#define NT_STORE(p, v) __builtin_nontemporal_store((v), (p))
#else
#define NT_STORE(p, v) (*(p) = (v))
#endif
#ifndef WT_STORES
#define WT_STORES 0
#endif
#if WT_STORES
#define RSRC(ptr, bytes) __builtin_amdgcn_make_buffer_rsrc((void*)(ptr), (short)0, (int)(bytes), 0x00020000)
#define ST16(rs, base, elt_off, v) __builtin_amdgcn_raw_buffer_store_b128((v), (rs), (unsigned)((elt_off) * sizeof(*(base))), 0, 16)
#else
#define RSRC(ptr, bytes) 0
#define ST16(rs, base, elt_off, v) (*(u32x4*)((base) + (elt_off)) = (v))
#endif
#define EPI_LANE() const int lane_ = (int)__builtin_amdgcn_mbcnt_hi(~0u, __builtin_amdgcn_mbcnt_lo(~0u, 0u)); const int wr = wid >> 2, wc = wid & 3, fr = lane_ & 15, fq = lane_ >> 4, tid = wid * 64 + lane_; (void)wr; (void)wc; (void)fr; (void)fq; (void)tid
__device__ __forceinline__ void row_rstd8(const float* ss, int rbase, int lane, int fr, float (&rs)[8]) {
    const float a = row_rstd(ss, rbase + lane), b = row_rstd(ss, rbase + 128 + lane);
#pragma unroll
    for (int m = 0; m < 4; ++m) { rs[m] = __shfl(a, m * 16 + fr); rs[4 + m] = __shfl(b, m * 16 + fr); }
}
enum { K_IN = 0, K_GATE = 1, K_BRANCH = 2, K_RES = 3, K_GU = 4 };

__device__ __forceinline__ void rot1(float& a, float& b, float rev) {
    const float fr_ = rev - floorf(rev), c = __builtin_amdgcn_cosf(fr_), s = __builtin_amdgcn_sinf(fr_);
    const float na = a * c - b * s, nb = b * c + a * s; a = na; b = nb;
}
__device__ __forceinline__ f32x4 rot4(f32x4 v, f32x4 t) { return (f32x4){v[0] * t[0] - v[1] * t[1], v[1] * t[0] + v[0] * t[1], v[2] * t[2] - v[3] * t[3], v[3] * t[2] + v[2] * t[3]}; }

struct EpiIn {
    static constexpr bool HAS_HOOK = false;
    __device__ __forceinline__ bool dbl(const Unit&) const { return (DBL_EPI & 1) != 0; }
    bf16_t* P; const float* ss;
    __device__ __forceinline__ void operator()(f32x4 (&acc)[2][2][4][2], const Unit& u, int wid, const bool zacc) const {
        EPI_LANE();
        const int pn = u.pn;
        const auto rsP = RSRC(P, (size_t)M * PW * 2); (void)rsP;
        const int cw = wc * 64 + 8 * fq;
        float ivA[4], ivR[4];
#pragma unroll
        for (int j = 0; j < 4; ++j) { ivA[j] = __builtin_amdgcn_exp2f(-(float)(4 * (fq & 1) + j) * (18.931568569324174f / 8.f)) * 0.15915494309189535f;
                                      ivR[j] = __builtin_amdgcn_exp2f(-(float)(4 * fq + j) * (13.287712379549449f / 32.f)) * 0.15915494309189535f; }
        float rs8[8];
        row_rstd8(ss, u.pm * 256 + wr * 64, lane_, fr, rs8);
#pragma unroll
        for (int ai = 0; ai < 2; ++ai)
#pragma unroll
            for (int m = 0; m < 4; ++m) {
                const int row = u.pm * 256 + ai * 128 + wr * 64 + m * 16 + fr;
                const float rstd = rs8[ai * 4 + m];
                const float fpos = (float)(row & (SEQ - 1));
#pragma unroll
                for (int bj = 0; bj < 2; ++bj) {
                    f32x4 v0 = acc[ai][bj][m][0] * rstd, v1 = acc[ai][bj][m][1] * rstd;
                    const int gc = pn * 256 + bj * 32 + cw;
                    if (pn >= 11) {
                        if (bj == 0) { const f32x4 x0 = acc[ai][1][m][0] * rstd, x1 = acc[ai][1][m][1] * rstd;
                            u32x4 w; w.x = pk2(v0[0] * x0[0], v0[1] * x0[1]); w.y = pk2(v0[2] * x0[2], v0[3] * x0[3]); w.z = pk2(v1[0] * x1[0], v1[1] * x1[1]); w.w = pk2(v1[2] * x1[2], v1[3] * x1[3]);
                            ST16(rsP, P, (size_t)row * PW + 2816 + (pn - 11) * 128 + wc * 32 + 8 * fq, w); }
                    } else {
                        if (pn < 2 || (pn == 2 && wc < 2)) {
                            if (bj == 0 && fq < 2) {
                                float x[8] = {v0[0], v0[1], v0[2], v0[3], v1[0], v1[1], v1[2], v1[3]};
#pragma unroll
                                for (int j = 0; j < 4; ++j) rot1(x[2 * j], x[2 * j + 1], fpos * ivA[j]);
                                v0 = (f32x4){x[0], x[1], x[2], x[3]}; v1 = (f32x4){x[4], x[5], x[6], x[7]};
                            }
                            if (pn < 2) { v0 = v0 * QSCALE; v1 = v1 * QSCALE; }
                        } else if (pn == 3 || pn == 4) {
                            float x[8] = {v0[0], v0[1], v0[2], v0[3], v1[0], v1[1], v1[2], v1[3]};
#pragma unroll
                            for (int j = 0; j < 4; ++j) rot1(x[2 * j], x[2 * j + 1], fpos * (bj ? ivR[j] * 0.01f : ivR[j]));
                            v0 = (f32x4){x[0], x[1], x[2], x[3]}; v1 = (f32x4){x[4], x[5], x[6], x[7]};
                            if (pn == 4) { v0 = v0 * 0.125f; v1 = v1 * 0.125f; }
                        } else if (pn == 7 || pn == 8) {
#pragma unroll
                            for (int j = 0; j < 4; ++j) { v0[j] = fsilu(v0[j]); v1[j] = fsilu(v1[j]); }
                        }
                        u32x4 w; w.x = pk2(v0[0], v0[1]); w.y = pk2(v0[2], v0[3]); w.z = pk2(v1[0], v1[1]); w.w = pk2(v1[2], v1[3]);
                        ST16(rsP, P, (size_t)row * PW + gc, w);
                    }
                    if (zacc) { acc[ai][bj][m][0] = (f32x4){0.f, 0.f, 0.f, 0.f}; acc[ai][bj][m][1] = (f32x4){0.f, 0.f, 0.f, 0.f}; }
                }
                asm volatile("" ::: "memory");
            }
    }
};

struct EpiC {
    static constexpr bool HAS_HOOK = true;
    __device__ __forceinline__ bool dbl(const Unit&) const { return false; }
    const float* ss; const float* bg; u32x4* G0; u32x4* G12; bf16_t* mb;
    __device__ __forceinline__ u32x4* gbuf(int br) const { return br == 0 ? G0 : G12 + (size_t)(br - 1) * 8192; }
    __device__ __forceinline__ void hook(f32x4 (&acc)[2][2][4][2], const Unit& u, int t, int wid) const {
        if (u.kind != K_BRANCH || (t != 8 && t != 16)) return;
        EPI_LANE();
        const int br = (t >> 3) - 1;
        const u32x4* Ga = gbuf(br); const u32x4* Gb = gbuf(br + 1);
#pragma unroll
        for (int ai = 0; ai < 2; ++ai) {
            u32x4 ga[8], gb[8];
#pragma unroll
            for (int q = 0; q < 8; ++q) { ga[q] = Ga[(unsigned)((ai * 8 + q) * 512 + tid)]; gb[q] = Gb[(unsigned)((ai * 8 + q) * 512 + tid)]; }
            asm volatile("" ::: "memory");
#pragma unroll
            for (int m = 0; m < 4; ++m)
#pragma unroll
                for (int bj = 0; bj < 2; ++bj) {
                    const u32x4 a_ = ga[m * 2 + bj], b_ = gb[m * 2 + bj];
                    f32x4 d0 = (f32x4){bflo(b_.x), bfhi(b_.x), bflo(b_.y), bfhi(b_.y)}, d1 = (f32x4){bflo(b_.z), bfhi(b_.z), bflo(b_.w), bfhi(b_.w)};
#pragma unroll
                    for (int j = 0; j < 4; ++j) { d0[j] = __builtin_amdgcn_rcpf(fmaxf(d0[j], 1e-30f)); d1[j] = __builtin_amdgcn_rcpf(fmaxf(d1[j], 1e-30f)); }
                    acc[ai][bj][m][0] = acc[ai][bj][m][0] * ((f32x4){bflo(a_.x), bfhi(a_.x), bflo(a_.y), bfhi(a_.y)} * d0);
                    acc[ai][bj][m][1] = acc[ai][bj][m][1] * ((f32x4){bflo(a_.z), bfhi(a_.z), bflo(a_.w), bfhi(a_.w)} * d1);
                }
            asm volatile("" ::: "memory");
        }
    }
    __device__ __forceinline__ void operator()(f32x4 (&acc)[2][2][4][2], const Unit& u, int wid, const bool zacc) const {
        EPI_LANE();
        const int cw = u.pn * 256 + wc * 64 + 8 * fq;
        if (EPIC_TEST(u.kind == K_GATE)) {
            const int br = u.aux;
            const float* b = bg + br * DM + cw; u32x4* Gw = gbuf(br);
            float rs8[8];
            row_rstd8(ss, u.pm * 256 + wr * 64, lane_, fr, rs8);
            const f32x4 bv00 = *(const f32x4*)(b), bv01 = *(const f32x4*)(b + 4), bv10 = *(const f32x4*)(b + 32), bv11 = *(const f32x4*)(b + 36);
            asm volatile("" ::: "memory");
#pragma unroll
            for (int ai = 0; ai < 2; ++ai)
#pragma unroll
                for (int m = 0; m < 4; ++m) {
                    const float rstd = rs8[ai * 4 + m];
#pragma unroll
                    for (int bj = 0; bj < 2; ++bj) {
                        f32x4 v0 = acc[ai][bj][m][0] * rstd + (bj ? bv10 : bv00), v1 = acc[ai][bj][m][1] * rstd + (bj ? bv11 : bv01);
#pragma unroll
                        for (int j = 0; j < 4; ++j) { v0[j] = fsigm(v0[j]); v1[j] = fsigm(v1[j]); }
                        u32x4 w; w.x = pk2(v0[0], v0[1]); w.y = pk2(v0[2], v0[3]); w.z = pk2(v1[0], v1[1]); w.w = pk2(v1[2], v1[3]);
                        Gw[(unsigned)(((ai * 4 + m) * 2 + bj) * 512 + tid)] = w;
                        if (zacc) { acc[ai][bj][m][0] = (f32x4){0.f, 0.f, 0.f, 0.f}; acc[ai][bj][m][1] = (f32x4){0.f, 0.f, 0.f, 0.f}; }
                    }
                    asm volatile("" ::: "memory");
                }
        } else {
            const u32x4* Ga = gbuf(2);
            const auto rsM = RSRC(mb, (size_t)M * DM * 2); (void)rsM;
#pragma unroll
            for (int ai = 0; ai < 2; ++ai) {
                u32x4 gg[8];
#pragma unroll
                for (int q = 0; q < 8; ++q) gg[q] = Ga[(unsigned)((ai * 8 + q) * 512 + tid)];
                asm volatile("" ::: "memory");
#pragma unroll
                for (int m = 0; m < 4; ++m) {
                    const int row = u.pm * 256 + ai * 128 + wr * 64 + m * 16 + fr;
#pragma unroll
                    for (int bj = 0; bj < 2; ++bj) {
                        const u32x4 g = gg[m * 2 + bj];
                        const f32x4 v0 = acc[ai][bj][m][0] * (f32x4){bflo(g.x), bfhi(g.x), bflo(g.y), bfhi(g.y)};
                        const f32x4 v1 = acc[ai][bj][m][1] * (f32x4){bflo(g.z), bfhi(g.z), bflo(g.w), bfhi(g.w)};
                        u32x4 w; w.x = pk2(v0[0], v0[1]); w.y = pk2(v0[2], v0[3]); w.z = pk2(v1[0], v1[1]); w.w = pk2(v1[2], v1[3]);
                        ST16(rsM, mb, (size_t)row * DM + bj * 32 + cw, w);
                        if (zacc) { acc[ai][bj][m][0] = (f32x4){0.f, 0.f, 0.f, 0.f}; acc[ai][bj][m][1] = (f32x4){0.f, 0.f, 0.f, 0.f}; }
                    }
                }
                asm volatile("" ::: "memory");
            }
        }
    }
};

struct EpiRes {
    static constexpr bool HAS_HOOK = false;
    __device__ __forceinline__ bool dbl(const Unit&) const { return (DBL_EPI & 4) != 0 && rin != H; }
    const float* rin; float* H; bf16_t* hb; float* ssout; int mode; bf16_t* hbd;
    __device__ __forceinline__ void operator()(f32x4 (&acc)[2][2][4][2], const Unit& u, int wid, const bool zacc) const {
        EPI_LANE();
        const int cw = u.pn * 256 + wc * 64 + 8 * fq;
        const auto rsH = RSRC(hb, (size_t)M * XW * 2); (void)rsH;
        if (mode & 1) {
            u32x4 rr[8][2];
#pragma unroll
            for (int q = 0; q < 8; ++q)
#pragma unroll
                for (int bj = 0; bj < 2; ++bj) rr[q][bj] = *(const u32x4*)(hb + (size_t)(u.pm * 256 + (q >> 2) * 128 + wr * 64 + (q & 3) * 16 + fr) * XW + bj * 32 + cw);
            asm volatile("" ::: "memory");
#pragma unroll
            for (int ai = 0; ai < 2; ++ai)
#pragma unroll
                for (int m = 0; m < 4; ++m) {
                    const int row = u.pm * 256 + ai * 128 + wr * 64 + m * 16 + fr;
                    float s = 0.f;
#pragma unroll
                    for (int bj = 0; bj < 2; ++bj) {
                        const size_t o = (size_t)row * DM + bj * 32 + cw;
                        const u32x4 w = rr[ai * 4 + m][bj];
                        const f32x4 v0 = acc[ai][bj][m][0] + (f32x4){bflo(w.x), bfhi(w.x), bflo(w.y), bfhi(w.y)}, v1 = acc[ai][bj][m][1] + (f32x4){bflo(w.z), bfhi(w.z), bflo(w.w), bfhi(w.w)};
                        if (mode & 2) { *(f32x4*)(H + o) = v0; *(f32x4*)(H + o + 4) = v1; }
                        u32x4 wo; wo.x = pk2(v0[0], v0[1]); wo.y = pk2(v0[2], v0[3]); wo.z = pk2(v1[0], v1[1]); wo.w = pk2(v1[2], v1[3]);
                        ST16(rsH, hb, (size_t)row * XW + bj * 32 + cw, wo);
                        if (hbd) *(u32x4*)(hbd + (size_t)row * DM + bj * 32 + cw) = wo;
                        s += (v0[0] * v0[0] + v0[1] * v0[1]) + (v0[2] * v0[2] + v0[3] * v0[3]) + (v1[0] * v1[0] + v1[1] * v1[1]) + (v1[2] * v1[2] + v1[3] * v1[3]);
                        if (zacc) { acc[ai][bj][m][0] = (f32x4){0.f, 0.f, 0.f, 0.f}; acc[ai][bj][m][1] = (f32x4){0.f, 0.f, 0.f, 0.f}; }
                    }
                    s += __shfl_xor(s, 16); s += __shfl_xor(s, 32);
                    if (fq == 0) ssout[(size_t)row * 16 + u.pn * 4 + wc] = s;
                }
            return;
        }
#pragma unroll
        for (int ai = 0; ai < 2; ++ai) {
            f32x4 rr[4][2][2];
#pragma unroll
            for (int m = 0; m < 4; ++m)
#pragma unroll
                for (int bj = 0; bj < 2; ++bj) { const float* rp = rin + (size_t)(u.pm * 256 + ai * 128 + wr * 64 + m * 16 + fr) * DM + bj * 32 + cw; rr[m][bj][0] = *(const f32x4*)rp; rr[m][bj][1] = *(const f32x4*)(rp + 4); }
            asm volatile("" ::: "memory");
#pragma unroll
            for (int m = 0; m < 4; ++m) {
                const int row = u.pm * 256 + ai * 128 + wr * 64 + m * 16 + fr;
                float s = 0.f;
#pragma unroll
                for (int bj = 0; bj < 2; ++bj) {
                    const size_t o = (size_t)row * DM + bj * 32 + cw;
                    const f32x4 v0 = acc[ai][bj][m][0] + rr[m][bj][0], v1 = acc[ai][bj][m][1] + rr[m][bj][1];
                    if (mode & 2) { *(f32x4*)(H + o) = v0; *(f32x4*)(H + o + 4) = v1; }
                    u32x4 w; w.x = pk2(v0[0], v0[1]); w.y = pk2(v0[2], v0[3]); w.z = pk2(v1[0], v1[1]); w.w = pk2(v1[2], v1[3]);
                    ST16(rsH, hb, (size_t)row * XW + bj * 32 + cw, w);
                    if (hbd) *(u32x4*)(hbd + (size_t)row * DM + bj * 32 + cw) = w;
                    s += (v0[0] * v0[0] + v0[1] * v0[1]) + (v0[2] * v0[2] + v0[3] * v0[3]) + (v1[0] * v1[0] + v1[1] * v1[1]) + (v1[2] * v1[2] + v1[3] * v1[3]);
                    if (zacc) { acc[ai][bj][m][0] = (f32x4){0.f, 0.f, 0.f, 0.f}; acc[ai][bj][m][1] = (f32x4){0.f, 0.f, 0.f, 0.f}; }
                }
                s += __shfl_xor(s, 16); s += __shfl_xor(s, 32);
                if (fq == 0) ssout[(size_t)row * 16 + u.pn * 4 + wc] = s;
            }
            asm volatile("" ::: "memory");
        }
    }
};

struct EpiGU {
    static constexpr bool HAS_HOOK = false;
    __device__ __forceinline__ bool dbl(const Unit&) const { return (DBL_EPI & 2) != 0; }
    const float* ss; bf16_t* ff;
    __device__ __forceinline__ void operator()(f32x4 (&acc)[2][2][4][2], const Unit& u, int wid, const bool zacc) const {
        EPI_LANE();
        const int cj = u.pn * 128 + wc * 32 + 8 * fq;
        const auto rsF = RSRC(ff, (size_t)M * DFF * 2); (void)rsF;
        float rs8[8];
        row_rstd8(ss, u.pm * 256 + wr * 64, lane_, fr, rs8);
        asm volatile("" ::: "memory");
#pragma unroll
        for (int ai = 0; ai < 2; ++ai)
#pragma unroll
            for (int m = 0; m < 4; ++m) {
                const int row = u.pm * 256 + ai * 128 + wr * 64 + m * 16 + fr;
                const float rstd = rs8[ai * 4 + m];
                const f32x4 g0 = acc[ai][0][m][0] * rstd, g1 = acc[ai][0][m][1] * rstd, u0 = acc[ai][1][m][0] * rstd, u1 = acc[ai][1][m][1] * rstd;
                u32x4 w; w.x = pk2(fsilu(g0[0]) * u0[0], fsilu(g0[1]) * u0[1]); w.y = pk2(fsilu(g0[2]) * u0[2], fsilu(g0[3]) * u0[3]);
                w.z = pk2(fsilu(g1[0]) * u1[0], fsilu(g1[1]) * u1[1]); w.w = pk2(fsilu(g1[2]) * u1[2], fsilu(g1[3]) * u1[3]);
                ST16(rsF, ff, (size_t)row * DFF + cj, w);
                if (zacc) {
#pragma unroll
                    for (int bj = 0; bj < 2; ++bj) { acc[ai][bj][m][0] = (f32x4){0.f, 0.f, 0.f, 0.f}; acc[ai][bj][m][1] = (f32x4){0.f, 0.f, 0.f, 0.f}; } }
            }
    }
};

struct SchedPlain {
    const char* A; const char* B; int lda, ldb, nt, nM, nN, G, c, kind, pm0;
    __device__ __forceinline__ bool next(int i, Unit& u) const {
        const int L = i * G + c; if (L >= nM * nN) return false;
        tile_of(L, nM, nN, u.pm, u.pn); u.pm += pm0;
        u.A = A + (size_t)u.pm * 256 * lda * 2; u.B = B + (size_t)u.pn * 256 * ldb * 2; u.nt = nt; u.kind = kind; u.aux = 0; return true;
    }
};
struct SchedC {
    const char* X; const char* Wg; const char* Wb; int nM, G, c, pm0;
    __device__ __forceinline__ bool next(int i, Unit& u) const {
        const int j = i >> 2, sub = i & 3, L = j * G + c; if (L >= nM * 4) return false;
        tile_of(L, nM, 4, u.pm, u.pn); u.pm += pm0;
        const bool gate = sub < 3;
        u.A = X + (size_t)u.pm * 256 * XW * 2 + (gate ? 0 : 1024 * 2);
        u.B = gate ? Wg + (size_t)sub * (1024 * KC * 2) + (size_t)u.pn * 256 * KC * 2 : Wb + (size_t)u.pn * 256 * KC * 2;
        u.nt = gate ? 16 : 24; u.kind = gate ? K_GATE : K_BRANCH; u.aux = sub; return true;
    }
};
}
__device__ const double INV_A[8] = {0.15915494309189535, 0.03086376340470123, 0.005985185712713705, 0.001160663641240061, 0.00022507907903927653, 4.364795279280289e-05, 8.464330808241401e-06, 1.6414262627950345e-06};
__device__ const double INV_R[32] = {0.15915494309189535, 0.11934937021124886, 0.08949940160889101, 0.06711508300522726, 0.050329212104487035, 0.03774158471741977, 0.0283021958306234, 0.02122365276477766,
    0.015915494309189534, 0.011934937021124886, 0.008949940160889102, 0.006711508300522725, 0.005032921210448704, 0.003774158471741977, 0.00283021958306234, 0.0021223652764777662,
    0.0015915494309189536, 0.0011934937021124885, 0.0008949940160889102, 0.0006711508300522726, 0.0005032921210448703, 0.00037741584717419774, 0.00028302195830623395, 0.0002122365276477766,
    0.00015915494309189535, 0.00011934937021124886, 8.949940160889102e-05, 6.711508300522725e-05, 5.0329212104487035e-05, 3.774158471741978e-05, 2.8302195830623396e-05, 2.122365276477766e-05};
__device__ __forceinline__ float lg_gamma(int h) { return h == 0 ? -0.04580368961312479f : h == 1 ? -0.02272007650008353f : h == 2 ? -0.011315313227834146f : -0.005646563141142062f; }
__device__ __forceinline__ float ex2(float x) { return __builtin_amdgcn_exp2f(x); }
__device__ __forceinline__ float wave_sum(float v) {
#pragma unroll
    for (int o = 1; o < 64; o <<= 1) v += __shfl_xor(v, o);
    return v;
}
#define LDS_WAIT() asm volatile("s_waitcnt lgkmcnt(0)" ::: "memory")

__device__ __forceinline__ int dst_in(int s) {
    if (s < 640) { const int p = s & 63; return (p < 16) ? (s & ~63) + ((p < 8) ? 2 * p : 2 * (p - 8) + 1) : s; }
    if (s < 768) return s;
    if (s < 1280) { const int p = s & 63; return (s & ~63) + ((p < 32) ? 2 * p : 2 * (p - 32) + 1); }
    if (s < 2816) return s;
    { const int j = (s < 3328) ? s - 2816 : s - 3328; return 2816 + (j >> 5) * 64 + ((s < 3328) ? 0 : 32) + (j & 31); }
}
struct CvDesc { const float* W; size_t ldw; const float* scale; bf16_t* dst; int c0, ld, k0, mode, rmul, radd; };
constexpr int CV_J0 = 3456, CV_J2 = 768, CV_J3 = 512, CV_J4 = 2816, CV_J5 = 1408, CV_PER_LAYER = CV_J0 + CV_J2 + CV_J3 + CV_J4 + CV_J5;
__device__ __forceinline__ CvDesc cv_desc(const Args& a, int it) {
    const int l = it / CV_PER_LAYER; int r = it - l * CV_PER_LAYER;
    bf16_t* Wl = (bf16_t*)(a.ws + WS_W + (size_t)l * WL_SIZE);
    if (r < CV_J0) { const int kb = r / 216, cb = r % 216;
        if (cb < 120) return CvDesc{a.w_in + (size_t)l * DM * DIN, DIN, a.norm_mix + l * DM, Wl + WL_IN / 2, cb * 32, DM, kb * 64, 1, 1, 0};
        return CvDesc{a.w_in + (size_t)l * DM * DIN, DIN, a.norm_mix + l * DM, Wl + WL_C / 2, cb * 32, KC, kb * 64, 0, 1, -3840}; }
    r -= CV_J0;
    if (r < CV_J2) { const int i = r >> 8, kb = (r >> 5) & 7, cb = r & 31;
        return CvDesc{a.w_branch + (size_t)(l * 3 + i) * 512 * DM, DM, nullptr, Wl + WL_B / 2 + i * 512, cb * 32, KC, kb * 64, 0, 1, 0}; }
    r -= CV_J2;
    if (r < CV_J3) { const int kb = r >> 5, cb = r & 31; return CvDesc{a.w_out + (size_t)l * DM * DM, DM, nullptr, Wl + WL_OUT / 2, cb * 32, DM, kb * 64, 0, 1, 0}; }
    r -= CV_J3;
    if (r < CV_J4) { const int up = r / 1408, q = r % 1408, kb = q / 88, cb = q % 88;
        return CvDesc{(up ? a.w_u : a.w_g) + (size_t)l * DM * DFF, DFF, a.norm_ffn + l * DM, Wl + WL_GU / 2, cb * 32, DM, kb * 64, 2, 1, up * 32}; }
    r -= CV_J4;
    { const int kb = r >> 5, cb = r & 31; return CvDesc{a.w_d + (size_t)l * DFF * DM, DM, nullptr, Wl + WL_D / 2, cb * 32, DFF, kb * 64, 0, 1, 0}; }
}
__device__ __forceinline__ void cv_load(const CvDesc& d, int lane, f32x4 (&v)[8], float (&sc)[8]) {
    const int kr = lane >> 3, c4 = lane & 7;
#pragma unroll
    for (int i = 0; i < 8; ++i) { v[i] = *(const f32x4*)(d.W + (size_t)(d.k0 + 8 * i + kr) * d.ldw + d.c0 + 4 * c4); sc[i] = d.scale ? d.scale[d.k0 + 8 * i + kr] : 1.f; }
}
__device__ __forceinline__ void cv_finish(const CvDesc& d, int lane, const f32x4 (&v)[8], const float (&sc)[8], LAS float* scr) {
    const int kr = lane >> 3, c4 = lane & 7;
#pragma unroll
    for (int i = 0; i < 8; ++i) { LAS float* p = scr + (8 * i + kr) * 33 + 4 * c4; p[0] = v[i][0] * sc[i]; p[1] = v[i][1] * sc[i]; p[2] = v[i][2] * sc[i]; p[3] = v[i][3] * sc[i]; }
    LDS_WAIT(); asm volatile("" ::: "memory");
    const int c = lane & 7;
#pragma unroll
    for (int j = 0; j < 4; ++j) { const int n = (lane >> 3) + 8 * j; const LAS float* s = scr + (8 * c) * 33 + n;
        u32x4 o; o.x = pk2(s[0 * 33], s[1 * 33]); o.y = pk2(s[2 * 33], s[3 * 33]); o.z = pk2(s[4 * 33], s[5 * 33]); o.w = pk2(s[6 * 33], s[7 * 33]);
        const int cc = d.c0 + n, row = (d.mode == 2) ? ((cc >> 5) * 64 + d.radd + (cc & 31)) : (d.mode ? dst_in(cc) : cc) * d.rmul + d.radd;
        *(u32x4*)(d.dst + (size_t)row * d.ld + d.k0 + 8 * c) = o; }
    LDS_WAIT(); asm volatile("" ::: "memory");
}
__device__ __forceinline__ void phase_prologue(const Args& a, LAS unsigned char* lds, int G, const int tid) {
    const int lane = tid & 63, wave = tid >> 6;
    const int gw = blockIdx.x * 8 + wave, NGW = G * 8;
    LAS float* scr = (LAS float*)(lds + wave * 16384);
    constexpr int NIT = DEPTH * CV_PER_LAYER;
    if (gw < NIT) {
        CvDesc cur = cv_desc(a, gw); f32x4 v[8]; float sc[8];
        cv_load(cur, lane, v, sc);
        for (int it = gw; it < NIT; it += NGW) {
            const bool more = it + NGW < NIT;
            CvDesc nxt = cv_desc(a, more ? it + NGW : it); f32x4 vn[8]; float scn[8];
            if (more) cv_load(nxt, lane, vn, scn);
            cv_finish(cur, lane, v, sc, scr);
            if (more) { cur = nxt;
#pragma unroll
                for (int i = 0; i < 8; ++i) { v[i] = vn[i]; sc[i] = scn[i]; } }
        }
    }
    bf16_t* X = (bf16_t*)(a.ws + WS_X); float* ss = (float*)(a.ws + WS_SS);
    for (int row = gw; row < M; row += NGW) {
        const f32x4* xr = (const f32x4*)(a.x + (size_t)row * DM) + lane; float s = 0.f;
#pragma unroll
        for (int j = 0; j < 4; ++j) { const f32x4 v = xr[64 * j]; s += (v[0] * v[0] + v[1] * v[1]) + (v[2] * v[2] + v[3] * v[3]);
            u32x2 w; w.x = pk2(v[0], v[1]); w.y = pk2(v[2], v[3]); *(u32x2*)(X + (size_t)row * XW + (64 * j + lane) * 4) = w; }
        s = wave_sum(s); if (lane < 16) ss[(size_t)row * 16 + lane] = (lane == 0) ? s : 0.f;
    }
}

__device__ __forceinline__ void attn_naive(LAS unsigned char* lds, const bf16_t* P, bf16_t* X, const float* sinks, int unit, const int tid) {
    const int b = unit >> 5, n = (unit >> 1) & 15, g = unit & 1;
    LAS bf16_t* Ks = (LAS bf16_t*)lds; LAS bf16_t* Vs = Ks + 256 * 72;
    const long row0 = (long)b * SEQ + n * 128 - 128;
    for (int c = tid; c < 2048; c += 512) {
        const int key = c >> 3, ch = c & 7; u32x4 kv = {0u, 0u, 0u, 0u}, vv = {0u, 0u, 0u, 0u};
        if (n > 0 || key >= 128) { const bf16_t* src = P + (size_t)(row0 + key) * PW + g * 64 + ch * 8; kv = *(const u32x4*)(src + 512); vv = *(const u32x4*)(src + 640); }
        *(LAS u32x4*)(Ks + key * 72 + ch * 8) = kv; *(LAS u32x4*)(Vs + key * 72 + ch * 8) = vv;
    }
    __syncthreads();
    const int r = tid & 127, hq = g * 4 + (tid >> 7);
    const size_t qrow = (size_t)b * SEQ + n * 128 + r;
    float q[64], o[64];
    { const u32x4* qp = (const u32x4*)(P + qrow * PW + hq * 64);
#pragma unroll
      for (int c = 0; c < 8; ++c) { const u32x4 w = qp[c]; q[8 * c] = bflo(w.x); q[8 * c + 1] = bfhi(w.x); q[8 * c + 2] = bflo(w.y); q[8 * c + 3] = bfhi(w.y); q[8 * c + 4] = bflo(w.z); q[8 * c + 5] = bfhi(w.z); q[8 * c + 6] = bflo(w.w); q[8 * c + 7] = bfhi(w.w); } }
#pragma unroll
    for (int d = 0; d < 64; ++d) o[d] = 0.f;
    float mx = sinks[hq] * LOG2E, l = 1.f;
    for (int j = 0; j < 128; ++j) {
        const int kt = r + 1 + j; const bool valid = (n > 0) || (kt >= 128);
        const LAS u32x4* kp = (const LAS u32x4*)(Ks + kt * 72);
        float s = 0.f;
#pragma unroll
        for (int c = 0; c < 8; ++c) { const u32x4 w = kp[c];
            s += q[8 * c] * bflo(w.x) + q[8 * c + 1] * bfhi(w.x) + q[8 * c + 2] * bflo(w.y) + q[8 * c + 3] * bfhi(w.y) + q[8 * c + 4] * bflo(w.z) + q[8 * c + 5] * bfhi(w.z) + q[8 * c + 6] * bflo(w.w) + q[8 * c + 7] * bfhi(w.w); }
        s = valid ? s : -INFINITY;
        const float mn = fmaxf(mx, s), sc = ex2(mx - mn), p = ex2(s - mn);
        l = l * sc + p; mx = mn;
        const LAS u32x4* vp = (const LAS u32x4*)(Vs + kt * 72);
#pragma unroll
        for (int c = 0; c < 8; ++c) { const u32x4 w = vp[c];
            o[8 * c] = o[8 * c] * sc + p * bflo(w.x); o[8 * c + 1] = o[8 * c + 1] * sc + p * bfhi(w.x); o[8 * c + 2] = o[8 * c + 2] * sc + p * bflo(w.y); o[8 * c + 3] = o[8 * c + 3] * sc + p * bfhi(w.y);
            o[8 * c + 4] = o[8 * c + 4] * sc + p * bflo(w.z); o[8 * c + 5] = o[8 * c + 5] * sc + p * bfhi(w.z); o[8 * c + 6] = o[8 * c + 6] * sc + p * bflo(w.w); o[8 * c + 7] = o[8 * c + 7] * sc + p * bfhi(w.w); }
    }
    const float il = 1.f / l;
    u32x4* op = (u32x4*)(X + qrow * XW + 1024 + hq * 64);
#pragma unroll
    for (int c = 0; c < 8; ++c) { u32x4 w; w.x = pk2(o[8 * c] * il, o[8 * c + 1] * il); w.y = pk2(o[8 * c + 2] * il, o[8 * c + 3] * il); w.z = pk2(o[8 * c + 4] * il, o[8 * c + 5] * il); w.w = pk2(o[8 * c + 6] * il, o[8 * c + 7] * il); op[c] = w; }
    __syncthreads();
}

__device__ __forceinline__ void kv_naive(LAS unsigned char* lds, const bf16_t* P, float* kv, int unit, const int tid) {
    const int b = unit >> 6, h = (unit >> 4) & 3, n = unit & 15;
    LAS float* kz = (LAS float*)lds; LAS float* vs = kz + 128 * 64;
    const size_t rowc = (size_t)b * SEQ + n * 128; const float lg = lg_gamma(h);
    for (int i = tid; i < 128 * 8; i += 512) { const int tok = i >> 3, ch = i & 7; const u32x4 w = *(const u32x4*)(P + (rowc + tok) * PW + 1024 + h * 64 + ch * 8); const float z = ex2((float)(127 - tok) * lg);
        LAS float* d = kz + tok * 64 + ch * 8; d[0] = bflo(w.x) * z; d[1] = bfhi(w.x) * z; d[2] = bflo(w.y) * z; d[3] = bfhi(w.y) * z; d[4] = bflo(w.z) * z; d[5] = bfhi(w.z) * z; d[6] = bflo(w.w) * z; d[7] = bfhi(w.w) * z; }
    for (int i = tid; i < 128 * 16; i += 512) { const int tok = i >> 4, ch = i & 15; const u32x4 w = *(const u32x4*)(P + (rowc + tok) * PW + 1280 + h * 128 + ch * 8);
        LAS float* d = vs + tok * 128 + ch * 8; d[0] = bflo(w.x); d[1] = bfhi(w.x); d[2] = bflo(w.y); d[3] = bfhi(w.y); d[4] = bflo(w.z); d[5] = bfhi(w.z); d[6] = bflo(w.w); d[7] = bfhi(w.w); }
    __syncthreads();
    const int e = tid & 127, d0 = (tid >> 7) * 16;
    float acc[16];
#pragma unroll
    for (int dd = 0; dd < 16; ++dd) acc[dd] = 0.f;
    for (int tok = 0; tok < 128; ++tok) { const float vv = vs[tok * 128 + e];
#pragma unroll
        for (int dd = 0; dd < 16; ++dd) acc[dd] += kz[tok * 64 + d0 + dd] * vv; }
#pragma unroll
    for (int dd = 0; dd < 16; ++dd) kv[((size_t)unit * 64 + d0 + dd) * 128 + e] = acc[dd];
    __syncthreads();
}

__device__ __forceinline__ void ret_naive(LAS unsigned char* lds, const bf16_t* P, const float* kv, bf16_t* X, int unit, const int tid) {
    const int b = unit >> 6, h = (unit >> 4) & 3, n = unit & 15;
    LAS float* St = (LAS float*)lds;
    LAS bf16_t* qs = (LAS bf16_t*)(lds + 32768);
    LAS bf16_t* ks = (LAS bf16_t*)(lds + 49152);
    LAS bf16_t* vs = (LAS bf16_t*)(lds + 65536);
    const size_t rowc = (size_t)b * SEQ + n * 128; const float lg = lg_gamma(h);
    { const int e = tid & 127, d0 = (tid >> 7) * 16; float s[16];
#pragma unroll
      for (int dd = 0; dd < 16; ++dd) s[dd] = 0.f;
      for (int j = 0; j < n; ++j) { const float w = ex2((float)((n - 1 - j) * 128) * lg); const float* kj = kv + ((size_t)(unit - n + j) * 64 + d0) * 128 + e;
#pragma unroll
          for (int dd = 0; dd < 16; ++dd) s[dd] += w * kj[dd * 128]; }
#pragma unroll
      for (int dd = 0; dd < 16; ++dd) St[(d0 + dd) * 128 + e] = s[dd]; }
    for (int i = tid; i < 128 * 8; i += 512) { const int tok = i >> 3, ch = i & 7; const bf16_t* src = P + (rowc + tok) * PW + h * 64 + ch * 8;
        *(LAS u32x4*)(qs + tok * 64 + ch * 8) = *(const u32x4*)(src + 768); *(LAS u32x4*)(ks + tok * 64 + ch * 8) = *(const u32x4*)(src + 1024); }
    for (int i = tid; i < 128 * 16; i += 512) { const int tok = i >> 4, ch = i & 15; *(LAS u32x4*)(vs + tok * 128 + ch * 8) = *(const u32x4*)(P + (rowc + tok) * PW + 1280 + h * 128 + ch * 8); }
    __syncthreads();
    const int r = tid >> 2, e0 = (tid & 3) * 32;
    float q[64], y[32];
    { const LAS u32x4* qp = (const LAS u32x4*)(qs + r * 64);
#pragma unroll
      for (int c = 0; c < 8; ++c) { const u32x4 w = qp[c]; q[8 * c] = bflo(w.x); q[8 * c + 1] = bfhi(w.x); q[8 * c + 2] = bflo(w.y); q[8 * c + 3] = bfhi(w.y); q[8 * c + 4] = bflo(w.z); q[8 * c + 5] = bfhi(w.z); q[8 * c + 6] = bflo(w.w); q[8 * c + 7] = bfhi(w.w); } }
#pragma unroll
    for (int ee = 0; ee < 32; ++ee) y[ee] = 0.f;
#pragma unroll 2
    for (int d = 0; d < 64; ++d) { const float qd = bf2f(qs[r * 64 + d]); const LAS f32x4* sp = (const LAS f32x4*)(St + d * 128 + e0);
#pragma unroll
        for (int c = 0; c < 8; ++c) { const f32x4 sv = sp[c]; y[4 * c] += qd * sv[0]; y[4 * c + 1] += qd * sv[1]; y[4 * c + 2] += qd * sv[2]; y[4 * c + 3] += qd * sv[3]; } }
    { const float xi = ex2((float)(r + 1) * lg);
#pragma unroll
      for (int ee = 0; ee < 32; ++ee) y[ee] *= xi; }
    const int rmax = (tid | 63) >> 2;
    for (int kk = 0; kk <= rmax; ++kk) {
        const LAS u32x4* kp = (const LAS u32x4*)(ks + kk * 64);
        float s = 0.f;
#pragma unroll
        for (int c = 0; c < 8; ++c) { const u32x4 w = kp[c];
            s += q[8 * c] * bflo(w.x) + q[8 * c + 1] * bfhi(w.x) + q[8 * c + 2] * bflo(w.y) + q[8 * c + 3] * bfhi(w.y) + q[8 * c + 4] * bflo(w.z) + q[8 * c + 5] * bfhi(w.z) + q[8 * c + 6] * bflo(w.w) + q[8 * c + 7] * bfhi(w.w); }
        const float aw = (kk <= r) ? s * ex2((float)(r - kk) * lg) : 0.f;
        const LAS u32x4* vp = (const LAS u32x4*)(vs + kk * 128 + e0);
#pragma unroll
        for (int c = 0; c < 4; ++c) { const u32x4 w = vp[c];
            y[8 * c] += aw * bflo(w.x); y[8 * c + 1] += aw * bfhi(w.x); y[8 * c + 2] += aw * bflo(w.y); y[8 * c + 3] += aw * bfhi(w.y); y[8 * c + 4] += aw * bflo(w.z); y[8 * c + 5] += aw * bfhi(w.z); y[8 * c + 6] += aw * bflo(w.w); y[8 * c + 7] += aw * bfhi(w.w); }
    }
    float sq = 0.f;
#pragma unroll
    for (int ee = 0; ee < 32; ++ee) sq += y[ee] * y[ee];
    sq += __shfl_xor(sq, 1); sq += __shfl_xor(sq, 2);
    const float rs = rsqrtf(sq * (1.f / 128.f) + EPS);
    const u32x4* gp = (const u32x4*)(P + (rowc + r) * PW + 1792 + h * 128 + e0);
    u32x4* op = (u32x4*)(X + (rowc + r) * XW + 1536 + h * 128 + e0);
#pragma unroll
    for (int c = 0; c < 4; ++c) { const u32x4 gw = gp[c]; u32x4 w;
        w.x = pk2(y[8 * c] * rs * bflo(gw.x), y[8 * c + 1] * rs * bfhi(gw.x)); w.y = pk2(y[8 * c + 2] * rs * bflo(gw.y), y[8 * c + 3] * rs * bfhi(gw.y));
        w.z = pk2(y[8 * c + 4] * rs * bflo(gw.z), y[8 * c + 5] * rs * bfhi(gw.z)); w.w = pk2(y[8 * c + 6] * rs * bflo(gw.w), y[8 * c + 7] * rs * bfhi(gw.w)); op[c] = w; }
    __syncthreads();
}

__device__ __forceinline__ void conv_all(const bf16_t* P, const float* cw, bf16_t* X, int G, int c, int row0, int nrows, const int tid) {
    const int gt = c * 512 + tid, NT = G * 512;
    const f32x4 w0a = *(const f32x4*)(cw + (gt & 63) * 8), w0b = *(const f32x4*)(cw + (gt & 63) * 8 + 4), w1a = *(const f32x4*)(cw + 512 + (gt & 63) * 8), w1b = *(const f32x4*)(cw + 512 + (gt & 63) * 8 + 4),
                w2a = *(const f32x4*)(cw + 1024 + (gt & 63) * 8), w2b = *(const f32x4*)(cw + 1024 + (gt & 63) * 8 + 4);
    for (int i0 = gt; i0 < nrows * 64; i0 += 2 * NT) {
        u32x4 cb[2], u0[2], u1[2], u2[2];
#pragma unroll
        for (int k = 0; k < 2; ++k) { const int i = i0 + k * NT, row = row0 + (i >> 6), ch = i & 63, t = row & (SEQ - 1);
            const bf16_t* p = P + (size_t)row * PW + ch * 8;
            cb[k] = *(const u32x4*)(p + 2304); u0[k] = *(const u32x4*)(p + 2816); u1[k] = (u32x4){0u, 0u, 0u, 0u}; u2[k] = u1[k];
            if (t >= 1) u1[k] = *(const u32x4*)(p + 2816 - PW);
            if (t >= 2) u2[k] = *(const u32x4*)(p + 2816 - 2 * PW); }
#pragma unroll
        for (int k = 0; k < 2; ++k) { const int i = i0 + k * NT, row = row0 + (i >> 6), ch = i & 63;
            u32x4 o;
            o.x = pk2(bflo(cb[k].x) * (w0a[0] * bflo(u2[k].x) + w1a[0] * bflo(u1[k].x) + w2a[0] * bflo(u0[k].x)), bfhi(cb[k].x) * (w0a[1] * bfhi(u2[k].x) + w1a[1] * bfhi(u1[k].x) + w2a[1] * bfhi(u0[k].x)));
            o.y = pk2(bflo(cb[k].y) * (w0a[2] * bflo(u2[k].y) + w1a[2] * bflo(u1[k].y) + w2a[2] * bflo(u0[k].y)), bfhi(cb[k].y) * (w0a[3] * bfhi(u2[k].y) + w1a[3] * bfhi(u1[k].y) + w2a[3] * bfhi(u0[k].y)));
            o.z = pk2(bflo(cb[k].z) * (w0b[0] * bflo(u2[k].z) + w1b[0] * bflo(u1[k].z) + w2b[0] * bflo(u0[k].z)), bfhi(cb[k].z) * (w0b[1] * bfhi(u2[k].z) + w1b[1] * bfhi(u1[k].z) + w2b[1] * bfhi(u0[k].z)));
            o.w = pk2(bflo(cb[k].w) * (w0b[2] * bflo(u2[k].w) + w1b[2] * bflo(u1[k].w) + w2b[2] * bflo(u0[k].w)), bfhi(cb[k].w) * (w0b[3] * bfhi(u2[k].w) + w1b[3] * bfhi(u1[k].w) + w2b[3] * bfhi(u0[k].w)));
            *(u32x4*)(X + (size_t)row * XW + 2048 + ch * 8) = o; }
    }
}

__device__ __forceinline__ void final_norm(float* H, const float* ss, const float* g, int G, int c, int row0, int nrows, const int tid) {
    const int lane = tid & 63, gw = c * 8 + (tid >> 6), NGW = G * 8;
    const f32x4* gr = (const f32x4*)g + lane;
    f32x4 gv[4];
#pragma unroll
    for (int j = 0; j < 4; ++j) gv[j] = gr[64 * j];
    for (int row = row0 + gw; row < row0 + nrows; row += 2 * NGW) {
        f32x4* h0 = (f32x4*)(H + (size_t)row * DM) + lane; f32x4* h1 = (f32x4*)(H + (size_t)(row + NGW) * DM) + lane;
        f32x4 a0[4], a1[4];
#pragma unroll
        for (int j = 0; j < 4; ++j) { a0[j] = h0[64 * j]; a1[j] = h1[64 * j]; }
        const float r0 = pg8::row_rstd(ss, row), r1 = pg8::row_rstd(ss, row + NGW);
#pragma unroll
        for (int j = 0; j < 4; ++j) { h0[64 * j] = a0[j] * r0 * gv[j]; h1[64 * j] = a1[j] * r1 * gv[j]; }
    }
}
#ifndef RET_PROBE
#define RET_PROBE 0
#endif
typedef float f32x16 __attribute__((ext_vector_type(16)));
#define MFMA32(a, b, c) __builtin_amdgcn_mfma_f32_32x32x16_bf16((a), (b), (c), 0, 0, 0)
__device__ __forceinline__ int crow(int i, int hh) { return (i & 3) + 8 * (i >> 2) + 4 * hh; }
__device__ __forceinline__ bf16x8 pack8(const f32x16& v, int s) {
    u32x4 t; t.x = pk2(v[8 * s], v[8 * s + 1]); t.y = pk2(v[8 * s + 2], v[8 * s + 3]); t.z = pk2(v[8 * s + 4], v[8 * s + 5]); t.w = pk2(v[8 * s + 6], v[8 * s + 7]);
    return __builtin_bit_cast(bf16x8, t);
}
__device__ __forceinline__ bf16x8 join8(u32x2 a, u32x2 b) { u32x4 t = {a.x, a.y, b.x, b.y}; return __builtin_bit_cast(bf16x8, t); }
__device__ __forceinline__ void tr_store8(LAS unsigned* T32, int pitch32, int ch, int p, u32x4 w0, u32x4 w1) {
    LAS unsigned* t = T32 + (ch * 8) * pitch32 + (p ^ ((ch & 7) << 2));
    t[0 * pitch32] = (w0.x & 0xffffu) | (w1.x << 16); t[1 * pitch32] = (w0.x >> 16) | (w1.x & 0xffff0000u);
    t[2 * pitch32] = (w0.y & 0xffffu) | (w1.y << 16); t[3 * pitch32] = (w0.y >> 16) | (w1.y & 0xffff0000u);
    t[4 * pitch32] = (w0.z & 0xffffu) | (w1.z << 16); t[5 * pitch32] = (w0.z >> 16) | (w1.z & 0xffff0000u);
    t[6 * pitch32] = (w0.w & 0xffffu) | (w1.w << 16); t[7 * pitch32] = (w0.w >> 16) | (w1.w & 0xffff0000u);
}
__device__ __forceinline__ int tr_off(int c, int pitch32, int d) { return 2 * (c * pitch32 + (d ^ (((c >> 3) & 7) << 2))); }

__device__ __forceinline__ void attn_mfma(LAS unsigned char* lds, const bf16_t* P, bf16_t* X, const float* sinks, int unit, const int tid) {
    const int lane = tid & 63, wid = __builtin_amdgcn_readfirstlane(tid >> 6), r32 = lane & 31, hh = lane >> 5;
    const int b = unit >> 5, n = (unit >> 1) & 15, g = unit & 1;
    LAS bf16_t* Ks = (LAS bf16_t*)lds;
    LAS bf16_t* Vt = Ks + 256 * 72;
    const long row0 = (long)b * SEQ + n * 128 - 128;
    { u32x4 kv[4], w0[2], w1[2];
#pragma unroll
      for (int i = 0; i < 4; ++i) { const int c = tid + 512 * i, key = c >> 3, ch = c & 7; kv[i] = (u32x4){0u, 0u, 0u, 0u};
          if (n > 0 || key >= 128) kv[i] = *(const u32x4*)(P + (size_t)(row0 + key) * PW + 512 + g * 64 + ch * 8); }
#pragma unroll
      for (int i = 0; i < 2; ++i) { const int it = tid + 512 * i, kp = it >> 3, ch = it & 7; w0[i] = (u32x4){0u, 0u, 0u, 0u}; w1[i] = w0[i];
          if (n > 0 || kp >= 64) { const bf16_t* src = P + (size_t)(row0 + 2 * kp) * PW + 640 + g * 64 + ch * 8; w0[i] = *(const u32x4*)src; w1[i] = *(const u32x4*)(src + PW); } }
#pragma unroll
      for (int i = 0; i < 4; ++i) { const int c = tid + 512 * i, key = c >> 3, ch = c & 7; *(LAS u32x4*)(Ks + key * 72 + ch * 8) = kv[i]; }
#pragma unroll
      for (int i = 0; i < 2; ++i) { const int it = tid + 512 * i, kp = it >> 3, ch = it & 7; tr_store8((LAS unsigned*)Vt, 132, ch, kp, w0[i], w1[i]); } }
    const int hq = g * 4 + (wid >> 1);
    const float sink2 = sinks[hq] * LOG2E;
    bf16x8 qfa[2][4];
#pragma unroll
    for (int pass = 0; pass < 2; ++pass) { const bf16_t* qp = P + ((size_t)b * SEQ + n * 128 + (wid & 1) * 64 + pass * 32 + r32) * PW + hq * 64 + 8 * hh;
#pragma unroll
        for (int s = 0; s < 4; ++s) qfa[pass][s] = *(const bf16x8*)(qp + 16 * s); }
    __syncthreads();
#pragma unroll
    for (int pass = 0; pass < 2; ++pass) {
        const int r0 = (wid & 1) * 64 + pass * 32;
        const size_t qrow = (size_t)b * SEQ + n * 128 + r0 + r32;
        const bf16x8 (&qf)[4] = qfa[pass];
        f32x16 S[5];
#pragma unroll
        for (int j = 0; j < 5; ++j) {
#pragma unroll
            for (int i = 0; i < 16; ++i) S[j][i] = 0.f;
            const LAS bf16_t* kp = Ks + (r0 + 32 * j + r32) * 72 + 8 * hh;
#pragma unroll
            for (int s = 0; s < 4; ++s) S[j] = MFMA32(*(const LAS bf16x8*)(kp + 16 * s), qf[s], S[j]);
        }
#pragma unroll
        for (int i = 0; i < 16; ++i) { const int c = crow(i, hh); if (c <= r32) S[0][i] = -INFINITY; if (c > r32) S[4][i] = -INFINITY; }
        if (n == 0) {
#pragma unroll
            for (int j = 0; j < 4; ++j) if (r0 + 32 * j < 128) {
#pragma unroll
                for (int i = 0; i < 16; ++i) S[j][i] = -INFINITY; }
        }
        float mx = sink2;
#pragma unroll
        for (int j = 0; j < 5; ++j)
#pragma unroll
            for (int i = 0; i < 16; ++i) mx = fmaxf(mx, S[j][i]);
        mx = fmaxf(mx, __shfl_xor(mx, 32));
        float l = 0.f;
#pragma unroll
        for (int j = 0; j < 5; ++j)
#pragma unroll
            for (int i = 0; i < 16; ++i) { const float p = ex2(S[j][i] - mx); S[j][i] = p; l += p; }
        l += __shfl_xor(l, 32);
        l += ex2(sink2 - mx);
        f32x16 o[2];
#pragma unroll
        for (int i = 0; i < 16; ++i) { o[0][i] = 0.f; o[1][i] = 0.f; }
#pragma unroll
        for (int j = 0; j < 5; ++j)
#pragma unroll
            for (int s = 0; s < 2; ++s) {
                const bf16x8 pf = pack8(S[j], s);
#pragma unroll
                for (int dt = 0; dt < 2; ++dt) {
                    const int dd = (r0 + 32 * j + 16 * s + 4 * hh) >> 1;
                    o[dt] = MFMA32(join8(*(const LAS u32x2*)(Vt + tr_off(32 * dt + r32, 132, dd)), *(const LAS u32x2*)(Vt + tr_off(32 * dt + r32, 132, dd + 4))), pf, o[dt]);
                }
            }
        const float il = 1.f / l;
        bf16_t* op = X + qrow * XW + 1024 + hq * 64 + 4 * hh;
#pragma unroll
        for (int dt = 0; dt < 2; ++dt)
#pragma unroll
            for (int g4 = 0; g4 < 4; ++g4) { u32x2 w; w.x = pk2(o[dt][4 * g4] * il, o[dt][4 * g4 + 1] * il); w.y = pk2(o[dt][4 * g4 + 2] * il, o[dt][4 * g4 + 3] * il);
                *(u32x2*)(op + 32 * dt + 8 * g4) = w; }
    }
    __syncthreads();
}

__device__ __forceinline__ void kv_mfma(LAS unsigned char* lds, const bf16_t* P, bf16_t* kvT, int unit, const int tid) {
    const int lane = tid & 63, wid = __builtin_amdgcn_readfirstlane(tid >> 6), r32 = lane & 31, hh = lane >> 5;
    const int b = unit >> 6, h = (unit >> 4) & 3, n = unit & 15;
    LAS bf16_t* Kt = (LAS bf16_t*)lds;
    LAS bf16_t* Vt = Kt + 64 * 136;
    const size_t rowc = (size_t)b * SEQ + n * 128; const float lg = lg_gamma(h);
    { const int tp = tid >> 3, ch = tid & 7;
      const bf16_t* src = P + (rowc + 2 * tp) * PW + 1024 + h * 64 + ch * 8; const u32x4 w0 = *(const u32x4*)src, w1 = *(const u32x4*)(src + PW);
      const int tv = tid >> 3, cv = 2 * (tid & 7);
      const bf16_t* sv = P + (rowc + 2 * tv) * PW + 1280 + h * 128 + cv * 8;
      const u32x4 va0 = *(const u32x4*)sv, va1 = *(const u32x4*)(sv + PW), vb0 = *(const u32x4*)(sv + 8), vb1 = *(const u32x4*)(sv + 8 + PW);
      const float z0 = ex2((float)(127 - 2 * tp) * lg), z1 = ex2((float)(126 - 2 * tp) * lg);
      LAS unsigned* t = (LAS unsigned*)Kt + (ch * 8) * 68 + (tp ^ ((ch & 7) << 2));
      t[0 * 68] = pk2(bflo(w0.x) * z0, bflo(w1.x) * z1); t[1 * 68] = pk2(bfhi(w0.x) * z0, bfhi(w1.x) * z1); t[2 * 68] = pk2(bflo(w0.y) * z0, bflo(w1.y) * z1); t[3 * 68] = pk2(bfhi(w0.y) * z0, bfhi(w1.y) * z1);
      t[4 * 68] = pk2(bflo(w0.z) * z0, bflo(w1.z) * z1); t[5 * 68] = pk2(bfhi(w0.z) * z0, bfhi(w1.z) * z1); t[6 * 68] = pk2(bflo(w0.w) * z0, bflo(w1.w) * z1); t[7 * 68] = pk2(bfhi(w0.w) * z0, bfhi(w1.w) * z1);
      tr_store8((LAS unsigned*)Vt, 68, cv, tv, va0, va1); tr_store8((LAS unsigned*)Vt, 68, cv + 1, tv, vb0, vb1); }
    __syncthreads();
    const int et = wid >> 1, dt = wid & 1;
    f32x16 acc;
#pragma unroll
    for (int i = 0; i < 16; ++i) acc[i] = 0.f;
#pragma unroll
    for (int s = 0; s < 8; ++s) acc = MFMA32(*(const LAS bf16x8*)(Kt + tr_off(32 * dt + r32, 68, 8 * s + 4 * hh)), *(const LAS bf16x8*)(Vt + tr_off(32 * et + r32, 68, 8 * s + 4 * hh)), acc);
    bf16_t* o = kvT + ((size_t)unit * 128 + 32 * et + r32) * 64 + 32 * dt + 4 * hh;
#pragma unroll
    for (int g4 = 0; g4 < 4; ++g4) { u32x2 w; w.x = pk2(acc[4 * g4], acc[4 * g4 + 1]); w.y = pk2(acc[4 * g4 + 2], acc[4 * g4 + 3]); *(u32x2*)(o + 8 * g4) = w; }
    __syncthreads();
}

__device__ __forceinline__ void ret_mfma(LAS unsigned char* lds, const bf16_t* P, const bf16_t* kvT, bf16_t* X, int unit, const int tid) {
    const int lane = tid & 63, wid = __builtin_amdgcn_readfirstlane(tid >> 6), r32 = lane & 31, hh = lane >> 5;
    const int b = unit >> 6, h = (unit >> 4) & 3, n = unit & 15;
    LAS bf16_t* St = (LAS bf16_t*)lds;
    LAS bf16_t* Ks = St + 128 * 72;
    LAS bf16_t* Vt = Ks + 128 * 72;
    LAS float* ssq = (LAS float*)(Vt + 128 * 136);
    const size_t rowc = (size_t)b * SEQ + n * 128; const float lg = lg_gamma(h);
    const int rb = wid >> 1, eh = wid & 1;
    const size_t qrow = rowc + 32 * rb + r32;
    bf16x8 qf[4];
    { const bf16_t* qp = P + qrow * PW + 768 + h * 64 + 8 * hh;
#pragma unroll
      for (int s = 0; s < 4; ++s) qf[s] = *(const bf16x8*)(qp + 16 * s);
    }
    {
    u32x4 kst[2], vst0[2], vst1[2];
#pragma unroll
    for (int i = 0; i < 2; ++i) { const int c = tid + 512 * i; kst[i] = *(const u32x4*)(P + (rowc + (c >> 3)) * PW + 1024 + h * 64 + (c & 7) * 8);
        const int it = tid + 512 * i; const bf16_t* src = P + (rowc + 2 * (it >> 4)) * PW + 1280 + h * 128 + (it & 15) * 8; vst0[i] = *(const u32x4*)src; vst1[i] = *(const u32x4*)(src + PW); }
    { const int e = tid >> 2, d0 = (tid & 3) * 16; float s[16];
#pragma unroll
      for (int k = 0; k < 16; ++k) s[k] = 0.f;
      if (n > 0) {
          const u32x4* kb = (const u32x4*)(kvT + ((size_t)(unit - n) * 128 + e) * 64 + d0);
#pragma unroll
          for (int g = 0; g < 2; ++g) {
              const int j0 = 12 * g, nj = g ? 3 : 12;
              if (g && n <= 12) break;
              u32x4 t[12][2];
#pragma unroll
              for (int j = 0; j < 12; ++j) if (j < nj) { const int jj = (j0 + j) < n ? (j0 + j) : n - 1; t[j][0] = kb[(size_t)jj * 1024]; t[j][1] = kb[(size_t)jj * 1024 + 1]; }
#pragma unroll
              for (int j = 0; j < 12; ++j) if (j < nj) { const float w = (j0 + j) < n ? ex2((float)((n - 1 - j0 - j) * 128) * lg) : 0.f;
#pragma unroll
                  for (int q = 0; q < 2; ++q) { const u32x4 v = t[j][q];
                      s[8 * q] += w * bflo(v.x); s[8 * q + 1] += w * bfhi(v.x); s[8 * q + 2] += w * bflo(v.y); s[8 * q + 3] += w * bfhi(v.y);
                      s[8 * q + 4] += w * bflo(v.z); s[8 * q + 5] += w * bfhi(v.z); s[8 * q + 6] += w * bflo(v.w); s[8 * q + 7] += w * bfhi(v.w); } }
          }
      }
      u32x4 w0, w1; w0.x = pk2(s[0], s[1]); w0.y = pk2(s[2], s[3]); w0.z = pk2(s[4], s[5]); w0.w = pk2(s[6], s[7]);
      w1.x = pk2(s[8], s[9]); w1.y = pk2(s[10], s[11]); w1.z = pk2(s[12], s[13]); w1.w = pk2(s[14], s[15]);
      *(LAS u32x4*)(St + e * 72 + d0) = w0; *(LAS u32x4*)(St + e * 72 + d0 + 8) = w1; }
#pragma unroll
    for (int i = 0; i < 2; ++i) { const int c = tid + 512 * i; *(LAS u32x4*)(Ks + (c >> 3) * 72 + (c & 7) * 8) = kst[i]; }
#pragma unroll
    for (int i = 0; i < 2; ++i) { const int it = tid + 512 * i; tr_store8((LAS unsigned*)Vt, 68, it & 15, it >> 4, vst0[i], vst1[i]); }
    __syncthreads();
    }
    {
    u32x2 gw[2][4];
    { const bf16_t* gp = P + qrow * PW + 1792 + h * 128 + 64 * eh + 4 * hh;
#pragma unroll
      for (int et = 0; et < 2; ++et)
#pragma unroll
          for (int g4 = 0; g4 < 4; ++g4) gw[et][g4] = *(const u32x2*)(gp + 32 * et + 8 * g4); }
    f32x16 o[2];
#pragma unroll
    for (int i = 0; i < 16; ++i) { o[0][i] = 0.f; o[1][i] = 0.f; }
#pragma unroll
    for (int et = 0; et < 2; ++et) { const LAS bf16_t* sp = St + (64 * eh + 32 * et + r32) * 72 + 8 * hh;
#pragma unroll
        for (int s = 0; s < 4; ++s) o[et] = MFMA32(*(const LAS bf16x8*)(sp + 16 * s), qf[s], o[et]); }
    { const float xi = ex2((float)(32 * rb + r32 + 1) * lg);
#pragma unroll
      for (int i = 0; i < 16; ++i) { o[0][i] *= xi; o[1][i] *= xi; } }
    for (int kt = 0; kt <= rb; ++kt) {
        f32x16 S;
#pragma unroll
        for (int i = 0; i < 16; ++i) S[i] = 0.f;
        const LAS bf16_t* kp = Ks + (32 * kt + r32) * 72 + 8 * hh;
#pragma unroll
        for (int s = 0; s < 4; ++s) S = MFMA32(*(const LAS bf16x8*)(kp + 16 * s), qf[s], S);
#pragma unroll
        for (int i = 0; i < 16; ++i) { const int diff = 32 * (rb - kt) + r32 - crow(i, hh); S[i] = diff >= 0 ? S[i] * ex2((float)diff * lg) : 0.f; }
#pragma unroll
        for (int s = 0; s < 2; ++s) {
            const bf16x8 pf = pack8(S, s);
#pragma unroll
            for (int et = 0; et < 2; ++et) {
                const int er = 64 * eh + 32 * et + r32, dd = 16 * kt + 8 * s + 2 * hh;
                o[et] = MFMA32(join8(*(const LAS u32x2*)(Vt + tr_off(er, 68, dd)), *(const LAS u32x2*)(Vt + tr_off(er, 68, dd + 4))), pf, o[et]);
            }
        }
    }
    float sq = 0.f;
#pragma unroll
    for (int i = 0; i < 16; ++i) sq += o[0][i] * o[0][i] + o[1][i] * o[1][i];
    sq += __shfl_xor(sq, 32);
    if (hh == 0) ssq[eh * 128 + 32 * rb + r32] = sq;
    __syncthreads();
    const float rs = rsqrtf((ssq[32 * rb + r32] + ssq[128 + 32 * rb + r32]) * (1.f / 128.f) + EPS);
    bf16_t* op = X + qrow * XW + 1536 + h * 128 + 64 * eh + 4 * hh;
#pragma unroll
    for (int et = 0; et < 2; ++et)
#pragma unroll
        for (int g4 = 0; g4 < 4; ++g4) { const u32x2 g = gw[et][g4]; u32x2 w;
            w.x = pk2(o[et][4 * g4] * rs * bflo(g.x), o[et][4 * g4 + 1] * rs * bfhi(g.x)); w.y = pk2(o[et][4 * g4 + 2] * rs * bflo(g.y), o[et][4 * g4 + 3] * rs * bfhi(g.y));
            *(u32x2*)(op + 32 * et + 8 * g4) = w; }
    }
    __syncthreads();
}
#define XB_TMO      128
#define XB_XCNT(j)  (256  + 64 * (j))
#define XB_XSUB(j)  (1280 + 64 * (j))
#define XB_XGEN(j)  (2304 + 64 * (j))
#define XB_TOP      3328
#define XB_TOPGEN   3392
#define XCD_BAR_WORDS 3456
#define XB_SPIN_CAP (1u << 18)
__device__ __forceinline__ unsigned xb_ld(unsigned* p)              { return __hip_atomic_load(p, __ATOMIC_RELAXED, __HIP_MEMORY_SCOPE_AGENT); }
__device__ __forceinline__ unsigned xb_add(unsigned* p, unsigned v) { return __hip_atomic_fetch_add(p, v, __ATOMIC_RELAXED, __HIP_MEMORY_SCOPE_AGENT); }
__device__ __forceinline__ unsigned xb_xcc_id() { return (unsigned)__builtin_amdgcn_s_getreg((3 << 11) | 20) & 0xFu; }
#define XB_SPIN(cond, bar) do { unsigned _sp = 0; while (cond) { __builtin_amdgcn_s_sleep(1); \
    if ((++_sp & 255u) == 0u) { if (xb_ld(&(bar)[XB_TMO])) break; if (_sp > XB_SPIN_CAP) { atomicAdd(&(bar)[XB_TMO], 1u); break; } } } } while (0)
struct XcdBarrier { unsigned* bar; unsigned x; volatile LAS unsigned* st; unsigned nexp; };
__device__ __forceinline__ XcdBarrier xcd_barrier_post(unsigned* bar, volatile LAS unsigned* st, unsigned nexp) {
    XcdBarrier b; b.bar = bar; b.x = xb_xcc_id(); b.st = st; b.nexp = nexp;
    if (threadIdx.x == 0) (void)xb_add(&bar[XB_XCNT(b.x)], 1u);
    return b;
}
__device__ __forceinline__ void xcd_barrier_complete(unsigned* bar, unsigned x, unsigned G, unsigned& nloc, unsigned& nx) {
    unsigned sum, cnt, mine, sp = 0u;
    for (;;) {
        sum = 0u; cnt = 0u; mine = 0u;
#pragma unroll
        for (unsigned j = 0; j < 16; ++j) { const unsigned c = xb_ld(&bar[XB_XCNT(j)]); sum += c; cnt += (c > 0u) ? 1u : 0u; mine = (j == x) ? c : mine; }
        if (sum == G) break;
        __builtin_amdgcn_s_sleep(1);
        if ((++sp & 255u) == 0u) { if (xb_ld(&bar[XB_TMO])) break; if (sp > XB_SPIN_CAP) { atomicAdd(&bar[XB_TMO], 1u); break; } }
    }
    nloc = mine > 0u ? mine : 1u; nx = cnt > 0u ? cnt : 1u;
}
__device__ __forceinline__ void xcd_barrier(const XcdBarrier& b) {
    asm volatile("s_waitcnt vmcnt(0)" ::: "memory");
    __syncthreads();
    if (threadIdx.x == 0) {
        unsigned* bar = b.bar;
        __builtin_amdgcn_s_waitcnt(0);
        unsigned nloc = b.st[0], nx = b.st[1];
        if (nloc == 0u) { xcd_barrier_complete(bar, b.x, b.nexp, nloc, nx); b.st[0] = nloc; b.st[1] = nx; }
        const unsigned old = xb_add(&bar[XB_XSUB(b.x)], 1u);
        const unsigned gen = old / nloc;
        if (old + 1u == (gen + 1u) * nloc) {
            __builtin_amdgcn_fence(__ATOMIC_RELEASE, "agent");
            asm volatile("s_waitcnt vmcnt(0)" ::: "memory");
            const unsigned og = xb_add(&bar[XB_TOP], 1u);
            const unsigned tg = og / nx;
            if (og + 1u == (tg + 1u) * nx) xb_add(&bar[XB_TOPGEN], 1u);
            else XB_SPIN(xb_ld(&bar[XB_TOPGEN]) == tg, bar);
            __builtin_amdgcn_fence(__ATOMIC_ACQUIRE, "agent");
            xb_add(&bar[XB_XGEN(b.x)], 1u);
            asm volatile("s_waitcnt vmcnt(0)" ::: "memory");
        } else {
            XB_SPIN(xb_ld(&bar[XB_XGEN(b.x)]) == gen, bar);
            __builtin_amdgcn_fence(__ATOMIC_ACQUIRE, "agent");
            asm volatile("s_waitcnt vmcnt(0)" ::: "memory");
        }
    }
    __syncthreads();
}

constexpr int NPH = 30;
#ifndef PHM
#define PHM 0x1ff
#endif
#ifndef MIX_NAIVE
#define MIX_NAIVE 0
#endif
#ifndef RES_BF16
#define RES_BF16 1
#endif
#ifndef HBD_EXP
#define HBD_EXP 0
#endif
#ifndef B1_PROBE
#define B1_PROBE 0
#endif
#ifndef DBL_BAR
#define DBL_BAR 0
#endif
#ifndef DBLM
#define DBLM 0
#endif
#ifndef MK_NG
#define MK_NG 1
#endif
#ifndef MK_STAGGER
#define MK_STAGGER 1500
#endif
__global__ void __launch_bounds__(512, 2) mk_fwd(Args a) {
    extern __shared__ __attribute__((aligned(16))) unsigned char lds_raw[];
    LAS unsigned char* lds = (LAS unsigned char*)lds_raw;
    const int Gall = gridDim.x, call = blockIdx.x;
    constexpr int NG = MK_NG, MG = M / NG;
    const int grp = (call >> 3) % NG, c = ((call >> 3) / NG) * 8 + (call & 7), G = Gall / NG;
    const int row0 = grp * MG, pm0 = grp * (MG / 256);
    volatile LAS unsigned* MISC = (volatile LAS unsigned*)(lds + MISC_OFF);
    if (threadIdx.x < 32) MISC[threadIdx.x] = 0u;
    __syncthreads();
    unsigned* ctl = (unsigned*)(a.ws + WS_CTL);
    const bool multi = (a.ph_hi - a.ph_lo) > 1;
    XcdBarrier barAll, bar; barAll.bar = ctl + 4096; barAll.x = 0; barAll.st = nullptr; barAll.nexp = 0; bar = barAll;
    if (multi) { barAll = xcd_barrier_post(ctl + 4096, MISC + 8, (unsigned)Gall);
                 bar = (NG == 1) ? barAll : xcd_barrier_post(ctl + 4096 + (1 + grp) * XCD_BAR_WORDS, MISC + 10, (unsigned)G); }

    bf16_t* X = (bf16_t*)(a.ws + WS_X); bf16_t* P = (bf16_t*)(a.ws + WS_P); float* ss = (float*)(a.ws + WS_SS);
#if MIX_NAIVE & 2
    float* kvb = (float*)(a.ws + WS_KV);
#else
    bf16_t* kvb = (bf16_t*)(a.ws + WS_KV);
#endif
    for (int ph = a.ph_lo; ph < a.ph_hi; ++ph) {
        const int kind_ = (ph == 0) ? 0 : (ph == NPH - 1) ? 1 : 2 + (ph - 1) % 7;
        for (int rep_ = 0; rep_ < (((DBLM >> kind_) & 1) ? 2 : 1); ++rep_) {
        if (rep_) __syncthreads();
        int tid = threadIdx.x; asm volatile("" : "+v"(tid));
        if (ph == 0) { if (PHM & 1) phase_prologue(a, lds, Gall, tid); }
        else if (ph == NPH - 1) { if (PHM & 2) final_norm(a.out, ss + (size_t)8 * M * 16, a.norm_final, G, c, row0, MG, tid); }
        else {
            const int l = (ph - 1) / 7, sub = (ph - 1) % 7;
            const char* Wl = (const char*)(a.ws + WS_W + (size_t)l * WL_SIZE);
            if (sub == 0 && (PHM & 4)) {
                pg8::SchedPlain S{(const char*)X, Wl + WL_IN, XW, DM, DM / 64, MG / 256, NIN / 256, G, c, pg8::K_IN, pm0};
                pg8::EpiIn E{P, ss + (size_t)(2 * l) * M * 16};
                pg8::gemm_phase(lds, XW, DM, S, E, tid);
            } else if (sub == 1 && (PHM & 8)) {
#if MIX_NAIVE & 1
                for (int u = c; u < 256 / NG; u += G) attn_naive(lds, P, X, a.sinks + l * 8, grp * (256 / NG) + u, tid);
#else
                for (int rr_ = 0; rr_ < ((B1_PROBE & 1) ? 2 : 1); ++rr_)
                for (int u = c; u < 256 / NG; u += G) attn_mfma(lds, P, X, a.sinks + l * 8, grp * (256 / NG) + u, tid);
#endif
#if MIX_NAIVE & 2
                for (int u = c; u < 512 / NG; u += G) kv_naive(lds, P, kvb, grp * (512 / NG) + u, tid);
#else
                for (int rr_ = 0; rr_ < ((B1_PROBE & 2) ? 2 : 1); ++rr_)
                for (int u = c; u < 512 / NG; u += G) kv_mfma(lds, P, kvb, grp * (512 / NG) + u, tid);
#endif
                for (int rr_ = 0; rr_ < ((B1_PROBE & 4) ? 2 : 1); ++rr_)
                conv_all(P, a.conv_w + l * 3 * 512, X, G, c, row0, MG, tid);
            } else if (sub == 2 && (PHM & 16)) {
#if MIX_NAIVE & 2
                for (int u = c; u < 512 / NG; u += G) ret_naive(lds, P, kvb, X, grp * (512 / NG) + u, tid);
#else
                for (int u = c; u < 512 / NG; u += G) ret_mfma(lds, P, kvb, X, grp * (512 / NG) + ((u < 256 / NG) ? u : (u & ~15) | (15 - (u & 15))), tid);
#endif
            } else if (sub == 3 && (PHM & 32)) {
                pg8::SchedC S{(const char*)X, Wl + WL_C, Wl + WL_B, MG / 256, G, c, pm0};
                pg8::EpiC E{ss + (size_t)(2 * l) * M * 16, a.b_gate + l * 3 * DM, (u32x4*)(a.ws + WS_GS) + (size_t)call * 8192, (u32x4*)(a.ws + WS_MACC) + (size_t)call * 16384, (bf16_t*)(a.ws + WS_MB)};
                pg8::gemm_phase(lds, XW, KC, S, E, tid);
            } else if (sub == 4 && (PHM & 64)) {
                pg8::SchedPlain S{(const char*)(a.ws + WS_MB), Wl + WL_OUT, DM, DM, DM / 64, MG / 256, DM / 256, G, c, pg8::K_RES, pm0};
                pg8::EpiRes E{l == 0 ? a.x : a.out, a.out, X, ss + (size_t)(2 * l + 1) * M * 16, RES_BF16 ? (l == 0 ? 0 : 1) : 2, HBD_EXP ? (bf16_t*)(a.ws + 398 * MiB) : nullptr};
                pg8::gemm_phase(lds, DM, DM, S, E, tid);
            } else if (sub == 5 && (PHM & 128)) {
                const int ldE = HBD_EXP ? DM : XW;
                pg8::SchedPlain S{HBD_EXP ? (const char*)(a.ws + 398 * MiB) : (const char*)X, Wl + WL_GU, ldE, DM, DM / 64, MG / 256, NGU / 256, G, c, pg8::K_GU, pm0};
                pg8::EpiGU E{ss + (size_t)(2 * l + 1) * M * 16, (bf16_t*)(a.ws + WS_FF)};
                pg8::gemm_phase(lds, ldE, DM, S, E, tid);
            } else if (sub == 6 && (PHM & 256)) {
                pg8::SchedPlain S{(const char*)(a.ws + WS_FF), Wl + WL_D, DFF, DFF, DFF / 64, MG / 256, DM / 256, G, c, pg8::K_RES, pm0};
                pg8::EpiRes E{a.out, a.out, X, ss + (size_t)(2 * l + 2) * M * 16, RES_BF16 ? (l == DEPTH - 1 ? 3 : 1) : 2, nullptr};
                pg8::gemm_phase(lds, DFF, DFF, S, E, tid);
            }
        }
        }
        if (ph + 1 < a.ph_hi) {
            if (ph == 0) { xcd_barrier(barAll);
                if (NG > 1 && grp > 0) { const unsigned long long t0 = __builtin_amdgcn_s_memrealtime(); while (__builtin_amdgcn_s_memrealtime() - t0 < (unsigned long long)(grp * MK_STAGGER)) __builtin_amdgcn_s_sleep(8); } }
            else xcd_barrier(bar);
#if DBL_BAR
            xcd_barrier(bar);
#endif
        }
    }
}

#ifndef MK_SINGLE
#define MK_SINGLE 0
#endif
extern "C" void kernel_launch(void* const* d_in, const int* in_sizes, int n_in, void* d_out, int out_size, void* d_ws, size_t ws_size, hipStream_t stream) {
    static int grid = 0;
    if (grid == 0) {
        if (n_in != 13 || out_size != M * DM || ws_size < WS_END) { fprintf(stderr, "kernel_launch: unexpected shapes (n_in %d, out %d, ws %zu)\n", n_in, out_size, ws_size); grid = -1; return; }
        int dev = 0, cus = 0, per_cu = 0;
        if (hipGetDevice(&dev) != hipSuccess || hipDeviceGetAttribute(&cus, hipDeviceAttributeMultiprocessorCount, dev) != hipSuccess) { grid = -1; return; }
        if (hipFuncSetAttribute((const void*)mk_fwd, hipFuncAttributeMaxDynamicSharedMemorySize, LDS_BYTES) != hipSuccess) { fprintf(stderr, "kernel_launch: hipFuncSetAttribute failed\n"); grid = -1; return; }
        if (hipOccupancyMaxActiveBlocksPerMultiprocessor(&per_cu, (const void*)mk_fwd, 512, LDS_BYTES) != hipSuccess || per_cu < 1) { fprintf(stderr, "kernel_launch: occupancy query says %d\n", per_cu); per_cu = 1; }
        (void)hipGetLastError();
        grid = cus;
        if (grid > 256) grid = 256;
    }
    if (grid < 0) return;
    (void)hipMemsetAsync((char*)d_ws + WS_CTL, 0, CTL_ZERO_BYTES, stream);
    Args a{};
    a.x = (const float*)d_in[0]; a.norm_mix = (const float*)d_in[1]; a.w_in = (const float*)d_in[2]; a.sinks = (const float*)d_in[3]; a.conv_w = (const float*)d_in[4];
    a.w_branch = (const float*)d_in[5]; a.b_gate = (const float*)d_in[6]; a.w_out = (const float*)d_in[7]; a.norm_ffn = (const float*)d_in[8];
    a.w_g = (const float*)d_in[9]; a.w_u = (const float*)d_in[10]; a.w_d = (const float*)d_in[11]; a.norm_final = (const float*)d_in[12];
    a.out = (float*)d_out; a.ws = (unsigned char*)d_ws;
#if MK_SINGLE
    a.ph_lo = 0; a.ph_hi = NPH;
    hipLaunchKernelGGL(mk_fwd, dim3(grid), dim3(512), LDS_BYTES, stream, a);
#else
    for (int ph = 0; ph < NPH; ++ph) { a.ph_lo = ph; a.ph_hi = ph + 1; hipLaunchKernelGGL(mk_fwd, dim3(grid), dim3(512), LDS_BYTES, stream, a); }
#endif
}
```

```cpp
#include <hip/hip_runtime.h>
#include <cstdio>
#include <cstdint>

#define LAS __attribute__((address_space(3)))
#define GAS __attribute__((address_space(1)))
typedef unsigned short bf16_t;
typedef short bf16x8 __attribute__((ext_vector_type(8)));
typedef float f32x4 __attribute__((ext_vector_type(4)));
typedef float f32x2 __attribute__((ext_vector_type(2)));
typedef unsigned u32x4 __attribute__((ext_vector_type(4)));
typedef unsigned u32x2 __attribute__((ext_vector_type(2)));
typedef __bf16 bf16x2_t __attribute__((ext_vector_type(2)));

constexpr int BATCH = 8, SEQ = 2048, DM = 1024, M = BATCH * SEQ, DEPTH = 4, DFF = 2816, DIN = 6912;
constexpr int PW = 3328;
constexpr int XW = 2560;
constexpr int NIN = 3840;
constexpr int NGU = 2 * DFF;
constexpr int KC = 1536;
constexpr float EPS = 1e-6f;
constexpr float LOG2E = 1.4426950408889634f;
constexpr float QSCALE = 0.18033688011112042f;

constexpr size_t MiB = 1u << 20;
constexpr size_t WS_CTL = 0, CTL_ZERO_BYTES = 262144;
constexpr size_t WS_SS = 388 * MiB;
constexpr size_t WS_TABA = 2 * MiB;
constexpr size_t WS_TABR = 2 * MiB + 131072;
constexpr size_t WS_W = 4 * MiB;
constexpr size_t WL_IN = 0, WL_C = 7864320, WL_B = 17301504, WL_OUT = 20447232, WL_GU = 22544384, WL_D = 34078720, WL_SIZE = 39845888;
constexpr size_t WS_X = 156 * MiB;
constexpr size_t WS_P = 236 * MiB;
constexpr size_t WS_MACC = WS_P, WS_MB = WS_P + 64 * MiB, WS_FF = WS_P;
constexpr size_t WS_GS = 340 * MiB;
constexpr size_t WS_KV = 372 * MiB;
constexpr size_t WS_END = 398 * MiB;
static_assert(WS_W + DEPTH * WL_SIZE <= WS_X, "weights");
static_assert((size_t)M * XW * 2 <= 80 * MiB && (size_t)M * PW * 2 <= 104 * MiB && (size_t)M * DFF * 2 <= 104 * MiB, "buffers");

constexpr int RING_BYTES = 131072, LDS_BYTES = 147456, MISC_OFF = RING_BYTES + 320;

__device__ __forceinline__ unsigned pk2(float lo, float hi) { f32x2 v = {lo, hi}; bf16x2_t b = __builtin_convertvector(v, bf16x2_t); return __builtin_bit_cast(unsigned, b); }
__device__ __forceinline__ float bflo(unsigned u) { return __uint_as_float(u << 16); }
__device__ __forceinline__ float bfhi(unsigned u) { return __uint_as_float(u & 0xffff0000u); }
__device__ __forceinline__ float bf2f(bf16_t b) { return __uint_as_float((unsigned)b << 16); }
__device__ __forceinline__ float fsilu(float x) { return x * __builtin_amdgcn_rcpf(1.f + __builtin_amdgcn_exp2f(-x * LOG2E)); }
__device__ __forceinline__ float fsigm(float x) { return __builtin_amdgcn_rcpf(1.f + __builtin_amdgcn_exp2f(-x * LOG2E)); }

struct Args {
    const float* x; const float* norm_mix; const float* w_in; const float* sinks; const float* conv_w; const float* w_branch; const float* b_gate; const float* w_out;
    const float* norm_ffn; const float* w_g; const float* w_u; const float* w_d; const float* norm_final;
    float* out; unsigned char* ws; int ph_lo, ph_hi;
};
#define MK_SINGLE 1
#ifndef DBL_EPI
#define DBL_EPI 0
#endif
namespace pg8 {
constexpr int BM = 256, BK = 64, HALF = 128, HTB = HALF * BK * 2  , STAGE_BYTES = 8 * HTB, NXCD = 8, WGM = 8;

__host__ __device__ __forceinline__ int lds_byte(int r, int c) { const int st = (r >> 4) * 2 + (c >> 5), rr = r & 15, cc = c & 31, ob = rr * 64 + cc * 2; return st * 1024 + (ob ^ (((ob >> 9) & 1) << 5)); }
__host__ __device__ __forceinline__ void stage_rc(int b, int& R, int& C) { const int st = b / 1024, sb = b % 1024, swz = sb ^ (((sb >> 9) & 1) << 5); R = (st >> 1) * 16 + swz / 64; C = (st & 1) * 32 + (swz % 64) / 2; }
__host__ __device__ __forceinline__ int perm32(int rho) { const int n = rho >> 4, i = rho & 15; return 8 * (i >> 2) + 4 * n + (i & 3); }

struct Unit { const char* A; const char* B; int nt, pm, pn, kind, aux; };

__device__ __forceinline__ void tile_of(int L, int nM, int nN, int& pm, int& pn) {
    const int nwg = nM * nN; int wgid = L;
    { const int q = nwg / NXCD, r = nwg % NXCD, xcd = wgid % NXCD, off = wgid / NXCD; wgid = (xcd < r ? xcd * (q + 1) : r * (q + 1) + (xcd - r) * q) + off; }
    const int nig = WGM * nN, gid = wgid / nig, fm = gid * WGM, gsz = (nM - fm) < WGM ? (nM - fm) : WGM;
    pm = fm + ((wgid % nig) % gsz); pn = (wgid % nig) / gsz;
}

template <class Epi, class Sched>
__device__ __forceinline__ void gemm_phase(LAS unsigned char* lds, const int lda, const int ldb, const Sched& S, const Epi& E, const int tid) {
    const int wid = __builtin_amdgcn_readfirstlane(tid >> 6), lane = tid & 63, wr = wid >> 2, wc = wid & 3, fr = lane & 15, fq = lane >> 4;
    unsigned voffA[2], voffB[2];
#pragma unroll
    for (int i = 0; i < 2; ++i) { int R, C; stage_rc(tid * 16 + i * 8192, R, C); const int Rb = 2 * (R & ~31) + perm32(R & 31);
        voffA[i] = (unsigned)(R * lda + C) * 2u; voffB[i] = (unsigned)(Rb * ldb + C) * 2u; }
    const size_t kstep = (size_t)(BK * 2);
    const size_t hstepA = (size_t)HALF * lda * 2, hstepB = (size_t)32 * ldb * 2;
    const unsigned ldsw = (unsigned)wid * 1024u;
    const int aoff = lds_byte(wr * 64 + fr, fq * 8), boff = lds_byte(wc * 32 + fr, fq * 8);
#define PG8_SA(b, h) (((b) * 2 + (h)) * HTB)
#define PG8_SB(b, h) ((4 + (b) * 2 + (h)) * HTB)
#define PG8_STAGE(bufoff, gbase, voff) do { _Pragma("unroll") for (int _i = 0; _i < 2; ++_i) \
        __builtin_amdgcn_global_load_lds((const unsigned*)((const char*)(gbase) + (voff)[_i]), (LAS unsigned*)(lds + (bufoff) + ldsw + _i * 8192), 16, 0, 0); } while (0)
#define PG8_LDA(dst, b, h) do { _Pragma("unroll") for (int m = 0; m < 4; ++m) _Pragma("unroll") for (int k = 0; k < 2; ++k) dst[m][k] = *(const LAS bf16x8*)(lds + PG8_SA(b, h) + aoff + m * 2048 + k * 1024); } while (0)
#define PG8_LDB(dst, b, h) do { _Pragma("unroll") for (int n = 0; n < 2; ++n) _Pragma("unroll") for (int k = 0; k < 2; ++k) dst[n][k] = *(const LAS bf16x8*)(lds + PG8_SB(b, h) + boff + n * 2048 + k * 1024); } while (0)
#define PG8_MMA(ai, bj, At, Bt) do { __builtin_amdgcn_s_setprio(1); _Pragma("unroll") for (int m = 0; m < 4; ++m) _Pragma("unroll") for (int n = 0; n < 2; ++n) _Pragma("unroll") for (int k = 0; k < 2; ++k) \
        acc[ai][bj][m][n] = __builtin_amdgcn_mfma_f32_16x16x32_bf16(Bt[n][k], At[m][k], acc[ai][bj][m][n], 0, 0, 0); __builtin_amdgcn_s_setprio(0); } while (0)
#define PG8_WAIT_V(n) asm volatile("s_waitcnt vmcnt(" #n ")" ::: "memory")
#define PG8_WAIT_L(n) asm volatile("s_waitcnt lgkmcnt(" #n ")" ::: "memory")
#define PG8_BAR __builtin_amdgcn_s_barrier()
#define PG8_SCHED __builtin_amdgcn_sched_barrier(0)
    Unit cur, nxt; int ui = 0;
    if (!S.next(0, cur)) return;
    f32x4 acc[2][2][4][2];
#pragma unroll
    for (int a = 0; a < 2; ++a)
#pragma unroll
        for (int b = 0; b < 2; ++b)
#pragma unroll
            for (int m = 0; m < 4; ++m)
#pragma unroll
                for (int n = 0; n < 2; ++n) acc[a][b][m][n] = (f32x4){0.f, 0.f, 0.f, 0.f};
    bf16x8 At[4][2], B0[2][2], B1[2][2];
    const char* cA = cur.A; const char* cB = cur.B;
    PG8_STAGE(PG8_SB(0, 0), cB, voffB); PG8_STAGE(PG8_SB(0, 1), cB + hstepB, voffB); PG8_STAGE(PG8_SA(0, 0), cA, voffA); PG8_STAGE(PG8_SA(0, 1), cA + hstepA, voffA);
    if (wr == 1) PG8_BAR;
    PG8_WAIT_V(2); PG8_BAR;
    PG8_STAGE(PG8_SB(1, 0), cB + kstep, voffB); PG8_STAGE(PG8_SA(1, 0), cA + kstep, voffA); PG8_STAGE(PG8_SB(1, 1), cB + hstepB + kstep, voffB);
    PG8_WAIT_V(6); PG8_BAR;
    for (;;) {
        const bool has_next = S.next(ui + 1, nxt);
        const char* nA = has_next ? nxt.A : cA; const char* nB = has_next ? nxt.B : cB;
        const int nt = cur.nt;
        for (int t = 0; t < nt; t += 2) {
            const bool last = (t == nt - 2);
            if constexpr (Epi::HAS_HOOK) E.hook(acc, cur, t, wid);
            const char* a1 = cA + (size_t)(t + 1) * kstep;
            const char* a2 = last ? nA : cA + (size_t)(t + 2) * kstep; const char* b2 = last ? nB : cB + (size_t)(t + 2) * kstep;
            const char* a3 = a2 + kstep; const char* b3 = b2 + kstep;
            PG8_LDB(B0, 0, 0); PG8_LDB(B1, 0, 1); PG8_SCHED; PG8_LDA(At, 0, 0); PG8_STAGE(PG8_SA(1, 1), a1 + hstepA, voffA);
            PG8_WAIT_V(8); PG8_WAIT_L(0); PG8_BAR; PG8_MMA(0, 0, At, B0); PG8_MMA(0, 1, At, B1); PG8_BAR; PG8_SCHED;
            PG8_LDA(At, 0, 1); PG8_STAGE(PG8_SB(0, 0), b2, voffB); PG8_STAGE(PG8_SB(0, 1), b2 + hstepB, voffB); PG8_STAGE(PG8_SA(0, 0), a2, voffA);
            PG8_WAIT_V(8); PG8_WAIT_L(0); PG8_BAR; PG8_MMA(1, 0, At, B0); PG8_MMA(1, 1, At, B1); PG8_BAR; PG8_SCHED;
            PG8_LDB(B0, 1, 0); PG8_LDB(B1, 1, 1); PG8_SCHED; PG8_LDA(At, 1, 0); PG8_STAGE(PG8_SA(0, 1), a2 + hstepA, voffA);
            PG8_WAIT_V(8); PG8_WAIT_L(0); PG8_BAR; PG8_MMA(0, 0, At, B0); PG8_MMA(0, 1, At, B1); PG8_BAR; PG8_SCHED;
            PG8_LDA(At, 1, 1); PG8_STAGE(PG8_SB(1, 0), b3, voffB); PG8_STAGE(PG8_SB(1, 1), b3 + hstepB, voffB); PG8_STAGE(PG8_SA(1, 0), a3, voffA);
            PG8_WAIT_V(8); PG8_WAIT_L(0); PG8_BAR; PG8_MMA(1, 0, At, B0); PG8_MMA(1, 1, At, B1); PG8_BAR; PG8_SCHED;
        }
        if (wr == 0) PG8_BAR;
#if DBL_EPI
        if (E.dbl(cur)) { E(acc, cur, wid, false); asm volatile("" ::: "memory"); }
#endif
        E(acc, cur, wid, true);
        if (!has_next) break;
        cur = nxt; cA = nA; cB = nB; ++ui;
        if (wr == 1) PG8_BAR;
    }
    PG8_WAIT_V(0);
    PG8_BAR;
#undef PG8_SA
#undef PG8_SB
#undef PG8_STAGE
#undef PG8_LDA
#undef PG8_LDB
#undef PG8_MMA
#undef PG8_WAIT_V
#undef PG8_WAIT_L
#undef PG8_BAR
#undef PG8_SCHED
}
}
namespace pg8 {
#ifndef EPIC_TEST
#define EPIC_TEST(x) (x)
#endif
__device__ __forceinline__ float row_rstd(const float* ss, int row) {
    const f32x4* p = (const f32x4*)(ss + (size_t)row * 16); const f32x4 a = p[0], b = p[1], c = p[2], d = p[3];
    const float s = ((a[0] + a[1]) + (a[2] + a[3])) + ((b[0] + b[1]) + (b[2] + b[3])) + (((c[0] + c[1]) + (c[2] + c[3])) + ((d[0] + d[1]) + (d[2] + d[3])));
    return rsqrtf(s * (1.f / DM) + EPS);
}
#ifndef USE_NT
#define USE_NT 0
#endif
#if USE_NT
#define NT_STORE(p, v) __builtin_nontemporal_store((v), (p))
#else
#define NT_STORE(p, v) (*(p) = (v))
#endif
#ifndef WT_STORES
#define WT_STORES 0
#endif
#if WT_STORES
#define RSRC(ptr, bytes) __builtin_amdgcn_make_buffer_rsrc((void*)(ptr), (short)0, (int)(bytes), 0x00020000)
#define ST16(rs, base, elt_off, v) __builtin_amdgcn_raw_buffer_store_b128((v), (rs), (unsigned)((elt_off) * sizeof(*(base))), 0, 16)
#else
#define RSRC(ptr, bytes) 0
#define ST16(rs, base, elt_off, v) (*(u32x4*)((base) + (elt_off)) = (v))
#endif
#define EPI_LANE() const int lane_ = (int)__builtin_amdgcn_mbcnt_hi(~0u, __builtin_amdgcn_mbcnt_lo(~0u, 0u)); const int wr = wid >> 2, wc = wid & 3, fr = lane_ & 15, fq = lane_ >> 4, tid = wid * 64 + lane_; (void)wr; (void)wc; (void)fr; (void)fq; (void)tid
__device__ __forceinline__ void row_rstd8(const float* ss, int rbase, int lane, int fr, float (&rs)[8]) {
    const float a = row_rstd(ss, rbase + lane), b = row_rstd(ss, rbase + 128 + lane);
#pragma unroll
    for (int m = 0; m < 4; ++m) { rs[m] = __shfl(a, m * 16 + fr); rs[4 + m] = __shfl(b, m * 16 + fr); }
}
enum { K_IN = 0, K_GATE = 1, K_BRANCH = 2, K_RES = 3, K_GU = 4 };

__device__ __forceinline__ void rot1(float& a, float& b, float rev) {
    const float fr_ = rev - floorf(rev), c = __builtin_amdgcn_cosf(fr_), s = __builtin_amdgcn_sinf(fr_);
    const float na = a * c - b * s, nb = b * c + a * s; a = na; b = nb;
}
__device__ __forceinline__ f32x4 rot4(f32x4 v, f32x4 t) { return (f32x4){v[0] * t[0] - v[1] * t[1], v[1] * t[0] + v[0] * t[1], v[2] * t[2] - v[3] * t[3], v[3] * t[2] + v[2] * t[3]}; }

struct EpiIn {
    static constexpr bool HAS_HOOK = false;
    __device__ __forceinline__ bool dbl(const Unit&) const { return (DBL_EPI & 1) != 0; }
    bf16_t* P; const float* ss;
    __device__ __forceinline__ void operator()(f32x4 (&acc)[2][2][4][2], const Unit& u, int wid, const bool zacc) const {
        EPI_LANE();
        const int pn = u.pn;
        const auto rsP = RSRC(P, (size_t)M * PW * 2); (void)rsP;
        const int cw = wc * 64 + 8 * fq;
        float ivA[4], ivR[4];
#pragma unroll
        for (int j = 0; j < 4; ++j) { ivA[j] = __builtin_amdgcn_exp2f(-(float)(4 * (fq & 1) + j) * (18.931568569324174f / 8.f)) * 0.15915494309189535f;
                                      ivR[j] = __builtin_amdgcn_exp2f(-(float)(4 * fq + j) * (13.287712379549449f / 32.f)) * 0.15915494309189535f; }
        float rs8[8];
        row_rstd8(ss, u.pm * 256 + wr * 64, lane_, fr, rs8);
#pragma unroll
        for (int ai = 0; ai < 2; ++ai)
#pragma unroll
            for (int m = 0; m < 4; ++m) {
                const int row = u.pm * 256 + ai * 128 + wr * 64 + m * 16 + fr;
                const float rstd = rs8[ai * 4 + m];
                const float fpos = (float)(row & (SEQ - 1));
#pragma unroll
                for (int bj = 0; bj < 2; ++bj) {
                    f32x4 v0 = acc[ai][bj][m][0] * rstd, v1 = acc[ai][bj][m][1] * rstd;
                    const int gc = pn * 256 + bj * 32 + cw;
                    if (pn >= 11) {
                        if (bj == 0) { const f32x4 x0 = acc[ai][1][m][0] * rstd, x1 = acc[ai][1][m][1] * rstd;
                            u32x4 w; w.x = pk2(v0[0] * x0[0], v0[1] * x0[1]); w.y = pk2(v0[2] * x0[2], v0[3] * x0[3]); w.z = pk2(v1[0] * x1[0], v1[1] * x1[1]); w.w = pk2(v1[2] * x1[2], v1[3] * x1[3]);
                            ST16(rsP, P, (size_t)row * PW + 2816 + (pn - 11) * 128 + wc * 32 + 8 * fq, w); }
                    } else {
                        if (pn < 2 || (pn == 2 && wc < 2)) {
                            if (bj == 0 && fq < 2) {
                                float x[8] = {v0[0], v0[1], v0[2], v0[3], v1[0], v1[1], v1[2], v1[3]};
#pragma unroll
                                for (int j = 0; j < 4; ++j) rot1(x[2 * j], x[2 * j + 1], fpos * ivA[j]);
                                v0 = (f32x4){x[0], x[1], x[2], x[3]}; v1 = (f32x4){x[4], x[5], x[6], x[7]};
                            }
                            if (pn < 2) { v0 = v0 * QSCALE; v1 = v1 * QSCALE; }
                        } else if (pn == 3 || pn == 4) {
                            float x[8] = {v0[0], v0[1], v0[2], v0[3], v1[0], v1[1], v1[2], v1[3]};
#pragma unroll
                            for (int j = 0; j < 4; ++j) rot1(x[2 * j], x[2 * j + 1], fpos * (bj ? ivR[j] * 0.01f : ivR[j]));
                            v0 = (f32x4){x[0], x[1], x[2], x[3]}; v1 = (f32x4){x[4], x[5], x[6], x[7]};
                            if (pn == 4) { v0 = v0 * 0.125f; v1 = v1 * 0.125f; }
                        } else if (pn == 7 || pn == 8) {
#pragma unroll
                            for (int j = 0; j < 4; ++j) { v0[j] = fsilu(v0[j]); v1[j] = fsilu(v1[j]); }
                        }
                        u32x4 w; w.x = pk2(v0[0], v0[1]); w.y = pk2(v0[2], v0[3]); w.z = pk2(v1[0], v1[1]); w.w = pk2(v1[2], v1[3]);
                        ST16(rsP, P, (size_t)row * PW + gc, w);
                    }
                    if (zacc) { acc[ai][bj][m][0] = (f32x4){0.f, 0.f, 0.f, 0.f}; acc[ai][bj][m][1] = (f32x4){0.f, 0.f, 0.f, 0.f}; }
                }
                asm volatile("" ::: "memory");
            }
    }
};

struct EpiC {
    static constexpr bool HAS_HOOK = true;
    __device__ __forceinline__ bool dbl(const Unit&) const { return false; }
    const float* ss; const float* bg; u32x4* G0; u32x4* G12; bf16_t* mb;
    __device__ __forceinline__ u32x4* gbuf(int br) const { return br == 0 ? G0 : G12 + (size_t)(br - 1) * 8192; }
    __device__ __forceinline__ void hook(f32x4 (&acc)[2][2][4][2], const Unit& u, int t, int wid) const {
        if (u.kind != K_BRANCH || (t != 8 && t != 16)) return;
        EPI_LANE();
        const int br = (t >> 3) - 1;
        const u32x4* Ga = gbuf(br); const u32x4* Gb = gbuf(br + 1);
#pragma unroll
        for (int ai = 0; ai < 2; ++ai) {
            u32x4 ga[8], gb[8];
#pragma unroll
            for (int q = 0; q < 8; ++q) { ga[q] = Ga[(unsigned)((ai * 8 + q) * 512 + tid)]; gb[q] = Gb[(unsigned)((ai * 8 + q) * 512 + tid)]; }
            asm volatile("" ::: "memory");
#pragma unroll
            for (int m = 0; m < 4; ++m)
#pragma unroll
                for (int bj = 0; bj < 2; ++bj) {
                    const u32x4 a_ = ga[m * 2 + bj], b_ = gb[m * 2 + bj];
                    f32x4 d0 = (f32x4){bflo(b_.x), bfhi(b_.x), bflo(b_.y), bfhi(b_.y)}, d1 = (f32x4){bflo(b_.z), bfhi(b_.z), bflo(b_.w), bfhi(b_.w)};
#pragma unroll
                    for (int j = 0; j < 4; ++j) { d0[j] = __builtin_amdgcn_rcpf(fmaxf(d0[j], 1e-30f)); d1[j] = __builtin_amdgcn_rcpf(fmaxf(d1[j], 1e-30f)); }
                    acc[ai][bj][m][0] = acc[ai][bj][m][0] * ((f32x4){bflo(a_.x), bfhi(a_.x), bflo(a_.y), bfhi(a_.y)} * d0);
                    acc[ai][bj][m][1] = acc[ai][bj][m][1] * ((f32x4){bflo(a_.z), bfhi(a_.z), bflo(a_.w), bfhi(a_.w)} * d1);
                }
            asm volatile("" ::: "memory");
        }
    }
    __device__ __forceinline__ void operator()(f32x4 (&acc)[2][2][4][2], const Unit& u, int wid, const bool zacc) const {
        EPI_LANE();
        const int cw = u.pn * 256 + wc * 64 + 8 * fq;
        if (EPIC_TEST(u.kind == K_GATE)) {
            const int br = u.aux;
            const float* b = bg + br * DM + cw; u32x4* Gw = gbuf(br);
            float rs8[8];
            row_rstd8(ss, u.pm * 256 + wr * 64, lane_, fr, rs8);
            const f32x4 bv00 = *(const f32x4*)(b), bv01 = *(const f32x4*)(b + 4), bv10 = *(const f32x4*)(b + 32), bv11 = *(const f32x4*)(b + 36);
            asm volatile("" ::: "memory");
#pragma unroll
            for (int ai = 0; ai < 2; ++ai)
#pragma unroll
                for (int m = 0; m < 4; ++m) {
                    const float rstd = rs8[ai * 4 + m];
#pragma unroll
                    for (int bj = 0; bj < 2; ++bj) {
                        f32x4 v0 = acc[ai][bj][m][0] * rstd + (bj ? bv10 : bv00), v1 = acc[ai][bj][m][1] * rstd + (bj ? bv11 : bv01);
#pragma unroll
                        for (int j = 0; j < 4; ++j) { v0[j] = fsigm(v0[j]); v1[j] = fsigm(v1[j]); }
                        u32x4 w; w.x = pk2(v0[0], v0[1]); w.y = pk2(v0[2], v0[3]); w.z = pk2(v1[0], v1[1]); w.w = pk2(v1[2], v1[3]);
                        Gw[(unsigned)(((ai * 4 + m) * 2 + bj) * 512 + tid)] = w;
                        if (zacc) { acc[ai][bj][m][0] = (f32x4){0.f, 0.f, 0.f, 0.f}; acc[ai][bj][m][1] = (f32x4){0.f, 0.f, 0.f, 0.f}; }
                    }
                    asm volatile("" ::: "memory");
                }
        } else {
            const u32x4* Ga = gbuf(2);
            const auto rsM = RSRC(mb, (size_t)M * DM * 2); (void)rsM;
#pragma unroll
            for (int ai = 0; ai < 2; ++ai) {
                u32x4 gg[8];
#pragma unroll
                for (int q = 0; q < 8; ++q) gg[q] = Ga[(unsigned)((ai * 8 + q) * 512 + tid)];
                asm volatile("" ::: "memory");
#pragma unroll
                for (int m = 0; m < 4; ++m) {
                    const int row = u.pm * 256 + ai * 128 + wr * 64 + m * 16 + fr;
#pragma unroll
                    for (int bj = 0; bj < 2; ++bj) {
                        const u32x4 g = gg[m * 2 + bj];
                        const f32x4 v0 = acc[ai][bj][m][0] * (f32x4){bflo(g.x), bfhi(g.x), bflo(g.y), bfhi(g.y)};
                        const f32x4 v1 = acc[ai][bj][m][1] * (f32x4){bflo(g.z), bfhi(g.z), bflo(g.w), bfhi(g.w)};
                        u32x4 w; w.x = pk2(v0[0], v0[1]); w.y = pk2(v0[2], v0[3]); w.z = pk2(v1[0], v1[1]); w.w = pk2(v1[2], v1[3]);
                        ST16(rsM, mb, (size_t)row * DM + bj * 32 + cw, w);
                        if (zacc) { acc[ai][bj][m][0] = (f32x4){0.f, 0.f, 0.f, 0.f}; acc[ai][bj][m][1] = (f32x4){0.f, 0.f, 0.f, 0.f}; }
                    }
                }
                asm volatile("" ::: "memory");
            }
        }
    }
};

struct EpiRes {
    static constexpr bool HAS_HOOK = false;
    __device__ __forceinline__ bool dbl(const Unit&) const { return (DBL_EPI & 4) != 0 && rin != H; }
    const float* rin; float* H; bf16_t* hb; float* ssout; int mode; bf16_t* hbd;
    __device__ __forceinline__ void operator()(f32x4 (&acc)[2][2][4][2], const Unit& u, int wid, const bool zacc) const {
        EPI_LANE();
        const int cw = u.pn * 256 + wc * 64 + 8 * fq;
        const auto rsH = RSRC(hb, (size_t)M * XW * 2); (void)rsH;
        if (mode & 1) {
            u32x4 rr[8][2];
#pragma unroll
            for (int q = 0; q < 8; ++q)
#pragma unroll
                for (int bj = 0; bj < 2; ++bj) rr[q][bj] = *(const u32x4*)(hb + (size_t)(u.pm * 256 + (q >> 2) * 128 + wr * 64 + (q & 3) * 16 + fr) * XW + bj * 32 + cw);
            asm volatile("" ::: "memory");
#pragma unroll
            for (int ai = 0; ai < 2; ++ai)
#pragma unroll
                for (int m = 0; m < 4; ++m) {
                    const int row = u.pm * 256 + ai * 128 + wr * 64 + m * 16 + fr;
                    float s = 0.f;
#pragma unroll
                    for (int bj = 0; bj < 2; ++bj) {
                        const size_t o = (size_t)row * DM + bj * 32 + cw;
                        const u32x4 w = rr[ai * 4 + m][bj];
                        const f32x4 v0 = acc[ai][bj][m][0] + (f32x4){bflo(w.x), bfhi(w.x), bflo(w.y), bfhi(w.y)}, v1 = acc[ai][bj][m][1] + (f32x4){bflo(w.z), bfhi(w.z), bflo(w.w), bfhi(w.w)};
                        if (mode & 2) { *(f32x4*)(H + o) = v0; *(f32x4*)(H + o + 4) = v1; }
                        u32x4 wo; wo.x = pk2(v0[0], v0[1]); wo.y = pk2(v0[2], v0[3]); wo.z = pk2(v1[0], v1[1]); wo.w = pk2(v1[2], v1[3]);
                        ST16(rsH, hb, (size_t)row * XW + bj * 32 + cw, wo);
                        if (hbd) *(u32x4*)(hbd + (size_t)row * DM + bj * 32 + cw) = wo;
                        s += (v0[0] * v0[0] + v0[1] * v0[1]) + (v0[2] * v0[2] + v0[3] * v0[3]) + (v1[0] * v1[0] + v1[1] * v1[1]) + (v1[2] * v1[2] + v1[3] * v1[3]);
                        if (zacc) { acc[ai][bj][m][0] = (f32x4){0.f, 0.f, 0.f, 0.f}; acc[ai][bj][m][1] = (f32x4){0.f, 0.f, 0.f, 0.f}; }
                    }
                    s += __shfl_xor(s, 16); s += __shfl_xor(s, 32);
                    if (fq == 0) ssout[(size_t)row * 16 + u.pn * 4 + wc] = s;
                }
            return;
        }
#pragma unroll
        for (int ai = 0; ai < 2; ++ai) {
            f32x4 rr[4][2][2];
#pragma unroll
            for (int m = 0; m < 4; ++m)
#pragma unroll
                for (int bj = 0; bj < 2; ++bj) { const float* rp = rin + (size_t)(u.pm * 256 + ai * 128 + wr * 64 + m * 16 + fr) * DM + bj * 32 + cw; rr[m][bj][0] = *(const f32x4*)rp; rr[m][bj][1] = *(const f32x4*)(rp + 4); }
            asm volatile("" ::: "memory");
#pragma unroll
            for (int m = 0; m < 4; ++m) {
                const int row = u.pm * 256 + ai * 128 + wr * 64 + m * 16 + fr;
                float s = 0.f;
#pragma unroll
                for (int bj = 0; bj < 2; ++bj) {
                    const size_t o = (size_t)row * DM + bj * 32 + cw;
                    const f32x4 v0 = acc[ai][bj][m][0] + rr[m][bj][0], v1 = acc[ai][bj][m][1] + rr[m][bj][1];
                    if (mode & 2) { *(f32x4*)(H + o) = v0; *(f32x4*)(H + o + 4) = v1; }
                    u32x4 w; w.x = pk2(v0[0], v0[1]); w.y = pk2(v0[2], v0[3]); w.z = pk2(v1[0], v1[1]); w.w = pk2(v1[2], v1[3]);
                    ST16(rsH, hb, (size_t)row * XW + bj * 32 + cw, w);
                    if (hbd) *(u32x4*)(hbd + (size_t)row * DM + bj * 32 + cw) = w;
                    s += (v0[0] * v0[0] + v0[1] * v0[1]) + (v0[2] * v0[2] + v0[3] * v0[3]) + (v1[0] * v1[0] + v1[1] * v1[1]) + (v1[2] * v1[2] + v1[3] * v1[3]);
                    if (zacc) { acc[ai][bj][m][0] = (f32x4){0.f, 0.f, 0.f, 0.f}; acc[ai][bj][m][1] = (f32x4){0.f, 0.f, 0.f, 0.f}; }
                }
                s += __shfl_xor(s, 16); s += __shfl_xor(s, 32);
                if (fq == 0) ssout[(size_t)row * 16 + u.pn * 4 + wc] = s;
            }
            asm volatile("" ::: "memory");
        }
    }
};

struct EpiGU {
    static constexpr bool HAS_HOOK = false;
    __device__ __forceinline__ bool dbl(const Unit&) const { return (DBL_EPI & 2) != 0; }
    const float* ss; bf16_t* ff;
    __device__ __forceinline__ void operator()(f32x4 (&acc)[2][2][4][2], const Unit& u, int wid, const bool zacc) const {
        EPI_LANE();
        const int cj = u.pn * 128 + wc * 32 + 8 * fq;
        const auto rsF = RSRC(ff, (size_t)M * DFF * 2); (void)rsF;
        float rs8[8];
        row_rstd8(ss, u.pm * 256 + wr * 64, lane_, fr, rs8);
        asm volatile("" ::: "memory");
#pragma unroll
        for (int ai = 0; ai < 2; ++ai)
#pragma unroll
            for (int m = 0; m < 4; ++m) {
                const int row = u.pm * 256 + ai * 128 + wr * 64 + m * 16 + fr;
                const float rstd = rs8[ai * 4 + m];
                const f32x4 g0 = acc[ai][0][m][0] * rstd, g1 = acc[ai][0][m][1] * rstd, u0 = acc[ai][1][m][0] * rstd, u1 = acc[ai][1][m][1] * rstd;
                u32x4 w; w.x = pk2(fsilu(g0[0]) * u0[0], fsilu(g0[1]) * u0[1]); w.y = pk2(fsilu(g0[2]) * u0[2], fsilu(g0[3]) * u0[3]);
                w.z = pk2(fsilu(g1[0]) * u1[0], fsilu(g1[1]) * u1[1]); w.w = pk2(fsilu(g1[2]) * u1[2], fsilu(g1[3]) * u1[3]);
                ST16(rsF, ff, (size_t)row * DFF + cj, w);
                if (zacc) {
#pragma unroll
                    for (int bj = 0; bj < 2; ++bj) { acc[ai][bj][m][0] = (f32x4){0.f, 0.f, 0.f, 0.f}; acc[ai][bj][m][1] = (f32x4){0.f, 0.f, 0.f, 0.f}; } }
            }
    }
};

struct SchedPlain {
    const char* A; const char* B; int lda, ldb, nt, nM, nN, G, c, kind, pm0;
    __device__ __forceinline__ bool next(int i, Unit& u) const {
        const int L = i * G + c; if (L >= nM * nN) return false;
        tile_of(L, nM, nN, u.pm, u.pn); u.pm += pm0;
        u.A = A + (size_t)u.pm * 256 * lda * 2; u.B = B + (size_t)u.pn * 256 * ldb * 2; u.nt = nt; u.kind = kind; u.aux = 0; return true;
    }
};
struct SchedC {
    const char* X; const char* Wg; const char* Wb; int nM, G, c, pm0;
    __device__ __forceinline__ bool next(int i, Unit& u) const {
        const int j = i >> 2, sub = i & 3, L = j * G + c; if (L >= nM * 4) return false;
        tile_of(L, nM, 4, u.pm, u.pn); u.pm += pm0;
        const bool gate = sub < 3;
        u.A = X + (size_t)u.pm * 256 * XW * 2 + (gate ? 0 : 1024 * 2);
        u.B = gate ? Wg + (size_t)sub * (1024 * KC * 2) + (size_t)u.pn * 256 * KC * 2 : Wb + (size_t)u.pn * 256 * KC * 2;
        u.nt = gate ? 16 : 24; u.kind = gate ? K_GATE : K_BRANCH; u.aux = sub; return true;
    }
};
}
__device__ const double INV_A[8] = {0.15915494309189535, 0.03086376340470123, 0.005985185712713705, 0.001160663641240061, 0.00022507907903927653, 4.364795279280289e-05, 8.464330808241401e-06, 1.6414262627950345e-06};
__device__ const double INV_R[32] = {0.15915494309189535, 0.11934937021124886, 0.08949940160889101, 0.06711508300522726, 0.050329212104487035, 0.03774158471741977, 0.0283021958306234, 0.02122365276477766,
    0.015915494309189534, 0.011934937021124886, 0.008949940160889102, 0.006711508300522725, 0.005032921210448704, 0.003774158471741977, 0.00283021958306234, 0.0021223652764777662,
    0.0015915494309189536, 0.0011934937021124885, 0.0008949940160889102, 0.0006711508300522726, 0.0005032921210448703, 0.00037741584717419774, 0.00028302195830623395, 0.0002122365276477766,
    0.00015915494309189535, 0.00011934937021124886, 8.949940160889102e-05, 6.711508300522725e-05, 5.0329212104487035e-05, 3.774158471741978e-05, 2.8302195830623396e-05, 2.122365276477766e-05};
__device__ __forceinline__ float lg_gamma(int h) { return h == 0 ? -0.04580368961312479f : h == 1 ? -0.02272007650008353f : h == 2 ? -0.011315313227834146f : -0.005646563141142062f; }
__device__ __forceinline__ float ex2(float x) { return __builtin_amdgcn_exp2f(x); }
__device__ __forceinline__ float wave_sum(float v) {
#pragma unroll
    for (int o = 1; o < 64; o <<= 1) v += __shfl_xor(v, o);
    return v;
}
#define LDS_WAIT() asm volatile("s_waitcnt lgkmcnt(0)" ::: "memory")

__device__ __forceinline__ int dst_in(int s) {
    if (s < 640) { const int p = s & 63; return (p < 16) ? (s & ~63) + ((p < 8) ? 2 * p : 2 * (p - 8) + 1) : s; }
    if (s < 768) return s;
    if (s < 1280) { const int p = s & 63; return (s & ~63) + ((p < 32) ? 2 * p : 2 * (p - 32) + 1); }
    if (s < 2816) return s;
    { const int j = (s < 3328) ? s - 2816 : s - 3328; return 2816 + (j >> 5) * 64 + ((s < 3328) ? 0 : 32) + (j & 31); }
}
struct CvDesc { const float* W; size_t ldw; const float* scale; bf16_t* dst; int c0, ld, k0, mode, rmul, radd; };
constexpr int CV_J0 = 3456, CV_J2 = 768, CV_J3 = 512, CV_J4 = 2816, CV_J5 = 1408, CV_PER_LAYER = CV_J0 + CV_J2 + CV_J3 + CV_J4 + CV_J5;
__device__ __forceinline__ CvDesc cv_desc(const Args& a, int it) {
    const int l = it / CV_PER_LAYER; int r = it - l * CV_PER_LAYER;
    bf16_t* Wl = (bf16_t*)(a.ws + WS_W + (size_t)l * WL_SIZE);
    if (r < CV_J0) { const int kb = r / 216, cb = r % 216;
        if (cb < 120) return CvDesc{a.w_in + (size_t)l * DM * DIN, DIN, a.norm_mix + l * DM, Wl + WL_IN / 2, cb * 32, DM, kb * 64, 1, 1, 0};
        return CvDesc{a.w_in + (size_t)l * DM * DIN, DIN, a.norm_mix + l * DM, Wl + WL_C / 2, cb * 32, KC, kb * 64, 0, 1, -3840}; }
    r -= CV_J0;
    if (r < CV_J2) { const int i = r >> 8, kb = (r >> 5) & 7, cb = r & 31;
        return CvDesc{a.w_branch + (size_t)(l * 3 + i) * 512 * DM, DM, nullptr, Wl + WL_B / 2 + i * 512, cb * 32, KC, kb * 64, 0, 1, 0}; }
    r -= CV_J2;
    if (r < CV_J3) { const int kb = r >> 5, cb = r & 31; return CvDesc{a.w_out + (size_t)l * DM * DM, DM, nullptr, Wl + WL_OUT / 2, cb * 32, DM, kb * 64, 0, 1, 0}; }
    r -= CV_J3;
    if (r < CV_J4) { const int up = r / 1408, q = r % 1408, kb = q / 88, cb = q % 88;
        return CvDesc{(up ? a.w_u : a.w_g) + (size_t)l * DM * DFF, DFF, a.norm_ffn + l * DM, Wl + WL_GU / 2, cb * 32, DM, kb * 64, 2, 1, up * 32}; }
    r -= CV_J4;
    { const int kb = r >> 5, cb = r & 31; return CvDesc{a.w_d + (size_t)l * DFF * DM, DM, nullptr, Wl + WL_D / 2, cb * 32, DFF, kb * 64, 0, 1, 0}; }
}
__device__ __forceinline__ void cv_load(const CvDesc& d, int lane, f32x4 (&v)[8], float (&sc)[8]) {
    const int kr = lane >> 3, c4 = lane & 7;
#pragma unroll
    for (int i = 0; i < 8; ++i) { v[i] = *(const f32x4*)(d.W + (size_t)(d.k0 + 8 * i + kr) * d.ldw + d.c0 + 4 * c4); sc[i] = d.scale ? d.scale[d.k0 + 8 * i + kr] : 1.f; }
}
__device__ __forceinline__ void cv_finish(const CvDesc& d, int lane, const f32x4 (&v)[8], const float (&sc)[8], LAS float* scr) {
    const int kr = lane >> 3, c4 = lane & 7;
#pragma unroll
    for (int i = 0; i < 8; ++i) { LAS float* p = scr + (8 * i + kr) * 33 + 4 * c4; p[0] = v[i][0] * sc[i]; p[1] = v[i][1] * sc[i]; p[2] = v[i][2] * sc[i]; p[3] = v[i][3] * sc[i]; }
    LDS_WAIT(); asm volatile("" ::: "memory");
    const int c = lane & 7;
#pragma unroll
    for (int j = 0; j < 4; ++j) { const int n = (lane >> 3) + 8 * j; const LAS float* s = scr + (8 * c) * 33 + n;
        u32x4 o; o.x = pk2(s[0 * 33], s[1 * 33]); o.y = pk2(s[2 * 33], s[3 * 33]); o.z = pk2(s[4 * 33], s[5 * 33]); o.w = pk2(s[6 * 33], s[7 * 33]);
        const int cc = d.c0 + n, row = (d.mode == 2) ? ((cc >> 5) * 64 + d.radd + (cc & 31)) : (d.mode ? dst_in(cc) : cc) * d.rmul + d.radd;
        *(u32x4*)(d.dst + (size_t)row * d.ld + d.k0 + 8 * c) = o; }
    LDS_WAIT(); asm volatile("" ::: "memory");
}
__device__ __forceinline__ void cv_range(const Args& a, LAS unsigned char* lds, int it0, int it1, int widx, int nw, const int tid) {
    const int lane = tid & 63, wave = tid >> 6;
    LAS float* scr = (LAS float*)(lds + wave * 16384);
    const int first = it0 + widx;
    if (first < it1) {
        CvDesc cur = cv_desc(a, first); f32x4 v[8]; float sc[8];
        cv_load(cur, lane, v, sc);
        for (int it = first; it < it1; it += nw) {
            const bool more = it + nw < it1;
            CvDesc nxt = cv_desc(a, more ? it + nw : it); f32x4 vn[8]; float scn[8];
            if (more) cv_load(nxt, lane, vn, scn);
            cv_finish(cur, lane, v, sc, scr);
            if (more) { cur = nxt;
#pragma unroll
                for (int i = 0; i < 8; ++i) { v[i] = vn[i]; sc[i] = scn[i]; } }
        }
    }
}
__device__ __forceinline__ void cv_fill(const Args& a, LAS unsigned char* lds, int layer, int it0, int it1, int total_units, int G, int c, const int tid) {
    const int rem = total_units % G; const int first_idle = rem ? rem : G;
    const int nidle = rem ? G - rem : G, idx = rem ? c - first_idle : c;
    if (idx < 0) return;
    cv_range(a, lds, layer * CV_PER_LAYER + it0, layer * CV_PER_LAYER + it1, idx * 8 + (tid >> 6), nidle * 8, tid);
}
#ifndef CV_LAZY
#define CV_LAZY 1
#endif
constexpr int CV_SPLIT = 2240;
__device__ __forceinline__ void phase_prologue(const Args& a, LAS unsigned char* lds, int G, const int tid) {
    const int lane = tid & 63, wave = tid >> 6;
    const int gw = blockIdx.x * 8 + wave, NGW = G * 8;
    cv_range(a, lds, 0, (CV_LAZY ? 1 : DEPTH) * CV_PER_LAYER, gw, NGW, tid);
    bf16_t* X = (bf16_t*)(a.ws + WS_X); float* ss = (float*)(a.ws + WS_SS);
    for (int row = gw; row < M; row += NGW) {
        const f32x4* xr = (const f32x4*)(a.x + (size_t)row * DM) + lane; float s = 0.f;
#pragma unroll
        for (int j = 0; j < 4; ++j) { const f32x4 v = xr[64 * j]; s += (v[0] * v[0] + v[1] * v[1]) + (v[2] * v[2] + v[3] * v[3]);
            u32x2 w; w.x = pk2(v[0], v[1]); w.y = pk2(v[2], v[3]); *(u32x2*)(X + (size_t)row * XW + (64 * j + lane) * 4) = w; }
        s = wave_sum(s); if (lane < 16) ss[(size_t)row * 16 + lane] = (lane == 0) ? s : 0.f;
    }
}

__device__ __forceinline__ void attn_naive(LAS unsigned char* lds, const bf16_t* P, bf16_t* X, const float* sinks, int unit, const int tid) {
    const int b = unit >> 5, n = (unit >> 1) & 15, g = unit & 1;
    LAS bf16_t* Ks = (LAS bf16_t*)lds; LAS bf16_t* Vs = Ks + 256 * 72;
    const long row0 = (long)b * SEQ + n * 128 - 128;
    for (int c = tid; c < 2048; c += 512) {
        const int key = c >> 3, ch = c & 7; u32x4 kv = {0u, 0u, 0u, 0u}, vv = {0u, 0u, 0u, 0u};
        if (n > 0 || key >= 128) { const bf16_t* src = P + (size_t)(row0 + key) * PW + g * 64 + ch * 8; kv = *(const u32x4*)(src + 512); vv = *(const u32x4*)(src + 640); }
        *(LAS u32x4*)(Ks + key * 72 + ch * 8) = kv; *(LAS u32x4*)(Vs + key * 72 + ch * 8) = vv;
    }
    __syncthreads();
    const int r = tid & 127, hq = g * 4 + (tid >> 7);
    const size_t qrow = (size_t)b * SEQ + n * 128 + r;
    float q[64], o[64];
    { const u32x4* qp = (const u32x4*)(P + qrow * PW + hq * 64);
#pragma unroll
      for (int c = 0; c < 8; ++c) { const u32x4 w = qp[c]; q[8 * c] = bflo(w.x); q[8 * c + 1] = bfhi(w.x); q[8 * c + 2] = bflo(w.y); q[8 * c + 3] = bfhi(w.y); q[8 * c + 4] = bflo(w.z); q[8 * c + 5] = bfhi(w.z); q[8 * c + 6] = bflo(w.w); q[8 * c + 7] = bfhi(w.w); } }
#pragma unroll
    for (int d = 0; d < 64; ++d) o[d] = 0.f;
    float mx = sinks[hq] * LOG2E, l = 1.f;
    for (int j = 0; j < 128; ++j) {
        const int kt = r + 1 + j; const bool valid = (n > 0) || (kt >= 128);
        const LAS u32x4* kp = (const LAS u32x4*)(Ks + kt * 72);
        float s = 0.f;
#pragma unroll
        for (int c = 0; c < 8; ++c) { const u32x4 w = kp[c];
            s += q[8 * c] * bflo(w.x) + q[8 * c + 1] * bfhi(w.x) + q[8 * c + 2] * bflo(w.y) + q[8 * c + 3] * bfhi(w.y) + q[8 * c + 4] * bflo(w.z) + q[8 * c + 5] * bfhi(w.z) + q[8 * c + 6] * bflo(w.w) + q[8 * c + 7] * bfhi(w.w); }
        s = valid ? s : -INFINITY;
        const float mn = fmaxf(mx, s), sc = ex2(mx - mn), p = ex2(s - mn);
        l = l * sc + p; mx = mn;
        const LAS u32x4* vp = (const LAS u32x4*)(Vs + kt * 72);
#pragma unroll
        for (int c = 0; c < 8; ++c) { const u32x4 w = vp[c];
            o[8 * c] = o[8 * c] * sc + p * bflo(w.x); o[8 * c + 1] = o[8 * c + 1] * sc + p * bfhi(w.x); o[8 * c + 2] = o[8 * c + 2] * sc + p * bflo(w.y); o[8 * c + 3] = o[8 * c + 3] * sc + p * bfhi(w.y);
            o[8 * c + 4] = o[8 * c + 4] * sc + p * bflo(w.z); o[8 * c + 5] = o[8 * c + 5] * sc + p * bfhi(w.z); o[8 * c + 6] = o[8 * c + 6] * sc + p * bflo(w.w); o[8 * c + 7] = o[8 * c + 7] * sc + p * bfhi(w.w); }
    }
    const float il = 1.f / l;
    u32x4* op = (u32x4*)(X + qrow * XW + 1024 + hq * 64);
#pragma unroll
    for (int c = 0; c < 8; ++c) { u32x4 w; w.x = pk2(o[8 * c] * il, o[8 * c + 1] * il); w.y = pk2(o[8 * c + 2] * il, o[8 * c + 3] * il); w.z = pk2(o[8 * c + 4] * il, o[8 * c + 5] * il); w.w = pk2(o[8 * c + 6] * il, o[8 * c + 7] * il); op[c] = w; }
    __syncthreads();
}

__device__ __forceinline__ void kv_naive(LAS unsigned char* lds, const bf16_t* P, float* kv, int unit, const int tid) {
    const int b = unit >> 6, h = (unit >> 4) & 3, n = unit & 15;
    LAS float* kz = (LAS float*)lds; LAS float* vs = kz + 128 * 64;
    const size_t rowc = (size_t)b * SEQ + n * 128; const float lg = lg_gamma(h);
    for (int i = tid; i < 128 * 8; i += 512) { const int tok = i >> 3, ch = i & 7; const u32x4 w = *(const u32x4*)(P + (rowc + tok) * PW + 1024 + h * 64 + ch * 8); const float z = ex2((float)(127 - tok) * lg);
        LAS float* d = kz + tok * 64 + ch * 8; d[0] = bflo(w.x) * z; d[1] = bfhi(w.x) * z; d[2] = bflo(w.y) * z; d[3] = bfhi(w.y) * z; d[4] = bflo(w.z) * z; d[5] = bfhi(w.z) * z; d[6] = bflo(w.w) * z; d[7] = bfhi(w.w) * z; }
    for (int i = tid; i < 128 * 16; i += 512) { const int tok = i >> 4, ch = i & 15; const u32x4 w = *(const u32x4*)(P + (rowc + tok) * PW + 1280 + h * 128 + ch * 8);
        LAS float* d = vs + tok * 128 + ch * 8; d[0] = bflo(w.x); d[1] = bfhi(w.x); d[2] = bflo(w.y); d[3] = bfhi(w.y); d[4] = bflo(w.z); d[5] = bfhi(w.z); d[6] = bflo(w.w); d[7] = bfhi(w.w); }
    __syncthreads();
    const int e = tid & 127, d0 = (tid >> 7) * 16;
    float acc[16];
#pragma unroll
    for (int dd = 0; dd < 16; ++dd) acc[dd] = 0.f;
    for (int tok = 0; tok < 128; ++tok) { const float vv = vs[tok * 128 + e];
#pragma unroll
        for (int dd = 0; dd < 16; ++dd) acc[dd] += kz[tok * 64 + d0 + dd] * vv; }
#pragma unroll
    for (int dd = 0; dd < 16; ++dd) kv[((size_t)unit * 64 + d0 + dd) * 128 + e] = acc[dd];
    __syncthreads();
}

__device__ __forceinline__ void ret_naive(LAS unsigned char* lds, const bf16_t* P, const float* kv, bf16_t* X, int unit, const int tid) {
    const int b = unit >> 6, h = (unit >> 4) & 3, n = unit & 15;
    LAS float* St = (LAS float*)lds;
    LAS bf16_t* qs = (LAS bf16_t*)(lds + 32768);
    LAS bf16_t* ks = (LAS bf16_t*)(lds + 49152);
    LAS bf16_t* vs = (LAS bf16_t*)(lds + 65536);
    const size_t rowc = (size_t)b * SEQ + n * 128; const float lg = lg_gamma(h);
    { const int e = tid & 127, d0 = (tid >> 7) * 16; float s[16];
#pragma unroll
      for (int dd = 0; dd < 16; ++dd) s[dd] = 0.f;
      for (int j = 0; j < n; ++j) { const float w = ex2((float)((n - 1 - j) * 128) * lg); const float* kj = kv + ((size_t)(unit - n + j) * 64 + d0) * 128 + e;
#pragma unroll
          for (int dd = 0; dd < 16; ++dd) s[dd] += w * kj[dd * 128]; }
#pragma unroll
      for (int dd = 0; dd < 16; ++dd) St[(d0 + dd) * 128 + e] = s[dd]; }
    for (int i = tid; i < 128 * 8; i += 512) { const int tok = i >> 3, ch = i & 7; const bf16_t* src = P + (rowc + tok) * PW + h * 64 + ch * 8;
        *(LAS u32x4*)(qs + tok * 64 + ch * 8) = *(const u32x4*)(src + 768); *(LAS u32x4*)(ks + tok * 64 + ch * 8) = *(const u32x4*)(src + 1024); }
    for (int i = tid; i < 128 * 16; i += 512) { const int tok = i >> 4, ch = i & 15; *(LAS u32x4*)(vs + tok * 128 + ch * 8) = *(const u32x4*)(P + (rowc + tok) * PW + 1280 + h * 128 + ch * 8); }
    __syncthreads();
    const int r = tid >> 2, e0 = (tid & 3) * 32;
    float q[64], y[32];
    { const LAS u32x4* qp = (const LAS u32x4*)(qs + r * 64);
#pragma unroll
      for (int c = 0; c < 8; ++c) { const u32x4 w = qp[c]; q[8 * c] = bflo(w.x); q[8 * c + 1] = bfhi(w.x); q[8 * c + 2] = bflo(w.y); q[8 * c + 3] = bfhi(w.y); q[8 * c + 4] = bflo(w.z); q[8 * c + 5] = bfhi(w.z); q[8 * c + 6] = bflo(w.w); q[8 * c + 7] = bfhi(w.w); } }
#pragma unroll
    for (int ee = 0; ee < 32; ++ee) y[ee] = 0.f;
#pragma unroll 2
    for (int d = 0; d < 64; ++d) { const float qd = bf2f(qs[r * 64 + d]); const LAS f32x4* sp = (const LAS f32x4*)(St + d * 128 + e0);
#pragma unroll
        for (int c = 0; c < 8; ++c) { const f32x4 sv = sp[c]; y[4 * c] += qd * sv[0]; y[4 * c + 1] += qd * sv[1]; y[4 * c + 2] += qd * sv[2]; y[4 * c + 3] += qd * sv[3]; } }
    { const float xi = ex2((float)(r + 1) * lg);
#pragma unroll
      for (int ee = 0; ee < 32; ++ee) y[ee] *= xi; }
    const int rmax = (tid | 63) >> 2;
    for (int kk = 0; kk <= rmax; ++kk) {
        const LAS u32x4* kp = (const LAS u32x4*)(ks + kk * 64);
        float s = 0.f;
#pragma unroll
        for (int c = 0; c < 8; ++c) { const u32x4 w = kp[c];
            s += q[8 * c] * bflo(w.x) + q[8 * c + 1] * bfhi(w.x) + q[8 * c + 2] * bflo(w.y) + q[8 * c + 3] * bfhi(w.y) + q[8 * c + 4] * bflo(w.z) + q[8 * c + 5] * bfhi(w.z) + q[8 * c + 6] * bflo(w.w) + q[8 * c + 7] * bfhi(w.w); }
        const float aw = (kk <= r) ? s * ex2((float)(r - kk) * lg) : 0.f;
        const LAS u32x4* vp = (const LAS u32x4*)(vs + kk * 128 + e0);
#pragma unroll
        for (int c = 0; c < 4; ++c) { const u32x4 w = vp[c];
            y[8 * c] += aw * bflo(w.x); y[8 * c + 1] += aw * bfhi(w.x); y[8 * c + 2] += aw * bflo(w.y); y[8 * c + 3] += aw * bfhi(w.y); y[8 * c + 4] += aw * bflo(w.z); y[8 * c + 5] += aw * bfhi(w.z); y[8 * c + 6] += aw * bflo(w.w); y[8 * c + 7] += aw * bfhi(w.w); }
    }
    float sq = 0.f;
#pragma unroll
    for (int ee = 0; ee < 32; ++ee) sq += y[ee] * y[ee];
    sq += __shfl_xor(sq, 1); sq += __shfl_xor(sq, 2);
    const float rs = rsqrtf(sq * (1.f / 128.f) + EPS);
    const u32x4* gp = (const u32x4*)(P + (rowc + r) * PW + 1792 + h * 128 + e0);
    u32x4* op = (u32x4*)(X + (rowc + r) * XW + 1536 + h * 128 + e0);
#pragma unroll
    for (int c = 0; c < 4; ++c) { const u32x4 gw = gp[c]; u32x4 w;
        w.x = pk2(y[8 * c] * rs * bflo(gw.x), y[8 * c + 1] * rs * bfhi(gw.x)); w.y = pk2(y[8 * c + 2] * rs * bflo(gw.y), y[8 * c + 3] * rs * bfhi(gw.y));
        w.z = pk2(y[8 * c + 4] * rs * bflo(gw.z), y[8 * c + 5] * rs * bfhi(gw.z)); w.w = pk2(y[8 * c + 6] * rs * bflo(gw.w), y[8 * c + 7] * rs * bfhi(gw.w)); op[c] = w; }
    __syncthreads();
}

__device__ __forceinline__ void conv_all(const bf16_t* P, const float* cw, bf16_t* X, int G, int c, int row0, int nrows, const int tid) {
    const int gt = c * 512 + tid, NT = G * 512;
    const f32x4 w0a = *(const f32x4*)(cw + (gt & 63) * 8), w0b = *(const f32x4*)(cw + (gt & 63) * 8 + 4), w1a = *(const f32x4*)(cw + 512 + (gt & 63) * 8), w1b = *(const f32x4*)(cw + 512 + (gt & 63) * 8 + 4),
                w2a = *(const f32x4*)(cw + 1024 + (gt & 63) * 8), w2b = *(const f32x4*)(cw + 1024 + (gt & 63) * 8 + 4);
    for (int i0 = gt; i0 < nrows * 64; i0 += 2 * NT) {
        u32x4 cb[2], u0[2], u1[2], u2[2];
#pragma unroll
        for (int k = 0; k < 2; ++k) { const int i = i0 + k * NT, row = row0 + (i >> 6), ch = i & 63, t = row & (SEQ - 1);
            const bf16_t* p = P + (size_t)row * PW + ch * 8;
            cb[k] = *(const u32x4*)(p + 2304); u0[k] = *(const u32x4*)(p + 2816); u1[k] = (u32x4){0u, 0u, 0u, 0u}; u2[k] = u1[k];
            if (t >= 1) u1[k] = *(const u32x4*)(p + 2816 - PW);
            if (t >= 2) u2[k] = *(const u32x4*)(p + 2816 - 2 * PW); }
#pragma unroll
        for (int k = 0; k < 2; ++k) { const int i = i0 + k * NT, row = row0 + (i >> 6), ch = i & 63;
            u32x4 o;
            o.x = pk2(bflo(cb[k].x) * (w0a[0] * bflo(u2[k].x) + w1a[0] * bflo(u1[k].x) + w2a[0] * bflo(u0[k].x)), bfhi(cb[k].x) * (w0a[1] * bfhi(u2[k].x) + w1a[1] * bfhi(u1[k].x) + w2a[1] * bfhi(u0[k].x)));
            o.y = pk2(bflo(cb[k].y) * (w0a[2] * bflo(u2[k].y) + w1a[2] * bflo(u1[k].y) + w2a[2] * bflo(u0[k].y)), bfhi(cb[k].y) * (w0a[3] * bfhi(u2[k].y) + w1a[3] * bfhi(u1[k].y) + w2a[3] * bfhi(u0[k].y)));
            o.z = pk2(bflo(cb[k].z) * (w0b[0] * bflo(u2[k].z) + w1b[0] * bflo(u1[k].z) + w2b[0] * bflo(u0[k].z)), bfhi(cb[k].z) * (w0b[1] * bfhi(u2[k].z) + w1b[1] * bfhi(u1[k].z) + w2b[1] * bfhi(u0[k].z)));
            o.w = pk2(bflo(cb[k].w) * (w0b[2] * bflo(u2[k].w) + w1b[2] * bflo(u1[k].w) + w2b[2] * bflo(u0[k].w)), bfhi(cb[k].w) * (w0b[3] * bfhi(u2[k].w) + w1b[3] * bfhi(u1[k].w) + w2b[3] * bfhi(u0[k].w)));
            *(u32x4*)(X + (size_t)row * XW + 2048 + ch * 8) = o; }
    }
}

__device__ __forceinline__ void final_norm(float* H, const float* ss, const float* g, int G, int c, int row0, int nrows, const int tid) {
    const int lane = tid & 63, gw = c * 8 + (tid >> 6), NGW = G * 8;
    const f32x4* gr = (const f32x4*)g + lane;
    f32x4 gv[4];
#pragma unroll
    for (int j = 0; j < 4; ++j) gv[j] = gr[64 * j];
    for (int row = row0 + gw; row < row0 + nrows; row += 2 * NGW) {
        f32x4* h0 = (f32x4*)(H + (size_t)row * DM) + lane; f32x4* h1 = (f32x4*)(H + (size_t)(row + NGW) * DM) + lane;
        f32x4 a0[4], a1[4];
#pragma unroll
        for (int j = 0; j < 4; ++j) { a0[j] = h0[64 * j]; a1[j] = h1[64 * j]; }
        const float r0 = pg8::row_rstd(ss, row), r1 = pg8::row_rstd(ss, row + NGW);
#pragma unroll
        for (int j = 0; j < 4; ++j) { h0[64 * j] = a0[j] * r0 * gv[j]; h1[64 * j] = a1[j] * r1 * gv[j]; }
    }
}
#ifndef RET_PROBE
#define RET_PROBE 0
#endif
typedef float f32x16 __attribute__((ext_vector_type(16)));
#define MFMA32(a, b, c) __builtin_amdgcn_mfma_f32_32x32x16_bf16((a), (b), (c), 0, 0, 0)
__device__ __forceinline__ int crow(int i, int hh) { return (i & 3) + 8 * (i >> 2) + 4 * hh; }
__device__ __forceinline__ bf16x8 pack8(const f32x16& v, int s) {
    u32x4 t; t.x = pk2(v[8 * s], v[8 * s + 1]); t.y = pk2(v[8 * s + 2], v[8 * s + 3]); t.z = pk2(v[8 * s + 4], v[8 * s + 5]); t.w = pk2(v[8 * s + 6], v[8 * s + 7]);
    return __builtin_bit_cast(bf16x8, t);
}
__device__ __forceinline__ bf16x8 join8(u32x2 a, u32x2 b) { u32x4 t = {a.x, a.y, b.x, b.y}; return __builtin_bit_cast(bf16x8, t); }
__device__ __forceinline__ void tr_store8(LAS unsigned* T32, int pitch32, int ch, int p, u32x4 w0, u32x4 w1) {
    LAS unsigned* t = T32 + (ch * 8) * pitch32 + (p ^ ((ch & 7) << 2));
    t[0 * pitch32] = (w0.x & 0xffffu) | (w1.x << 16); t[1 * pitch32] = (w0.x >> 16) | (w1.x & 0xffff0000u);
    t[2 * pitch32] = (w0.y & 0xffffu) | (w1.y << 16); t[3 * pitch32] = (w0.y >> 16) | (w1.y & 0xffff0000u);
    t[4 * pitch32] = (w0.z & 0xffffu) | (w1.z << 16); t[5 * pitch32] = (w0.z >> 16) | (w1.z & 0xffff0000u);
    t[6 * pitch32] = (w0.w & 0xffffu) | (w1.w << 16); t[7 * pitch32] = (w0.w >> 16) | (w1.w & 0xffff0000u);
}
__device__ __forceinline__ int tr_off(int c, int pitch32, int d) { return 2 * (c * pitch32 + (d ^ (((c >> 3) & 7) << 2))); }

__device__ __forceinline__ void attn_mfma(LAS unsigned char* lds, const bf16_t* P, bf16_t* X, const float* sinks, int unit, const int tid) {
    const int lane = tid & 63, wid = __builtin_amdgcn_readfirstlane(tid >> 6), r32 = lane & 31, hh = lane >> 5;
    const int b = unit >> 5, n = (unit >> 1) & 15, g = unit & 1;
    LAS bf16_t* Ks = (LAS bf16_t*)lds;
    LAS bf16_t* Vt = Ks + 256 * 72;
    const long row0 = (long)b * SEQ + n * 128 - 128;
    { u32x4 kv[4], w0[2], w1[2];
#pragma unroll
      for (int i = 0; i < 4; ++i) { const int c = tid + 512 * i, key = c >> 3, ch = c & 7; kv[i] = (u32x4){0u, 0u, 0u, 0u};
          if (n > 0 || key >= 128) kv[i] = *(const u32x4*)(P + (size_t)(row0 + key) * PW + 512 + g * 64 + ch * 8); }
#pragma unroll
      for (int i = 0; i < 2; ++i) { const int it = tid + 512 * i, kp = it >> 3, ch = it & 7; w0[i] = (u32x4){0u, 0u, 0u, 0u}; w1[i] = w0[i];
          if (n > 0 || kp >= 64) { const bf16_t* src = P + (size_t)(row0 + 2 * kp) * PW + 640 + g * 64 + ch * 8; w0[i] = *(const u32x4*)src; w1[i] = *(const u32x4*)(src + PW); } }
#pragma unroll
      for (int i = 0; i < 4; ++i) { const int c = tid + 512 * i, key = c >> 3, ch = c & 7; *(LAS u32x4*)(Ks + key * 72 + ch * 8) = kv[i]; }
#pragma unroll
      for (int i = 0; i < 2; ++i) { const int it = tid + 512 * i, kp = it >> 3, ch = it & 7; tr_store8((LAS unsigned*)Vt, 132, ch, kp, w0[i], w1[i]); } }
    const int hq = g * 4 + (wid >> 1);
    const float sink2 = sinks[hq] * LOG2E;
    bf16x8 qfa[2][4];
#pragma unroll
    for (int pass = 0; pass < 2; ++pass) { const bf16_t* qp = P + ((size_t)b * SEQ + n * 128 + (wid & 1) * 64 + pass * 32 + r32) * PW + hq * 64 + 8 * hh;
#pragma unroll
        for (int s = 0; s < 4; ++s) qfa[pass][s] = *(const bf16x8*)(qp + 16 * s); }
    __syncthreads();
#pragma unroll
    for (int pass = 0; pass < 2; ++pass) {
        const int r0 = (wid & 1) * 64 + pass * 32;
        const size_t qrow = (size_t)b * SEQ + n * 128 + r0 + r32;
        const bf16x8 (&qf)[4] = qfa[pass];
        f32x16 S[5];
#pragma unroll
        for (int j = 0; j < 5; ++j) {
#pragma unroll
            for (int i = 0; i < 16; ++i) S[j][i] = 0.f;
            const LAS bf16_t* kp = Ks + (r0 + 32 * j + r32) * 72 + 8 * hh;
#pragma unroll
            for (int s = 0; s < 4; ++s) S[j] = MFMA32(*(const LAS bf16x8*)(kp + 16 * s), qf[s], S[j]);
        }
#pragma unroll
        for (int i = 0; i < 16; ++i) { const int c = crow(i, hh); if (c <= r32) S[0][i] = -INFINITY; if (c > r32) S[4][i] = -INFINITY; }
        if (n == 0) {
#pragma unroll
            for (int j = 0; j < 4; ++j) if (r0 + 32 * j < 128) {
#pragma unroll
                for (int i = 0; i < 16; ++i) S[j][i] = -INFINITY; }
        }
        float mx = sink2;
#pragma unroll
        for (int j = 0; j < 5; ++j)
#pragma unroll
            for (int i = 0; i < 16; ++i) mx = fmaxf(mx, S[j][i]);
        mx = fmaxf(mx, __shfl_xor(mx, 32));
        float l = 0.f;
#pragma unroll
        for (int j = 0; j < 5; ++j)
#pragma unroll
            for (int i = 0; i < 16; ++i) { const float p = ex2(S[j][i] - mx); S[j][i] = p; l += p; }
        l += __shfl_xor(l, 32);
        l += ex2(sink2 - mx);
        f32x16 o[2];
#pragma unroll
        for (int i = 0; i < 16; ++i) { o[0][i] = 0.f; o[1][i] = 0.f; }
#pragma unroll
        for (int j = 0; j < 5; ++j)
#pragma unroll
            for (int s = 0; s < 2; ++s) {
                const bf16x8 pf = pack8(S[j], s);
#pragma unroll
                for (int dt = 0; dt < 2; ++dt) {
                    const int dd = (r0 + 32 * j + 16 * s + 4 * hh) >> 1;
                    o[dt] = MFMA32(join8(*(const LAS u32x2*)(Vt + tr_off(32 * dt + r32, 132, dd)), *(const LAS u32x2*)(Vt + tr_off(32 * dt + r32, 132, dd + 4))), pf, o[dt]);
                }
            }
        const float il = 1.f / l;
        bf16_t* op = X + qrow * XW + 1024 + hq * 64 + 4 * hh;
#pragma unroll
        for (int dt = 0; dt < 2; ++dt)
#pragma unroll
            for (int g4 = 0; g4 < 4; ++g4) { u32x2 w; w.x = pk2(o[dt][4 * g4] * il, o[dt][4 * g4 + 1] * il); w.y = pk2(o[dt][4 * g4 + 2] * il, o[dt][4 * g4 + 3] * il);
                *(u32x2*)(op + 32 * dt + 8 * g4) = w; }
    }
    __syncthreads();
}

__device__ __forceinline__ void kv_mfma(LAS unsigned char* lds, const bf16_t* P, bf16_t* kvT, int unit, const int tid) {
    const int lane = tid & 63, wid = __builtin_amdgcn_readfirstlane(tid >> 6), r32 = lane & 31, hh = lane >> 5;
    const int b = unit >> 6, h = (unit >> 4) & 3, n = unit & 15;
    LAS bf16_t* Kt = (LAS bf16_t*)lds;
    LAS bf16_t* Vt = Kt + 64 * 136;
    const size_t rowc = (size_t)b * SEQ + n * 128; const float lg = lg_gamma(h);
    { const int tp = tid >> 3, ch = tid & 7;
      const bf16_t* src = P + (rowc + 2 * tp) * PW + 1024 + h * 64 + ch * 8; const u32x4 w0 = *(const u32x4*)src, w1 = *(const u32x4*)(src + PW);
      const int tv = tid >> 3, cv = 2 * (tid & 7);
      const bf16_t* sv = P + (rowc + 2 * tv) * PW + 1280 + h * 128 + cv * 8;
      const u32x4 va0 = *(const u32x4*)sv, va1 = *(const u32x4*)(sv + PW), vb0 = *(const u32x4*)(sv + 8), vb1 = *(const u32x4*)(sv + 8 + PW);
      const float z0 = ex2((float)(127 - 2 * tp) * lg), z1 = ex2((float)(126 - 2 * tp) * lg);
      LAS unsigned* t = (LAS unsigned*)Kt + (ch * 8) * 68 + (tp ^ ((ch & 7) << 2));
      t[0 * 68] = pk2(bflo(w0.x) * z0, bflo(w1.x) * z1); t[1 * 68] = pk2(bfhi(w0.x) * z0, bfhi(w1.x) * z1); t[2 * 68] = pk2(bflo(w0.y) * z0, bflo(w1.y) * z1); t[3 * 68] = pk2(bfhi(w0.y) * z0, bfhi(w1.y) * z1);
      t[4 * 68] = pk2(bflo(w0.z) * z0, bflo(w1.z) * z1); t[5 * 68] = pk2(bfhi(w0.z) * z0, bfhi(w1.z) * z1); t[6 * 68] = pk2(bflo(w0.w) * z0, bflo(w1.w) * z1); t[7 * 68] = pk2(bfhi(w0.w) * z0, bfhi(w1.w) * z1);
      tr_store8((LAS unsigned*)Vt, 68, cv, tv, va0, va1); tr_store8((LAS unsigned*)Vt, 68, cv + 1, tv, vb0, vb1); }
    __syncthreads();
    const int et = wid >> 1, dt = wid & 1;
    f32x16 acc;
#pragma unroll
    for (int i = 0; i < 16; ++i) acc[i] = 0.f;
#pragma unroll
    for (int s = 0; s < 8; ++s) acc = MFMA32(*(const LAS bf16x8*)(Kt + tr_off(32 * dt + r32, 68, 8 * s + 4 * hh)), *(const LAS bf16x8*)(Vt + tr_off(32 * et + r32, 68, 8 * s + 4 * hh)), acc);
    bf16_t* o = kvT + ((size_t)unit * 128 + 32 * et + r32) * 64 + 32 * dt + 4 * hh;
#pragma unroll
    for (int g4 = 0; g4 < 4; ++g4) { u32x2 w; w.x = pk2(acc[4 * g4], acc[4 * g4 + 1]); w.y = pk2(acc[4 * g4 + 2], acc[4 * g4 + 3]); *(u32x2*)(o + 8 * g4) = w; }
    __syncthreads();
}

__device__ __forceinline__ void ret_mfma(LAS unsigned char* lds, const bf16_t* P, const bf16_t* kvT, bf16_t* X, int unit, const int tid) {
    const int lane = tid & 63, wid = __builtin_amdgcn_readfirstlane(tid >> 6), r32 = lane & 31, hh = lane >> 5;
    const int b = unit >> 6, h = (unit >> 4) & 3, n = unit & 15;
    LAS bf16_t* St = (LAS bf16_t*)lds;
    LAS bf16_t* Ks = St + 128 * 72;
    LAS bf16_t* Vt = Ks + 128 * 72;
    LAS float* ssq = (LAS float*)(Vt + 128 * 136);
    const size_t rowc = (size_t)b * SEQ + n * 128; const float lg = lg_gamma(h);
    const int rb = wid >> 1, eh = wid & 1;
    const size_t qrow = rowc + 32 * rb + r32;
    bf16x8 qf[4];
    { const bf16_t* qp = P + qrow * PW + 768 + h * 64 + 8 * hh;
#pragma unroll
      for (int s = 0; s < 4; ++s) qf[s] = *(const bf16x8*)(qp + 16 * s);
    }
    {
    u32x4 kst[2], vst0[2], vst1[2];
#pragma unroll
    for (int i = 0; i < 2; ++i) { const int c = tid + 512 * i; kst[i] = *(const u32x4*)(P + (rowc + (c >> 3)) * PW + 1024 + h * 64 + (c & 7) * 8);
        const int it = tid + 512 * i; const bf16_t* src = P + (rowc + 2 * (it >> 4)) * PW + 1280 + h * 128 + (it & 15) * 8; vst0[i] = *(const u32x4*)src; vst1[i] = *(const u32x4*)(src + PW); }
    { const int e = tid >> 2, d0 = (tid & 3) * 16; float s[16];
#pragma unroll
      for (int k = 0; k < 16; ++k) s[k] = 0.f;
      if (n > 0) {
          const u32x4* kb = (const u32x4*)(kvT + ((size_t)(unit - n) * 128 + e) * 64 + d0);
#pragma unroll
          for (int g = 0; g < 2; ++g) {
              const int j0 = 12 * g, nj = g ? 3 : 12;
              if (g && n <= 12) break;
              u32x4 t[12][2];
#pragma unroll
              for (int j = 0; j < 12; ++j) if (j < nj) { const int jj = (j0 + j) < n ? (j0 + j) : n - 1; t[j][0] = kb[(size_t)jj * 1024]; t[j][1] = kb[(size_t)jj * 1024 + 1]; }
#pragma unroll
              for (int j = 0; j < 12; ++j) if (j < nj) { const float w = (j0 + j) < n ? ex2((float)((n - 1 - j0 - j) * 128) * lg) : 0.f;
#pragma unroll
                  for (int q = 0; q < 2; ++q) { const u32x4 v = t[j][q];
                      s[8 * q] += w * bflo(v.x); s[8 * q + 1] += w * bfhi(v.x); s[8 * q + 2] += w * bflo(v.y); s[8 * q + 3] += w * bfhi(v.y);
                      s[8 * q + 4] += w * bflo(v.z); s[8 * q + 5] += w * bfhi(v.z); s[8 * q + 6] += w * bflo(v.w); s[8 * q + 7] += w * bfhi(v.w); } }
          }
      }
      u32x4 w0, w1; w0.x = pk2(s[0], s[1]); w0.y = pk2(s[2], s[3]); w0.z = pk2(s[4], s[5]); w0.w = pk2(s[6], s[7]);
      w1.x = pk2(s[8], s[9]); w1.y = pk2(s[10], s[11]); w1.z = pk2(s[12], s[13]); w1.w = pk2(s[14], s[15]);
      *(LAS u32x4*)(St + e * 72 + d0) = w0; *(LAS u32x4*)(St + e * 72 + d0 + 8) = w1; }
#pragma unroll
    for (int i = 0; i < 2; ++i) { const int c = tid + 512 * i; *(LAS u32x4*)(Ks + (c >> 3) * 72 + (c & 7) * 8) = kst[i]; }
#pragma unroll
    for (int i = 0; i < 2; ++i) { const int it = tid + 512 * i; tr_store8((LAS unsigned*)Vt, 68, it & 15, it >> 4, vst0[i], vst1[i]); }
    __syncthreads();
    }
    {
    u32x2 gw[2][4];
    { const bf16_t* gp = P + qrow * PW + 1792 + h * 128 + 64 * eh + 4 * hh;
#pragma unroll
      for (int et = 0; et < 2; ++et)
#pragma unroll
          for (int g4 = 0; g4 < 4; ++g4) gw[et][g4] = *(const u32x2*)(gp + 32 * et + 8 * g4); }
    f32x16 o[2];
#pragma unroll
    for (int i = 0; i < 16; ++i) { o[0][i] = 0.f; o[1][i] = 0.f; }
#pragma unroll
    for (int et = 0; et < 2; ++et) { const LAS bf16_t* sp = St + (64 * eh + 32 * et + r32) * 72 + 8 * hh;
#pragma unroll
        for (int s = 0; s < 4; ++s) o[et] = MFMA32(*(const LAS bf16x8*)(sp + 16 * s), qf[s], o[et]); }
    { const float xi = ex2((float)(32 * rb + r32 + 1) * lg);
#pragma unroll
      for (int i = 0; i < 16; ++i) { o[0][i] *= xi; o[1][i] *= xi; } }
    for (int kt = 0; kt <= rb; ++kt) {
        f32x16 S;
#pragma unroll
        for (int i = 0; i < 16; ++i) S[i] = 0.f;
        const LAS bf16_t* kp = Ks + (32 * kt + r32) * 72 + 8 * hh;
#pragma unroll
        for (int s = 0; s < 4; ++s) S = MFMA32(*(const LAS bf16x8*)(kp + 16 * s), qf[s], S);
#pragma unroll
        for (int i = 0; i < 16; ++i) { const int diff = 32 * (rb - kt) + r32 - crow(i, hh); S[i] = diff >= 0 ? S[i] * ex2((float)diff * lg) : 0.f; }
#pragma unroll
        for (int s = 0; s < 2; ++s) {
            const bf16x8 pf = pack8(S, s);
#pragma unroll
            for (int et = 0; et < 2; ++et) {
                const int er = 64 * eh + 32 * et + r32, dd = 16 * kt + 8 * s + 2 * hh;
                o[et] = MFMA32(join8(*(const LAS u32x2*)(Vt + tr_off(er, 68, dd)), *(const LAS u32x2*)(Vt + tr_off(er, 68, dd + 4))), pf, o[et]);
            }
        }
    }
    float sq = 0.f;
#pragma unroll
    for (int i = 0; i < 16; ++i) sq += o[0][i] * o[0][i] + o[1][i] * o[1][i];
    sq += __shfl_xor(sq, 32);
    if (hh == 0) ssq[eh * 128 + 32 * rb + r32] = sq;
    __syncthreads();
    const float rs = rsqrtf((ssq[32 * rb + r32] + ssq[128 + 32 * rb + r32]) * (1.f / 128.f) + EPS);
    bf16_t* op = X + qrow * XW + 1536 + h * 128 + 64 * eh + 4 * hh;
#pragma unroll
    for (int et = 0; et < 2; ++et)
#pragma unroll
        for (int g4 = 0; g4 < 4; ++g4) { const u32x2 g = gw[et][g4]; u32x2 w;
            w.x = pk2(o[et][4 * g4] * rs * bflo(g.x), o[et][4 * g4 + 1] * rs * bfhi(g.x)); w.y = pk2(o[et][4 * g4 + 2] * rs * bflo(g.y), o[et][4 * g4 + 3] * rs * bfhi(g.y));
            *(u32x2*)(op + 32 * et + 8 * g4) = w; }
    }
    __syncthreads();
}
#define XB_TMO      128
#define XB_XCNT(j)  (256  + 64 * (j))
#define XB_XSUB(j)  (1280 + 64 * (j))
#define XB_XGEN(j)  (2304 + 64 * (j))
#define XB_TOP      3328
#define XB_TOPGEN   3392
#define XCD_BAR_WORDS 3456
#define XB_SPIN_CAP (1u << 18)
__device__ __forceinline__ unsigned xb_ld(unsigned* p)              { return __hip_atomic_load(p, __ATOMIC_RELAXED, __HIP_MEMORY_SCOPE_AGENT); }
__device__ __forceinline__ unsigned xb_add(unsigned* p, unsigned v) { return __hip_atomic_fetch_add(p, v, __ATOMIC_RELAXED, __HIP_MEMORY_SCOPE_AGENT); }
__device__ __forceinline__ unsigned xb_xcc_id() { return (unsigned)__builtin_amdgcn_s_getreg((3 << 11) | 20) & 0xFu; }
#define XB_SPIN(cond, bar) do { unsigned _sp = 0; while (cond) { __builtin_amdgcn_s_sleep(1); \
    if ((++_sp & 255u) == 0u) { if (xb_ld(&(bar)[XB_TMO])) break; if (_sp > XB_SPIN_CAP) { atomicAdd(&(bar)[XB_TMO], 1u); break; } } } } while (0)
struct XcdBarrier { unsigned* bar; unsigned x; volatile LAS unsigned* st; unsigned nexp; };
__device__ __forceinline__ XcdBarrier xcd_barrier_post(unsigned* bar, volatile LAS unsigned* st, unsigned nexp) {
    XcdBarrier b; b.bar = bar; b.x = xb_xcc_id(); b.st = st; b.nexp = nexp;
    if (threadIdx.x == 0) (void)xb_add(&bar[XB_XCNT(b.x)], 1u);
    return b;
}
__device__ __forceinline__ void xcd_barrier_complete(unsigned* bar, unsigned x, unsigned G, unsigned& nloc, unsigned& nx) {
    unsigned sum, cnt, mine, sp = 0u;
    for (;;) {
        sum = 0u; cnt = 0u; mine = 0u;
#pragma unroll
        for (unsigned j = 0; j < 16; ++j) { const unsigned c = xb_ld(&bar[XB_XCNT(j)]); sum += c; cnt += (c > 0u) ? 1u : 0u; mine = (j == x) ? c : mine; }
        if (sum == G) break;
        __builtin_amdgcn_s_sleep(1);
        if ((++sp & 255u) == 0u) { if (xb_ld(&bar[XB_TMO])) break; if (sp > XB_SPIN_CAP) { atomicAdd(&bar[XB_TMO], 1u); break; } }
    }
    nloc = mine > 0u ? mine : 1u; nx = cnt > 0u ? cnt : 1u;
}
__device__ __forceinline__ void xcd_barrier(const XcdBarrier& b) {
    asm volatile("s_waitcnt vmcnt(0)" ::: "memory");
    __syncthreads();
    if (threadIdx.x == 0) {
        unsigned* bar = b.bar;
        __builtin_amdgcn_s_waitcnt(0);
        unsigned nloc = b.st[0], nx = b.st[1];
        if (nloc == 0u) { xcd_barrier_complete(bar, b.x, b.nexp, nloc, nx); b.st[0] = nloc; b.st[1] = nx; }
        const unsigned old = xb_add(&bar[XB_XSUB(b.x)], 1u);
        const unsigned gen = old / nloc;
        if (old + 1u == (gen + 1u) * nloc) {
            __builtin_amdgcn_fence(__ATOMIC_RELEASE, "agent");
            asm volatile("s_waitcnt vmcnt(0)" ::: "memory");
            const unsigned og = xb_add(&bar[XB_TOP], 1u);
            const unsigned tg = og / nx;
            if (og + 1u == (tg + 1u) * nx) xb_add(&bar[XB_TOPGEN], 1u);
            else XB_SPIN(xb_ld(&bar[XB_TOPGEN]) == tg, bar);
            __builtin_amdgcn_fence(__ATOMIC_ACQUIRE, "agent");
            xb_add(&bar[XB_XGEN(b.x)], 1u);
            asm volatile("s_waitcnt vmcnt(0)" ::: "memory");
        } else {
            XB_SPIN(xb_ld(&bar[XB_XGEN(b.x)]) == gen, bar);
            __builtin_amdgcn_fence(__ATOMIC_ACQUIRE, "agent");
            asm volatile("s_waitcnt vmcnt(0)" ::: "memory");
        }
    }
    __syncthreads();
}

constexpr int NPH = 30;
#ifndef PHM
#define PHM 0x1ff
#endif
#ifndef MIX_NAIVE
#define MIX_NAIVE 0
#endif
#ifndef RES_BF16
#define RES_BF16 1
#endif
#ifndef HBD_EXP
#define HBD_EXP 0
#endif
#ifndef B1_PROBE
#define B1_PROBE 0
#endif
#ifndef DBL_BAR
#define DBL_BAR 0
#endif
#ifndef DBLM
#define DBLM 0
#endif
#ifndef MK_NG
#define MK_NG 1
#endif
#ifndef MK_STAGGER
#define MK_STAGGER 1500
#endif
__global__ void __launch_bounds__(512, 2) mk_fwd(Args a) {
    extern __shared__ __attribute__((aligned(16))) unsigned char lds_raw[];
    LAS unsigned char* lds = (LAS unsigned char*)lds_raw;
    const int Gall = gridDim.x, call = blockIdx.x;
    constexpr int NG = MK_NG, MG = M / NG;
    const int grp = (call >> 3) % NG, c = ((call >> 3) / NG) * 8 + (call & 7), G = Gall / NG;
    const int row0 = grp * MG, pm0 = grp * (MG / 256);
    volatile LAS unsigned* MISC = (volatile LAS unsigned*)(lds + MISC_OFF);
    if (threadIdx.x < 32) MISC[threadIdx.x] = 0u;
    __syncthreads();
    unsigned* ctl = (unsigned*)(a.ws + WS_CTL);
    const bool multi = (a.ph_hi - a.ph_lo) > 1;
    XcdBarrier barAll, bar; barAll.bar = ctl + 4096; barAll.x = 0; barAll.st = nullptr; barAll.nexp = 0; bar = barAll;
    if (multi) { barAll = xcd_barrier_post(ctl + 4096, MISC + 8, (unsigned)Gall);
                 bar = (NG == 1) ? barAll : xcd_barrier_post(ctl + 4096 + (1 + grp) * XCD_BAR_WORDS, MISC + 10, (unsigned)G); }

    bf16_t* X = (bf16_t*)(a.ws + WS_X); bf16_t* P = (bf16_t*)(a.ws + WS_P); float* ss = (float*)(a.ws + WS_SS);
#if MIX_NAIVE & 2
    float* kvb = (float*)(a.ws + WS_KV);
#else
    bf16_t* kvb = (bf16_t*)(a.ws + WS_KV);
#endif
    for (int ph = a.ph_lo; ph < a.ph_hi; ++ph) {
        const int kind_ = (ph == 0) ? 0 : (ph == NPH - 1) ? 1 : 2 + (ph - 1) % 7;
        for (int rep_ = 0; rep_ < (((DBLM >> kind_) & 1) ? 2 : 1); ++rep_) {
        if (rep_) __syncthreads();
        int tid = threadIdx.x; asm volatile("" : "+v"(tid));
        if (ph == 0) { if (PHM & 1) phase_prologue(a, lds, Gall, tid); }
        else if (ph == NPH - 1) { if (PHM & 2) final_norm(a.out, ss + (size_t)8 * M * 16, a.norm_final, G, c, row0, MG, tid); }
        else {
            const int l = (ph - 1) / 7, sub = (ph - 1) % 7;
            const char* Wl = (const char*)(a.ws + WS_W + (size_t)l * WL_SIZE);
            if (sub == 0 && (PHM & 4)) {
                pg8::SchedPlain S{(const char*)X, Wl + WL_IN, XW, DM, DM / 64, MG / 256, NIN / 256, G, c, pg8::K_IN, pm0};
                pg8::EpiIn E{P, ss + (size_t)(2 * l) * M * 16};
                pg8::gemm_phase(lds, XW, DM, S, E, tid);
                if (CV_LAZY && l + 1 < DEPTH) cv_fill(a, lds, l + 1, 0, CV_SPLIT, (MG / 256) * (NIN / 256), G, c, tid);
            } else if (sub == 1 && (PHM & 8)) {
#if MIX_NAIVE & 1
                for (int u = c; u < 256 / NG; u += G) attn_naive(lds, P, X, a.sinks + l * 8, grp * (256 / NG) + u, tid);
#else
                for (int rr_ = 0; rr_ < ((B1_PROBE & 1) ? 2 : 1); ++rr_)
                for (int u = c; u < 256 / NG; u += G) attn_mfma(lds, P, X, a.sinks + l * 8, grp * (256 / NG) + u, tid);
#endif
#if MIX_NAIVE & 2
                for (int u = c; u < 512 / NG; u += G) kv_naive(lds, P, kvb, grp * (512 / NG) + u, tid);
#else
                for (int rr_ = 0; rr_ < ((B1_PROBE & 2) ? 2 : 1); ++rr_)
                for (int u = c; u < 512 / NG; u += G) kv_mfma(lds, P, kvb, grp * (512 / NG) + u, tid);
#endif
                for (int rr_ = 0; rr_ < ((B1_PROBE & 4) ? 2 : 1); ++rr_)
                conv_all(P, a.conv_w + l * 3 * 512, X, G, c, row0, MG, tid);
            } else if (sub == 2 && (PHM & 16)) {
#if MIX_NAIVE & 2
                for (int u = c; u < 512 / NG; u += G) ret_naive(lds, P, kvb, X, grp * (512 / NG) + u, tid);
#else
                for (int u = c; u < 512 / NG; u += G) ret_mfma(lds, P, kvb, X, grp * (512 / NG) + ((u < 256 / NG) ? u : (u & ~15) | (15 - (u & 15))), tid);
#endif
            } else if (sub == 3 && (PHM & 32)) {
                pg8::SchedC S{(const char*)X, Wl + WL_C, Wl + WL_B, MG / 256, G, c, pm0};
                pg8::EpiC E{ss + (size_t)(2 * l) * M * 16, a.b_gate + l * 3 * DM, (u32x4*)(a.ws + WS_GS) + (size_t)call * 8192, (u32x4*)(a.ws + WS_MACC) + (size_t)call * 16384, (bf16_t*)(a.ws + WS_MB)};
                pg8::gemm_phase(lds, XW, KC, S, E, tid);
            } else if (sub == 4 && (PHM & 64)) {
                pg8::SchedPlain S{(const char*)(a.ws + WS_MB), Wl + WL_OUT, DM, DM, DM / 64, MG / 256, DM / 256, G, c, pg8::K_RES, pm0};
                pg8::EpiRes E{l == 0 ? a.x : a.out, a.out, X, ss + (size_t)(2 * l + 1) * M * 16, RES_BF16 ? (l == 0 ? 0 : 1) : 2, HBD_EXP ? (bf16_t*)(a.ws + 398 * MiB) : nullptr};
                pg8::gemm_phase(lds, DM, DM, S, E, tid);
            } else if (sub == 5 && (PHM & 128)) {
                const int ldE = HBD_EXP ? DM : XW;
                pg8::SchedPlain S{HBD_EXP ? (const char*)(a.ws + 398 * MiB) : (const char*)X, Wl + WL_GU, ldE, DM, DM / 64, MG / 256, NGU / 256, G, c, pg8::K_GU, pm0};
                pg8::EpiGU E{ss + (size_t)(2 * l + 1) * M * 16, (bf16_t*)(a.ws + WS_FF)};
                pg8::gemm_phase(lds, ldE, DM, S, E, tid);
                if (CV_LAZY && l + 1 < DEPTH) cv_fill(a, lds, l + 1, CV_SPLIT, CV_PER_LAYER, (MG / 256) * (NGU / 256), G, c, tid);
            } else if (sub == 6 && (PHM & 256)) {
                pg8::SchedPlain S{(const char*)(a.ws + WS_FF), Wl + WL_D, DFF, DFF, DFF / 64, MG / 256, DM / 256, G, c, pg8::K_RES, pm0};
                pg8::EpiRes E{a.out, a.out, X, ss + (size_t)(2 * l + 2) * M * 16, RES_BF16 ? (l == DEPTH - 1 ? 3 : 1) : 2, nullptr};
                pg8::gemm_phase(lds, DFF, DFF, S, E, tid);
            }
        }
        }
        if (ph + 1 < a.ph_hi) {
            if (ph == 0) { xcd_barrier(barAll);
                if (NG > 1 && grp > 0) { const unsigned long long t0 = __builtin_amdgcn_s_memrealtime(); while (__builtin_amdgcn_s_memrealtime() - t0 < (unsigned long long)(grp * MK_STAGGER)) __builtin_amdgcn_s_sleep(8); } }
            else xcd_barrier(bar);
#if DBL_BAR
            xcd_barrier(bar);
#endif
        }
    }
}

#ifndef MK_SINGLE
#define MK_SINGLE 0
#endif
extern "C" void kernel_launch(void* const* d_in, const int* in_sizes, int n_in, void* d_out, int out_size, void* d_ws, size_t ws_size, hipStream_t stream) {
    static int grid = 0;
    if (grid == 0) {
        if (n_in != 13 || out_size != M * DM || ws_size < WS_END) { fprintf(stderr, "kernel_launch: unexpected shapes (n_in %d, out %d, ws %zu)\n", n_in, out_size, ws_size); grid = -1; return; }
        int dev = 0, cus = 0, per_cu = 0;
        if (hipGetDevice(&dev) != hipSuccess || hipDeviceGetAttribute(&cus, hipDeviceAttributeMultiprocessorCount, dev) != hipSuccess) { grid = -1; return; }
        if (hipFuncSetAttribute((const void*)mk_fwd, hipFuncAttributeMaxDynamicSharedMemorySize, LDS_BYTES) != hipSuccess) { fprintf(stderr, "kernel_launch: hipFuncSetAttribute failed\n"); grid = -1; return; }
        if (hipOccupancyMaxActiveBlocksPerMultiprocessor(&per_cu, (const void*)mk_fwd, 512, LDS_BYTES) != hipSuccess || per_cu < 1) { fprintf(stderr, "kernel_launch: occupancy query says %d\n", per_cu); per_cu = 1; }
        (void)hipGetLastError();
        grid = cus;
        if (grid > 256) grid = 256;
    }
    if (grid < 0) return;
    (void)hipMemsetAsync((char*)d_ws + WS_CTL, 0, CTL_ZERO_BYTES, stream);
    Args a{};
    a.x = (const float*)d_in[0]; a.norm_mix = (const float*)d_in[1]; a.w_in = (const float*)d_in[2]; a.sinks = (const float*)d_in[3]; a.conv_w = (const float*)d_in[4];
    a.w_branch = (const float*)d_in[5]; a.b_gate = (const float*)d_in[6]; a.w_out = (const float*)d_in[7]; a.norm_ffn = (const float*)d_in[8];
    a.w_g = (const float*)d_in[9]; a.w_u = (const float*)d_in[10]; a.w_d = (const float*)d_in[11]; a.norm_final = (const float*)d_in[12];
    a.out = (float*)d_out; a.ws = (unsigned char*)d_ws;
#if MK_SINGLE
    a.ph_lo = 0; a.ph_hi = NPH;
    hipLaunchKernelGGL(mk_fwd, dim3(grid), dim3(512), LDS_BYTES, stream, a);
#else
    for (int ph = 0; ph < NPH; ++ph) { a.ph_lo = ph; a.ph_hi = ph + 1; hipLaunchKernelGGL(mk_fwd, dim3(grid), dim3(512), LDS_BYTES, stream, a); }
#endif
}
```

```cpp
#include <hip/hip_runtime.h>
#include <cstdio>
#include <cstdint>

#define LAS __attribute__((address_space(3)))
#define GAS __attribute__((address_space(1)))
typedef unsigned short bf16_t;
typedef short bf16x8 __attribute__((ext_vector_type(8)));
typedef float f32x4 __attribute__((ext_vector_type(4)));
typedef float f32x2 __attribute__((ext_vector_type(2)));
typedef unsigned u32x4 __attribute__((ext_vector_type(4)));
typedef unsigned u32x2 __attribute__((ext_vector_type(2)));
typedef __bf16 bf16x2_t __attribute__((ext_vector_type(2)));

constexpr int BATCH = 8, SEQ = 2048, DM = 1024, M = BATCH * SEQ, DEPTH = 4, DFF = 2816, DIN = 6912;
constexpr int PW = 3328;
constexpr int XW = 2560;
constexpr int NIN = 3840;
constexpr int NGU = 2 * DFF;
constexpr int KC = 1536;
constexpr float EPS = 1e-6f;
constexpr float LOG2E = 1.4426950408889634f;
constexpr float QSCALE = 0.18033688011112042f;

constexpr size_t MiB = 1u << 20;
constexpr size_t WS_CTL = 0, CTL_ZERO_BYTES = 262144;
constexpr size_t WS_SS = 388 * MiB;
constexpr size_t WS_TABA = 2 * MiB;
constexpr size_t WS_TABR = 2 * MiB + 131072;
constexpr size_t WS_W = 4 * MiB;
constexpr size_t WL_IN = 0, WL_C = 7864320, WL_B = 17301504, WL_OUT = 20447232, WL_GU = 22544384, WL_D = 34078720, WL_SIZE = 39845888;
constexpr size_t WS_X = 156 * MiB;
constexpr size_t WS_P = 236 * MiB;
constexpr size_t WS_MACC = WS_P, WS_MB = WS_P + 64 * MiB, WS_FF = WS_P;
constexpr size_t WS_GS = 340 * MiB;
constexpr size_t WS_KV = 372 * MiB;
constexpr size_t WS_END = 398 * MiB;
static_assert(WS_W + DEPTH * WL_SIZE <= WS_X, "weights");
static_assert((size_t)M * XW * 2 <= 80 * MiB && (size_t)M * PW * 2 <= 104 * MiB && (size_t)M * DFF * 2 <= 104 * MiB, "buffers");

constexpr int RING_BYTES = 131072, LDS_BYTES = 147456, MISC_OFF = RING_BYTES + 320;

__device__ __forceinline__ unsigned pk2(float lo, float hi) { f32x2 v = {lo, hi}; bf16x2_t b = __builtin_convertvector(v, bf16x2_t); return __builtin_bit_cast(unsigned, b); }
__device__ __forceinline__ float bflo(unsigned u) { return __uint_as_float(u << 16); }
__device__ __forceinline__ float bfhi(unsigned u) { return __uint_as_float(u & 0xffff0000u); }
__device__ __forceinline__ float bf2f(bf16_t b) { return __uint_as_float((unsigned)b << 16); }
__device__ __forceinline__ float fsilu(float x) { return x * __builtin_amdgcn_rcpf(1.f + __builtin_amdgcn_exp2f(-x * LOG2E)); }
__device__ __forceinline__ float fsigm(float x) { return __builtin_amdgcn_rcpf(1.f + __builtin_amdgcn_exp2f(-x * LOG2E)); }

struct Args {
    const float* x; const float* norm_mix; const float* w_in; const float* sinks; const float* conv_w; const float* w_branch; const float* b_gate; const float* w_out;
    const float* norm_ffn; const float* w_g; const float* w_u; const float* w_d; const float* norm_final;
    float* out; unsigned char* ws; int ph_lo, ph_hi;
};
#define MK_SINGLE 1
#ifndef DBL_EPI
#define DBL_EPI 0
#endif
namespace pg8 {
constexpr int BM = 256, BK = 64, HALF = 128, HTB = HALF * BK * 2  , STAGE_BYTES = 8 * HTB, NXCD = 8, WGM = 8;

__host__ __device__ __forceinline__ int lds_byte(int r, int c) { const int st = (r >> 4) * 2 + (c >> 5), rr = r & 15, cc = c & 31, ob = rr * 64 + cc * 2; return st * 1024 + (ob ^ (((ob >> 9) & 1) << 5)); }
__host__ __device__ __forceinline__ void stage_rc(int b, int& R, int& C) { const int st = b / 1024, sb = b % 1024, swz = sb ^ (((sb >> 9) & 1) << 5); R = (st >> 1) * 16 + swz / 64; C = (st & 1) * 32 + (swz % 64) / 2; }
__host__ __device__ __forceinline__ int perm32(int rho) { const int n = rho >> 4, i = rho & 15; return 8 * (i >> 2) + 4 * n + (i & 3); }

struct Unit { const char* A; const char* B; int nt, pm, pn, kind, aux; };

__device__ __forceinline__ void tile_of(int L, int nM, int nN, int& pm, int& pn) {
    const int nwg = nM * nN; int wgid = L;
    { const int q = nwg / NXCD, r = nwg % NXCD, xcd = wgid % NXCD, off = wgid / NXCD; wgid = (xcd < r ? xcd * (q + 1) : r * (q + 1) + (xcd - r) * q) + off; }
    const int nig = WGM * nN, gid = wgid / nig, fm = gid * WGM, gsz = (nM - fm) < WGM ? (nM - fm) : WGM;
    pm = fm + ((wgid % nig) % gsz); pn = (wgid % nig) / gsz;
}

template <class Epi, class Sched>
__device__ __forceinline__ void gemm_phase(LAS unsigned char* lds, const int lda, const int ldb, const Sched& S, const Epi& E, const int tid) {
    const int wid = __builtin_amdgcn_readfirstlane(tid >> 6), lane = tid & 63, wr = wid >> 2, wc = wid & 3, fr = lane & 15, fq = lane >> 4;
    unsigned voffA[2], voffB[2];
#pragma unroll
    for (int i = 0; i < 2; ++i) { int R, C; stage_rc(tid * 16 + i * 8192, R, C); const int Rb = 2 * (R & ~31) + perm32(R & 31);
        voffA[i] = (unsigned)(R * lda + C) * 2u; voffB[i] = (unsigned)(Rb * ldb + C) * 2u; }
    const size_t kstep = (size_t)(BK * 2);
    const size_t hstepA = (size_t)HALF * lda * 2, hstepB = (size_t)32 * ldb * 2;
    const unsigned ldsw = (unsigned)wid * 1024u;
    const int aoff = lds_byte(wr * 64 + fr, fq * 8), boff = lds_byte(wc * 32 + fr, fq * 8);
#define PG8_SA(b, h) (((b) * 2 + (h)) * HTB)
#define PG8_SB(b, h) ((4 + (b) * 2 + (h)) * HTB)
#define PG8_STAGE(bufoff, gbase, voff) do { _Pragma("unroll") for (int _i = 0; _i < 2; ++_i) \
        __builtin_amdgcn_global_load_lds((const unsigned*)((const char*)(gbase) + (voff)[_i]), (LAS unsigned*)(lds + (bufoff) + ldsw + _i * 8192), 16, 0, 0); } while (0)
#define PG8_LDA(dst, b, h) do { _Pragma("unroll") for (int m = 0; m < 4; ++m) _Pragma("unroll") for (int k = 0; k < 2; ++k) dst[m][k] = *(const LAS bf16x8*)(lds + PG8_SA(b, h) + aoff + m * 2048 + k * 1024); } while (0)
#define PG8_LDB(dst, b, h) do { _Pragma("unroll") for (int n = 0; n < 2; ++n) _Pragma("unroll") for (int k = 0; k < 2; ++k) dst[n][k] = *(const LAS bf16x8*)(lds + PG8_SB(b, h) + boff + n * 2048 + k * 1024); } while (0)
#define PG8_MMA(ai, bj, At, Bt) do { __builtin_amdgcn_s_setprio(1); _Pragma("unroll") for (int m = 0; m < 4; ++m) _Pragma("unroll") for (int n = 0; n < 2; ++n) _Pragma("unroll") for (int k = 0; k < 2; ++k) \
        acc[ai][bj][m][n] = __builtin_amdgcn_mfma_f32_16x16x32_bf16(Bt[n][k], At[m][k], acc[ai][bj][m][n], 0, 0, 0); __builtin_amdgcn_s_setprio(0); } while (0)
#define PG8_WAIT_V(n) asm volatile("s_waitcnt vmcnt(" #n ")" ::: "memory")
#define PG8_WAIT_L(n) asm volatile("s_waitcnt lgkmcnt(" #n ")" ::: "memory")
#define PG8_BAR __builtin_amdgcn_s_barrier()
#define PG8_SCHED __builtin_amdgcn_sched_barrier(0)
    Unit cur, nxt; int ui = 0;
    if (!S.next(0, cur)) return;
    f32x4 acc[2][2][4][2];
#pragma unroll
    for (int a = 0; a < 2; ++a)
#pragma unroll
        for (int b = 0; b < 2; ++b)
#pragma unroll
            for (int m = 0; m < 4; ++m)
#pragma unroll
                for (int n = 0; n < 2; ++n) acc[a][b][m][n] = (f32x4){0.f, 0.f, 0.f, 0.f};
    bf16x8 At[4][2], B0[2][2], B1[2][2];
    const char* cA = cur.A; const char* cB = cur.B;
    PG8_STAGE(PG8_SB(0, 0), cB, voffB); PG8_STAGE(PG8_SB(0, 1), cB + hstepB, voffB); PG8_STAGE(PG8_SA(0, 0), cA, voffA); PG8_STAGE(PG8_SA(0, 1), cA + hstepA, voffA);
    if (wr == 1) PG8_BAR;
    PG8_WAIT_V(2); PG8_BAR;
    PG8_STAGE(PG8_SB(1, 0), cB + kstep, voffB); PG8_STAGE(PG8_SA(1, 0), cA + kstep, voffA); PG8_STAGE(PG8_SB(1, 1), cB + hstepB + kstep, voffB);
    PG8_WAIT_V(6); PG8_BAR;
    for (;;) {
        const bool has_next = S.next(ui + 1, nxt);
        const char* nA = has_next ? nxt.A : cA; const char* nB = has_next ? nxt.B : cB;
        const int nt = cur.nt;
        for (int t = 0; t < nt; t += 2) {
            const bool last = (t == nt - 2);
            if constexpr (Epi::HAS_HOOK) E.hook(acc, cur, t, wid);
            const char* a1 = cA + (size_t)(t + 1) * kstep;
            const char* a2 = last ? nA : cA + (size_t)(t + 2) * kstep; const char* b2 = last ? nB : cB + (size_t)(t + 2) * kstep;
            const char* a3 = a2 + kstep; const char* b3 = b2 + kstep;
            PG8_LDB(B0, 0, 0); PG8_LDB(B1, 0, 1); PG8_SCHED; PG8_LDA(At, 0, 0); PG8_STAGE(PG8_SA(1, 1), a1 + hstepA, voffA);
            PG8_WAIT_V(8); PG8_WAIT_L(0); PG8_BAR; PG8_MMA(0, 0, At, B0); PG8_MMA(0, 1, At, B1); PG8_BAR; PG8_SCHED;
            PG8_LDA(At, 0, 1); PG8_STAGE(PG8_SB(0, 0), b2, voffB); PG8_STAGE(PG8_SB(0, 1), b2 + hstepB, voffB); PG8_STAGE(PG8_SA(0, 0), a2, voffA);
            PG8_WAIT_V(8); PG8_WAIT_L(0); PG8_BAR; PG8_MMA(1, 0, At, B0); PG8_MMA(1, 1, At, B1); PG8_BAR; PG8_SCHED;
            PG8_LDB(B0, 1, 0); PG8_LDB(B1, 1, 1); PG8_SCHED; PG8_LDA(At, 1, 0); PG8_STAGE(PG8_SA(0, 1), a2 + hstepA, voffA);
            PG8_WAIT_V(8); PG8_WAIT_L(0); PG8_BAR; PG8_MMA(0, 0, At, B0); PG8_MMA(0, 1, At, B1); PG8_BAR; PG8_SCHED;
            PG8_LDA(At, 1, 1); PG8_STAGE(PG8_SB(1, 0), b3, voffB); PG8_STAGE(PG8_SB(1, 1), b3 + hstepB, voffB); PG8_STAGE(PG8_SA(1, 0), a3, voffA);
            PG8_WAIT_V(8); PG8_WAIT_L(0); PG8_BAR; PG8_MMA(1, 0, At, B0); PG8_MMA(1, 1, At, B1); PG8_BAR; PG8_SCHED;
        }
        if (wr == 0) PG8_BAR;
#if DBL_EPI
        if (E.dbl(cur)) { E(acc, cur, wid, false); asm volatile("" ::: "memory"); }
#endif
        E(acc, cur, wid, true);
        if (!has_next) break;
        cur = nxt; cA = nA; cB = nB; ++ui;
        if (wr == 1) PG8_BAR;
    }
    PG8_WAIT_V(0);
    PG8_BAR;
#undef PG8_SA
#undef PG8_SB
#undef PG8_STAGE
#undef PG8_LDA
#undef PG8_LDB
#undef PG8_MMA
#undef PG8_WAIT_V
#undef PG8_WAIT_L
#undef PG8_BAR
#undef PG8_SCHED
}
}
namespace pg8 {
#ifndef EPIC_TEST
#define EPIC_TEST(x) (x)
#endif
__device__ __forceinline__ float row_rstd(const float* ss, int row) {
    const f32x4* p = (const f32x4*)(ss + (size_t)row * 16); const f32x4 a = p[0], b = p[1], c = p[2], d = p[3];
    const float s = ((a[0] + a[1]) + (a[2] + a[3])) + ((b[0] + b[1]) + (b[2] + b[3])) + (((c[0] + c[1]) + (c[2] + c[3])) + ((d[0] + d[1]) + (d[2] + d[3])));
    return rsqrtf(s * (1.f / DM) + EPS);
}
#ifndef USE_NT
#define USE_NT 0
#endif
#if USE_NT
#define NT_STORE(p, v) __builtin_nontemporal_store((v), (p))
#else
#define NT_STORE(p, v) (*(p) = (v))
#endif
#ifndef WT_STORES
#define WT_STORES 0
#endif
#if WT_STORES
#define RSRC(ptr, bytes) __builtin_amdgcn_make_buffer_rsrc((void*)(ptr), (short)0, (int)(bytes), 0x00020000)
#define ST16(rs, base, elt_off, v) __builtin_amdgcn_raw_buffer_store_b128((v), (rs), (unsigned)((elt_off) * sizeof(*(base))), 0, 16)
#else
#define RSRC(ptr, bytes) 0
#define ST16(rs, base, elt_off, v) (*(u32x4*)((base) + (elt_off)) = (v))
#endif
#define EPI_LANE() const int lane_ = (int)__builtin_amdgcn_mbcnt_hi(~0u, __builtin_amdgcn_mbcnt_lo(~0u, 0u)); const int wr = wid >> 2, wc = wid & 3, fr = lane_ & 15, fq = lane_ >> 4, tid = wid * 64 + lane_; (void)wr; (void)wc; (void)fr; (void)fq; (void)tid
__device__ __forceinline__ void row_rstd8(const float* ss, int rbase, int lane, int fr, float (&rs)[8]) {
    const float a = row_rstd(ss, rbase + lane), b = row_rstd(ss, rbase + 128 + lane);
#pragma unroll
    for (int m = 0; m < 4; ++m) { rs[m] = __shfl(a, m * 16 + fr); rs[4 + m] = __shfl(b, m * 16 + fr); }
}
enum { K_IN = 0, K_GATE = 1, K_BRANCH = 2, K_RES = 3, K_GU = 4 };

__device__ __forceinline__ void rot1(float& a, float& b, float rev) {
    const float fr_ = rev - floorf(rev), c = __builtin_amdgcn_cosf(fr_), s = __builtin_amdgcn_sinf(fr_);
    const float na = a * c - b * s, nb = b * c + a * s; a = na; b = nb;
}
__device__ __forceinline__ f32x4 rot4(f32x4 v, f32x4 t) { return (f32x4){v[0] * t[0] - v[1] * t[1], v[1] * t[0] + v[0] * t[1], v[2] * t[2] - v[3] * t[3], v[3] * t[2] + v[2] * t[3]}; }

struct EpiIn {
    static constexpr bool HAS_HOOK = false;
    __device__ __forceinline__ bool dbl(const Unit&) const { return (DBL_EPI & 1) != 0; }
    bf16_t* P; const float* ss;
    __device__ __forceinline__ void operator()(f32x4 (&acc)[2][2][4][2], const Unit& u, int wid, const bool zacc) const {
        EPI_LANE();
        const int pn = u.pn;
        const auto rsP = RSRC(P, (size_t)M * PW * 2); (void)rsP;
        const int cw = wc * 64 + 8 * fq;
        float ivA[4], ivR[4];
#pragma unroll
        for (int j = 0; j < 4; ++j) { ivA[j] = __builtin_amdgcn_exp2f(-(float)(4 * (fq & 1) + j) * (18.931568569324174f / 8.f)) * 0.15915494309189535f;
                                      ivR[j] = __builtin_amdgcn_exp2f(-(float)(4 * fq + j) * (13.287712379549449f / 32.f)) * 0.15915494309189535f; }
        float rs8[8];
        row_rstd8(ss, u.pm * 256 + wr * 64, lane_, fr, rs8);
#pragma unroll
        for (int ai = 0; ai < 2; ++ai)
#pragma unroll
            for (int m = 0; m < 4; ++m) {
                const int row = u.pm * 256 + ai * 128 + wr * 64 + m * 16 + fr;
                const float rstd = rs8[ai * 4 + m];
                const float fpos = (float)(row & (SEQ - 1));
#pragma unroll
                for (int bj = 0; bj < 2; ++bj) {
                    f32x4 v0 = acc[ai][bj][m][0] * rstd, v1 = acc[ai][bj][m][1] * rstd;
                    const int gc = pn * 256 + bj * 32 + cw;
                    if (pn >= 11) {
                        if (bj == 0) { const f32x4 x0 = acc[ai][1][m][0] * rstd, x1 = acc[ai][1][m][1] * rstd;
                            u32x4 w; w.x = pk2(v0[0] * x0[0], v0[1] * x0[1]); w.y = pk2(v0[2] * x0[2], v0[3] * x0[3]); w.z = pk2(v1[0] * x1[0], v1[1] * x1[1]); w.w = pk2(v1[2] * x1[2], v1[3] * x1[3]);
                            ST16(rsP, P, (size_t)row * PW + 2816 + (pn - 11) * 128 + wc * 32 + 8 * fq, w); }
                    } else {
                        if (pn < 2 || (pn == 2 && wc < 2)) {
                            if (bj == 0 && fq < 2) {
                                float x[8] = {v0[0], v0[1], v0[2], v0[3], v1[0], v1[1], v1[2], v1[3]};
#pragma unroll
                                for (int j = 0; j < 4; ++j) rot1(x[2 * j], x[2 * j + 1], fpos * ivA[j]);
                                v0 = (f32x4){x[0], x[1], x[2], x[3]}; v1 = (f32x4){x[4], x[5], x[6], x[7]};
                            }
                            if (pn < 2) { v0 = v0 * QSCALE; v1 = v1 * QSCALE; }
                        } else if (pn == 3 || pn == 4) {
                            float x[8] = {v0[0], v0[1], v0[2], v0[3], v1[0], v1[1], v1[2], v1[3]};
#pragma unroll
                            for (int j = 0; j < 4; ++j) rot1(x[2 * j], x[2 * j + 1], fpos * (bj ? ivR[j] * 0.01f : ivR[j]));
                            v0 = (f32x4){x[0], x[1], x[2], x[3]}; v1 = (f32x4){x[4], x[5], x[6], x[7]};
                            if (pn == 4) { v0 = v0 * 0.125f; v1 = v1 * 0.125f; }
                        } else if (pn == 7 || pn == 8) {
#pragma unroll
                            for (int j = 0; j < 4; ++j) { v0[j] = fsilu(v0[j]); v1[j] = fsilu(v1[j]); }
                        }
                        u32x4 w; w.x = pk2(v0[0], v0[1]); w.y = pk2(v0[2], v0[3]); w.z = pk2(v1[0], v1[1]); w.w = pk2(v1[2], v1[3]);
                        ST16(rsP, P, (size_t)row * PW + gc, w);
                    }
                    if (zacc) { acc[ai][bj][m][0] = (f32x4){0.f, 0.f, 0.f, 0.f}; acc[ai][bj][m][1] = (f32x4){0.f, 0.f, 0.f, 0.f}; }
                }
                asm volatile("" ::: "memory");
            }
    }
};

struct EpiC {
    static constexpr bool HAS_HOOK = true;
    __device__ __forceinline__ bool dbl(const Unit&) const { return false; }
    const float* ss; const float* bg; u32x4* G0; u32x4* G12; bf16_t* mb;
    __device__ __forceinline__ u32x4* gbuf(int br) const { return br == 0 ? G0 : G12 + (size_t)(br - 1) * 8192; }
    __device__ __forceinline__ void hook(f32x4 (&acc)[2][2][4][2], const Unit& u, int t, int wid) const {
        if (u.kind != K_BRANCH || (t != 8 && t != 16)) return;
        EPI_LANE();
        const int br = (t >> 3) - 1;
        const u32x4* Ga = gbuf(br); const u32x4* Gb = gbuf(br + 1);
#pragma unroll
        for (int ai = 0; ai < 2; ++ai) {
            u32x4 ga[8], gb[8];
#pragma unroll
            for (int q = 0; q < 8; ++q) { ga[q] = Ga[(unsigned)((ai * 8 + q) * 512 + tid)]; gb[q] = Gb[(unsigned)((ai * 8 + q) * 512 + tid)]; }
            asm volatile("" ::: "memory");
#pragma unroll
            for (int m = 0; m < 4; ++m)
#pragma unroll
                for (int bj = 0; bj < 2; ++bj) {
                    const u32x4 a_ = ga[m * 2 + bj], b_ = gb[m * 2 + bj];
                    f32x4 d0 = (f32x4){bflo(b_.x), bfhi(b_.x), bflo(b_.y), bfhi(b_.y)}, d1 = (f32x4){bflo(b_.z), bfhi(b_.z), bflo(b_.w), bfhi(b_.w)};
#pragma unroll
                    for (int j = 0; j < 4; ++j) { d0[j] = __builtin_amdgcn_rcpf(fmaxf(d0[j], 1e-30f)); d1[j] = __builtin_amdgcn_rcpf(fmaxf(d1[j], 1e-30f)); }
                    acc[ai][bj][m][0] = acc[ai][bj][m][0] * ((f32x4){bflo(a_.x), bfhi(a_.x), bflo(a_.y), bfhi(a_.y)} * d0);
                    acc[ai][bj][m][1] = acc[ai][bj][m][1] * ((f32x4){bflo(a_.z), bfhi(a_.z), bflo(a_.w), bfhi(a_.w)} * d1);
                }
            asm volatile("" ::: "memory");
        }
    }
    __device__ __forceinline__ void operator()(f32x4 (&acc)[2][2][4][2], const Unit& u, int wid, const bool zacc) const {
        EPI_LANE();
        const int cw = u.pn * 256 + wc * 64 + 8 * fq;
        if (EPIC_TEST(u.kind == K_GATE)) {
            const int br = u.aux;
            const float* b = bg + br * DM + cw; u32x4* Gw = gbuf(br);
            float rs8[8];
            row_rstd8(ss, u.pm * 256 + wr * 64, lane_, fr, rs8);
            const f32x4 bv00 = *(const f32x4*)(b), bv01 = *(const f32x4*)(b + 4), bv10 = *(const f32x4*)(b + 32), bv11 = *(const f32x4*)(b + 36);
            asm volatile("" ::: "memory");
#pragma unroll
            for (int ai = 0; ai < 2; ++ai)
#pragma unroll
                for (int m = 0; m < 4; ++m) {
                    const float rstd = rs8[ai * 4 + m];
#pragma unroll
                    for (int bj = 0; bj < 2; ++bj) {
                        f32x4 v0 = acc[ai][bj][m][0] * rstd + (bj ? bv10 : bv00), v1 = acc[ai][bj][m][1] * rstd + (bj ? bv11 : bv01);
#pragma unroll
                        for (int j = 0; j < 4; ++j) { v0[j] = fsigm(v0[j]); v1[j] = fsigm(v1[j]); }
                        u32x4 w; w.x = pk2(v0[0], v0[1]); w.y = pk2(v0[2], v0[3]); w.z = pk2(v1[0], v1[1]); w.w = pk2(v1[2], v1[3]);
                        Gw[(unsigned)(((ai * 4 + m) * 2 + bj) * 512 + tid)] = w;
                        if (zacc) { acc[ai][bj][m][0] = (f32x4){0.f, 0.f, 0.f, 0.f}; acc[ai][bj][m][1] = (f32x4){0.f, 0.f, 0.f, 0.f}; }
                    }
                    asm volatile("" ::: "memory");
                }
        } else {
            const u32x4* Ga = gbuf(2);
            const auto rsM = RSRC(mb, (size_t)M * DM * 2); (void)rsM;
#pragma unroll
            for (int ai = 0; ai < 2; ++ai) {
                u32x4 gg[8];
#pragma unroll
                for (int q = 0; q < 8; ++q) gg[q] = Ga[(unsigned)((ai * 8 + q) * 512 + tid)];
                asm volatile("" ::: "memory");
#pragma unroll
                for (int m = 0; m < 4; ++m) {
                    const int row = u.pm * 256 + ai * 128 + wr * 64 + m * 16 + fr;
#pragma unroll
                    for (int bj = 0; bj < 2; ++bj) {
                        const u32x4 g = gg[m * 2 + bj];
                        const f32x4 v0 = acc[ai][bj][m][0] * (f32x4){bflo(g.x), bfhi(g.x), bflo(g.y), bfhi(g.y)};
                        const f32x4 v1 = acc[ai][bj][m][1] * (f32x4){bflo(g.z), bfhi(g.z), bflo(g.w), bfhi(g.w)};
                        u32x4 w; w.x = pk2(v0[0], v0[1]); w.y = pk2(v0[2], v0[3]); w.z = pk2(v1[0], v1[1]); w.w = pk2(v1[2], v1[3]);
                        ST16(rsM, mb, (size_t)row * DM + bj * 32 + cw, w);
                        if (zacc) { acc[ai][bj][m][0] = (f32x4){0.f, 0.f, 0.f, 0.f}; acc[ai][bj][m][1] = (f32x4){0.f, 0.f, 0.f, 0.f}; }
                    }
                }
                asm volatile("" ::: "memory");
            }
        }
    }
};

struct EpiRes {
    static constexpr bool HAS_HOOK = false;
    __device__ __forceinline__ bool dbl(const Unit&) const { return (DBL_EPI & 4) != 0 && rin != H; }
    const float* rin; float* H; bf16_t* hb; float* ssout; int mode; bf16_t* hbd;
    __device__ __forceinline__ void operator()(f32x4 (&acc)[2][2][4][2], const Unit& u, int wid, const bool zacc) const {
        EPI_LANE();
        const int cw = u.pn * 256 + wc * 64 + 8 * fq;
        const auto rsH = RSRC(hb, (size_t)M * XW * 2); (void)rsH;
        if (mode & 1) {
            u32x4 rr[8][2];
#pragma unroll
            for (int q = 0; q < 8; ++q)
#pragma unroll
                for (int bj = 0; bj < 2; ++bj) rr[q][bj] = *(const u32x4*)(hb + (size_t)(u.pm * 256 + (q >> 2) * 128 + wr * 64 + (q & 3) * 16 + fr) * XW + bj * 32 + cw);
            asm volatile("" ::: "memory");
#pragma unroll
            for (int ai = 0; ai < 2; ++ai)
#pragma unroll
                for (int m = 0; m < 4; ++m) {
                    const int row = u.pm * 256 + ai * 128 + wr * 64 + m * 16 + fr;
                    float s = 0.f;
#pragma unroll
                    for (int bj = 0; bj < 2; ++bj) {
                        const size_t o = (size_t)row * DM + bj * 32 + cw;
                        const u32x4 w = rr[ai * 4 + m][bj];
                        const f32x4 v0 = acc[ai][bj][m][0] + (f32x4){bflo(w.x), bfhi(w.x), bflo(w.y), bfhi(w.y)}, v1 = acc[ai][bj][m][1] + (f32x4){bflo(w.z), bfhi(w.z), bflo(w.w), bfhi(w.w)};
                        if (mode & 2) { *(f32x4*)(H + o) = v0; *(f32x4*)(H + o + 4) = v1; }
                        u32x4 wo; wo.x = pk2(v0[0], v0[1]); wo.y = pk2(v0[2], v0[3]); wo.z = pk2(v1[0], v1[1]); wo.w = pk2(v1[2], v1[3]);
                        ST16(rsH, hb, (size_t)row * XW + bj * 32 + cw, wo);
                        if (hbd) *(u32x4*)(hbd + (size_t)row * DM + bj * 32 + cw) = wo;
                        s += (v0[0] * v0[0] + v0[1] * v0[1]) + (v0[2] * v0[2] + v0[3] * v0[3]) + (v1[0] * v1[0] + v1[1] * v1[1]) + (v1[2] * v1[2] + v1[3] * v1[3]);
                        if (zacc) { acc[ai][bj][m][0] = (f32x4){0.f, 0.f, 0.f, 0.f}; acc[ai][bj][m][1] = (f32x4){0.f, 0.f, 0.f, 0.f}; }
                    }
                    s += __shfl_xor(s, 16); s += __shfl_xor(s, 32);
                    if (fq == 0) ssout[(size_t)row * 16 + u.pn * 4 + wc] = s;
                }
            return;
        }
#pragma unroll
        for (int ai = 0; ai < 2; ++ai) {
            f32x4 rr[4][2][2];
#pragma unroll
            for (int m = 0; m < 4; ++m)
#pragma unroll
                for (int bj = 0; bj < 2; ++bj) { const float* rp = rin + (size_t)(u.pm * 256 + ai * 128 + wr * 64 + m * 16 + fr) * DM + bj * 32 + cw; rr[m][bj][0] = *(const f32x4*)rp; rr[m][bj][1] = *(const f32x4*)(rp + 4); }
            asm volatile("" ::: "memory");
#pragma unroll
            for (int m = 0; m < 4; ++m) {
                const int row = u.pm * 256 + ai * 128 + wr * 64 + m * 16 + fr;
                float s = 0.f;
#pragma unroll
                for (int bj = 0; bj < 2; ++bj) {
                    const size_t o = (size_t)row * DM + bj * 32 + cw;
                    const f32x4 v0 = acc[ai][bj][m][0] + rr[m][bj][0], v1 = acc[ai][bj][m][1] + rr[m][bj][1];
                    if (mode & 2) { *(f32x4*)(H + o) = v0; *(f32x4*)(H + o + 4) = v1; }
                    u32x4 w; w.x = pk2(v0[0], v0[1]); w.y = pk2(v0[2], v0[3]); w.z = pk2(v1[0], v1[1]); w.w = pk2(v1[2], v1[3]);
                    ST16(rsH, hb, (size_t)row * XW + bj * 32 + cw, w);
                    if (hbd) *(u32x4*)(hbd + (size_t)row * DM + bj * 32 + cw) = w;
                    s += (v0[0] * v0[0] + v0[1] * v0[1]) + (v0[2] * v0[2] + v0[3] * v0[3]) + (v1[0] * v1[0] + v1[1] * v1[1]) + (v1[2] * v1[2] + v1[3] * v1[3]);
                    if (zacc) { acc[ai][bj][m][0] = (f32x4){0.f, 0.f, 0.f, 0.f}; acc[ai][bj][m][1] = (f32x4){0.f, 0.f, 0.f, 0.f}; }
                }
                s += __shfl_xor(s, 16); s += __shfl_xor(s, 32);
                if (fq == 0) ssout[(size_t)row * 16 + u.pn * 4 + wc] = s;
            }
            asm volatile("" ::: "memory");
        }
    }
};

struct EpiGU {
    static constexpr bool HAS_HOOK = false;
    __device__ __forceinline__ bool dbl(const Unit&) const { return (DBL_EPI & 2) != 0; }
    const float* ss; bf16_t* ff;
    __device__ __forceinline__ void operator()(f32x4 (&acc)[2][2][4][2], const Unit& u, int wid, const bool zacc) const {
        EPI_LANE();
        const int cj = u.pn * 128 + wc * 32 + 8 * fq;
        const auto rsF = RSRC(ff, (size_t)M * DFF * 2); (void)rsF;
        float rs8[8];
        row_rstd8(ss, u.pm * 256 + wr * 64, lane_, fr, rs8);
        asm volatile("" ::: "memory");
#pragma unroll
        for (int ai = 0; ai < 2; ++ai)
#pragma unroll
            for (int m = 0; m < 4; ++m) {
                const int row = u.pm * 256 + ai * 128 + wr * 64 + m * 16 + fr;
                const float rstd = rs8[ai * 4 + m];
                const f32x4 g0 = acc[ai][0][m][0] * rstd, g1 = acc[ai][0][m][1] * rstd, u0 = acc[ai][1][m][0] * rstd, u1 = acc[ai][1][m][1] * rstd;
                u32x4 w; w.x = pk2(fsilu(g0[0]) * u0[0], fsilu(g0[1]) * u0[1]); w.y = pk2(fsilu(g0[2]) * u0[2], fsilu(g0[3]) * u0[3]);
                w.z = pk2(fsilu(g1[0]) * u1[0], fsilu(g1[1]) * u1[1]); w.w = pk2(fsilu(g1[2]) * u1[2], fsilu(g1[3]) * u1[3]);
                ST16(rsF, ff, (size_t)row * DFF + cj, w);
                if (zacc) {
#pragma unroll
                    for (int bj = 0; bj < 2; ++bj) { acc[ai][bj][m][0] = (f32x4){0.f, 0.f, 0.f, 0.f}; acc[ai][bj][m][1] = (f32x4){0.f, 0.f, 0.f, 0.f}; } }
            }
    }
};

struct SchedPlain {
    const char* A; const char* B; int lda, ldb, nt, nM, nN, G, c, kind, pm0;
    __device__ __forceinline__ bool next(int i, Unit& u) const {
        const int L = i * G + c; if (L >= nM * nN) return false;
        tile_of(L, nM, nN, u.pm, u.pn); u.pm += pm0;
        u.A = A + (size_t)u.pm * 256 * lda * 2; u.B = B + (size_t)u.pn * 256 * ldb * 2; u.nt = nt; u.kind = kind; u.aux = 0; return true;
    }
};
struct SchedC {
    const char* X; const char* Wg; const char* Wb; int nM, G, c, pm0;
    __device__ __forceinline__ bool next(int i, Unit& u) const {
        const int j = i >> 2, sub = i & 3, L = j * G + c; if (L >= nM * 4) return false;
        tile_of(L, nM, 4, u.pm, u.pn); u.pm += pm0;
        const bool gate = sub < 3;
        u.A = X + (size_t)u.pm * 256 * XW * 2 + (gate ? 0 : 1024 * 2);
        u.B = gate ? Wg + (size_t)sub * (1024 * KC * 2) + (size_t)u.pn * 256 * KC * 2 : Wb + (size_t)u.pn * 256 * KC * 2;
        u.nt = gate ? 16 : 24; u.kind = gate ? K_GATE : K_BRANCH; u.aux = sub; return true;
    }
};
}
__device__ const double INV_A[8] = {0.15915494309189535, 0.03086376340470123, 0.005985185712713705, 0.001160663641240061, 0.00022507907903927653, 4.364795279280289e-05, 8.464330808241401e-06, 1.6414262627950345e-06};
__device__ const double INV_R[32] = {0.15915494309189535, 0.11934937021124886, 0.08949940160889101, 0.06711508300522726, 0.050329212104487035, 0.03774158471741977, 0.0283021958306234, 0.02122365276477766,
    0.015915494309189534, 0.011934937021124886, 0.008949940160889102, 0.006711508300522725, 0.005032921210448704, 0.003774158471741977, 0.00283021958306234, 0.0021223652764777662,
    0.0015915494309189536, 0.0011934937021124885, 0.0008949940160889102, 0.0006711508300522726, 0.0005032921210448703, 0.00037741584717419774, 0.00028302195830623395, 0.0002122365276477766,
    0.00015915494309189535, 0.00011934937021124886, 8.949940160889102e-05, 6.711508300522725e-05, 5.0329212104487035e-05, 3.774158471741978e-05, 2.8302195830623396e-05, 2.122365276477766e-05};
__device__ __forceinline__ float lg_gamma(int h) { return h == 0 ? -0.04580368961312479f : h == 1 ? -0.02272007650008353f : h == 2 ? -0.011315313227834146f : -0.005646563141142062f; }
__device__ __forceinline__ float ex2(float x) { return __builtin_amdgcn_exp2f(x); }
__device__ __forceinline__ float wave_sum(float v) {
#pragma unroll
    for (int o = 1; o < 64; o <<= 1) v += __shfl_xor(v, o);
    return v;
}
#define LDS_WAIT() asm volatile("s_waitcnt lgkmcnt(0)" ::: "memory")

__device__ __forceinline__ int dst_in(int s) {
    if (s < 640) { const int p = s & 63; return (p < 16) ? (s & ~63) + ((p < 8) ? 2 * p : 2 * (p - 8) + 1) : s; }
    if (s < 768) return s;
    if (s < 1280) { const int p = s & 63; return (s & ~63) + ((p < 32) ? 2 * p : 2 * (p - 32) + 1); }
    if (s < 2816) return s;
    { const int j = (s < 3328) ? s - 2816 : s - 3328; return 2816 + (j >> 5) * 64 + ((s < 3328) ? 0 : 32) + (j & 31); }
}
struct CvDesc { const float* W; size_t ldw; const float* scale; bf16_t* dst; int c0, ld, k0, mode, rmul, radd; };
constexpr int CV_J0 = 3456, CV_J2 = 768, CV_J3 = 512, CV_J4 = 2816, CV_J5 = 1408, CV_PER_LAYER = CV_J0 + CV_J2 + CV_J3 + CV_J4 + CV_J5;
__device__ __forceinline__ CvDesc cv_desc(const Args& a, int it) {
    const int l = it / CV_PER_LAYER; int r = it - l * CV_PER_LAYER;
    bf16_t* Wl = (bf16_t*)(a.ws + WS_W + (size_t)l * WL_SIZE);
    if (r < CV_J0) { const int kb = r / 216, cb = r % 216;
        if (cb < 120) return CvDesc{a.w_in + (size_t)l * DM * DIN, DIN, a.norm_mix + l * DM, Wl + WL_IN / 2, cb * 32, DM, kb * 64, 1, 1, 0};
        return CvDesc{a.w_in + (size_t)l * DM * DIN, DIN, a.norm_mix + l * DM, Wl + WL_C / 2, cb * 32, KC, kb * 64, 0, 1, -3840}; }
    r -= CV_J0;
    if (r < CV_J2) { const int i = r >> 8, kb = (r >> 5) & 7, cb = r & 31;
        return CvDesc{a.w_branch + (size_t)(l * 3 + i) * 512 * DM, DM, nullptr, Wl + WL_B / 2 + i * 512, cb * 32, KC, kb * 64, 0, 1, 0}; }
    r -= CV_J2;
    if (r < CV_J3) { const int kb = r >> 5, cb = r & 31; return CvDesc{a.w_out + (size_t)l * DM * DM, DM, nullptr, Wl + WL_OUT / 2, cb * 32, DM, kb * 64, 0, 1, 0}; }
    r -= CV_J3;
    if (r < CV_J4) { const int up = r / 1408, q = r % 1408, kb = q / 88, cb = q % 88;
        return CvDesc{(up ? a.w_u : a.w_g) + (size_t)l * DM * DFF, DFF, a.norm_ffn + l * DM, Wl + WL_GU / 2, cb * 32, DM, kb * 64, 2, 1, up * 32}; }
    r -= CV_J4;
    { const int kb = r >> 5, cb = r & 31; return CvDesc{a.w_d + (size_t)l * DFF * DM, DM, nullptr, Wl + WL_D / 2, cb * 32, DFF, kb * 64, 0, 1, 0}; }
}
__device__ __forceinline__ void cv_load(const CvDesc& d, int lane, f32x4 (&v)[8], float (&sc)[8]) {
    const int kr = lane >> 3, c4 = lane & 7;
#pragma unroll
    for (int i = 0; i < 8; ++i) { v[i] = *(const f32x4*)(d.W + (size_t)(d.k0 + 8 * i + kr) * d.ldw + d.c0 + 4 * c4); sc[i] = d.scale ? d.scale[d.k0 + 8 * i + kr] : 1.f; }
}
__device__ __forceinline__ void cv_finish(const CvDesc& d, int lane, const f32x4 (&v)[8], const float (&sc)[8], LAS float* scr) {
    const int kr = lane >> 3, c4 = lane & 7;
#pragma unroll
    for (int i = 0; i < 8; ++i) { LAS float* p = scr + (8 * i + kr) * 33 + 4 * c4; p[0] = v[i][0] * sc[i]; p[1] = v[i][1] * sc[i]; p[2] = v[i][2] * sc[i]; p[3] = v[i][3] * sc[i]; }
    LDS_WAIT(); asm volatile("" ::: "memory");
    const int c = lane & 7;
#pragma unroll
    for (int j = 0; j < 4; ++j) { const int n = (lane >> 3) + 8 * j; const LAS float* s = scr + (8 * c) * 33 + n;
        u32x4 o; o.x = pk2(s[0 * 33], s[1 * 33]); o.y = pk2(s[2 * 33], s[3 * 33]); o.z = pk2(s[4 * 33], s[5 * 33]); o.w = pk2(s[6 * 33], s[7 * 33]);
        const int cc = d.c0 + n, row = (d.mode == 2) ? ((cc >> 5) * 64 + d.radd + (cc & 31)) : (d.mode ? dst_in(cc) : cc) * d.rmul + d.radd;
        *(u32x4*)(d.dst + (size_t)row * d.ld + d.k0 + 8 * c) = o; }
    LDS_WAIT(); asm volatile("" ::: "memory");
}
__device__ __forceinline__ void cv_range(const Args& a, LAS unsigned char* lds, int it0, int it1, int widx, int nw, const int tid) {
    const int lane = tid & 63, wave = tid >> 6;
    LAS float* scr = (LAS float*)(lds + wave * 16384);
    const int first = it0 + widx;
    if (first < it1) {
        CvDesc cur = cv_desc(a, first); f32x4 v[8]; float sc[8];
        cv_load(cur, lane, v, sc);
        for (int it = first; it < it1; it += nw) {
            const bool more = it + nw < it1;
            CvDesc nxt = cv_desc(a, more ? it + nw : it); f32x4 vn[8]; float scn[8];
            if (more) cv_load(nxt, lane, vn, scn);
            cv_finish(cur, lane, v, sc, scr);
            if (more) { cur = nxt;
#pragma unroll
                for (int i = 0; i < 8; ++i) { v[i] = vn[i]; sc[i] = scn[i]; } }
        }
    }
}
__device__ __forceinline__ void cv_fill(const Args& a, LAS unsigned char* lds, int layer, int it0, int it1, int total_units, int G, int c, const int tid) {
    const int rem = total_units % G; const int first_idle = rem ? rem : G;
    const int nidle = rem ? G - rem : G, idx = rem ? c - first_idle : c;
    if (idx < 0) return;
    cv_range(a, lds, layer * CV_PER_LAYER + it0, layer * CV_PER_LAYER + it1, idx * 8 + (tid >> 6), nidle * 8, tid);
}
#ifndef CV_LAZY
#define CV_LAZY 1
#endif
constexpr int CV_SPLIT = 0;
__device__ __forceinline__ void phase_prologue(const Args& a, LAS unsigned char* lds, int G, const int tid) {
    const int lane = tid & 63, wave = tid >> 6;
    const int gw = blockIdx.x * 8 + wave, NGW = G * 8;
    cv_range(a, lds, 0, (CV_LAZY ? 1 : DEPTH) * CV_PER_LAYER, gw, NGW, tid);
    bf16_t* X = (bf16_t*)(a.ws + WS_X); float* ss = (float*)(a.ws + WS_SS);
    for (int row = gw; row < M; row += NGW) {
        const f32x4* xr = (const f32x4*)(a.x + (size_t)row * DM) + lane; float s = 0.f;
#pragma unroll
        for (int j = 0; j < 4; ++j) { const f32x4 v = xr[64 * j]; s += (v[0] * v[0] + v[1] * v[1]) + (v[2] * v[2] + v[3] * v[3]);
            u32x2 w; w.x = pk2(v[0], v[1]); w.y = pk2(v[2], v[3]); *(u32x2*)(X + (size_t)row * XW + (64 * j + lane) * 4) = w; }
        s = wave_sum(s); if (lane < 16) ss[(size_t)row * 16 + lane] = (lane == 0) ? s : 0.f;
    }
}

__device__ __forceinline__ void attn_naive(LAS unsigned char* lds, const bf16_t* P, bf16_t* X, const float* sinks, int unit, const int tid) {
    const int b = unit >> 5, n = (unit >> 1) & 15, g = unit & 1;
    LAS bf16_t* Ks = (LAS bf16_t*)lds; LAS bf16_t* Vs = Ks + 256 * 72;
    const long row0 = (long)b * SEQ + n * 128 - 128;
    for (int c = tid; c < 2048; c += 512) {
        const int key = c >> 3, ch = c & 7; u32x4 kv = {0u, 0u, 0u, 0u}, vv = {0u, 0u, 0u, 0u};
        if (n > 0 || key >= 128) { const bf16_t* src = P + (size_t)(row0 + key) * PW + g * 64 + ch * 8; kv = *(const u32x4*)(src + 512); vv = *(const u32x4*)(src + 640); }
        *(LAS u32x4*)(Ks + key * 72 + ch * 8) = kv; *(LAS u32x4*)(Vs + key * 72 + ch * 8) = vv;
    }
    __syncthreads();
    const int r = tid & 127, hq = g * 4 + (tid >> 7);
    const size_t qrow = (size_t)b * SEQ + n * 128 + r;
    float q[64], o[64];
    { const u32x4* qp = (const u32x4*)(P + qrow * PW + hq * 64);
#pragma unroll
      for (int c = 0; c < 8; ++c) { const u32x4 w = qp[c]; q[8 * c] = bflo(w.x); q[8 * c + 1] = bfhi(w.x); q[8 * c + 2] = bflo(w.y); q[8 * c + 3] = bfhi(w.y); q[8 * c + 4] = bflo(w.z); q[8 * c + 5] = bfhi(w.z); q[8 * c + 6] = bflo(w.w); q[8 * c + 7] = bfhi(w.w); } }
#pragma unroll
    for (int d = 0; d < 64; ++d) o[d] = 0.f;
    float mx = sinks[hq] * LOG2E, l = 1.f;
    for (int j = 0; j < 128; ++j) {
        const int kt = r + 1 + j; const bool valid = (n > 0) || (kt >= 128);
        const LAS u32x4* kp = (const LAS u32x4*)(Ks + kt * 72);
        float s = 0.f;
#pragma unroll
        for (int c = 0; c < 8; ++c) { const u32x4 w = kp[c];
            s += q[8 * c] * bflo(w.x) + q[8 * c + 1] * bfhi(w.x) + q[8 * c + 2] * bflo(w.y) + q[8 * c + 3] * bfhi(w.y) + q[8 * c + 4] * bflo(w.z) + q[8 * c + 5] * bfhi(w.z) + q[8 * c + 6] * bflo(w.w) + q[8 * c + 7] * bfhi(w.w); }
        s = valid ? s : -INFINITY;
        const float mn = fmaxf(mx, s), sc = ex2(mx - mn), p = ex2(s - mn);
        l = l * sc + p; mx = mn;
        const LAS u32x4* vp = (const LAS u32x4*)(Vs + kt * 72);
#pragma unroll
        for (int c = 0; c < 8; ++c) { const u32x4 w = vp[c];
            o[8 * c] = o[8 * c] * sc + p * bflo(w.x); o[8 * c + 1] = o[8 * c + 1] * sc + p * bfhi(w.x); o[8 * c + 2] = o[8 * c + 2] * sc + p * bflo(w.y); o[8 * c + 3] = o[8 * c + 3] * sc + p * bfhi(w.y);
            o[8 * c + 4] = o[8 * c + 4] * sc + p * bflo(w.z); o[8 * c + 5] = o[8 * c + 5] * sc + p * bfhi(w.z); o[8 * c + 6] = o[8 * c + 6] * sc + p * bflo(w.w); o[8 * c + 7] = o[8 * c + 7] * sc + p * bfhi(w.w); }
    }
    const float il = 1.f / l;
    u32x4* op = (u32x4*)(X + qrow * XW + 1024 + hq * 64);
#pragma unroll
    for (int c = 0; c < 8; ++c) { u32x4 w; w.x = pk2(o[8 * c] * il, o[8 * c + 1] * il); w.y = pk2(o[8 * c + 2] * il, o[8 * c + 3] * il); w.z = pk2(o[8 * c + 4] * il, o[8 * c + 5] * il); w.w = pk2(o[8 * c + 6] * il, o[8 * c + 7] * il); op[c] = w; }
    __syncthreads();
}

__device__ __forceinline__ void kv_naive(LAS unsigned char* lds, const bf16_t* P, float* kv, int unit, const int tid) {
    const int b = unit >> 6, h = (unit >> 4) & 3, n = unit & 15;
    LAS float* kz = (LAS float*)lds; LAS float* vs = kz + 128 * 64;
    const size_t rowc = (size_t)b * SEQ + n * 128; const float lg = lg_gamma(h);
    for (int i = tid; i < 128 * 8; i += 512) { const int tok = i >> 3, ch = i & 7; const u32x4 w = *(const u32x4*)(P + (rowc + tok) * PW + 1024 + h * 64 + ch * 8); const float z = ex2((float)(127 - tok) * lg);
        LAS float* d = kz + tok * 64 + ch * 8; d[0] = bflo(w.x) * z; d[1] = bfhi(w.x) * z; d[2] = bflo(w.y) * z; d[3] = bfhi(w.y) * z; d[4] = bflo(w.z) * z; d[5] = bfhi(w.z) * z; d[6] = bflo(w.w) * z; d[7] = bfhi(w.w) * z; }
    for (int i = tid; i < 128 * 16; i += 512) { const int tok = i >> 4, ch = i & 15; const u32x4 w = *(const u32x4*)(P + (rowc + tok) * PW + 1280 + h * 128 + ch * 8);
        LAS float* d = vs + tok * 128 + ch * 8; d[0] = bflo(w.x); d[1] = bfhi(w.x); d[2] = bflo(w.y); d[3] = bfhi(w.y); d[4] = bflo(w.z); d[5] = bfhi(w.z); d[6] = bflo(w.w); d[7] = bfhi(w.w); }
    __syncthreads();
    const int e = tid & 127, d0 = (tid >> 7) * 16;
    float acc[16];
#pragma unroll
    for (int dd = 0; dd < 16; ++dd) acc[dd] = 0.f;
    for (int tok = 0; tok < 128; ++tok) { const float vv = vs[tok * 128 + e];
#pragma unroll
        for (int dd = 0; dd < 16; ++dd) acc[dd] += kz[tok * 64 + d0 + dd] * vv; }
#pragma unroll
    for (int dd = 0; dd < 16; ++dd) kv[((size_t)unit * 64 + d0 + dd) * 128 + e] = acc[dd];
    __syncthreads();
}

__device__ __forceinline__ void ret_naive(LAS unsigned char* lds, const bf16_t* P, const float* kv, bf16_t* X, int unit, const int tid) {
    const int b = unit >> 6, h = (unit >> 4) & 3, n = unit & 15;
    LAS float* St = (LAS float*)lds;
    LAS bf16_t* qs = (LAS bf16_t*)(lds + 32768);
    LAS bf16_t* ks = (LAS bf16_t*)(lds + 49152);
    LAS bf16_t* vs = (LAS bf16_t*)(lds + 65536);
    const size_t rowc = (size_t)b * SEQ + n * 128; const float lg = lg_gamma(h);
    { const int e = tid & 127, d0 = (tid >> 7) * 16; float s[16];
#pragma unroll
      for (int dd = 0; dd < 16; ++dd) s[dd] = 0.f;
      for (int j = 0; j < n; ++j) { const float w = ex2((float)((n - 1 - j) * 128) * lg); const float* kj = kv + ((size_t)(unit - n + j) * 64 + d0) * 128 + e;
#pragma unroll
          for (int dd = 0; dd < 16; ++dd) s[dd] += w * kj[dd * 128]; }
#pragma unroll
      for (int dd = 0; dd < 16; ++dd) St[(d0 + dd) * 128 + e] = s[dd]; }
    for (int i = tid; i < 128 * 8; i += 512) { const int tok = i >> 3, ch = i & 7; const bf16_t* src = P + (rowc + tok) * PW + h * 64 + ch * 8;
        *(LAS u32x4*)(qs + tok * 64 + ch * 8) = *(const u32x4*)(src + 768); *(LAS u32x4*)(ks + tok * 64 + ch * 8) = *(const u32x4*)(src + 1024); }
    for (int i = tid; i < 128 * 16; i += 512) { const int tok = i >> 4, ch = i & 15; *(LAS u32x4*)(vs + tok * 128 + ch * 8) = *(const u32x4*)(P + (rowc + tok) * PW + 1280 + h * 128 + ch * 8); }
    __syncthreads();
    const int r = tid >> 2, e0 = (tid & 3) * 32;
    float q[64], y[32];
    { const LAS u32x4* qp = (const LAS u32x4*)(qs + r * 64);
#pragma unroll
      for (int c = 0; c < 8; ++c) { const u32x4 w = qp[c]; q[8 * c] = bflo(w.x); q[8 * c + 1] = bfhi(w.x); q[8 * c + 2] = bflo(w.y); q[8 * c + 3] = bfhi(w.y); q[8 * c + 4] = bflo(w.z); q[8 * c + 5] = bfhi(w.z); q[8 * c + 6] = bflo(w.w); q[8 * c + 7] = bfhi(w.w); } }
#pragma unroll
    for (int ee = 0; ee < 32; ++ee) y[ee] = 0.f;
#pragma unroll 2
    for (int d = 0; d < 64; ++d) { const float qd = bf2f(qs[r * 64 + d]); const LAS f32x4* sp = (const LAS f32x4*)(St + d * 128 + e0);
#pragma unroll
        for (int c = 0; c < 8; ++c) { const f32x4 sv = sp[c]; y[4 * c] += qd * sv[0]; y[4 * c + 1] += qd * sv[1]; y[4 * c + 2] += qd * sv[2]; y[4 * c + 3] += qd * sv[3]; } }
    { const float xi = ex2((float)(r + 1) * lg);
#pragma unroll
      for (int ee = 0; ee < 32; ++ee) y[ee] *= xi; }
    const int rmax = (tid | 63) >> 2;
    for (int kk = 0; kk <= rmax; ++kk) {
        const LAS u32x4* kp = (const LAS u32x4*)(ks + kk * 64);
        float s = 0.f;
#pragma unroll
        for (int c = 0; c < 8; ++c) { const u32x4 w = kp[c];
            s += q[8 * c] * bflo(w.x) + q[8 * c + 1] * bfhi(w.x) + q[8 * c + 2] * bflo(w.y) + q[8 * c + 3] * bfhi(w.y) + q[8 * c + 4] * bflo(w.z) + q[8 * c + 5] * bfhi(w.z) + q[8 * c + 6] * bflo(w.w) + q[8 * c + 7] * bfhi(w.w); }
        const float aw = (kk <= r) ? s * ex2((float)(r - kk) * lg) : 0.f;
        const LAS u32x4* vp = (const LAS u32x4*)(vs + kk * 128 + e0);
#pragma unroll
        for (int c = 0; c < 4; ++c) { const u32x4 w = vp[c];
            y[8 * c] += aw * bflo(w.x); y[8 * c + 1] += aw * bfhi(w.x); y[8 * c + 2] += aw * bflo(w.y); y[8 * c + 3] += aw * bfhi(w.y); y[8 * c + 4] += aw * bflo(w.z); y[8 * c + 5] += aw * bfhi(w.z); y[8 * c + 6] += aw * bflo(w.w); y[8 * c + 7] += aw * bfhi(w.w); }
    }
    float sq = 0.f;
#pragma unroll
    for (int ee = 0; ee < 32; ++ee) sq += y[ee] * y[ee];
    sq += __shfl_xor(sq, 1); sq += __shfl_xor(sq, 2);
    const float rs = rsqrtf(sq * (1.f / 128.f) + EPS);
    const u32x4* gp = (const u32x4*)(P + (rowc + r) * PW + 1792 + h * 128 + e0);
    u32x4* op = (u32x4*)(X + (rowc + r) * XW + 1536 + h * 128 + e0);
#pragma unroll
    for (int c = 0; c < 4; ++c) { const u32x4 gw = gp[c]; u32x4 w;
        w.x = pk2(y[8 * c] * rs * bflo(gw.x), y[8 * c + 1] * rs * bfhi(gw.x)); w.y = pk2(y[8 * c + 2] * rs * bflo(gw.y), y[8 * c + 3] * rs * bfhi(gw.y));
        w.z = pk2(y[8 * c + 4] * rs * bflo(gw.z), y[8 * c + 5] * rs * bfhi(gw.z)); w.w = pk2(y[8 * c + 6] * rs * bflo(gw.w), y[8 * c + 7] * rs * bfhi(gw.w)); op[c] = w; }
    __syncthreads();
}

__device__ __forceinline__ void conv_all(const bf16_t* P, const float* cw, bf16_t* X, int G, int c, int row0, int nrows, const int tid) {
    const int gt = c * 512 + tid, NT = G * 512;
    const f32x4 w0a = *(const f32x4*)(cw + (gt & 63) * 8), w0b = *(const f32x4*)(cw + (gt & 63) * 8 + 4), w1a = *(const f32x4*)(cw + 512 + (gt & 63) * 8), w1b = *(const f32x4*)(cw + 512 + (gt & 63) * 8 + 4),
                w2a = *(const f32x4*)(cw + 1024 + (gt & 63) * 8), w2b = *(const f32x4*)(cw + 1024 + (gt & 63) * 8 + 4);
    for (int i0 = gt; i0 < nrows * 64; i0 += 2 * NT) {
        u32x4 cb[2], u0[2], u1[2], u2[2];
#pragma unroll
        for (int k = 0; k < 2; ++k) { const int i = i0 + k * NT, row = row0 + (i >> 6), ch = i & 63, t = row & (SEQ - 1);
            const bf16_t* p = P + (size_t)row * PW + ch * 8;
            cb[k] = *(const u32x4*)(p + 2304); u0[k] = *(const u32x4*)(p + 2816); u1[k] = (u32x4){0u, 0u, 0u, 0u}; u2[k] = u1[k];
            if (t >= 1) u1[k] = *(const u32x4*)(p + 2816 - PW);
            if (t >= 2) u2[k] = *(const u32x4*)(p + 2816 - 2 * PW); }
#pragma unroll
        for (int k = 0; k < 2; ++k) { const int i = i0 + k * NT, row = row0 + (i >> 6), ch = i & 63;
            u32x4 o;
            o.x = pk2(bflo(cb[k].x) * (w0a[0] * bflo(u2[k].x) + w1a[0] * bflo(u1[k].x) + w2a[0] * bflo(u0[k].x)), bfhi(cb[k].x) * (w0a[1] * bfhi(u2[k].x) + w1a[1] * bfhi(u1[k].x) + w2a[1] * bfhi(u0[k].x)));
            o.y = pk2(bflo(cb[k].y) * (w0a[2] * bflo(u2[k].y) + w1a[2] * bflo(u1[k].y) + w2a[2] * bflo(u0[k].y)), bfhi(cb[k].y) * (w0a[3] * bfhi(u2[k].y) + w1a[3] * bfhi(u1[k].y) + w2a[3] * bfhi(u0[k].y)));
            o.z = pk2(bflo(cb[k].z) * (w0b[0] * bflo(u2[k].z) + w1b[0] * bflo(u1[k].z) + w2b[0] * bflo(u0[k].z)), bfhi(cb[k].z) * (w0b[1] * bfhi(u2[k].z) + w1b[1] * bfhi(u1[k].z) + w2b[1] * bfhi(u0[k].z)));
            o.w = pk2(bflo(cb[k].w) * (w0b[2] * bflo(u2[k].w) + w1b[2] * bflo(u1[k].w) + w2b[2] * bflo(u0[k].w)), bfhi(cb[k].w) * (w0b[3] * bfhi(u2[k].w) + w1b[3] * bfhi(u1[k].w) + w2b[3] * bfhi(u0[k].w)));
            *(u32x4*)(X + (size_t)row * XW + 2048 + ch * 8) = o; }
    }
}

__device__ __forceinline__ void final_norm(float* H, const float* ss, const float* g, int G, int c, int row0, int nrows, const int tid) {
    const int lane = tid & 63, gw = c * 8 + (tid >> 6), NGW = G * 8;
    const f32x4* gr = (const f32x4*)g + lane;
    f32x4 gv[4];
#pragma unroll
    for (int j = 0; j < 4; ++j) gv[j] = gr[64 * j];
    for (int row = row0 + gw; row < row0 + nrows; row += 2 * NGW) {
        f32x4* h0 = (f32x4*)(H + (size_t)row * DM) + lane; f32x4* h1 = (f32x4*)(H + (size_t)(row + NGW) * DM) + lane;
        f32x4 a0[4], a1[4];
#pragma unroll
        for (int j = 0; j < 4; ++j) { a0[j] = h0[64 * j]; a1[j] = h1[64 * j]; }
        const float r0 = pg8::row_rstd(ss, row), r1 = pg8::row_rstd(ss, row + NGW);
#pragma unroll
        for (int j = 0; j < 4; ++j) { h0[64 * j] = a0[j] * r0 * gv[j]; h1[64 * j] = a1[j] * r1 * gv[j]; }
    }
}
#ifndef RET_PROBE
#define RET_PROBE 0
#endif
typedef float f32x16 __attribute__((ext_vector_type(16)));
#define MFMA32(a, b, c) __builtin_amdgcn_mfma_f32_32x32x16_bf16((a), (b), (c), 0, 0, 0)
__device__ __forceinline__ int crow(int i, int hh) { return (i & 3) + 8 * (i >> 2) + 4 * hh; }
__device__ __forceinline__ bf16x8 pack8(const f32x16& v, int s) {
    u32x4 t; t.x = pk2(v[8 * s], v[8 * s + 1]); t.y = pk2(v[8 * s + 2], v[8 * s + 3]); t.z = pk2(v[8 * s + 4], v[8 * s + 5]); t.w = pk2(v[8 * s + 6], v[8 * s + 7]);
    return __builtin_bit_cast(bf16x8, t);
}
__device__ __forceinline__ bf16x8 join8(u32x2 a, u32x2 b) { u32x4 t = {a.x, a.y, b.x, b.y}; return __builtin_bit_cast(bf16x8, t); }
__device__ __forceinline__ void tr_store8(LAS unsigned* T32, int pitch32, int ch, int p, u32x4 w0, u32x4 w1) {
    LAS unsigned* t = T32 + (ch * 8) * pitch32 + (p ^ ((ch & 7) << 2));
    t[0 * pitch32] = (w0.x & 0xffffu) | (w1.x << 16); t[1 * pitch32] = (w0.x >> 16) | (w1.x & 0xffff0000u);
    t[2 * pitch32] = (w0.y & 0xffffu) | (w1.y << 16); t[3 * pitch32] = (w0.y >> 16) | (w1.y & 0xffff0000u);
    t[4 * pitch32] = (w0.z & 0xffffu) | (w1.z << 16); t[5 * pitch32] = (w0.z >> 16) | (w1.z & 0xffff0000u);
    t[6 * pitch32] = (w0.w & 0xffffu) | (w1.w << 16); t[7 * pitch32] = (w0.w >> 16) | (w1.w & 0xffff0000u);
}
__device__ __forceinline__ int tr_off(int c, int pitch32, int d) { return 2 * (c * pitch32 + (d ^ (((c >> 3) & 7) << 2))); }

__device__ __forceinline__ void attn_mfma(LAS unsigned char* lds, const bf16_t* P, bf16_t* X, const float* sinks, int unit, const int tid) {
    const int lane = tid & 63, wid = __builtin_amdgcn_readfirstlane(tid >> 6), r32 = lane & 31, hh = lane >> 5;
    const int b = unit >> 5, n = (unit >> 1) & 15, g = unit & 1;
    LAS bf16_t* Ks = (LAS bf16_t*)lds;
    LAS bf16_t* Vt = Ks + 256 * 72;
    const long row0 = (long)b * SEQ + n * 128 - 128;
    { u32x4 kv[4], w0[2], w1[2];
#pragma unroll
      for (int i = 0; i < 4; ++i) { const int c = tid + 512 * i, key = c >> 3, ch = c & 7; kv[i] = (u32x4){0u, 0u, 0u, 0u};
          if (n > 0 || key >= 128) kv[i] = *(const u32x4*)(P + (size_t)(row0 + key) * PW + 512 + g * 64 + ch * 8); }
#pragma unroll
      for (int i = 0; i < 2; ++i) { const int it = tid + 512 * i, kp = it >> 3, ch = it & 7; w0[i] = (u32x4){0u, 0u, 0u, 0u}; w1[i] = w0[i];
          if (n > 0 || kp >= 64) { const bf16_t* src = P + (size_t)(row0 + 2 * kp) * PW + 640 + g * 64 + ch * 8; w0[i] = *(const u32x4*)src; w1[i] = *(const u32x4*)(src + PW); } }
#pragma unroll
      for (int i = 0; i < 4; ++i) { const int c = tid + 512 * i, key = c >> 3, ch = c & 7; *(LAS u32x4*)(Ks + key * 72 + ch * 8) = kv[i]; }
#pragma unroll
      for (int i = 0; i < 2; ++i) { const int it = tid + 512 * i, kp = it >> 3, ch = it & 7; tr_store8((LAS unsigned*)Vt, 132, ch, kp, w0[i], w1[i]); } }
    const int hq = g * 4 + (wid >> 1);
    const float sink2 = sinks[hq] * LOG2E;
    bf16x8 qfa[2][4];
#pragma unroll
    for (int pass = 0; pass < 2; ++pass) { const bf16_t* qp = P + ((size_t)b * SEQ + n * 128 + (wid & 1) * 64 + pass * 32 + r32) * PW + hq * 64 + 8 * hh;
#pragma unroll
        for (int s = 0; s < 4; ++s) qfa[pass][s] = *(const bf16x8*)(qp + 16 * s); }
    __syncthreads();
#pragma unroll
    for (int pass = 0; pass < 2; ++pass) {
        const int r0 = (wid & 1) * 64 + pass * 32;
        const size_t qrow = (size_t)b * SEQ + n * 128 + r0 + r32;
        const bf16x8 (&qf)[4] = qfa[pass];
        f32x16 S[5];
#pragma unroll
        for (int j = 0; j < 5; ++j) {
#pragma unroll
            for (int i = 0; i < 16; ++i) S[j][i] = 0.f;
            const LAS bf16_t* kp = Ks + (r0 + 32 * j + r32) * 72 + 8 * hh;
#pragma unroll
            for (int s = 0; s < 4; ++s) S[j] = MFMA32(*(const LAS bf16x8*)(kp + 16 * s), qf[s], S[j]);
        }
#pragma unroll
        for (int i = 0; i < 16; ++i) { const int c = crow(i, hh); if (c <= r32) S[0][i] = -INFINITY; if (c > r32) S[4][i] = -INFINITY; }
        if (n == 0) {
#pragma unroll
            for (int j = 0; j < 4; ++j) if (r0 + 32 * j < 128) {
#pragma unroll
                for (int i = 0; i < 16; ++i) S[j][i] = -INFINITY; }
        }
        float mx = sink2;
#pragma unroll
        for (int j = 0; j < 5; ++j)
#pragma unroll
            for (int i = 0; i < 16; ++i) mx = fmaxf(mx, S[j][i]);
        mx = fmaxf(mx, __shfl_xor(mx, 32));
        float l = 0.f;
#pragma unroll
        for (int j = 0; j < 5; ++j)
#pragma unroll
            for (int i = 0; i < 16; ++i) { const float p = ex2(S[j][i] - mx); S[j][i] = p; l += p; }
        l += __shfl_xor(l, 32);
        l += ex2(sink2 - mx);
        f32x16 o[2];
#pragma unroll
        for (int i = 0; i < 16; ++i) { o[0][i] = 0.f; o[1][i] = 0.f; }
#pragma unroll
        for (int j = 0; j < 5; ++j)
#pragma unroll
            for (int s = 0; s < 2; ++s) {
                const bf16x8 pf = pack8(S[j], s);
#pragma unroll
                for (int dt = 0; dt < 2; ++dt) {
                    const int dd = (r0 + 32 * j + 16 * s + 4 * hh) >> 1;
                    o[dt] = MFMA32(join8(*(const LAS u32x2*)(Vt + tr_off(32 * dt + r32, 132, dd)), *(const LAS u32x2*)(Vt + tr_off(32 * dt + r32, 132, dd + 4))), pf, o[dt]);
                }
            }
        const float il = 1.f / l;
        bf16_t* op = X + qrow * XW + 1024 + hq * 64 + 4 * hh;
#pragma unroll
        for (int dt = 0; dt < 2; ++dt)
#pragma unroll
            for (int g4 = 0; g4 < 4; ++g4) { u32x2 w; w.x = pk2(o[dt][4 * g4] * il, o[dt][4 * g4 + 1] * il); w.y = pk2(o[dt][4 * g4 + 2] * il, o[dt][4 * g4 + 3] * il);
                *(u32x2*)(op + 32 * dt + 8 * g4) = w; }
    }
    __syncthreads();
}

__device__ __forceinline__ void kv_mfma(LAS unsigned char* lds, const bf16_t* P, bf16_t* kvT, int unit, const int tid) {
    const int lane = tid & 63, wid = __builtin_amdgcn_readfirstlane(tid >> 6), r32 = lane & 31, hh = lane >> 5;
    const int b = unit >> 6, h = (unit >> 4) & 3, n = unit & 15;
    LAS bf16_t* Kt = (LAS bf16_t*)lds;
    LAS bf16_t* Vt = Kt + 64 * 136;
    const size_t rowc = (size_t)b * SEQ + n * 128; const float lg = lg_gamma(h);
    { const int tp = tid >> 3, ch = tid & 7;
      const bf16_t* src = P + (rowc + 2 * tp) * PW + 1024 + h * 64 + ch * 8; const u32x4 w0 = *(const u32x4*)src, w1 = *(const u32x4*)(src + PW);
      const int tv = tid >> 3, cv = 2 * (tid & 7);
      const bf16_t* sv = P + (rowc + 2 * tv) * PW + 1280 + h * 128 + cv * 8;
      const u32x4 va0 = *(const u32x4*)sv, va1 = *(const u32x4*)(sv + PW), vb0 = *(const u32x4*)(sv + 8), vb1 = *(const u32x4*)(sv + 8 + PW);
      const float z0 = ex2((float)(127 - 2 * tp) * lg), z1 = ex2((float)(126 - 2 * tp) * lg);
      LAS unsigned* t = (LAS unsigned*)Kt + (ch * 8) * 68 + (tp ^ ((ch & 7) << 2));
      t[0 * 68] = pk2(bflo(w0.x) * z0, bflo(w1.x) * z1); t[1 * 68] = pk2(bfhi(w0.x) * z0, bfhi(w1.x) * z1); t[2 * 68] = pk2(bflo(w0.y) * z0, bflo(w1.y) * z1); t[3 * 68] = pk2(bfhi(w0.y) * z0, bfhi(w1.y) * z1);
      t[4 * 68] = pk2(bflo(w0.z) * z0, bflo(w1.z) * z1); t[5 * 68] = pk2(bfhi(w0.z) * z0, bfhi(w1.z) * z1); t[6 * 68] = pk2(bflo(w0.w) * z0, bflo(w1.w) * z1); t[7 * 68] = pk2(bfhi(w0.w) * z0, bfhi(w1.w) * z1);
      tr_store8((LAS unsigned*)Vt, 68, cv, tv, va0, va1); tr_store8((LAS unsigned*)Vt, 68, cv + 1, tv, vb0, vb1); }
    __syncthreads();
    const int et = wid >> 1, dt = wid & 1;
    f32x16 acc;
#pragma unroll
    for (int i = 0; i < 16; ++i) acc[i] = 0.f;
#pragma unroll
    for (int s = 0; s < 8; ++s) acc = MFMA32(*(const LAS bf16x8*)(Kt + tr_off(32 * dt + r32, 68, 8 * s + 4 * hh)), *(const LAS bf16x8*)(Vt + tr_off(32 * et + r32, 68, 8 * s + 4 * hh)), acc);
    bf16_t* o = kvT + ((size_t)unit * 128 + 32 * et + r32) * 64 + 32 * dt + 4 * hh;
#pragma unroll
    for (int g4 = 0; g4 < 4; ++g4) { u32x2 w; w.x = pk2(acc[4 * g4], acc[4 * g4 + 1]); w.y = pk2(acc[4 * g4 + 2], acc[4 * g4 + 3]); *(u32x2*)(o + 8 * g4) = w; }
    __syncthreads();
}

__device__ __forceinline__ void ret_mfma(LAS unsigned char* lds, const bf16_t* P, const bf16_t* kvT, bf16_t* X, int unit, const int tid) {
    const int lane = tid & 63, wid = __builtin_amdgcn_readfirstlane(tid >> 6), r32 = lane & 31, hh = lane >> 5;
    const int b = unit >> 6, h = (unit >> 4) & 3, n = unit & 15;
    LAS bf16_t* St = (LAS bf16_t*)lds;
    LAS bf16_t* Ks = St + 128 * 72;
    LAS bf16_t* Vt = Ks + 128 * 72;
    LAS float* ssq = (LAS float*)(Vt + 128 * 136);
    const size_t rowc = (size_t)b * SEQ + n * 128; const float lg = lg_gamma(h);
    const int rb = wid >> 1, eh = wid & 1;
    const size_t qrow = rowc + 32 * rb + r32;
    bf16x8 qf[4];
    { const bf16_t* qp = P + qrow * PW + 768 + h * 64 + 8 * hh;
#pragma unroll
      for (int s = 0; s < 4; ++s) qf[s] = *(const bf16x8*)(qp + 16 * s);
    }
    {
    u32x4 kst[2], vst0[2], vst1[2];
#pragma unroll
    for (int i = 0; i < 2; ++i) { const int c = tid + 512 * i; kst[i] = *(const u32x4*)(P + (rowc + (c >> 3)) * PW + 1024 + h * 64 + (c & 7) * 8);
        const int it = tid + 512 * i; const bf16_t* src = P + (rowc + 2 * (it >> 4)) * PW + 1280 + h * 128 + (it & 15) * 8; vst0[i] = *(const u32x4*)src; vst1[i] = *(const u32x4*)(src + PW); }
    { const int e = tid >> 2, d0 = (tid & 3) * 16; float s[16];
#pragma unroll
      for (int k = 0; k < 16; ++k) s[k] = 0.f;
      if (n > 0) {
          const u32x4* kb = (const u32x4*)(kvT + ((size_t)(unit - n) * 128 + e) * 64 + d0);
#pragma unroll
          for (int g = 0; g < 2; ++g) {
              const int j0 = 12 * g, nj = g ? 3 : 12;
              if (g && n <= 12) break;
              u32x4 t[12][2];
#pragma unroll
              for (int j = 0; j < 12; ++j) if (j < nj) { const int jj = (j0 + j) < n ? (j0 + j) : n - 1; t[j][0] = kb[(size_t)jj * 1024]; t[j][1] = kb[(size_t)jj * 1024 + 1]; }
#pragma unroll
              for (int j = 0; j < 12; ++j) if (j < nj) { const float w = (j0 + j) < n ? ex2((float)((n - 1 - j0 - j) * 128) * lg) : 0.f;
#pragma unroll
                  for (int q = 0; q < 2; ++q) { const u32x4 v = t[j][q];
                      s[8 * q] += w * bflo(v.x); s[8 * q + 1] += w * bfhi(v.x); s[8 * q + 2] += w * bflo(v.y); s[8 * q + 3] += w * bfhi(v.y);
                      s[8 * q + 4] += w * bflo(v.z); s[8 * q + 5] += w * bfhi(v.z); s[8 * q + 6] += w * bflo(v.w); s[8 * q + 7] += w * bfhi(v.w); } }
          }
      }
      u32x4 w0, w1; w0.x = pk2(s[0], s[1]); w0.y = pk2(s[2], s[3]); w0.z = pk2(s[4], s[5]); w0.w = pk2(s[6], s[7]);
      w1.x = pk2(s[8], s[9]); w1.y = pk2(s[10], s[11]); w1.z = pk2(s[12], s[13]); w1.w = pk2(s[14], s[15]);
      *(LAS u32x4*)(St + e * 72 + d0) = w0; *(LAS u32x4*)(St + e * 72 + d0 + 8) = w1; }
#pragma unroll
    for (int i = 0; i < 2; ++i) { const int c = tid + 512 * i; *(LAS u32x4*)(Ks + (c >> 3) * 72 + (c & 7) * 8) = kst[i]; }
#pragma unroll
    for (int i = 0; i < 2; ++i) { const int it = tid + 512 * i; tr_store8((LAS unsigned*)Vt, 68, it & 15, it >> 4, vst0[i], vst1[i]); }
    __syncthreads();
    }
    {
    u32x2 gw[2][4];
    { const bf16_t* gp = P + qrow * PW + 1792 + h * 128 + 64 * eh + 4 * hh;
#pragma unroll
      for (int et = 0; et < 2; ++et)
#pragma unroll
          for (int g4 = 0; g4 < 4; ++g4) gw[et][g4] = *(const u32x2*)(gp + 32 * et + 8 * g4); }
    f32x16 o[2];
#pragma unroll
    for (int i = 0; i < 16; ++i) { o[0][i] = 0.f; o[1][i] = 0.f; }
#pragma unroll
    for (int et = 0; et < 2; ++et) { const LAS bf16_t* sp = St + (64 * eh + 32 * et + r32) * 72 + 8 * hh;
#pragma unroll
        for (int s = 0; s < 4; ++s) o[et] = MFMA32(*(const LAS bf16x8*)(sp + 16 * s), qf[s], o[et]); }
    { const float xi = ex2((float)(32 * rb + r32 + 1) * lg);
#pragma unroll
      for (int i = 0; i < 16; ++i) { o[0][i] *= xi; o[1][i] *= xi; } }
    for (int kt = 0; kt <= rb; ++kt) {
        f32x16 S;
#pragma unroll
        for (int i = 0; i < 16; ++i) S[i] = 0.f;
        const LAS bf16_t* kp = Ks + (32 * kt + r32) * 72 + 8 * hh;
#pragma unroll
        for (int s = 0; s < 4; ++s) S = MFMA32(*(const LAS bf16x8*)(kp + 16 * s), qf[s], S);
#pragma unroll
        for (int i = 0; i < 16; ++i) { const int diff = 32 * (rb - kt) + r32 - crow(i, hh); S[i] = diff >= 0 ? S[i] * ex2((float)diff * lg) : 0.f; }
#pragma unroll
        for (int s = 0; s < 2; ++s) {
            const bf16x8 pf = pack8(S, s);
#pragma unroll
            for (int et = 0; et < 2; ++et) {
                const int er = 64 * eh + 32 * et + r32, dd = 16 * kt + 8 * s + 2 * hh;
                o[et] = MFMA32(join8(*(const LAS u32x2*)(Vt + tr_off(er, 68, dd)), *(const LAS u32x2*)(Vt + tr_off(er, 68, dd + 4))), pf, o[et]);
            }
        }
    }
    float sq = 0.f;
#pragma unroll
    for (int i = 0; i < 16; ++i) sq += o[0][i] * o[0][i] + o[1][i] * o[1][i];
    sq += __shfl_xor(sq, 32);
    if (hh == 0) ssq[eh * 128 + 32 * rb + r32] = sq;
    __syncthreads();
    const float rs = rsqrtf((ssq[32 * rb + r32] + ssq[128 + 32 * rb + r32]) * (1.f / 128.f) + EPS);
    bf16_t* op = X + qrow * XW + 1536 + h * 128 + 64 * eh + 4 * hh;
#pragma unroll
    for (int et = 0; et < 2; ++et)
#pragma unroll
        for (int g4 = 0; g4 < 4; ++g4) { const u32x2 g = gw[et][g4]; u32x2 w;
            w.x = pk2(o[et][4 * g4] * rs * bflo(g.x), o[et][4 * g4 + 1] * rs * bfhi(g.x)); w.y = pk2(o[et][4 * g4 + 2] * rs * bflo(g.y), o[et][4 * g4 + 3] * rs * bfhi(g.y));
            *(u32x2*)(op + 32 * et + 8 * g4) = w; }
    }
    __syncthreads();
}
#define XB_TMO      128
#define XB_XCNT(j)  (256  + 64 * (j))
#define XB_XSUB(j)  (1280 + 64 * (j))
#define XB_XGEN(j)  (2304 + 64 * (j))
#define XB_TOP      3328
#define XB_TOPGEN   3392
#define XCD_BAR_WORDS 3456
#define XB_SPIN_CAP (1u << 18)
__device__ __forceinline__ unsigned xb_ld(unsigned* p)              { return __hip_atomic_load(p, __ATOMIC_RELAXED, __HIP_MEMORY_SCOPE_AGENT); }
__device__ __forceinline__ unsigned xb_add(unsigned* p, unsigned v) { return __hip_atomic_fetch_add(p, v, __ATOMIC_RELAXED, __HIP_MEMORY_SCOPE_AGENT); }
__device__ __forceinline__ unsigned xb_xcc_id() { return (unsigned)__builtin_amdgcn_s_getreg((3 << 11) | 20) & 0xFu; }
#define XB_SPIN(cond, bar) do { unsigned _sp = 0; while (cond) { __builtin_amdgcn_s_sleep(1); \
    if ((++_sp & 255u) == 0u) { if (xb_ld(&(bar)[XB_TMO])) break; if (_sp > XB_SPIN_CAP) { atomicAdd(&(bar)[XB_TMO], 1u); break; } } } } while (0)
struct XcdBarrier { unsigned* bar; unsigned x; volatile LAS unsigned* st; unsigned nexp; };
__device__ __forceinline__ XcdBarrier xcd_barrier_post(unsigned* bar, volatile LAS unsigned* st, unsigned nexp) {
    XcdBarrier b; b.bar = bar; b.x = xb_xcc_id(); b.st = st; b.nexp = nexp;
    if (threadIdx.x == 0) (void)xb_add(&bar[XB_XCNT(b.x)], 1u);
    return b;
}
__device__ __forceinline__ void xcd_barrier_complete(unsigned* bar, unsigned x, unsigned G, unsigned& nloc, unsigned& nx) {
    unsigned sum, cnt, mine, sp = 0u;
    for (;;) {
        sum = 0u; cnt = 0u; mine = 0u;
#pragma unroll
        for (unsigned j = 0; j < 16; ++j) { const unsigned c = xb_ld(&bar[XB_XCNT(j)]); sum += c; cnt += (c > 0u) ? 1u : 0u; mine = (j == x) ? c : mine; }
        if (sum == G) break;
        __builtin_amdgcn_s_sleep(1);
        if ((++sp & 255u) == 0u) { if (xb_ld(&bar[XB_TMO])) break; if (sp > XB_SPIN_CAP) { atomicAdd(&bar[XB_TMO], 1u); break; } }
    }
    nloc = mine > 0u ? mine : 1u; nx = cnt > 0u ? cnt : 1u;
}
__device__ __forceinline__ void xcd_barrier(const XcdBarrier& b) {
    asm volatile("s_waitcnt vmcnt(0)" ::: "memory");
    __syncthreads();
    if (threadIdx.x == 0) {
        unsigned* bar = b.bar;
        __builtin_amdgcn_s_waitcnt(0);
        unsigned nloc = b.st[0], nx = b.st[1];
        if (nloc == 0u) { xcd_barrier_complete(bar, b.x, b.nexp, nloc, nx); b.st[0] = nloc; b.st[1] = nx; }
        const unsigned old = xb_add(&bar[XB_XSUB(b.x)], 1u);
        const unsigned gen = old / nloc;
        if (old + 1u == (gen + 1u) * nloc) {
            __builtin_amdgcn_fence(__ATOMIC_RELEASE, "agent");
            asm volatile("s_waitcnt vmcnt(0)" ::: "memory");
            const unsigned og = xb_add(&bar[XB_TOP], 1u);
            const unsigned tg = og / nx;
            if (og + 1u == (tg + 1u) * nx) xb_add(&bar[XB_TOPGEN], 1u);
            else XB_SPIN(xb_ld(&bar[XB_TOPGEN]) == tg, bar);
            __builtin_amdgcn_fence(__ATOMIC_ACQUIRE, "agent");
            xb_add(&bar[XB_XGEN(b.x)], 1u);
            asm volatile("s_waitcnt vmcnt(0)" ::: "memory");
        } else {
            XB_SPIN(xb_ld(&bar[XB_XGEN(b.x)]) == gen, bar);
            __builtin_amdgcn_fence(__ATOMIC_ACQUIRE, "agent");
            asm volatile("s_waitcnt vmcnt(0)" ::: "memory");
        }
    }
    __syncthreads();
}

constexpr int NPH = 30;
#ifndef PHM
#define PHM 0x1ff
#endif
#ifndef MIX_NAIVE
#define MIX_NAIVE 0
#endif
#ifndef RES_BF16
#define RES_BF16 1
#endif
#ifndef HBD_EXP
#define HBD_EXP 0
#endif
#ifndef B1_PROBE
#define B1_PROBE 0
#endif
#ifndef DBL_BAR
#define DBL_BAR 0
#endif
#ifndef DBLM
#define DBLM 0
#endif
#ifndef MK_NG
#define MK_NG 1
#endif
#ifndef MK_STAGGER
#define MK_STAGGER 1500
#endif
__global__ void __launch_bounds__(512, 2) mk_fwd(Args a) {
    extern __shared__ __attribute__((aligned(16))) unsigned char lds_raw[];
    LAS unsigned char* lds = (LAS unsigned char*)lds_raw;
    const int Gall = gridDim.x, call = blockIdx.x;
    constexpr int NG = MK_NG, MG = M / NG;
    const int grp = (call >> 3) % NG, c = ((call >> 3) / NG) * 8 + (call & 7), G = Gall / NG;
    const int row0 = grp * MG, pm0 = grp * (MG / 256);
    volatile LAS unsigned* MISC = (volatile LAS unsigned*)(lds + MISC_OFF);
    if (threadIdx.x < 32) MISC[threadIdx.x] = 0u;
    __syncthreads();
    unsigned* ctl = (unsigned*)(a.ws + WS_CTL);
    const bool multi = (a.ph_hi - a.ph_lo) > 1;
    XcdBarrier barAll, bar; barAll.bar = ctl + 4096; barAll.x = 0; barAll.st = nullptr; barAll.nexp = 0; bar = barAll;
    if (multi) { barAll = xcd_barrier_post(ctl + 4096, MISC + 8, (unsigned)Gall);
                 bar = (NG == 1) ? barAll : xcd_barrier_post(ctl + 4096 + (1 + grp) * XCD_BAR_WORDS, MISC + 10, (unsigned)G); }

    bf16_t* X = (bf16_t*)(a.ws + WS_X); bf16_t* P = (bf16_t*)(a.ws + WS_P); float* ss = (float*)(a.ws + WS_SS);
#if MIX_NAIVE & 2
    float* kvb = (float*)(a.ws + WS_KV);
#else
    bf16_t* kvb = (bf16_t*)(a.ws + WS_KV);
#endif
    for (int ph = a.ph_lo; ph < a.ph_hi; ++ph) {
        const int kind_ = (ph == 0) ? 0 : (ph == NPH - 1) ? 1 : 2 + (ph - 1) % 7;
        for (int rep_ = 0; rep_ < (((DBLM >> kind_) & 1) ? 2 : 1); ++rep_) {
        if (rep_) __syncthreads();
        int tid = threadIdx.x; asm volatile("" : "+v"(tid));
        if (ph == 0) { if (PHM & 1) phase_prologue(a, lds, Gall, tid); }
        else if (ph == NPH - 1) { if (PHM & 2) final_norm(a.out, ss + (size_t)8 * M * 16, a.norm_final, G, c, row0, MG, tid); }
        else {
            const int l = (ph - 1) / 7, sub = (ph - 1) % 7;
            const char* Wl = (const char*)(a.ws + WS_W + (size_t)l * WL_SIZE);
            if (sub == 0 && (PHM & 4)) {
                pg8::SchedPlain S{(const char*)X, Wl + WL_IN, XW, DM, DM / 64, MG / 256, NIN / 256, G, c, pg8::K_IN, pm0};
                pg8::EpiIn E{P, ss + (size_t)(2 * l) * M * 16};
                pg8::gemm_phase(lds, XW, DM, S, E, tid);
                if (CV_LAZY && CV_SPLIT > 0 && l + 1 < DEPTH) cv_fill(a, lds, l + 1, 0, CV_SPLIT, (MG / 256) * (NIN / 256), G, c, tid);
            } else if (sub == 1 && (PHM & 8)) {
#if MIX_NAIVE & 1
                for (int u = c; u < 256 / NG; u += G) attn_naive(lds, P, X, a.sinks + l * 8, grp * (256 / NG) + u, tid);
#else
                for (int rr_ = 0; rr_ < ((B1_PROBE & 1) ? 2 : 1); ++rr_)
                for (int u = c; u < 256 / NG; u += G) attn_mfma(lds, P, X, a.sinks + l * 8, grp * (256 / NG) + u, tid);
#endif
#if MIX_NAIVE & 2
                for (int u = c; u < 512 / NG; u += G) kv_naive(lds, P, kvb, grp * (512 / NG) + u, tid);
#else
                for (int rr_ = 0; rr_ < ((B1_PROBE & 2) ? 2 : 1); ++rr_)
                for (int u = c; u < 512 / NG; u += G) kv_mfma(lds, P, kvb, grp * (512 / NG) + u, tid);
#endif
                for (int rr_ = 0; rr_ < ((B1_PROBE & 4) ? 2 : 1); ++rr_)
                conv_all(P, a.conv_w + l * 3 * 512, X, G, c, row0, MG, tid);
            } else if (sub == 2 && (PHM & 16)) {
#if MIX_NAIVE & 2
                for (int u = c; u < 512 / NG; u += G) ret_naive(lds, P, kvb, X, grp * (512 / NG) + u, tid);
#else
                for (int u = c; u < 512 / NG; u += G) ret_mfma(lds, P, kvb, X, grp * (512 / NG) + ((u < 256 / NG) ? u : (u & ~15) | (15 - (u & 15))), tid);
#endif
            } else if (sub == 3 && (PHM & 32)) {
                pg8::SchedC S{(const char*)X, Wl + WL_C, Wl + WL_B, MG / 256, G, c, pm0};
                pg8::EpiC E{ss + (size_t)(2 * l) * M * 16, a.b_gate + l * 3 * DM, (u32x4*)(a.ws + WS_GS) + (size_t)call * 8192, (u32x4*)(a.ws + WS_MACC) + (size_t)call * 16384, (bf16_t*)(a.ws + WS_MB)};
                pg8::gemm_phase(lds, XW, KC, S, E, tid);
            } else if (sub == 4 && (PHM & 64)) {
                pg8::SchedPlain S{(const char*)(a.ws + WS_MB), Wl + WL_OUT, DM, DM, DM / 64, MG / 256, DM / 256, G, c, pg8::K_RES, pm0};
                pg8::EpiRes E{l == 0 ? a.x : a.out, a.out, X, ss + (size_t)(2 * l + 1) * M * 16, RES_BF16 ? (l == 0 ? 0 : 1) : 2, HBD_EXP ? (bf16_t*)(a.ws + 398 * MiB) : nullptr};
                pg8::gemm_phase(lds, DM, DM, S, E, tid);
            } else if (sub == 5 && (PHM & 128)) {
                const int ldE = HBD_EXP ? DM : XW;
                pg8::SchedPlain S{HBD_EXP ? (const char*)(a.ws + 398 * MiB) : (const char*)X, Wl + WL_GU, ldE, DM, DM / 64, MG / 256, NGU / 256, G, c, pg8::K_GU, pm0};
                pg8::EpiGU E{ss + (size_t)(2 * l + 1) * M * 16, (bf16_t*)(a.ws + WS_FF)};
                pg8::gemm_phase(lds, ldE, DM, S, E, tid);
                if (CV_LAZY && l + 1 < DEPTH) cv_fill(a, lds, l + 1, CV_SPLIT, CV_PER_LAYER, (MG / 256) * (NGU / 256), G, c, tid);
            } else if (sub == 6 && (PHM & 256)) {
                pg8::SchedPlain S{(const char*)(a.ws + WS_FF), Wl + WL_D, DFF, DFF, DFF / 64, MG / 256, DM / 256, G, c, pg8::K_RES, pm0};
                pg8::EpiRes E{a.out, a.out, X, ss + (size_t)(2 * l + 2) * M * 16, RES_BF16 ? (l == DEPTH - 1 ? 3 : 1) : 2, nullptr};
                pg8::gemm_phase(lds, DFF, DFF, S, E, tid);
            }
        }
        }
        if (ph + 1 < a.ph_hi) {
            if (ph == 0) { xcd_barrier(barAll);
                if (NG > 1 && grp > 0) { const unsigned long long t0 = __builtin_amdgcn_s_memrealtime(); while (__builtin_amdgcn_s_memrealtime() - t0 < (unsigned long long)(grp * MK_STAGGER)) __builtin_amdgcn_s_sleep(8); } }
            else xcd_barrier(bar);
#if DBL_BAR
            xcd_barrier(bar);
#endif
        }
    }
}

#ifndef MK_SINGLE
#define MK_SINGLE 0
#endif
extern "C" void kernel_launch(void* const* d_in, const int* in_sizes, int n_in, void* d_out, int out_size, void* d_ws, size_t ws_size, hipStream_t stream) {
    static int grid = 0;
    if (grid == 0) {
        if (n_in != 13 || out_size != M * DM || ws_size < WS_END) { fprintf(stderr, "kernel_launch: unexpected shapes (n_in %d, out %d, ws %zu)\n", n_in, out_size, ws_size); grid = -1; return; }
        int dev = 0, cus = 0, per_cu = 0;
        if (hipGetDevice(&dev) != hipSuccess || hipDeviceGetAttribute(&cus, hipDeviceAttributeMultiprocessorCount, dev) != hipSuccess) { grid = -1; return; }
        if (hipFuncSetAttribute((const void*)mk_fwd, hipFuncAttributeMaxDynamicSharedMemorySize, LDS_BYTES) != hipSuccess) { fprintf(stderr, "kernel_launch: hipFuncSetAttribute failed\n"); grid = -1; return; }
        if (hipOccupancyMaxActiveBlocksPerMultiprocessor(&per_cu, (const void*)mk_fwd, 512, LDS_BYTES) != hipSuccess || per_cu < 1) { fprintf(stderr, "kernel_launch: occupancy query says %d\n", per_cu); per_cu = 1; }
        (void)hipGetLastError();
        grid = cus;
        if (grid > 256) grid = 256;
    }
    if (grid < 0) return;
    (void)hipMemsetAsync((char*)d_ws + WS_CTL, 0, CTL_ZERO_BYTES, stream);
    Args a{};
    a.x = (const float*)d_in[0]; a.norm_mix = (const float*)d_in[1]; a.w_in = (const float*)d_in[2]; a.sinks = (const float*)d_in[3]; a.conv_w = (const float*)d_in[4];
    a.w_branch = (const float*)d_in[5]; a.b_gate = (const float*)d_in[6]; a.w_out = (const float*)d_in[7]; a.norm_ffn = (const float*)d_in[8];
    a.w_g = (const float*)d_in[9]; a.w_u = (const float*)d_in[10]; a.w_d = (const float*)d_in[11]; a.norm_final = (const float*)d_in[12];
    a.out = (float*)d_out; a.ws = (unsigned char*)d_ws;
#if MK_SINGLE
    a.ph_lo = 0; a.ph_hi = NPH;
    hipLaunchKernelGGL(mk_fwd, dim3(grid), dim3(512), LDS_BYTES, stream, a);
#else
    for (int ph = 0; ph < NPH; ++ph) { a.ph_lo = ph; a.ph_hi = ph + 1; hipLaunchKernelGGL(mk_fwd, dim3(grid), dim3(512), LDS_BYTES, stream, a); }
#endif
}
```

```cpp
#include <hip/hip_runtime.h>
#include <cstdio>
#include <cstdint>

#define LAS __attribute__((address_space(3)))
#define GAS __attribute__((address_space(1)))
typedef unsigned short bf16_t;
typedef short bf16x8 __attribute__((ext_vector_type(8)));
typedef float f32x4 __attribute__((ext_vector_type(4)));
typedef float f32x2 __attribute__((ext_vector_type(2)));
typedef unsigned u32x4 __attribute__((ext_vector_type(4)));
typedef unsigned u32x2 __attribute__((ext_vector_type(2)));
typedef __bf16 bf16x2_t __attribute__((ext_vector_type(2)));

constexpr int BATCH = 8, SEQ = 2048, DM = 1024, M = BATCH * SEQ, DEPTH = 4, DFF = 2816, DIN = 6912;
constexpr int PW = 3328;
constexpr int XW = 2560;
constexpr int NIN = 3840;
constexpr int NGU = 2 * DFF;
constexpr int KC = 1536;
constexpr float EPS = 1e-6f;
constexpr float LOG2E = 1.4426950408889634f;
constexpr float QSCALE = 0.18033688011112042f;

constexpr size_t MiB = 1u << 20;
constexpr size_t WS_CTL = 0, CTL_ZERO_BYTES = 262144;
constexpr size_t WS_SS = 388 * MiB;
constexpr size_t WS_TABA = 2 * MiB;
constexpr size_t WS_TABR = 2 * MiB + 131072;
constexpr size_t WS_W = 4 * MiB;
constexpr size_t WL_IN = 0, WL_C = 7864320, WL_B = 17301504, WL_OUT = 20447232, WL_GU = 22544384, WL_D = 34078720, WL_SIZE = 39845888;
constexpr size_t WS_X = 156 * MiB;
constexpr size_t WS_P = 236 * MiB;
constexpr size_t WS_MACC = WS_P, WS_MB = WS_P + 64 * MiB, WS_FF = WS_P;
constexpr size_t WS_GS = 340 * MiB;
constexpr size_t WS_KV = 372 * MiB;
constexpr size_t WS_END = 398 * MiB;
static_assert(WS_W + DEPTH * WL_SIZE <= WS_X, "weights");
static_assert((size_t)M * XW * 2 <= 80 * MiB && (size_t)M * PW * 2 <= 104 * MiB && (size_t)M * DFF * 2 <= 104 * MiB, "buffers");

constexpr int RING_BYTES = 131072, LDS_BYTES = 163840, MISC_OFF = LDS_BYTES - 512;

__device__ __forceinline__ unsigned pk2(float lo, float hi) { f32x2 v = {lo, hi}; bf16x2_t b = __builtin_convertvector(v, bf16x2_t); return __builtin_bit_cast(unsigned, b); }
__device__ __forceinline__ float bflo(unsigned u) { return __uint_as_float(u << 16); }
__device__ __forceinline__ float bfhi(unsigned u) { return __uint_as_float(u & 0xffff0000u); }
__device__ __forceinline__ float bf2f(bf16_t b) { return __uint_as_float((unsigned)b << 16); }
__device__ __forceinline__ float fsilu(float x) { return x * __builtin_amdgcn_rcpf(1.f + __builtin_amdgcn_exp2f(-x * LOG2E)); }
__device__ __forceinline__ float fsigm(float x) { return __builtin_amdgcn_rcpf(1.f + __builtin_amdgcn_exp2f(-x * LOG2E)); }

struct Args {
    const float* x; const float* norm_mix; const float* w_in; const float* sinks; const float* conv_w; const float* w_branch; const float* b_gate; const float* w_out;
    const float* norm_ffn; const float* w_g; const float* w_u; const float* w_d; const float* norm_final;
    float* out; unsigned char* ws; int ph_lo, ph_hi;
};
#define MK_SINGLE 1
#ifndef DBL_EPI
#define DBL_EPI 0
#endif
namespace pg8 {
constexpr int BM = 256, BK = 64, HALF = 128, HTB = HALF * BK * 2  , STAGE_BYTES = 8 * HTB, NXCD = 8, WGM = 8;

__host__ __device__ __forceinline__ int lds_byte(int r, int c) { const int st = (r >> 4) * 2 + (c >> 5), rr = r & 15, cc = c & 31, ob = rr * 64 + cc * 2; return st * 1024 + (ob ^ (((ob >> 9) & 1) << 5)); }
__host__ __device__ __forceinline__ void stage_rc(int b, int& R, int& C) { const int st = b / 1024, sb = b % 1024, swz = sb ^ (((sb >> 9) & 1) << 5); R = (st >> 1) * 16 + swz / 64; C = (st & 1) * 32 + (swz % 64) / 2; }
__host__ __device__ __forceinline__ int perm32(int rho) { const int n = rho >> 4, i = rho & 15; return 8 * (i >> 2) + 4 * n + (i & 3); }

struct Unit { const char* A; const char* B; int nt, pm, pn, kind, aux; };

__device__ __forceinline__ void tile_of(int L, int nM, int nN, int& pm, int& pn) {
    const int nwg = nM * nN; int wgid = L;
    { const int q = nwg / NXCD, r = nwg % NXCD, xcd = wgid % NXCD, off = wgid / NXCD; wgid = (xcd < r ? xcd * (q + 1) : r * (q + 1) + (xcd - r) * q) + off; }
    const int nig = WGM * nN, gid = wgid / nig, fm = gid * WGM, gsz = (nM - fm) < WGM ? (nM - fm) : WGM;
    pm = fm + ((wgid % nig) % gsz); pn = (wgid % nig) / gsz;
}

template <class Epi, class Sched>
__device__ __forceinline__ void gemm_phase(LAS unsigned char* lds, const int lda, const int ldb, const Sched& S, const Epi& E, const int tid) {
    const int wid = __builtin_amdgcn_readfirstlane(tid >> 6), lane = tid & 63, wr = wid >> 2, wc = wid & 3, fr = lane & 15, fq = lane >> 4;
    unsigned voffA[2], voffB[2];
#pragma unroll
    for (int i = 0; i < 2; ++i) { int R, C; stage_rc(tid * 16 + i * 8192, R, C); const int Rb = 2 * (R & ~31) + perm32(R & 31);
        voffA[i] = (unsigned)(R * lda + C) * 2u; voffB[i] = (unsigned)(Rb * ldb + C) * 2u; }
    const size_t kstep = (size_t)(BK * 2);
    const size_t hstepA = (size_t)HALF * lda * 2, hstepB = (size_t)32 * ldb * 2;
    const unsigned ldsw = (unsigned)wid * 1024u;
    const int aoff = lds_byte(wr * 64 + fr, fq * 8), boff = lds_byte(wc * 32 + fr, fq * 8);
#define PG8_SA(b, h) (((b) * 2 + (h)) * HTB)
#define PG8_SB(b, h) ((4 + (b) * 2 + (h)) * HTB)
#define PG8_STAGE(bufoff, gbase, voff) do { _Pragma("unroll") for (int _i = 0; _i < 2; ++_i) \
        __builtin_amdgcn_global_load_lds((const unsigned*)((const char*)(gbase) + (voff)[_i]), (LAS unsigned*)(lds + (bufoff) + ldsw + _i * 8192), 16, 0, 0); } while (0)
#define PG8_LDA(dst, b, h) do { _Pragma("unroll") for (int m = 0; m < 4; ++m) _Pragma("unroll") for (int k = 0; k < 2; ++k) dst[m][k] = *(const LAS bf16x8*)(lds + PG8_SA(b, h) + aoff + m * 2048 + k * 1024); } while (0)
#define PG8_LDB(dst, b, h) do { _Pragma("unroll") for (int n = 0; n < 2; ++n) _Pragma("unroll") for (int k = 0; k < 2; ++k) dst[n][k] = *(const LAS bf16x8*)(lds + PG8_SB(b, h) + boff + n * 2048 + k * 1024); } while (0)
#define PG8_MMA(ai, bj, At, Bt) do { __builtin_amdgcn_s_setprio(1); _Pragma("unroll") for (int m = 0; m < 4; ++m) _Pragma("unroll") for (int n = 0; n < 2; ++n) _Pragma("unroll") for (int k = 0; k < 2; ++k) \
        acc[ai][bj][m][n] = __builtin_amdgcn_mfma_f32_16x16x32_bf16(Bt[n][k], At[m][k], acc[ai][bj][m][n], 0, 0, 0); __builtin_amdgcn_s_setprio(0); } while (0)
#define PG8_WAIT_V(n) asm volatile("s_waitcnt vmcnt(" #n ")" ::: "memory")
#define PG8_WAIT_L(n) asm volatile("s_waitcnt lgkmcnt(" #n ")" ::: "memory")
#define PG8_BAR __builtin_amdgcn_s_barrier()
#define PG8_SCHED __builtin_amdgcn_sched_barrier(0)
    Unit cur, nxt; int ui = 0;
    if (!S.next(0, cur)) return;
    f32x4 acc[2][2][4][2];
#pragma unroll
    for (int a = 0; a < 2; ++a)
#pragma unroll
        for (int b = 0; b < 2; ++b)
#pragma unroll
            for (int m = 0; m < 4; ++m)
#pragma unroll
                for (int n = 0; n < 2; ++n) acc[a][b][m][n] = (f32x4){0.f, 0.f, 0.f, 0.f};
    bf16x8 At[4][2], B0[2][2], B1[2][2];
    const char* cA = cur.A; const char* cB = cur.B;
    PG8_STAGE(PG8_SB(0, 0), cB, voffB); PG8_STAGE(PG8_SB(0, 1), cB + hstepB, voffB); PG8_STAGE(PG8_SA(0, 0), cA, voffA); PG8_STAGE(PG8_SA(0, 1), cA + hstepA, voffA);
    if (wr == 1) PG8_BAR;
    PG8_WAIT_V(2); PG8_BAR;
    PG8_STAGE(PG8_SB(1, 0), cB + kstep, voffB); PG8_STAGE(PG8_SA(1, 0), cA + kstep, voffA); PG8_STAGE(PG8_SB(1, 1), cB + hstepB + kstep, voffB);
    PG8_WAIT_V(6); PG8_BAR;
    for (;;) {
        const bool has_next = S.next(ui + 1, nxt);
        const char* nA = has_next ? nxt.A : cA; const char* nB = has_next ? nxt.B : cB;
        const int nt = cur.nt;
        for (int t = 0; t < nt; t += 2) {
            const bool last = (t == nt - 2);
            if constexpr (Epi::HAS_HOOK) E.hook(acc, cur, t, wid);
            const char* a1 = cA + (size_t)(t + 1) * kstep;
            const char* a2 = last ? nA : cA + (size_t)(t + 2) * kstep; const char* b2 = last ? nB : cB + (size_t)(t + 2) * kstep;
            const char* a3 = a2 + kstep; const char* b3 = b2 + kstep;
            PG8_LDB(B0, 0, 0); PG8_LDB(B1, 0, 1); PG8_SCHED; PG8_LDA(At, 0, 0); PG8_STAGE(PG8_SA(1, 1), a1 + hstepA, voffA);
            PG8_WAIT_V(8); PG8_WAIT_L(0); PG8_BAR; PG8_MMA(0, 0, At, B0); PG8_MMA(0, 1, At, B1); PG8_BAR; PG8_SCHED;
            PG8_LDA(At, 0, 1); PG8_STAGE(PG8_SB(0, 0), b2, voffB); PG8_STAGE(PG8_SB(0, 1), b2 + hstepB, voffB); PG8_STAGE(PG8_SA(0, 0), a2, voffA);
            PG8_WAIT_V(8); PG8_WAIT_L(0); PG8_BAR; PG8_MMA(1, 0, At, B0); PG8_MMA(1, 1, At, B1); PG8_BAR; PG8_SCHED;
            PG8_LDB(B0, 1, 0); PG8_LDB(B1, 1, 1); PG8_SCHED; PG8_LDA(At, 1, 0); PG8_STAGE(PG8_SA(0, 1), a2 + hstepA, voffA);
            PG8_WAIT_V(8); PG8_WAIT_L(0); PG8_BAR; PG8_MMA(0, 0, At, B0); PG8_MMA(0, 1, At, B1); PG8_BAR; PG8_SCHED;
            PG8_LDA(At, 1, 1); PG8_STAGE(PG8_SB(1, 0), b3, voffB); PG8_STAGE(PG8_SB(1, 1), b3 + hstepB, voffB); PG8_STAGE(PG8_SA(1, 0), a3, voffA);
            PG8_WAIT_V(8); PG8_WAIT_L(0); PG8_BAR; PG8_MMA(1, 0, At, B0); PG8_MMA(1, 1, At, B1); PG8_BAR; PG8_SCHED;
        }
        if (wr == 0) PG8_BAR;
#if DBL_EPI
        if (E.dbl(cur)) { E(acc, cur, wid, false); asm volatile("" ::: "memory"); }
#endif
        E(acc, cur, wid, true);
        if (!has_next) break;
        cur = nxt; cA = nA; cB = nB; ++ui;
        if (wr == 1) PG8_BAR;
    }
    PG8_WAIT_V(0);
    PG8_BAR;
#undef PG8_SA
#undef PG8_SB
#undef PG8_STAGE
#undef PG8_LDA
#undef PG8_LDB
#undef PG8_MMA
#undef PG8_WAIT_V
#undef PG8_WAIT_L
#undef PG8_BAR
#undef PG8_SCHED
}
}
namespace pg8 {
#ifndef EPIC_TEST
#define EPIC_TEST(x) (x)
#endif
__device__ __forceinline__ float row_rstd(const float* ss, int row) {
    const f32x4* p = (const f32x4*)(ss + (size_t)row * 16); const f32x4 a = p[0], b = p[1], c = p[2], d = p[3];
    const float s = ((a[0] + a[1]) + (a[2] + a[3])) + ((b[0] + b[1]) + (b[2] + b[3])) + (((c[0] + c[1]) + (c[2] + c[3])) + ((d[0] + d[1]) + (d[2] + d[3])));
    return rsqrtf(s * (1.f / DM) + EPS);
}
#ifndef USE_NT
#define USE_NT 0
#endif
#if USE_NT
#define NT_STORE(p, v) __builtin_nontemporal_store((v), (p))
#else
#define NT_STORE(p, v) (*(p) = (v))
#endif
#ifndef WT_STORES
#define WT_STORES 0
#endif
#if WT_STORES
#define RSRC(ptr, bytes) __builtin_amdgcn_make_buffer_rsrc((void*)(ptr), (short)0, (int)(bytes), 0x00020000)
#define ST16(rs, base, elt_off, v) __builtin_amdgcn_raw_buffer_store_b128((v), (rs), (unsigned)((elt_off) * sizeof(*(base))), 0, 16)
#else
#define RSRC(ptr, bytes) 0
#define ST16(rs, base, elt_off, v) (*(u32x4*)((base) + (elt_off)) = (v))
#endif
#define EPI_LANE() const int lane_ = (int)__builtin_amdgcn_mbcnt_hi(~0u, __builtin_amdgcn_mbcnt_lo(~0u, 0u)); const int wr = wid >> 2, wc = wid & 3, fr = lane_ & 15, fq = lane_ >> 4, tid = wid * 64 + lane_; (void)wr; (void)wc; (void)fr; (void)fq; (void)tid
__device__ __forceinline__ void row_rstd8(const float* ss, int rbase, int lane, int fr, float (&rs)[8]) {
    const float a = row_rstd(ss, rbase + lane), b = row_rstd(ss, rbase + 128 + lane);
#pragma unroll
    for (int m = 0; m < 4; ++m) { rs[m] = __shfl(a, m * 16 + fr); rs[4 + m] = __shfl(b, m * 16 + fr); }
}
enum { K_IN = 0, K_GATE = 1, K_BRANCH = 2, K_RES = 3, K_GU = 4 };

__device__ __forceinline__ void rot1(float& a, float& b, float rev) {
    const float fr_ = rev - floorf(rev), c = __builtin_amdgcn_cosf(fr_), s = __builtin_amdgcn_sinf(fr_);
    const float na = a * c - b * s, nb = b * c + a * s; a = na; b = nb;
}
__device__ __forceinline__ f32x4 rot4(f32x4 v, f32x4 t) { return (f32x4){v[0] * t[0] - v[1] * t[1], v[1] * t[0] + v[0] * t[1], v[2] * t[2] - v[3] * t[3], v[3] * t[2] + v[2] * t[3]}; }

struct EpiIn {
    static constexpr bool HAS_HOOK = false;
    __device__ __forceinline__ bool dbl(const Unit&) const { return (DBL_EPI & 1) != 0; }
    bf16_t* P; const float* ss;
    __device__ __forceinline__ void operator()(f32x4 (&acc)[2][2][4][2], const Unit& u, int wid, const bool zacc) const {
        EPI_LANE();
        const int pn = u.pn;
        const auto rsP = RSRC(P, (size_t)M * PW * 2); (void)rsP;
        const int cw = wc * 64 + 8 * fq;
        float ivA[4], ivR[4];
#pragma unroll
        for (int j = 0; j < 4; ++j) { ivA[j] = __builtin_amdgcn_exp2f(-(float)(4 * (fq & 1) + j) * (18.931568569324174f / 8.f)) * 0.15915494309189535f;
                                      ivR[j] = __builtin_amdgcn_exp2f(-(float)(4 * fq + j) * (13.287712379549449f / 32.f)) * 0.15915494309189535f; }
        float rs8[8];
        row_rstd8(ss, u.pm * 256 + wr * 64, lane_, fr, rs8);
#pragma unroll
        for (int ai = 0; ai < 2; ++ai)
#pragma unroll
            for (int m = 0; m < 4; ++m) {
                const int row = u.pm * 256 + ai * 128 + wr * 64 + m * 16 + fr;
                const float rstd = rs8[ai * 4 + m];
                const float fpos = (float)(row & (SEQ - 1));
#pragma unroll
                for (int bj = 0; bj < 2; ++bj) {
                    f32x4 v0 = acc[ai][bj][m][0] * rstd, v1 = acc[ai][bj][m][1] * rstd;
                    const int gc = pn * 256 + bj * 32 + cw;
                    if (pn >= 11) {
                        if (bj == 0) { const f32x4 x0 = acc[ai][1][m][0] * rstd, x1 = acc[ai][1][m][1] * rstd;
                            u32x4 w; w.x = pk2(v0[0] * x0[0], v0[1] * x0[1]); w.y = pk2(v0[2] * x0[2], v0[3] * x0[3]); w.z = pk2(v1[0] * x1[0], v1[1] * x1[1]); w.w = pk2(v1[2] * x1[2], v1[3] * x1[3]);
                            ST16(rsP, P, (size_t)row * PW + 2816 + (pn - 11) * 128 + wc * 32 + 8 * fq, w); }
                    } else {
                        if (pn < 2 || (pn == 2 && wc < 2)) {
                            if (bj == 0 && fq < 2) {
                                float x[8] = {v0[0], v0[1], v0[2], v0[3], v1[0], v1[1], v1[2], v1[3]};
#pragma unroll
                                for (int j = 0; j < 4; ++j) rot1(x[2 * j], x[2 * j + 1], fpos * ivA[j]);
                                v0 = (f32x4){x[0], x[1], x[2], x[3]}; v1 = (f32x4){x[4], x[5], x[6], x[7]};
                            }
                            if (pn < 2) { v0 = v0 * QSCALE; v1 = v1 * QSCALE; }
                        } else if (pn == 3 || pn == 4) {
                            float x[8] = {v0[0], v0[1], v0[2], v0[3], v1[0], v1[1], v1[2], v1[3]};
#pragma unroll
                            for (int j = 0; j < 4; ++j) rot1(x[2 * j], x[2 * j + 1], fpos * (bj ? ivR[j] * 0.01f : ivR[j]));
                            v0 = (f32x4){x[0], x[1], x[2], x[3]}; v1 = (f32x4){x[4], x[5], x[6], x[7]};
                            if (pn == 4) { v0 = v0 * 0.125f; v1 = v1 * 0.125f; }
                        } else if (pn == 7 || pn == 8) {
#pragma unroll
                            for (int j = 0; j < 4; ++j) { v0[j] = fsilu(v0[j]); v1[j] = fsilu(v1[j]); }
                        }
                        u32x4 w; w.x = pk2(v0[0], v0[1]); w.y = pk2(v0[2], v0[3]); w.z = pk2(v1[0], v1[1]); w.w = pk2(v1[2], v1[3]);
                        ST16(rsP, P, (size_t)row * PW + gc, w);
                    }
                    if (zacc) { acc[ai][bj][m][0] = (f32x4){0.f, 0.f, 0.f, 0.f}; acc[ai][bj][m][1] = (f32x4){0.f, 0.f, 0.f, 0.f}; }
                }
                asm volatile("" ::: "memory");
            }
    }
};

struct EpiC {
    static constexpr bool HAS_HOOK = true;
    __device__ __forceinline__ bool dbl(const Unit&) const { return false; }
    const float* ss; const float* bg; u32x4* G0; u32x4* G12; bf16_t* mb;
    __device__ __forceinline__ u32x4* gbuf(int br) const { return br == 0 ? G0 : G12 + (size_t)(br - 1) * 8192; }
    __device__ __forceinline__ void hook(f32x4 (&acc)[2][2][4][2], const Unit& u, int t, int wid) const {
        if (u.kind != K_BRANCH || (t != 8 && t != 16)) return;
        EPI_LANE();
        const int br = (t >> 3) - 1;
        const u32x4* Ga = gbuf(br); const u32x4* Gb = gbuf(br + 1);
#pragma unroll
        for (int ai = 0; ai < 2; ++ai) {
            u32x4 ga[8], gb[8];
#pragma unroll
            for (int q = 0; q < 8; ++q) { ga[q] = Ga[(unsigned)((ai * 8 + q) * 512 + tid)]; gb[q] = Gb[(unsigned)((ai * 8 + q) * 512 + tid)]; }
            asm volatile("" ::: "memory");
#pragma unroll
            for (int m = 0; m < 4; ++m)
#pragma unroll
                for (int bj = 0; bj < 2; ++bj) {
                    const u32x4 a_ = ga[m * 2 + bj], b_ = gb[m * 2 + bj];
                    f32x4 d0 = (f32x4){bflo(b_.x), bfhi(b_.x), bflo(b_.y), bfhi(b_.y)}, d1 = (f32x4){bflo(b_.z), bfhi(b_.z), bflo(b_.w), bfhi(b_.w)};
#pragma unroll
                    for (int j = 0; j < 4; ++j) { d0[j] = __builtin_amdgcn_rcpf(fmaxf(d0[j], 1e-30f)); d1[j] = __builtin_amdgcn_rcpf(fmaxf(d1[j], 1e-30f)); }
                    acc[ai][bj][m][0] = acc[ai][bj][m][0] * ((f32x4){bflo(a_.x), bfhi(a_.x), bflo(a_.y), bfhi(a_.y)} * d0);
                    acc[ai][bj][m][1] = acc[ai][bj][m][1] * ((f32x4){bflo(a_.z), bfhi(a_.z), bflo(a_.w), bfhi(a_.w)} * d1);
                }
            asm volatile("" ::: "memory");
        }
    }
    __device__ __forceinline__ void operator()(f32x4 (&acc)[2][2][4][2], const Unit& u, int wid, const bool zacc) const {
        EPI_LANE();
        const int cw = u.pn * 256 + wc * 64 + 8 * fq;
        if (EPIC_TEST(u.kind == K_GATE)) {
            const int br = u.aux;
            const float* b = bg + br * DM + cw; u32x4* Gw = gbuf(br);
            float rs8[8];
            row_rstd8(ss, u.pm * 256 + wr * 64, lane_, fr, rs8);
            const f32x4 bv00 = *(const f32x4*)(b), bv01 = *(const f32x4*)(b + 4), bv10 = *(const f32x4*)(b + 32), bv11 = *(const f32x4*)(b + 36);
            asm volatile("" ::: "memory");
#pragma unroll
            for (int ai = 0; ai < 2; ++ai)
#pragma unroll
                for (int m = 0; m < 4; ++m) {
                    const float rstd = rs8[ai * 4 + m];
#pragma unroll
                    for (int bj = 0; bj < 2; ++bj) {
                        f32x4 v0 = acc[ai][bj][m][0] * rstd + (bj ? bv10 : bv00), v1 = acc[ai][bj][m][1] * rstd + (bj ? bv11 : bv01);
#pragma unroll
                        for (int j = 0; j < 4; ++j) { v0[j] = fsigm(v0[j]); v1[j] = fsigm(v1[j]); }
                        u32x4 w; w.x = pk2(v0[0], v0[1]); w.y = pk2(v0[2], v0[3]); w.z = pk2(v1[0], v1[1]); w.w = pk2(v1[2], v1[3]);
                        Gw[(unsigned)(((ai * 4 + m) * 2 + bj) * 512 + tid)] = w;
                        if (zacc) { acc[ai][bj][m][0] = (f32x4){0.f, 0.f, 0.f, 0.f}; acc[ai][bj][m][1] = (f32x4){0.f, 0.f, 0.f, 0.f}; }
                    }
                    asm volatile("" ::: "memory");
                }
        } else {
            const u32x4* Ga = gbuf(2);
            const auto rsM = RSRC(mb, (size_t)M * DM * 2); (void)rsM;
#pragma unroll
            for (int ai = 0; ai < 2; ++ai) {
                u32x4 gg[8];
#pragma unroll
                for (int q = 0; q < 8; ++q) gg[q] = Ga[(unsigned)((ai * 8 + q) * 512 + tid)];
                asm volatile("" ::: "memory");
#pragma unroll
                for (int m = 0; m < 4; ++m) {
                    const int row = u.pm * 256 + ai * 128 + wr * 64 + m * 16 + fr;
#pragma unroll
                    for (int bj = 0; bj < 2; ++bj) {
                        const u32x4 g = gg[m * 2 + bj];
                        const f32x4 v0 = acc[ai][bj][m][0] * (f32x4){bflo(g.x), bfhi(g.x), bflo(g.y), bfhi(g.y)};
                        const f32x4 v1 = acc[ai][bj][m][1] * (f32x4){bflo(g.z), bfhi(g.z), bflo(g.w), bfhi(g.w)};
                        u32x4 w; w.x = pk2(v0[0], v0[1]); w.y = pk2(v0[2], v0[3]); w.z = pk2(v1[0], v1[1]); w.w = pk2(v1[2], v1[3]);
                        ST16(rsM, mb, (size_t)row * DM + bj * 32 + cw, w);
                        if (zacc) { acc[ai][bj][m][0] = (f32x4){0.f, 0.f, 0.f, 0.f}; acc[ai][bj][m][1] = (f32x4){0.f, 0.f, 0.f, 0.f}; }
                    }
                }
                asm volatile("" ::: "memory");
            }
        }
    }
};

struct EpiRes {
    static constexpr bool HAS_HOOK = false;
    __device__ __forceinline__ bool dbl(const Unit&) const { return (DBL_EPI & 4) != 0 && rin != H; }
    const float* rin; float* H; bf16_t* hb; float* ssout; int mode; bf16_t* hbd;
    __device__ __forceinline__ void operator()(f32x4 (&acc)[2][2][4][2], const Unit& u, int wid, const bool zacc) const {
        EPI_LANE();
        const int cw = u.pn * 256 + wc * 64 + 8 * fq;
        const auto rsH = RSRC(hb, (size_t)M * XW * 2); (void)rsH;
        if (mode & 1) {
            u32x4 rr[8][2];
#pragma unroll
            for (int q = 0; q < 8; ++q)
#pragma unroll
                for (int bj = 0; bj < 2; ++bj) rr[q][bj] = *(const u32x4*)(hb + (size_t)(u.pm * 256 + (q >> 2) * 128 + wr * 64 + (q & 3) * 16 + fr) * XW + bj * 32 + cw);
            asm volatile("" ::: "memory");
#pragma unroll
            for (int ai = 0; ai < 2; ++ai)
#pragma unroll
                for (int m = 0; m < 4; ++m) {
                    const int row = u.pm * 256 + ai * 128 + wr * 64 + m * 16 + fr;
                    float s = 0.f;
#pragma unroll
                    for (int bj = 0; bj < 2; ++bj) {
                        const size_t o = (size_t)row * DM + bj * 32 + cw;
                        const u32x4 w = rr[ai * 4 + m][bj];
                        const f32x4 v0 = acc[ai][bj][m][0] + (f32x4){bflo(w.x), bfhi(w.x), bflo(w.y), bfhi(w.y)}, v1 = acc[ai][bj][m][1] + (f32x4){bflo(w.z), bfhi(w.z), bflo(w.w), bfhi(w.w)};
                        if (mode & 2) { *(f32x4*)(H + o) = v0; *(f32x4*)(H + o + 4) = v1; }
                        u32x4 wo; wo.x = pk2(v0[0], v0[1]); wo.y = pk2(v0[2], v0[3]); wo.z = pk2(v1[0], v1[1]); wo.w = pk2(v1[2], v1[3]);
                        ST16(rsH, hb, (size_t)row * XW + bj * 32 + cw, wo);
                        if (hbd) *(u32x4*)(hbd + (size_t)row * DM + bj * 32 + cw) = wo;
                        s += (v0[0] * v0[0] + v0[1] * v0[1]) + (v0[2] * v0[2] + v0[3] * v0[3]) + (v1[0] * v1[0] + v1[1] * v1[1]) + (v1[2] * v1[2] + v1[3] * v1[3]);
                        if (zacc) { acc[ai][bj][m][0] = (f32x4){0.f, 0.f, 0.f, 0.f}; acc[ai][bj][m][1] = (f32x4){0.f, 0.f, 0.f, 0.f}; }
                    }
                    s += __shfl_xor(s, 16); s += __shfl_xor(s, 32);
                    if (fq == 0) ssout[(size_t)row * 16 + u.pn * 4 + wc] = s;
                }
            return;
        }
#pragma unroll
        for (int ai = 0; ai < 2; ++ai) {
            f32x4 rr[4][2][2];
#pragma unroll
            for (int m = 0; m < 4; ++m)
#pragma unroll
                for (int bj = 0; bj < 2; ++bj) { const float* rp = rin + (size_t)(u.pm * 256 + ai * 128 + wr * 64 + m * 16 + fr) * DM + bj * 32 + cw; rr[m][bj][0] = *(const f32x4*)rp; rr[m][bj][1] = *(const f32x4*)(rp + 4); }
            asm volatile("" ::: "memory");
#pragma unroll
            for (int m = 0; m < 4; ++m) {
                const int row = u.pm * 256 + ai * 128 + wr * 64 + m * 16 + fr;
                float s = 0.f;
#pragma unroll
                for (int bj = 0; bj < 2; ++bj) {
                    const size_t o = (size_t)row * DM + bj * 32 + cw;
                    const f32x4 v0 = acc[ai][bj][m][0] + rr[m][bj][0], v1 = acc[ai][bj][m][1] + rr[m][bj][1];
                    if (mode & 2) { *(f32x4*)(H + o) = v0; *(f32x4*)(H + o + 4) = v1; }
                    u32x4 w; w.x = pk2(v0[0], v0[1]); w.y = pk2(v0[2], v0[3]); w.z = pk2(v1[0], v1[1]); w.w = pk2(v1[2], v1[3]);
                    ST16(rsH, hb, (size_t)row * XW + bj * 32 + cw, w);
                    if (hbd) *(u32x4*)(hbd + (size_t)row * DM + bj * 32 + cw) = w;
                    s += (v0[0] * v0[0] + v0[1] * v0[1]) + (v0[2] * v0[2] + v0[3] * v0[3]) + (v1[0] * v1[0] + v1[1] * v1[1]) + (v1[2] * v1[2] + v1[3] * v1[3]);
                    if (zacc) { acc[ai][bj][m][0] = (f32x4){0.f, 0.f, 0.f, 0.f}; acc[ai][bj][m][1] = (f32x4){0.f, 0.f, 0.f, 0.f}; }
                }
                s += __shfl_xor(s, 16); s += __shfl_xor(s, 32);
                if (fq == 0) ssout[(size_t)row * 16 + u.pn * 4 + wc] = s;
            }
            asm volatile("" ::: "memory");
        }
    }
};

struct EpiGU {
    static constexpr bool HAS_HOOK = false;
    __device__ __forceinline__ bool dbl(const Unit&) const { return (DBL_EPI & 2) != 0; }
    const float* ss; bf16_t* ff;
    __device__ __forceinline__ void operator()(f32x4 (&acc)[2][2][4][2], const Unit& u, int wid, const bool zacc) const {
        EPI_LANE();
        const int cj = u.pn * 128 + wc * 32 + 8 * fq;
        const auto rsF = RSRC(ff, (size_t)M * DFF * 2); (void)rsF;
        float rs8[8];
        row_rstd8(ss, u.pm * 256 + wr * 64, lane_, fr, rs8);
        asm volatile("" ::: "memory");
#pragma unroll
        for (int ai = 0; ai < 2; ++ai)
#pragma unroll
            for (int m = 0; m < 4; ++m) {
                const int row = u.pm * 256 + ai * 128 + wr * 64 + m * 16 + fr;
                const float rstd = rs8[ai * 4 + m];
                const f32x4 g0 = acc[ai][0][m][0] * rstd, g1 = acc[ai][0][m][1] * rstd, u0 = acc[ai][1][m][0] * rstd, u1 = acc[ai][1][m][1] * rstd;
                u32x4 w; w.x = pk2(fsilu(g0[0]) * u0[0], fsilu(g0[1]) * u0[1]); w.y = pk2(fsilu(g0[2]) * u0[2], fsilu(g0[3]) * u0[3]);
                w.z = pk2(fsilu(g1[0]) * u1[0], fsilu(g1[1]) * u1[1]); w.w = pk2(fsilu(g1[2]) * u1[2], fsilu(g1[3]) * u1[3]);
                ST16(rsF, ff, (size_t)row * DFF + cj, w);
                if (zacc) {
#pragma unroll
                    for (int bj = 0; bj < 2; ++bj) { acc[ai][bj][m][0] = (f32x4){0.f, 0.f, 0.f, 0.f}; acc[ai][bj][m][1] = (f32x4){0.f, 0.f, 0.f, 0.f}; } }
            }
    }
};

struct SchedPlain {
    const char* A; const char* B; int lda, ldb, nt, nM, nN, G, c, kind, pm0;
    __device__ __forceinline__ bool next(int i, Unit& u) const {
        const int L = i * G + c; if (L >= nM * nN) return false;
        tile_of(L, nM, nN, u.pm, u.pn); u.pm += pm0;
        u.A = A + (size_t)u.pm * 256 * lda * 2; u.B = B + (size_t)u.pn * 256 * ldb * 2; u.nt = nt; u.kind = kind; u.aux = 0; return true;
    }
};
struct SchedC {
    const char* X; const char* Wg; const char* Wb; int nM, G, c, pm0;
    __device__ __forceinline__ bool next(int i, Unit& u) const {
        const int j = i >> 2, sub = i & 3, L = j * G + c; if (L >= nM * 4) return false;
        tile_of(L, nM, 4, u.pm, u.pn); u.pm += pm0;
        const bool gate = sub < 3;
        u.A = X + (size_t)u.pm * 256 * XW * 2 + (gate ? 0 : 1024 * 2);
        u.B = gate ? Wg + (size_t)sub * (1024 * KC * 2) + (size_t)u.pn * 256 * KC * 2 : Wb + (size_t)u.pn * 256 * KC * 2;
        u.nt = gate ? 16 : 24; u.kind = gate ? K_GATE : K_BRANCH; u.aux = sub; return true;
    }
};
}
__device__ const double INV_A[8] = {0.15915494309189535, 0.03086376340470123, 0.005985185712713705, 0.001160663641240061, 0.00022507907903927653, 4.364795279280289e-05, 8.464330808241401e-06, 1.6414262627950345e-06};
__device__ const double INV_R[32] = {0.15915494309189535, 0.11934937021124886, 0.08949940160889101, 0.06711508300522726, 0.050329212104487035, 0.03774158471741977, 0.0283021958306234, 0.02122365276477766,
    0.015915494309189534, 0.011934937021124886, 0.008949940160889102, 0.006711508300522725, 0.005032921210448704, 0.003774158471741977, 0.00283021958306234, 0.0021223652764777662,
    0.0015915494309189536, 0.0011934937021124885, 0.0008949940160889102, 0.0006711508300522726, 0.0005032921210448703, 0.00037741584717419774, 0.00028302195830623395, 0.0002122365276477766,
    0.00015915494309189535, 0.00011934937021124886, 8.949940160889102e-05, 6.711508300522725e-05, 5.0329212104487035e-05, 3.774158471741978e-05, 2.8302195830623396e-05, 2.122365276477766e-05};
__device__ __forceinline__ float lg_gamma(int h) { return h == 0 ? -0.04580368961312479f : h == 1 ? -0.02272007650008353f : h == 2 ? -0.011315313227834146f : -0.005646563141142062f; }
__device__ __forceinline__ float ex2(float x) { return __builtin_amdgcn_exp2f(x); }
__device__ __forceinline__ float wave_sum(float v) {
#pragma unroll
    for (int o = 1; o < 64; o <<= 1) v += __shfl_xor(v, o);
    return v;
}
#define LDS_WAIT() asm volatile("s_waitcnt lgkmcnt(0)" ::: "memory")

__device__ __forceinline__ int dst_in(int s) {
    if (s < 640) { const int p = s & 63; return (p < 16) ? (s & ~63) + ((p < 8) ? 2 * p : 2 * (p - 8) + 1) : s; }
    if (s < 768) return s;
    if (s < 1280) { const int p = s & 63; return (s & ~63) + ((p < 32) ? 2 * p : 2 * (p - 32) + 1); }
    if (s < 2816) return s;
    { const int j = (s < 3328) ? s - 2816 : s - 3328; return 2816 + (j >> 5) * 64 + ((s < 3328) ? 0 : 32) + (j & 31); }
}
struct CvDesc { const float* W; size_t ldw; const float* scale; bf16_t* dst; int c0, ld, k0, mode, rmul, radd; };
constexpr int CV_J0 = 3456, CV_J2 = 768, CV_J3 = 512, CV_J4 = 2816, CV_J5 = 1408, CV_PER_LAYER = CV_J0 + CV_J2 + CV_J3 + CV_J4 + CV_J5;
__device__ __forceinline__ CvDesc cv_desc(const Args& a, int it) {
    const int l = it / CV_PER_LAYER; int r = it - l * CV_PER_LAYER;
    bf16_t* Wl = (bf16_t*)(a.ws + WS_W + (size_t)l * WL_SIZE);
    if (r < CV_J0) { const int kb = r / 216, cb = r % 216;
        if (cb < 120) return CvDesc{a.w_in + (size_t)l * DM * DIN, DIN, a.norm_mix + l * DM, Wl + WL_IN / 2, cb * 32, DM, kb * 64, 1, 1, 0};
        return CvDesc{a.w_in + (size_t)l * DM * DIN, DIN, a.norm_mix + l * DM, Wl + WL_C / 2, cb * 32, KC, kb * 64, 0, 1, -3840}; }
    r -= CV_J0;
    if (r < CV_J2) { const int i = r >> 8, kb = (r >> 5) & 7, cb = r & 31;
        return CvDesc{a.w_branch + (size_t)(l * 3 + i) * 512 * DM, DM, nullptr, Wl + WL_B / 2 + i * 512, cb * 32, KC, kb * 64, 0, 1, 0}; }
    r -= CV_J2;
    if (r < CV_J3) { const int kb = r >> 5, cb = r & 31; return CvDesc{a.w_out + (size_t)l * DM * DM, DM, nullptr, Wl + WL_OUT / 2, cb * 32, DM, kb * 64, 0, 1, 0}; }
    r -= CV_J3;
    if (r < CV_J4) { const int up = r / 1408, q = r % 1408, kb = q / 88, cb = q % 88;
        return CvDesc{(up ? a.w_u : a.w_g) + (size_t)l * DM * DFF, DFF, a.norm_ffn + l * DM, Wl + WL_GU / 2, cb * 32, DM, kb * 64, 2, 1, up * 32}; }
    r -= CV_J4;
    { const int kb = r >> 5, cb = r & 31; return CvDesc{a.w_d + (size_t)l * DFF * DM, DM, nullptr, Wl + WL_D / 2, cb * 32, DFF, kb * 64, 0, 1, 0}; }
}
__device__ __forceinline__ void cv_load(const CvDesc& d, int lane, f32x4 (&v)[8], float (&sc)[8]) {
    const int kr = lane >> 3, c4 = lane & 7;
#pragma unroll
    for (int i = 0; i < 8; ++i) { v[i] = *(const f32x4*)(d.W + (size_t)(d.k0 + 8 * i + kr) * d.ldw + d.c0 + 4 * c4); sc[i] = d.scale ? d.scale[d.k0 + 8 * i + kr] : 1.f; }
}
__device__ __forceinline__ void cv_finish(const CvDesc& d, int lane, const f32x4 (&v)[8], const float (&sc)[8], LAS float* scr) {
    const int kr = lane >> 3, c4 = lane & 7;
#pragma unroll
    for (int i = 0; i < 8; ++i) { LAS float* p = scr + (8 * i + kr) * 33 + 4 * c4; p[0] = v[i][0] * sc[i]; p[1] = v[i][1] * sc[i]; p[2] = v[i][2] * sc[i]; p[3] = v[i][3] * sc[i]; }
    LDS_WAIT(); asm volatile("" ::: "memory");
    const int c = lane & 7;
#pragma unroll
    for (int j = 0; j < 4; ++j) { const int n = (lane >> 3) + 8 * j; const LAS float* s = scr + (8 * c) * 33 + n;
        u32x4 o; o.x = pk2(s[0 * 33], s[1 * 33]); o.y = pk2(s[2 * 33], s[3 * 33]); o.z = pk2(s[4 * 33], s[5 * 33]); o.w = pk2(s[6 * 33], s[7 * 33]);
        const int cc = d.c0 + n, row = (d.mode == 2) ? ((cc >> 5) * 64 + d.radd + (cc & 31)) : (d.mode ? dst_in(cc) : cc) * d.rmul + d.radd;
        *(u32x4*)(d.dst + (size_t)row * d.ld + d.k0 + 8 * c) = o; }
    LDS_WAIT(); asm volatile("" ::: "memory");
}
__device__ __forceinline__ void cv_range(const Args& a, LAS unsigned char* lds, int it0, int it1, int widx, int nw, const int tid) {
    const int lane = tid & 63, wave = tid >> 6;
    LAS float* scr = (LAS float*)(lds + wave * 16384);
    const int first = it0 + widx;
    if (first < it1) {
        CvDesc cur = cv_desc(a, first); f32x4 v[8]; float sc[8];
        cv_load(cur, lane, v, sc);
        for (int it = first; it < it1; it += nw) {
            const bool more = it + nw < it1;
            CvDesc nxt = cv_desc(a, more ? it + nw : it); f32x4 vn[8]; float scn[8];
            if (more) cv_load(nxt, lane, vn, scn);
            cv_finish(cur, lane, v, sc, scr);
            if (more) { cur = nxt;
#pragma unroll
                for (int i = 0; i < 8; ++i) { v[i] = vn[i]; sc[i] = scn[i]; } }
        }
    }
}
__device__ __forceinline__ void cv_fill(const Args& a, LAS unsigned char* lds, int layer, int it0, int it1, int total_units, int G, int c, const int tid) {
    const int rem = total_units % G; const int first_idle = rem ? rem : G;
    const int nidle = rem ? G - rem : G, idx = rem ? c - first_idle : c;
    if (idx < 0) return;
    cv_range(a, lds, layer * CV_PER_LAYER + it0, layer * CV_PER_LAYER + it1, idx * 8 + (tid >> 6), nidle * 8, tid);
}
#ifndef CV_LAZY
#define CV_LAZY 1
#endif
constexpr int CV_SPLIT = 0;
__device__ __forceinline__ void phase_prologue(const Args& a, LAS unsigned char* lds, int G, const int tid) {
    const int lane = tid & 63, wave = tid >> 6;
    const int gw = blockIdx.x * 8 + wave, NGW = G * 8;
    cv_range(a, lds, 0, (CV_LAZY ? 1 : DEPTH) * CV_PER_LAYER, gw, NGW, tid);
    bf16_t* X = (bf16_t*)(a.ws + WS_X); float* ss = (float*)(a.ws + WS_SS);
    for (int row = gw; row < M; row += NGW) {
        const f32x4* xr = (const f32x4*)(a.x + (size_t)row * DM) + lane; float s = 0.f;
#pragma unroll
        for (int j = 0; j < 4; ++j) { const f32x4 v = xr[64 * j]; s += (v[0] * v[0] + v[1] * v[1]) + (v[2] * v[2] + v[3] * v[3]);
            u32x2 w; w.x = pk2(v[0], v[1]); w.y = pk2(v[2], v[3]); *(u32x2*)(X + (size_t)row * XW + (64 * j + lane) * 4) = w; }
        s = wave_sum(s); if (lane < 16) ss[(size_t)row * 16 + lane] = (lane == 0) ? s : 0.f;
    }
}

__device__ __forceinline__ void attn_naive(LAS unsigned char* lds, const bf16_t* P, bf16_t* X, const float* sinks, int unit, const int tid) {
    const int b = unit >> 5, n = (unit >> 1) & 15, g = unit & 1;
    LAS bf16_t* Ks = (LAS bf16_t*)lds; LAS bf16_t* Vs = Ks + 256 * 72;
    const long row0 = (long)b * SEQ + n * 128 - 128;
    for (int c = tid; c < 2048; c += 512) {
        const int key = c >> 3, ch = c & 7; u32x4 kv = {0u, 0u, 0u, 0u}, vv = {0u, 0u, 0u, 0u};
        if (n > 0 || key >= 128) { const bf16_t* src = P + (size_t)(row0 + key) * PW + g * 64 + ch * 8; kv = *(const u32x4*)(src + 512); vv = *(const u32x4*)(src + 640); }
        *(LAS u32x4*)(Ks + key * 72 + ch * 8) = kv; *(LAS u32x4*)(Vs + key * 72 + ch * 8) = vv;
    }
    __syncthreads();
    const int r = tid & 127, hq = g * 4 + (tid >> 7);
    const size_t qrow = (size_t)b * SEQ + n * 128 + r;
    float q[64], o[64];
    { const u32x4* qp = (const u32x4*)(P + qrow * PW + hq * 64);
#pragma unroll
      for (int c = 0; c < 8; ++c) { const u32x4 w = qp[c]; q[8 * c] = bflo(w.x); q[8 * c + 1] = bfhi(w.x); q[8 * c + 2] = bflo(w.y); q[8 * c + 3] = bfhi(w.y); q[8 * c + 4] = bflo(w.z); q[8 * c + 5] = bfhi(w.z); q[8 * c + 6] = bflo(w.w); q[8 * c + 7] = bfhi(w.w); } }
#pragma unroll
    for (int d = 0; d < 64; ++d) o[d] = 0.f;
    float mx = sinks[hq] * LOG2E, l = 1.f;
    for (int j = 0; j < 128; ++j) {
        const int kt = r + 1 + j; const bool valid = (n > 0) || (kt >= 128);
        const LAS u32x4* kp = (const LAS u32x4*)(Ks + kt * 72);
        float s = 0.f;
#pragma unroll
        for (int c = 0; c < 8; ++c) { const u32x4 w = kp[c];
            s += q[8 * c] * bflo(w.x) + q[8 * c + 1] * bfhi(w.x) + q[8 * c + 2] * bflo(w.y) + q[8 * c + 3] * bfhi(w.y) + q[8 * c + 4] * bflo(w.z) + q[8 * c + 5] * bfhi(w.z) + q[8 * c + 6] * bflo(w.w) + q[8 * c + 7] * bfhi(w.w); }
        s = valid ? s : -INFINITY;
        const float mn = fmaxf(mx, s), sc = ex2(mx - mn), p = ex2(s - mn);
        l = l * sc + p; mx = mn;
        const LAS u32x4* vp = (const LAS u32x4*)(Vs + kt * 72);
#pragma unroll
        for (int c = 0; c < 8; ++c) { const u32x4 w = vp[c];
            o[8 * c] = o[8 * c] * sc + p * bflo(w.x); o[8 * c + 1] = o[8 * c + 1] * sc + p * bfhi(w.x); o[8 * c + 2] = o[8 * c + 2] * sc + p * bflo(w.y); o[8 * c + 3] = o[8 * c + 3] * sc + p * bfhi(w.y);
            o[8 * c + 4] = o[8 * c + 4] * sc + p * bflo(w.z); o[8 * c + 5] = o[8 * c + 5] * sc + p * bfhi(w.z); o[8 * c + 6] = o[8 * c + 6] * sc + p * bflo(w.w); o[8 * c + 7] = o[8 * c + 7] * sc + p * bfhi(w.w); }
    }
    const float il = 1.f / l;
    u32x4* op = (u32x4*)(X + qrow * XW + 1024 + hq * 64);
#pragma unroll
    for (int c = 0; c < 8; ++c) { u32x4 w; w.x = pk2(o[8 * c] * il, o[8 * c + 1] * il); w.y = pk2(o[8 * c + 2] * il, o[8 * c + 3] * il); w.z = pk2(o[8 * c + 4] * il, o[8 * c + 5] * il); w.w = pk2(o[8 * c + 6] * il, o[8 * c + 7] * il); op[c] = w; }
    __syncthreads();
}

__device__ __forceinline__ void kv_naive(LAS unsigned char* lds, const bf16_t* P, float* kv, int unit, const int tid) {
    const int b = unit >> 6, h = (unit >> 4) & 3, n = unit & 15;
    LAS float* kz = (LAS float*)lds; LAS float* vs = kz + 128 * 64;
    const size_t rowc = (size_t)b * SEQ + n * 128; const float lg = lg_gamma(h);
    for (int i = tid; i < 128 * 8; i += 512) { const int tok = i >> 3, ch = i & 7; const u32x4 w = *(const u32x4*)(P + (rowc + tok) * PW + 1024 + h * 64 + ch * 8); const float z = ex2((float)(127 - tok) * lg);
        LAS float* d = kz + tok * 64 + ch * 8; d[0] = bflo(w.x) * z; d[1] = bfhi(w.x) * z; d[2] = bflo(w.y) * z; d[3] = bfhi(w.y) * z; d[4] = bflo(w.z) * z; d[5] = bfhi(w.z) * z; d[6] = bflo(w.w) * z; d[7] = bfhi(w.w) * z; }
    for (int i = tid; i < 128 * 16; i += 512) { const int tok = i >> 4, ch = i & 15; const u32x4 w = *(const u32x4*)(P + (rowc + tok) * PW + 1280 + h * 128 + ch * 8);
        LAS float* d = vs + tok * 128 + ch * 8; d[0] = bflo(w.x); d[1] = bfhi(w.x); d[2] = bflo(w.y); d[3] = bfhi(w.y); d[4] = bflo(w.z); d[5] = bfhi(w.z); d[6] = bflo(w.w); d[7] = bfhi(w.w); }
    __syncthreads();
    const int e = tid & 127, d0 = (tid >> 7) * 16;
    float acc[16];
#pragma unroll
    for (int dd = 0; dd < 16; ++dd) acc[dd] = 0.f;
    for (int tok = 0; tok < 128; ++tok) { const float vv = vs[tok * 128 + e];
#pragma unroll
        for (int dd = 0; dd < 16; ++dd) acc[dd] += kz[tok * 64 + d0 + dd] * vv; }
#pragma unroll
    for (int dd = 0; dd < 16; ++dd) kv[((size_t)unit * 64 + d0 + dd) * 128 + e] = acc[dd];
    __syncthreads();
}

__device__ __forceinline__ void ret_naive(LAS unsigned char* lds, const bf16_t* P, const float* kv, bf16_t* X, int unit, const int tid) {
    const int b = unit >> 6, h = (unit >> 4) & 3, n = unit & 15;
    LAS float* St = (LAS float*)lds;
    LAS bf16_t* qs = (LAS bf16_t*)(lds + 32768);
    LAS bf16_t* ks = (LAS bf16_t*)(lds + 49152);
    LAS bf16_t* vs = (LAS bf16_t*)(lds + 65536);
    const size_t rowc = (size_t)b * SEQ + n * 128; const float lg = lg_gamma(h);
    { const int e = tid & 127, d0 = (tid >> 7) * 16; float s[16];
#pragma unroll
      for (int dd = 0; dd < 16; ++dd) s[dd] = 0.f;
      for (int j = 0; j < n; ++j) { const float w = ex2((float)((n - 1 - j) * 128) * lg); const float* kj = kv + ((size_t)(unit - n + j) * 64 + d0) * 128 + e;
#pragma unroll
          for (int dd = 0; dd < 16; ++dd) s[dd] += w * kj[dd * 128]; }
#pragma unroll
      for (int dd = 0; dd < 16; ++dd) St[(d0 + dd) * 128 + e] = s[dd]; }
    for (int i = tid; i < 128 * 8; i += 512) { const int tok = i >> 3, ch = i & 7; const bf16_t* src = P + (rowc + tok) * PW + h * 64 + ch * 8;
        *(LAS u32x4*)(qs + tok * 64 + ch * 8) = *(const u32x4*)(src + 768); *(LAS u32x4*)(ks + tok * 64 + ch * 8) = *(const u32x4*)(src + 1024); }
    for (int i = tid; i < 128 * 16; i += 512) { const int tok = i >> 4, ch = i & 15; *(LAS u32x4*)(vs + tok * 128 + ch * 8) = *(const u32x4*)(P + (rowc + tok) * PW + 1280 + h * 128 + ch * 8); }
    __syncthreads();
    const int r = tid >> 2, e0 = (tid & 3) * 32;
    float q[64], y[32];
    { const LAS u32x4* qp = (const LAS u32x4*)(qs + r * 64);
#pragma unroll
      for (int c = 0; c < 8; ++c) { const u32x4 w = qp[c]; q[8 * c] = bflo(w.x); q[8 * c + 1] = bfhi(w.x); q[8 * c + 2] = bflo(w.y); q[8 * c + 3] = bfhi(w.y); q[8 * c + 4] = bflo(w.z); q[8 * c + 5] = bfhi(w.z); q[8 * c + 6] = bflo(w.w); q[8 * c + 7] = bfhi(w.w); } }
#pragma unroll
    for (int ee = 0; ee < 32; ++ee) y[ee] = 0.f;
#pragma unroll 2
    for (int d = 0; d < 64; ++d) { const float qd = bf2f(qs[r * 64 + d]); const LAS f32x4* sp = (const LAS f32x4*)(St + d * 128 + e0);
#pragma unroll
        for (int c = 0; c < 8; ++c) { const f32x4 sv = sp[c]; y[4 * c] += qd * sv[0]; y[4 * c + 1] += qd * sv[1]; y[4 * c + 2] += qd * sv[2]; y[4 * c + 3] += qd * sv[3]; } }
    { const float xi = ex2((float)(r + 1) * lg);
#pragma unroll
      for (int ee = 0; ee < 32; ++ee) y[ee] *= xi; }
    const int rmax = (tid | 63) >> 2;
    for (int kk = 0; kk <= rmax; ++kk) {
        const LAS u32x4* kp = (const LAS u32x4*)(ks + kk * 64);
        float s = 0.f;
#pragma unroll
        for (int c = 0; c < 8; ++c) { const u32x4 w = kp[c];
            s += q[8 * c] * bflo(w.x) + q[8 * c + 1] * bfhi(w.x) + q[8 * c + 2] * bflo(w.y) + q[8 * c + 3] * bfhi(w.y) + q[8 * c + 4] * bflo(w.z) + q[8 * c + 5] * bfhi(w.z) + q[8 * c + 6] * bflo(w.w) + q[8 * c + 7] * bfhi(w.w); }
        const float aw = (kk <= r) ? s * ex2((float)(r - kk) * lg) : 0.f;
        const LAS u32x4* vp = (const LAS u32x4*)(vs + kk * 128 + e0);
#pragma unroll
        for (int c = 0; c < 4; ++c) { const u32x4 w = vp[c];
            y[8 * c] += aw * bflo(w.x); y[8 * c + 1] += aw * bfhi(w.x); y[8 * c + 2] += aw * bflo(w.y); y[8 * c + 3] += aw * bfhi(w.y); y[8 * c + 4] += aw * bflo(w.z); y[8 * c + 5] += aw * bfhi(w.z); y[8 * c + 6] += aw * bflo(w.w); y[8 * c + 7] += aw * bfhi(w.w); }
    }
    float sq = 0.f;
#pragma unroll
    for (int ee = 0; ee < 32; ++ee) sq += y[ee] * y[ee];
    sq += __shfl_xor(sq, 1); sq += __shfl_xor(sq, 2);
    const float rs = rsqrtf(sq * (1.f / 128.f) + EPS);
    const u32x4* gp = (const u32x4*)(P + (rowc + r) * PW + 1792 + h * 128 + e0);
    u32x4* op = (u32x4*)(X + (rowc + r) * XW + 1536 + h * 128 + e0);
#pragma unroll
    for (int c = 0; c < 4; ++c) { const u32x4 gw = gp[c]; u32x4 w;
        w.x = pk2(y[8 * c] * rs * bflo(gw.x), y[8 * c + 1] * rs * bfhi(gw.x)); w.y = pk2(y[8 * c + 2] * rs * bflo(gw.y), y[8 * c + 3] * rs * bfhi(gw.y));
        w.z = pk2(y[8 * c + 4] * rs * bflo(gw.z), y[8 * c + 5] * rs * bfhi(gw.z)); w.w = pk2(y[8 * c + 6] * rs * bflo(gw.w), y[8 * c + 7] * rs * bfhi(gw.w)); op[c] = w; }
    __syncthreads();
}

__device__ __forceinline__ void conv_all(const bf16_t* P, const float* cw, bf16_t* X, int G, int c, int row0, int nrows, const int tid) {
    const int gt = c * 512 + tid, NT = G * 512;
    const f32x4 w0a = *(const f32x4*)(cw + (gt & 63) * 8), w0b = *(const f32x4*)(cw + (gt & 63) * 8 + 4), w1a = *(const f32x4*)(cw + 512 + (gt & 63) * 8), w1b = *(const f32x4*)(cw + 512 + (gt & 63) * 8 + 4),
                w2a = *(const f32x4*)(cw + 1024 + (gt & 63) * 8), w2b = *(const f32x4*)(cw + 1024 + (gt & 63) * 8 + 4);
    for (int i0 = gt; i0 < nrows * 64; i0 += 2 * NT) {
        u32x4 cb[2], u0[2], u1[2], u2[2];
#pragma unroll
        for (int k = 0; k < 2; ++k) { const int i = i0 + k * NT, row = row0 + (i >> 6), ch = i & 63, t = row & (SEQ - 1);
            const bf16_t* p = P + (size_t)row * PW + ch * 8;
            cb[k] = *(const u32x4*)(p + 2304); u0[k] = *(const u32x4*)(p + 2816); u1[k] = (u32x4){0u, 0u, 0u, 0u}; u2[k] = u1[k];
            if (t >= 1) u1[k] = *(const u32x4*)(p + 2816 - PW);
            if (t >= 2) u2[k] = *(const u32x4*)(p + 2816 - 2 * PW); }
#pragma unroll
        for (int k = 0; k < 2; ++k) { const int i = i0 + k * NT, row = row0 + (i >> 6), ch = i & 63;
            u32x4 o;
            o.x = pk2(bflo(cb[k].x) * (w0a[0] * bflo(u2[k].x) + w1a[0] * bflo(u1[k].x) + w2a[0] * bflo(u0[k].x)), bfhi(cb[k].x) * (w0a[1] * bfhi(u2[k].x) + w1a[1] * bfhi(u1[k].x) + w2a[1] * bfhi(u0[k].x)));
            o.y = pk2(bflo(cb[k].y) * (w0a[2] * bflo(u2[k].y) + w1a[2] * bflo(u1[k].y) + w2a[2] * bflo(u0[k].y)), bfhi(cb[k].y) * (w0a[3] * bfhi(u2[k].y) + w1a[3] * bfhi(u1[k].y) + w2a[3] * bfhi(u0[k].y)));
            o.z = pk2(bflo(cb[k].z) * (w0b[0] * bflo(u2[k].z) + w1b[0] * bflo(u1[k].z) + w2b[0] * bflo(u0[k].z)), bfhi(cb[k].z) * (w0b[1] * bfhi(u2[k].z) + w1b[1] * bfhi(u1[k].z) + w2b[1] * bfhi(u0[k].z)));
            o.w = pk2(bflo(cb[k].w) * (w0b[2] * bflo(u2[k].w) + w1b[2] * bflo(u1[k].w) + w2b[2] * bflo(u0[k].w)), bfhi(cb[k].w) * (w0b[3] * bfhi(u2[k].w) + w1b[3] * bfhi(u1[k].w) + w2b[3] * bfhi(u0[k].w)));
            *(u32x4*)(X + (size_t)row * XW + 2048 + ch * 8) = o; }
    }
}

__device__ __forceinline__ void final_norm(float* H, const float* ss, const float* g, int G, int c, int row0, int nrows, const int tid) {
    const int lane = tid & 63, gw = c * 8 + (tid >> 6), NGW = G * 8;
    const f32x4* gr = (const f32x4*)g + lane;
    f32x4 gv[4];
#pragma unroll
    for (int j = 0; j < 4; ++j) gv[j] = gr[64 * j];
    for (int row = row0 + gw; row < row0 + nrows; row += 2 * NGW) {
        f32x4* h0 = (f32x4*)(H + (size_t)row * DM) + lane; f32x4* h1 = (f32x4*)(H + (size_t)(row + NGW) * DM) + lane;
        f32x4 a0[4], a1[4];
#pragma unroll
        for (int j = 0; j < 4; ++j) { a0[j] = h0[64 * j]; a1[j] = h1[64 * j]; }
        const float r0 = pg8::row_rstd(ss, row), r1 = pg8::row_rstd(ss, row + NGW);
#pragma unroll
        for (int j = 0; j < 4; ++j) { h0[64 * j] = a0[j] * r0 * gv[j]; h1[64 * j] = a1[j] * r1 * gv[j]; }
    }
}
#ifndef RET_PROBE
#define RET_PROBE 0
#endif
typedef float f32x16 __attribute__((ext_vector_type(16)));
#define MFMA32(a, b, c) __builtin_amdgcn_mfma_f32_32x32x16_bf16((a), (b), (c), 0, 0, 0)
__device__ __forceinline__ int crow(int i, int hh) { return (i & 3) + 8 * (i >> 2) + 4 * hh; }
__device__ __forceinline__ bf16x8 pack8(const f32x16& v, int s) {
    u32x4 t; t.x = pk2(v[8 * s], v[8 * s + 1]); t.y = pk2(v[8 * s + 2], v[8 * s + 3]); t.z = pk2(v[8 * s + 4], v[8 * s + 5]); t.w = pk2(v[8 * s + 6], v[8 * s + 7]);
    return __builtin_bit_cast(bf16x8, t);
}
__device__ __forceinline__ bf16x8 join8(u32x2 a, u32x2 b) { u32x4 t = {a.x, a.y, b.x, b.y}; return __builtin_bit_cast(bf16x8, t); }
__device__ __forceinline__ void tr_store8(LAS unsigned* T32, int pitch32, int ch, int p, u32x4 w0, u32x4 w1) {
    LAS unsigned* t = T32 + (ch * 8) * pitch32 + (p ^ ((ch & 7) << 2));
    t[0 * pitch32] = (w0.x & 0xffffu) | (w1.x << 16); t[1 * pitch32] = (w0.x >> 16) | (w1.x & 0xffff0000u);
    t[2 * pitch32] = (w0.y & 0xffffu) | (w1.y << 16); t[3 * pitch32] = (w0.y >> 16) | (w1.y & 0xffff0000u);
    t[4 * pitch32] = (w0.z & 0xffffu) | (w1.z << 16); t[5 * pitch32] = (w0.z >> 16) | (w1.z & 0xffff0000u);
    t[6 * pitch32] = (w0.w & 0xffffu) | (w1.w << 16); t[7 * pitch32] = (w0.w >> 16) | (w1.w & 0xffff0000u);
}
__device__ __forceinline__ int tr_off(int c, int pitch32, int d) { return 2 * (c * pitch32 + (d ^ (((c >> 3) & 7) << 2))); }

__device__ __forceinline__ void attn_mfma(LAS unsigned char* lds, const bf16_t* P, bf16_t* X, const float* sinks, int unit, const int tid) {
    const int lane = tid & 63, wid = __builtin_amdgcn_readfirstlane(tid >> 6), r32 = lane & 31, hh = lane >> 5;
    const int b = unit >> 5, n = (unit >> 1) & 15, g = unit & 1;
    LAS bf16_t* Ks = (LAS bf16_t*)lds;
    LAS bf16_t* Vt = Ks + 256 * 72;
    const long row0 = (long)b * SEQ + n * 128 - 128;
    { u32x4 kv[4], w0[2], w1[2];
#pragma unroll
      for (int i = 0; i < 4; ++i) { const int c = tid + 512 * i, key = c >> 3, ch = c & 7; kv[i] = (u32x4){0u, 0u, 0u, 0u};
          if (n > 0 || key >= 128) kv[i] = *(const u32x4*)(P + (size_t)(row0 + key) * PW + 512 + g * 64 + ch * 8); }
#pragma unroll
      for (int i = 0; i < 2; ++i) { const int it = tid + 512 * i, kp = it >> 3, ch = it & 7; w0[i] = (u32x4){0u, 0u, 0u, 0u}; w1[i] = w0[i];
          if (n > 0 || kp >= 64) { const bf16_t* src = P + (size_t)(row0 + 2 * kp) * PW + 640 + g * 64 + ch * 8; w0[i] = *(const u32x4*)src; w1[i] = *(const u32x4*)(src + PW); } }
#pragma unroll
      for (int i = 0; i < 4; ++i) { const int c = tid + 512 * i, key = c >> 3, ch = c & 7; *(LAS u32x4*)(Ks + key * 72 + ch * 8) = kv[i]; }
#pragma unroll
      for (int i = 0; i < 2; ++i) { const int it = tid + 512 * i, kp = it >> 3, ch = it & 7; tr_store8((LAS unsigned*)Vt, 132, ch, kp, w0[i], w1[i]); } }
    const int hq = g * 4 + (wid >> 1);
    const float sink2 = sinks[hq] * LOG2E;
    bf16x8 qfa[2][4];
#pragma unroll
    for (int pass = 0; pass < 2; ++pass) { const bf16_t* qp = P + ((size_t)b * SEQ + n * 128 + (wid & 1) * 64 + pass * 32 + r32) * PW + hq * 64 + 8 * hh;
#pragma unroll
        for (int s = 0; s < 4; ++s) qfa[pass][s] = *(const bf16x8*)(qp + 16 * s); }
    __syncthreads();
#pragma unroll
    for (int pass = 0; pass < 2; ++pass) {
        const int r0 = (wid & 1) * 64 + pass * 32;
        const size_t qrow = (size_t)b * SEQ + n * 128 + r0 + r32;
        const bf16x8 (&qf)[4] = qfa[pass];
        f32x16 S[5];
#pragma unroll
        for (int j = 0; j < 5; ++j) {
#pragma unroll
            for (int i = 0; i < 16; ++i) S[j][i] = 0.f;
            const LAS bf16_t* kp = Ks + (r0 + 32 * j + r32) * 72 + 8 * hh;
#pragma unroll
            for (int s = 0; s < 4; ++s) S[j] = MFMA32(*(const LAS bf16x8*)(kp + 16 * s), qf[s], S[j]);
        }
#pragma unroll
        for (int i = 0; i < 16; ++i) { const int c = crow(i, hh); if (c <= r32) S[0][i] = -INFINITY; if (c > r32) S[4][i] = -INFINITY; }
        if (n == 0) {
#pragma unroll
            for (int j = 0; j < 4; ++j) if (r0 + 32 * j < 128) {
#pragma unroll
                for (int i = 0; i < 16; ++i) S[j][i] = -INFINITY; }
        }
        float mx = sink2;
#pragma unroll
        for (int j = 0; j < 5; ++j)
#pragma unroll
            for (int i = 0; i < 16; ++i) mx = fmaxf(mx, S[j][i]);
        mx = fmaxf(mx, __shfl_xor(mx, 32));
        float l = 0.f;
#pragma unroll
        for (int j = 0; j < 5; ++j)
#pragma unroll
            for (int i = 0; i < 16; ++i) { const float p = ex2(S[j][i] - mx); S[j][i] = p; l += p; }
        l += __shfl_xor(l, 32);
        l += ex2(sink2 - mx);
        f32x16 o[2];
#pragma unroll
        for (int i = 0; i < 16; ++i) { o[0][i] = 0.f; o[1][i] = 0.f; }
#pragma unroll
        for (int j = 0; j < 5; ++j)
#pragma unroll
            for (int s = 0; s < 2; ++s) {
                const bf16x8 pf = pack8(S[j], s);
#pragma unroll
                for (int dt = 0; dt < 2; ++dt) {
                    const int dd = (r0 + 32 * j + 16 * s + 4 * hh) >> 1;
                    o[dt] = MFMA32(join8(*(const LAS u32x2*)(Vt + tr_off(32 * dt + r32, 132, dd)), *(const LAS u32x2*)(Vt + tr_off(32 * dt + r32, 132, dd + 4))), pf, o[dt]);
                }
            }
        const float il = 1.f / l;
        bf16_t* op = X + qrow * XW + 1024 + hq * 64 + 4 * hh;
#pragma unroll
        for (int dt = 0; dt < 2; ++dt)
#pragma unroll
            for (int g4 = 0; g4 < 4; ++g4) { u32x2 w; w.x = pk2(o[dt][4 * g4] * il, o[dt][4 * g4 + 1] * il); w.y = pk2(o[dt][4 * g4 + 2] * il, o[dt][4 * g4 + 3] * il);
                *(u32x2*)(op + 32 * dt + 8 * g4) = w; }
    }
    __syncthreads();
}

__device__ __forceinline__ void kv_mfma(LAS unsigned char* lds, const bf16_t* P, bf16_t* kvT, int unit, const int tid) {
    const int lane = tid & 63, wid = __builtin_amdgcn_readfirstlane(tid >> 6), r32 = lane & 31, hh = lane >> 5;
    const int b = unit >> 6, h = (unit >> 4) & 3, n = unit & 15;
    LAS bf16_t* Kt = (LAS bf16_t*)lds;
    LAS bf16_t* Vt = Kt + 64 * 136;
    const size_t rowc = (size_t)b * SEQ + n * 128; const float lg = lg_gamma(h);
    { const int tp = tid >> 3, ch = tid & 7;
      const bf16_t* src = P + (rowc + 2 * tp) * PW + 1024 + h * 64 + ch * 8; const u32x4 w0 = *(const u32x4*)src, w1 = *(const u32x4*)(src + PW);
      const int tv = tid >> 3, cv = 2 * (tid & 7);
      const bf16_t* sv = P + (rowc + 2 * tv) * PW + 1280 + h * 128 + cv * 8;
      const u32x4 va0 = *(const u32x4*)sv, va1 = *(const u32x4*)(sv + PW), vb0 = *(const u32x4*)(sv + 8), vb1 = *(const u32x4*)(sv + 8 + PW);
      const float z0 = ex2((float)(127 - 2 * tp) * lg), z1 = ex2((float)(126 - 2 * tp) * lg);
      LAS unsigned* t = (LAS unsigned*)Kt + (ch * 8) * 68 + (tp ^ ((ch & 7) << 2));
      t[0 * 68] = pk2(bflo(w0.x) * z0, bflo(w1.x) * z1); t[1 * 68] = pk2(bfhi(w0.x) * z0, bfhi(w1.x) * z1); t[2 * 68] = pk2(bflo(w0.y) * z0, bflo(w1.y) * z1); t[3 * 68] = pk2(bfhi(w0.y) * z0, bfhi(w1.y) * z1);
      t[4 * 68] = pk2(bflo(w0.z) * z0, bflo(w1.z) * z1); t[5 * 68] = pk2(bfhi(w0.z) * z0, bfhi(w1.z) * z1); t[6 * 68] = pk2(bflo(w0.w) * z0, bflo(w1.w) * z1); t[7 * 68] = pk2(bfhi(w0.w) * z0, bfhi(w1.w) * z1);
      tr_store8((LAS unsigned*)Vt, 68, cv, tv, va0, va1); tr_store8((LAS unsigned*)Vt, 68, cv + 1, tv, vb0, vb1); }
    __syncthreads();
    const int et = wid >> 1, dt = wid & 1;
    f32x16 acc;
#pragma unroll
    for (int i = 0; i < 16; ++i) acc[i] = 0.f;
#pragma unroll
    for (int s = 0; s < 8; ++s) acc = MFMA32(*(const LAS bf16x8*)(Kt + tr_off(32 * dt + r32, 68, 8 * s + 4 * hh)), *(const LAS bf16x8*)(Vt + tr_off(32 * et + r32, 68, 8 * s + 4 * hh)), acc);
    bf16_t* o = kvT + ((size_t)unit * 128 + 32 * et + r32) * 64 + 32 * dt + 4 * hh;
#pragma unroll
    for (int g4 = 0; g4 < 4; ++g4) { u32x2 w; w.x = pk2(acc[4 * g4], acc[4 * g4 + 1]); w.y = pk2(acc[4 * g4 + 2], acc[4 * g4 + 3]); *(u32x2*)(o + 8 * g4) = w; }
    __syncthreads();
}

__device__ __forceinline__ void ret_stage(LAS unsigned char* reg, const bf16_t* P, const bf16_t* kvT, int unit, const int tid) {
    const int h = (unit >> 4) & 3, n = unit & 15, b = unit >> 6;
    LAS bf16_t* St = (LAS bf16_t*)reg; LAS bf16_t* Ks = St + 128 * 72; LAS bf16_t* Vt = Ks + 128 * 72;
    const size_t rowc = (size_t)b * SEQ + n * 128; const float lg = lg_gamma(h);
    u32x4 kst[2], vst0[2], vst1[2];
#pragma unroll
    for (int i = 0; i < 2; ++i) { const int c = tid + 512 * i; kst[i] = *(const u32x4*)(P + (rowc + (c >> 3)) * PW + 1024 + h * 64 + (c & 7) * 8);
        const int it = tid + 512 * i; const bf16_t* src = P + (rowc + 2 * (it >> 4)) * PW + 1280 + h * 128 + (it & 15) * 8; vst0[i] = *(const u32x4*)src; vst1[i] = *(const u32x4*)(src + PW); }
    { const int e = tid >> 2, d0 = (tid & 3) * 16; float s[16];
#pragma unroll
      for (int k = 0; k < 16; ++k) s[k] = 0.f;
      if (n > 0) {
          const u32x4* kb = (const u32x4*)(kvT + ((size_t)(unit - n) * 128 + e) * 64 + d0);
#pragma unroll
          for (int g = 0; g < 2; ++g) {
              const int j0 = 12 * g, nj = g ? 3 : 12;
              if (g && n <= 12) break;
              u32x4 t[12][2];
#pragma unroll
              for (int j = 0; j < 12; ++j) if (j < nj) { const int jj = (j0 + j) < n ? (j0 + j) : n - 1; t[j][0] = kb[(size_t)jj * 1024]; t[j][1] = kb[(size_t)jj * 1024 + 1]; }
#pragma unroll
              for (int j = 0; j < 12; ++j) if (j < nj) { const float w = (j0 + j) < n ? ex2((float)((n - 1 - j0 - j) * 128) * lg) : 0.f;
#pragma unroll
                  for (int q = 0; q < 2; ++q) { const u32x4 v = t[j][q];
                      s[8 * q] += w * bflo(v.x); s[8 * q + 1] += w * bfhi(v.x); s[8 * q + 2] += w * bflo(v.y); s[8 * q + 3] += w * bfhi(v.y);
                      s[8 * q + 4] += w * bflo(v.z); s[8 * q + 5] += w * bfhi(v.z); s[8 * q + 6] += w * bflo(v.w); s[8 * q + 7] += w * bfhi(v.w); } }
          }
      }
      u32x4 w0, w1; w0.x = pk2(s[0], s[1]); w0.y = pk2(s[2], s[3]); w0.z = pk2(s[4], s[5]); w0.w = pk2(s[6], s[7]);
      w1.x = pk2(s[8], s[9]); w1.y = pk2(s[10], s[11]); w1.z = pk2(s[12], s[13]); w1.w = pk2(s[14], s[15]);
      *(LAS u32x4*)(St + e * 72 + d0) = w0; *(LAS u32x4*)(St + e * 72 + d0 + 8) = w1; }
#pragma unroll
    for (int i = 0; i < 2; ++i) { const int c = tid + 512 * i; *(LAS u32x4*)(Ks + (c >> 3) * 72 + (c & 7) * 8) = kst[i]; }
#pragma unroll
    for (int i = 0; i < 2; ++i) { const int it = tid + 512 * i; tr_store8((LAS unsigned*)Vt, 68, it & 15, it >> 4, vst0[i], vst1[i]); }
}
constexpr int RET_REGION = 2 * 128 * 72 * 2 + 128 * 136 * 2;
__device__ __forceinline__ void ret_mfma2(LAS unsigned char* lds, const bf16_t* P, const bf16_t* kvT, bf16_t* X, int unitA, int unitB, const int tid) {
    const int lane = tid & 63, wid = __builtin_amdgcn_readfirstlane(tid >> 6), r32 = lane & 31, hh = lane >> 5;
    const int half = wid >> 2, rb = wid & 3;
    const int unit = half ? unitB : unitA;
    const int b = unit >> 6, h = (unit >> 4) & 3, n = unit & 15;
    const size_t rowc = (size_t)b * SEQ + n * 128; const float lg = lg_gamma(h);
    const size_t qrow = rowc + 32 * rb + r32;
    bf16x8 qf[4];
    { const bf16_t* qp = P + qrow * PW + 768 + h * 64 + 8 * hh;
#pragma unroll
      for (int s = 0; s < 4; ++s) qf[s] = *(const bf16x8*)(qp + 16 * s); }
    ret_stage(lds, P, kvT, unitA, tid);
    ret_stage(lds + RET_REGION, P, kvT, unitB, tid);
    __syncthreads();
    LAS bf16_t* St = (LAS bf16_t*)(lds + half * RET_REGION); LAS bf16_t* Ks = St + 128 * 72; LAS bf16_t* Vt = Ks + 128 * 72;
    u32x2 gw[4][4];
    { const bf16_t* gp = P + qrow * PW + 1792 + h * 128 + 4 * hh;
#pragma unroll
      for (int et = 0; et < 4; ++et)
#pragma unroll
          for (int g4 = 0; g4 < 4; ++g4) gw[et][g4] = *(const u32x2*)(gp + 32 * et + 8 * g4); }
    f32x16 o[4];
#pragma unroll
    for (int et = 0; et < 4; ++et)
#pragma unroll
        for (int i = 0; i < 16; ++i) o[et][i] = 0.f;
#pragma unroll
    for (int et = 0; et < 4; ++et) { const LAS bf16_t* sp = St + (32 * et + r32) * 72 + 8 * hh;
#pragma unroll
        for (int s = 0; s < 4; ++s) o[et] = MFMA32(*(const LAS bf16x8*)(sp + 16 * s), qf[s], o[et]); }
    { const float xi = ex2((float)(32 * rb + r32 + 1) * lg);
#pragma unroll
      for (int et = 0; et < 4; ++et)
#pragma unroll
          for (int i = 0; i < 16; ++i) o[et][i] *= xi; }
    for (int kt = 0; kt <= rb; ++kt) {
        f32x16 S;
#pragma unroll
        for (int i = 0; i < 16; ++i) S[i] = 0.f;
        const LAS bf16_t* kp = Ks + (32 * kt + r32) * 72 + 8 * hh;
#pragma unroll
        for (int s = 0; s < 4; ++s) S = MFMA32(*(const LAS bf16x8*)(kp + 16 * s), qf[s], S);
#pragma unroll
        for (int i = 0; i < 16; ++i) { const int diff = 32 * (rb - kt) + r32 - crow(i, hh); S[i] = diff >= 0 ? S[i] * ex2((float)diff * lg) : 0.f; }
#pragma unroll
        for (int s = 0; s < 2; ++s) {
            const bf16x8 pf = pack8(S, s);
#pragma unroll
            for (int et = 0; et < 4; ++et) {
                const int er = 32 * et + r32, dd = 16 * kt + 8 * s + 2 * hh;
                o[et] = MFMA32(join8(*(const LAS u32x2*)(Vt + tr_off(er, 68, dd)), *(const LAS u32x2*)(Vt + tr_off(er, 68, dd + 4))), pf, o[et]);
            }
        }
    }
    float sq = 0.f;
#pragma unroll
    for (int et = 0; et < 4; ++et)
#pragma unroll
        for (int i = 0; i < 16; ++i) sq += o[et][i] * o[et][i];
    sq += __shfl_xor(sq, 32);
    const float rs = rsqrtf(sq * (1.f / 128.f) + EPS);
    bf16_t* op = X + qrow * XW + 1536 + h * 128 + 4 * hh;
#pragma unroll
    for (int et = 0; et < 4; ++et)
#pragma unroll
        for (int g4 = 0; g4 < 4; ++g4) { const u32x2 g = gw[et][g4]; u32x2 w;
            w.x = pk2(o[et][4 * g4] * rs * bflo(g.x), o[et][4 * g4 + 1] * rs * bfhi(g.x)); w.y = pk2(o[et][4 * g4 + 2] * rs * bflo(g.y), o[et][4 * g4 + 3] * rs * bfhi(g.y));
            *(u32x2*)(op + 32 * et + 8 * g4) = w; }
    __syncthreads();
}
#define XB_TMO      128
#define XB_XCNT(j)  (256  + 64 * (j))
#define XB_XSUB(j)  (1280 + 64 * (j))
#define XB_XGEN(j)  (2304 + 64 * (j))
#define XB_TOP      3328
#define XB_TOPGEN   3392
#define XCD_BAR_WORDS 3456
#define XB_SPIN_CAP (1u << 18)
__device__ __forceinline__ unsigned xb_ld(unsigned* p)              { return __hip_atomic_load(p, __ATOMIC_RELAXED, __HIP_MEMORY_SCOPE_AGENT); }
__device__ __forceinline__ unsigned xb_add(unsigned* p, unsigned v) { return __hip_atomic_fetch_add(p, v, __ATOMIC_RELAXED, __HIP_MEMORY_SCOPE_AGENT); }
__device__ __forceinline__ unsigned xb_xcc_id() { return (unsigned)__builtin_amdgcn_s_getreg((3 << 11) | 20) & 0xFu; }
#define XB_SPIN(cond, bar) do { unsigned _sp = 0; while (cond) { __builtin_amdgcn_s_sleep(1); \
    if ((++_sp & 255u) == 0u) { if (xb_ld(&(bar)[XB_TMO])) break; if (_sp > XB_SPIN_CAP) { atomicAdd(&(bar)[XB_TMO], 1u); break; } } } } while (0)
struct XcdBarrier { unsigned* bar; unsigned x; volatile LAS unsigned* st; unsigned nexp; };
__device__ __forceinline__ XcdBarrier xcd_barrier_post(unsigned* bar, volatile LAS unsigned* st, unsigned nexp) {
    XcdBarrier b; b.bar = bar; b.x = xb_xcc_id(); b.st = st; b.nexp = nexp;
    if (threadIdx.x == 0) (void)xb_add(&bar[XB_XCNT(b.x)], 1u);
    return b;
}
__device__ __forceinline__ void xcd_barrier_complete(unsigned* bar, unsigned x, unsigned G, unsigned& nloc, unsigned& nx) {
    unsigned sum, cnt, mine, sp = 0u;
    for (;;) {
        sum = 0u; cnt = 0u; mine = 0u;
#pragma unroll
        for (unsigned j = 0; j < 16; ++j) { const unsigned c = xb_ld(&bar[XB_XCNT(j)]); sum += c; cnt += (c > 0u) ? 1u : 0u; mine = (j == x) ? c : mine; }
        if (sum == G) break;
        __builtin_amdgcn_s_sleep(1);
        if ((++sp & 255u) == 0u) { if (xb_ld(&bar[XB_TMO])) break; if (sp > XB_SPIN_CAP) { atomicAdd(&bar[XB_TMO], 1u); break; } }
    }
    nloc = mine > 0u ? mine : 1u; nx = cnt > 0u ? cnt : 1u;
}
__device__ __forceinline__ void xcd_barrier(const XcdBarrier& b) {
    asm volatile("s_waitcnt vmcnt(0)" ::: "memory");
    __syncthreads();
    if (threadIdx.x == 0) {
        unsigned* bar = b.bar;
        __builtin_amdgcn_s_waitcnt(0);
        unsigned nloc = b.st[0], nx = b.st[1];
        if (nloc == 0u) { xcd_barrier_complete(bar, b.x, b.nexp, nloc, nx); b.st[0] = nloc; b.st[1] = nx; }
        const unsigned old = xb_add(&bar[XB_XSUB(b.x)], 1u);
        const unsigned gen = old / nloc;
        if (old + 1u == (gen + 1u) * nloc) {
            __builtin_amdgcn_fence(__ATOMIC_RELEASE, "agent");
            asm volatile("s_waitcnt vmcnt(0)" ::: "memory");
            const unsigned og = xb_add(&bar[XB_TOP], 1u);
            const unsigned tg = og / nx;
            if (og + 1u == (tg + 1u) * nx) xb_add(&bar[XB_TOPGEN], 1u);
            else XB_SPIN(xb_ld(&bar[XB_TOPGEN]) == tg, bar);
            __builtin_amdgcn_fence(__ATOMIC_ACQUIRE, "agent");
            xb_add(&bar[XB_XGEN(b.x)], 1u);
            asm volatile("s_waitcnt vmcnt(0)" ::: "memory");
        } else {
            XB_SPIN(xb_ld(&bar[XB_XGEN(b.x)]) == gen, bar);
            __builtin_amdgcn_fence(__ATOMIC_ACQUIRE, "agent");
            asm volatile("s_waitcnt vmcnt(0)" ::: "memory");
        }
    }
    __syncthreads();
}

constexpr int NPH = 30;
#ifndef PHM
#define PHM 0x1ff
#endif
#ifndef MIX_NAIVE
#define MIX_NAIVE 0
#endif
#ifndef RES_BF16
#define RES_BF16 1
#endif
#ifndef HBD_EXP
#define HBD_EXP 0
#endif
#ifndef B1_PROBE
#define B1_PROBE 0
#endif
#ifndef DBL_BAR
#define DBL_BAR 0
#endif
#ifndef DBLM
#define DBLM 0
#endif
#ifndef MK_NG
#define MK_NG 1
#endif
#ifndef MK_STAGGER
#define MK_STAGGER 1500
#endif
__global__ void __launch_bounds__(512, 2) mk_fwd(Args a) {
    extern __shared__ __attribute__((aligned(16))) unsigned char lds_raw[];
    LAS unsigned char* lds = (LAS unsigned char*)lds_raw;
    const int Gall = gridDim.x, call = blockIdx.x;
    constexpr int NG = MK_NG, MG = M / NG;
    const int grp = (call >> 3) % NG, c = ((call >> 3) / NG) * 8 + (call & 7), G = Gall / NG;
    const int row0 = grp * MG, pm0 = grp * (MG / 256);
    volatile LAS unsigned* MISC = (volatile LAS unsigned*)(lds + MISC_OFF);
    if (threadIdx.x < 32) MISC[threadIdx.x] = 0u;
    __syncthreads();
    unsigned* ctl = (unsigned*)(a.ws + WS_CTL);
    const bool multi = (a.ph_hi - a.ph_lo) > 1;
    XcdBarrier barAll, bar; barAll.bar = ctl + 4096; barAll.x = 0; barAll.st = nullptr; barAll.nexp = 0; bar = barAll;
    if (multi) { barAll = xcd_barrier_post(ctl + 4096, MISC + 8, (unsigned)Gall);
                 bar = (NG == 1) ? barAll : xcd_barrier_post(ctl + 4096 + (1 + grp) * XCD_BAR_WORDS, MISC + 10, (unsigned)G); }

    bf16_t* X = (bf16_t*)(a.ws + WS_X); bf16_t* P = (bf16_t*)(a.ws + WS_P); float* ss = (float*)(a.ws + WS_SS);
#if MIX_NAIVE & 2
    float* kvb = (float*)(a.ws + WS_KV);
#else
    bf16_t* kvb = (bf16_t*)(a.ws + WS_KV);
#endif
    for (int ph = a.ph_lo; ph < a.ph_hi; ++ph) {
        const int kind_ = (ph == 0) ? 0 : (ph == NPH - 1) ? 1 : 2 + (ph - 1) % 7;
        for (int rep_ = 0; rep_ < (((DBLM >> kind_) & 1) ? 2 : 1); ++rep_) {
        if (rep_) __syncthreads();
        int tid = threadIdx.x; asm volatile("" : "+v"(tid));
        if (ph == 0) { if (PHM & 1) phase_prologue(a, lds, Gall, tid); }
        else if (ph == NPH - 1) { if (PHM & 2) final_norm(a.out, ss + (size_t)8 * M * 16, a.norm_final, G, c, row0, MG, tid); }
        else {
            const int l = (ph - 1) / 7, sub = (ph - 1) % 7;
            const char* Wl = (const char*)(a.ws + WS_W + (size_t)l * WL_SIZE);
            if (sub == 0 && (PHM & 4)) {
                pg8::SchedPlain S{(const char*)X, Wl + WL_IN, XW, DM, DM / 64, MG / 256, NIN / 256, G, c, pg8::K_IN, pm0};
                pg8::EpiIn E{P, ss + (size_t)(2 * l) * M * 16};
                pg8::gemm_phase(lds, XW, DM, S, E, tid);
                if (CV_LAZY && CV_SPLIT > 0 && l + 1 < DEPTH) cv_fill(a, lds, l + 1, 0, CV_SPLIT, (MG / 256) * (NIN / 256), G, c, tid);
            } else if (sub == 1 && (PHM & 8)) {
#if MIX_NAIVE & 1
                for (int u = c; u < 256 / NG; u += G) attn_naive(lds, P, X, a.sinks + l * 8, grp * (256 / NG) + u, tid);
#else
                for (int rr_ = 0; rr_ < ((B1_PROBE & 1) ? 2 : 1); ++rr_)
                for (int u = c; u < 256 / NG; u += G) attn_mfma(lds, P, X, a.sinks + l * 8, grp * (256 / NG) + u, tid);
#endif
#if MIX_NAIVE & 2
                for (int u = c; u < 512 / NG; u += G) kv_naive(lds, P, kvb, grp * (512 / NG) + u, tid);
#else
                for (int rr_ = 0; rr_ < ((B1_PROBE & 2) ? 2 : 1); ++rr_)
                for (int u = c; u < 512 / NG; u += G) kv_mfma(lds, P, kvb, grp * (512 / NG) + u, tid);
#endif
                for (int rr_ = 0; rr_ < ((B1_PROBE & 4) ? 2 : 1); ++rr_)
                conv_all(P, a.conv_w + l * 3 * 512, X, G, c, row0, MG, tid);
            } else if (sub == 2 && (PHM & 16)) {
#if MIX_NAIVE & 2
                for (int u = c; u < 512 / NG; u += G) ret_naive(lds, P, kvb, X, grp * (512 / NG) + u, tid);
#else
                for (int u = c; u < 256 / NG; u += G) ret_mfma2(lds, P, kvb, X, grp * (512 / NG) + u, grp * (512 / NG) + (((u + 256 / NG) & ~15) | (15 - (u & 15))), tid);
#endif
            } else if (sub == 3 && (PHM & 32)) {
                pg8::SchedC S{(const char*)X, Wl + WL_C, Wl + WL_B, MG / 256, G, c, pm0};
                pg8::EpiC E{ss + (size_t)(2 * l) * M * 16, a.b_gate + l * 3 * DM, (u32x4*)(a.ws + WS_GS) + (size_t)call * 8192, (u32x4*)(a.ws + WS_MACC) + (size_t)call * 16384, (bf16_t*)(a.ws + WS_MB)};
                pg8::gemm_phase(lds, XW, KC, S, E, tid);
            } else if (sub == 4 && (PHM & 64)) {
                pg8::SchedPlain S{(const char*)(a.ws + WS_MB), Wl + WL_OUT, DM, DM, DM / 64, MG / 256, DM / 256, G, c, pg8::K_RES, pm0};
                pg8::EpiRes E{l == 0 ? a.x : a.out, a.out, X, ss + (size_t)(2 * l + 1) * M * 16, RES_BF16 ? (l == 0 ? 0 : 1) : 2, HBD_EXP ? (bf16_t*)(a.ws + 398 * MiB) : nullptr};
                pg8::gemm_phase(lds, DM, DM, S, E, tid);
            } else if (sub == 5 && (PHM & 128)) {
                const int ldE = HBD_EXP ? DM : XW;
                pg8::SchedPlain S{HBD_EXP ? (const char*)(a.ws + 398 * MiB) : (const char*)X, Wl + WL_GU, ldE, DM, DM / 64, MG / 256, NGU / 256, G, c, pg8::K_GU, pm0};
                pg8::EpiGU E{ss + (size_t)(2 * l + 1) * M * 16, (bf16_t*)(a.ws + WS_FF)};
                pg8::gemm_phase(lds, ldE, DM, S, E, tid);
                if (CV_LAZY && l + 1 < DEPTH) cv_fill(a, lds, l + 1, CV_SPLIT, CV_PER_LAYER, (MG / 256) * (NGU / 256), G, c, tid);
            } else if (sub == 6 && (PHM & 256)) {
                pg8::SchedPlain S{(const char*)(a.ws + WS_FF), Wl + WL_D, DFF, DFF, DFF / 64, MG / 256, DM / 256, G, c, pg8::K_RES, pm0};
                pg8::EpiRes E{a.out, a.out, X, ss + (size_t)(2 * l + 2) * M * 16, RES_BF16 ? (l == DEPTH - 1 ? 3 : 1) : 2, nullptr};
                pg8::gemm_phase(lds, DFF, DFF, S, E, tid);
            }
        }
        }
        if (ph + 1 < a.ph_hi) {
            if (ph == 0) { xcd_barrier(barAll);
                if (NG > 1 && grp > 0) { const unsigned long long t0 = __builtin_amdgcn_s_memrealtime(); while (__builtin_amdgcn_s_memrealtime() - t0 < (unsigned long long)(grp * MK_STAGGER)) __builtin_amdgcn_s_sleep(8); } }
            else xcd_barrier(bar);
#if DBL_BAR
            xcd_barrier(bar);
#endif
        }
    }
}

#ifndef MK_SINGLE
#define MK_SINGLE 0
#endif
extern "C" void kernel_launch(void* const* d_in, const int* in_sizes, int n_in, void* d_out, int out_size, void* d_ws, size_t ws_size, hipStream_t stream) {
    static int grid = 0;
    if (grid == 0) {
        if (n_in != 13 || out_size != M * DM || ws_size < WS_END) { fprintf(stderr, "kernel_launch: unexpected shapes (n_in %d, out %d, ws %zu)\n", n_in, out_size, ws_size); grid = -1; return; }
        int dev = 0, cus = 0, per_cu = 0;
        if (hipGetDevice(&dev) != hipSuccess || hipDeviceGetAttribute(&cus, hipDeviceAttributeMultiprocessorCount, dev) != hipSuccess) { grid = -1; return; }
        if (hipFuncSetAttribute((const void*)mk_fwd, hipFuncAttributeMaxDynamicSharedMemorySize, LDS_BYTES) != hipSuccess) { fprintf(stderr, "kernel_launch: hipFuncSetAttribute failed\n"); grid = -1; return; }
        if (hipOccupancyMaxActiveBlocksPerMultiprocessor(&per_cu, (const void*)mk_fwd, 512, LDS_BYTES) != hipSuccess || per_cu < 1) { fprintf(stderr, "kernel_launch: occupancy query says %d\n", per_cu); per_cu = 1; }
        (void)hipGetLastError();
        grid = cus;
        if (grid > 256) grid = 256;
    }
    if (grid < 0) return;
    (void)hipMemsetAsync((char*)d_ws + WS_CTL, 0, CTL_ZERO_BYTES, stream);
    Args a{};
    a.x = (const float*)d_in[0]; a.norm_mix = (const float*)d_in[1]; a.w_in = (const float*)d_in[2]; a.sinks = (const float*)d_in[3]; a.conv_w = (const float*)d_in[4];
    a.w_branch = (const float*)d_in[5]; a.b_gate = (const float*)d_in[6]; a.w_out = (const float*)d_in[7]; a.norm_ffn = (const float*)d_in[8];
    a.w_g = (const float*)d_in[9]; a.w_u = (const float*)d_in[10]; a.w_d = (const float*)d_in[11]; a.norm_final = (const float*)d_in[12];
    a.out = (float*)d_out; a.ws = (unsigned char*)d_ws;
#if MK_SINGLE
    a.ph_lo = 0; a.ph_hi = NPH;
    hipLaunchKernelGGL(mk_fwd, dim3(grid), dim3(512), LDS_BYTES, stream, a);
#else
    for (int ph = 0; ph < NPH; ++ph) { a.ph_lo = ph; a.ph_hi = ph + 1; hipLaunchKernelGGL(mk_fwd, dim3(grid), dim3(512), LDS_BYTES, stream, a); }
#endif
}
```
